# Optimizing an MI355X kernel written in HIP

```python
import math
import jax
import jax.numpy as jnp
from jax import lax
import numpy as np

D_MODEL = 1024
BATCH = 8
SEQ = 8192
DEPTH = 1
DEC_BATCH = 2
DEC_SEQ = 8192
PAST_LEN = 128

A_HEADS = 8
A_HEAD_DIM = 64
A_WIDTH = A_HEADS * A_HEAD_DIM
DECAY_RANK = 64
ICLR_RANK = 64
A_COLS = 4 * A_WIDTH + 2 * DECAY_RANK + 2 * ICLR_RANK
GN_EPS = 64e-5

B_GROUPS = ((128, 1), (512, 4), (2048, 16))
N_GROUPS = len(B_GROUPS)
B_HEADS_PER_GROUP = 4
B_HEAD_DIM = 128
B_HEADS = N_GROUPS * B_HEADS_PER_GROUP
B_QKV = B_HEADS * B_HEAD_DIM
B_WIDTH = B_HEADS_PER_GROUP * B_HEAD_DIM
B_COLS = 3 * B_QKV + B_WIDTH
Q_BLOCK = 128

N_BUCKETS = 32
MAX_EXACT = 8
MAX_DISTANCE = 1024

IN_COLS = A_COLS + B_COLS + 2 * D_MODEL
RMS_EPS = 1e-6
NEG = -1e30

kernel_name = 'hybrid_rwkv7_dilated_encoder'


def _rmsnorm(z):
    z = z.astype(jnp.float32)
    return z * lax.rsqrt(jnp.mean(z * z, axis=-1, keepdims=True) + RMS_EPS)


def _rwkv7_step(S, inp):
    r, w, k, v, a, b = inp
    Sa = jnp.einsum('dbhvk,dbhk->dbhv', S, a)
    S = S * w[..., None, :] + Sa[..., :, None] * b[..., None, :] + v[..., :, None] * k[..., None, :]
    return S, jnp.einsum('dbhvk,dbhk->dbhv', S, r)


def rwkv7_bidirectional(pa, mu, w0, w2, a0, a2, k_k, k_a, r_k, lnx_w, lnx_b):
    Bn, T, _ = pa.shape
    pa = pa.astype(jnp.float32)
    prev = jnp.pad(pa, ((0, 0), (1, 0), (0, 0)))[:, :-1]
    nxt = jnp.pad(pa, ((0, 0), (0, 1), (0, 0)))[:, 1:]
    pa = pa + mu[0] * (prev - pa) + mu[1] * (nxt - pa)
    r, k, v, g, wlo, alo = jnp.split(
        pa, [A_WIDTH, 2 * A_WIDTH, 3 * A_WIDTH, 4 * A_WIDTH, 4 * A_WIDTH + 2 * DECAY_RANK], axis=-1)
    wlo = wlo.reshape(Bn, T, 2, DECAY_RANK)
    alo = alo.reshape(Bn, T, 2, ICLR_RANK)
    wlog = -jax.nn.softplus(-(w0 + jnp.einsum('btdr,drc->btdc', jnp.tanh(wlo), w2))) - 0.5
    decay = jnp.exp(-jnp.exp(wlog))
    a = jax.nn.sigmoid(a0 + jnp.einsum('btdr,drc->btdc', alo, a2))
    kk = (k * k_k).reshape(Bn, T, A_HEADS, A_HEAD_DIM)
    kk = kk / jnp.maximum(jnp.sqrt(jnp.sum(kk * kk, axis=-1, keepdims=True)), 1e-12)
    kk = kk.reshape(Bn, T, A_WIDTH)
    k_dir = k[:, :, None] * (1.0 + (a - 1.0) * k_a)
    b_dir = kk[:, :, None] * a

    def both(z):
        return jnp.broadcast_to(z[:, :, None], (Bn, T, 2, A_WIDTH))

    def time_major(z):
        z = jnp.stack([z[:, :, 0], z[:, ::-1, 1]], axis=0)
        return z.reshape(2, Bn, T, A_HEADS, A_HEAD_DIM).transpose(2, 0, 1, 3, 4)

    xs = (time_major(both(r)), time_major(decay), time_major(k_dir),
          time_major(both(v)), time_major(both(-kk)), time_major(b_dir))
    S0 = jnp.zeros((2, Bn, A_HEADS, A_HEAD_DIM, A_HEAD_DIM), jnp.float32)
    _, y = lax.scan(_rwkv7_step, S0, xs)
    y = (y[:, 0] + y[::-1, 1]).transpose(1, 0, 2, 3)
    mean = jnp.mean(y, axis=-1, keepdims=True)
    var = jnp.mean(jnp.square(y - mean), axis=-1, keepdims=True)
    yn = ((y - mean) * lax.rsqrt(var + GN_EPS)).reshape(Bn, T, A_WIDTH) * lnx_w + lnx_b
    bonus = jnp.sum((r[:, :, None] * k_dir * r_k.reshape(A_WIDTH)).reshape(Bn, T, 2, A_HEADS, A_HEAD_DIM),
                    axis=(2, 4))[..., None] * v.reshape(Bn, T, A_HEADS, A_HEAD_DIM)
    return (yn + bonus.reshape(Bn, T, A_WIDTH)) * jax.nn.silu(g)


def t5_bucket(rel):
    half_b = N_BUCKETS // 2
    ret = jnp.where(rel > 0, half_b, 0)
    n = jnp.abs(rel)
    large = MAX_EXACT + (jnp.log(jnp.maximum(n, 1).astype(jnp.float32) / MAX_EXACT)
                         / math.log(MAX_DISTANCE / MAX_EXACT) * (half_b - MAX_EXACT)).astype(jnp.int32)
    large = jnp.minimum(large, half_b - 1)
    return ret + jnp.where(n < MAX_EXACT, n, large)


def band_bias(table, dil, half):
    i = jnp.arange(Q_BLOCK)[:, None]
    j = jnp.arange(2 * Q_BLOCK)[None, :]
    rel = j - half - i
    b = table[t5_bucket(rel * dil)].astype(jnp.float32)
    b = jnp.where((jnp.abs(rel) <= half)[..., None], b, NEG)
    return b.transpose(2, 0, 1)


def by_residue(z, dil):
    Bn, T, H, E = z.shape
    return z.reshape(Bn, T // dil, dil, H, E).transpose(0, 2, 3, 1, 4).reshape(Bn * dil, H, T // dil, E)


def from_residue(z, Bn, dil):
    N, H, L, E = z.shape
    return z.reshape(Bn, dil, H, L, E).transpose(0, 3, 1, 2, 4).reshape(Bn, L * dil, H, E)


def banded_attention(q, k, v, bias, half):
    N, H, L, E = q.shape
    nb = -(-L // Q_BLOCK)
    Lp = nb * Q_BLOCK
    qb = jnp.pad(q, ((0, 0), (0, 0), (0, Lp - L), (0, 0))).reshape(N, H, nb, Q_BLOCK, E)

    def windows(z):
        zp = jnp.pad(z, ((0, 0), (0, 0), (half, Lp - L + Q_BLOCK - half), (0, 0)))
        zp = zp.reshape(N, H, nb + 1, Q_BLOCK, E)
        return jnp.concatenate([zp[:, :, :-1], zp[:, :, 1:]], axis=3)

    kw, vw = windows(k), windows(v)
    pos = jnp.arange(nb)[:, None] * Q_BLOCK + jnp.arange(2 * Q_BLOCK)[None, :] - half
    valid = (pos >= 0) & (pos < L)
    s = jnp.einsum('nhbqe,nhbke->nhbqk', qb, kw) * (B_HEAD_DIM ** -0.5) + bias[:, None]
    s = jnp.where(valid[:, None, :], s, NEG)
    m = jnp.max(s, axis=-1, keepdims=True)
    p = jnp.exp(s - m)
    den = jnp.sum(p, axis=-1, keepdims=True)
    o = jnp.einsum('nhbqk,nhbke->nhbqe', p, vw) / den
    lse = (m + jnp.log(den))[..., 0]
    return o.reshape(N, H, Lp, E)[:, :, :L], lse.reshape(N, H, Lp)[:, :, :L]


def dilated_attention(pb, q_gain, k_gain, rel_bias):
    Bn, T, _ = pb.shape
    q, k, v, g = jnp.split(pb, [B_QKV, 2 * B_QKV, 3 * B_QKV], axis=-1)
    shp = (Bn, T, N_GROUPS, B_HEADS_PER_GROUP, B_HEAD_DIM)
    q = _rmsnorm(q.reshape(shp)) * q_gain
    k = _rmsnorm(k.reshape(shp)) * k_gain
    v = v.reshape(shp).astype(jnp.float32)
    outs, lses = [], []
    for gi, (window, dil) in enumerate(B_GROUPS):
        half = window // (2 * dil)
        bias = band_bias(rel_bias[:, gi * B_HEADS_PER_GROUP:(gi + 1) * B_HEADS_PER_GROUP], dil, half)
        o, lse = banded_attention(by_residue(q[:, :, gi], dil), by_residue(k[:, :, gi], dil),
                                  by_residue(v[:, :, gi], dil), bias, half)
        outs.append(from_residue(o, Bn, dil))
        lses.append(from_residue(lse[..., None], Bn, dil)[..., 0])
    alpha = jax.nn.softmax(jnp.stack(lses, axis=2), axis=2)
    o = jnp.einsum('btgh,btghe->bthe', alpha, jnp.stack(outs, axis=2))
    return o.reshape(Bn, T, B_WIDTH) * jax.nn.silu(g.astype(jnp.float32))


def encoder_layer(x, c, rel_bias, norm_w, w_ada, b_ada, w_in, shift_mu, w0, w2, a0, a2,
                  k_k, k_a, r_k, lnx_w, lnx_b, q_gain, k_gain, w_out_a, w_out_b, w_out):
    mod = jax.nn.silu(c.astype(jnp.float32)) @ w_ada + b_ada
    shift, scale, gate = jnp.split(mod, 3, axis=-1)
    h = _rmsnorm(x) * norm_w * (1.0 + scale[:, None]) + shift[:, None]
    p = h @ w_in
    pa, pb, pg = jnp.split(p, [A_COLS, A_COLS + B_COLS], axis=-1)
    ya = rwkv7_bidirectional(pa, shift_mu, w0, w2, a0, a2, k_k, k_a, r_k, lnx_w, lnx_b)
    yb = dilated_attention(pb, q_gain, k_gain, rel_bias)
    gates = jax.nn.sigmoid(pg.astype(jnp.float32))
    merged = gates[..., :D_MODEL] * (ya @ w_out_a) + gates[..., D_MODEL:] * (yb @ w_out_b)
    return (x + gate[:, None] * (merged @ w_out)).astype(x.dtype)


def setup_inputs(seed: int = 0) -> dict:
    key = jax.random.key(seed)
    ks = jax.random.split(key, 24)
    f32 = jnp.float32

    def nrm(k, shape, s):
        return s * jax.random.normal(k, shape, f32)

    L = DEPTH
    return {
        'x_prompt': nrm(ks[0], (BATCH, SEQ, D_MODEL), 1.0),
        'x_sample': nrm(ks[1], (DEC_BATCH, DEC_SEQ, D_MODEL), 1.0),
        'c_prompt': nrm(ks[2], (BATCH, D_MODEL), 1.0),
        'c_sample': nrm(ks[3], (DEC_BATCH, D_MODEL), 1.0),
        'rel_bias': nrm(ks[4], (N_BUCKETS, B_HEADS), 0.5),
        'norm_w': 1.0 + nrm(ks[5], (L, D_MODEL), 0.02),
        'w_ada': nrm(ks[6], (L, D_MODEL, 3 * D_MODEL), D_MODEL ** -0.5),
        'b_ada': nrm(ks[7], (L, 3 * D_MODEL), 0.02),
        'w_in': nrm(ks[8], (L, D_MODEL, IN_COLS), D_MODEL ** -0.5),
        'shift_mu': jax.random.uniform(ks[9], (L, 2, A_COLS), f32, 0.0, 0.5),
        'w0': jax.random.uniform(ks[10], (L, 2, A_WIDTH), f32, -6.0, 1.0),
        'w2': nrm(ks[11], (L, 2, DECAY_RANK, A_WIDTH), 0.1 * DECAY_RANK ** -0.5),
        'a0': nrm(ks[12], (L, 2, A_WIDTH), 0.5),
        'a2': nrm(ks[13], (L, 2, ICLR_RANK, A_WIDTH), 0.5 * ICLR_RANK ** -0.5),
        'k_k': 0.85 + nrm(ks[14], (L, A_WIDTH), 0.05),
        'k_a': 1.0 + nrm(ks[15], (L, A_WIDTH), 0.05),
        'r_k': nrm(ks[16], (L, A_HEADS, A_HEAD_DIM), 0.1),
        'lnx_w': 1.0 + nrm(ks[17], (L, A_WIDTH), 0.02),
        'lnx_b': nrm(ks[18], (L, A_WIDTH), 0.02),
        'q_gain': 1.0 + nrm(ks[19], (L, B_HEAD_DIM), 0.02),
        'k_gain': 1.0 + nrm(ks[20], (L, B_HEAD_DIM), 0.02),
        'w_out_a': nrm(ks[21], (L, A_WIDTH, D_MODEL), A_WIDTH ** -0.5),
        'w_out_b': nrm(ks[22], (L, B_WIDTH, D_MODEL), B_WIDTH ** -0.5),
        'w_out': nrm(ks[23], (L, D_MODEL, D_MODEL), D_MODEL ** -0.5),
    }


def reference(x_prompt, x_sample, c_prompt, c_sample, rel_bias, norm_w, w_ada, b_ada, w_in,
              shift_mu, w0, w2, a0, a2, k_k, k_a, r_k, lnx_w, lnx_b, q_gain, k_gain,
              w_out_a, w_out_b, w_out):
    def trunk(x, c):
        for l in range(DEPTH):
            x = encoder_layer(x, c, rel_bias, norm_w[l], w_ada[l], b_ada[l], w_in[l], shift_mu[l],
                              w0[l], w2[l], a0[l], a2[l], k_k[l], k_a[l], r_k[l], lnx_w[l], lnx_b[l],
                              q_gain[l], k_gain[l], w_out_a[l], w_out_b[l], w_out[l])
        return x

    y_prompt = trunk(x_prompt, c_prompt)
    y_sample = trunk(x_sample, c_sample)
    return (y_prompt, y_sample)
```

```cpp
#include <hip/hip_runtime.h>
#include <cstdio>
#include <cstdint>
namespace pg8 {
#define PG8_LAS __attribute__((address_space(3)))
typedef unsigned short bf16_t;
typedef short bf16x8 __attribute__((ext_vector_type(8)));
typedef float f32x4 __attribute__((ext_vector_type(4)));
typedef unsigned u32x4 __attribute__((ext_vector_type(4)));
constexpr int BM = 256, BK = 64, HALF = 128, HTB = HALF * BK * 2  , STAGE_BYTES = 8 * HTB, NXCD = 8, WGM = 8;

__host__ __device__ __forceinline__ int lds_byte(int r, int c) { const int st = (r >> 4) * 2 + (c >> 5), rr = r & 15, cc = c & 31, ob = rr * 64 + cc * 2; return st * 1024 + (ob ^ (((ob >> 9) & 1) << 5)); }
__host__ __device__ __forceinline__ void stage_rc(int b, int& R, int& C) { const int st = b / 1024, sb = b % 1024, swz = sb ^ (((sb >> 9) & 1) << 5); R = (st >> 1) * 16 + swz / 64; C = (st & 1) * 32 + (swz % 64) / 2; }
__host__ __device__ __forceinline__ int perm32(int rho) { const int n = rho >> 4, i = rho & 15; return 8 * (i >> 2) + 4 * n + (i & 3); }

struct Unit { int pm, pn, sel; };
struct Gemm { const bf16_t* A0; const bf16_t* B0; const bf16_t* A1; const bf16_t* B1; int lda; int K; };

struct Order {
    int nM, nN, nwg, G, c, CH;
    __host__ __device__ void init(int M, int N, int G_, int c_, int CH_) { nM = M / BM; nN = N / BM; nwg = nM * nN; G = G_; c = c_; CH = CH_; }
    __host__ __device__ bool next(int i, Unit& u) const {
        const int ti = (CH == 2) ? (i >> 1) : i; u.sel = (CH == 2) ? (i & 1) : 0;
        const long L = (long)ti * G + c; if (L >= nwg) return false;
        int wgid = (int)L; { const int q = nwg / NXCD, r = nwg % NXCD, xcd = wgid % NXCD, off = wgid / NXCD; wgid = (xcd < r ? xcd * (q + 1) : r * (q + 1) + (xcd - r) * q) + off; }
        const int nig = WGM * nN, gid = wgid / nig, fm = gid * WGM, gsz = (nM - fm) < WGM ? (nM - fm) : WGM;
        u.pm = fm + ((wgid % nig) % gsz); u.pn = (wgid % nig) / gsz; return true;
    }
};
__device__ __forceinline__ unsigned cvt_pk_bf16(float lo, float hi) { unsigned r; asm volatile("v_cvt_pk_bf16_f32 %0, %1, %2" : "=v"(r) : "v"(lo), "v"(hi)); return r; }
template <class Epi, class Sched, bool ALIGN_EPI = false, bool SP2 = false>
__device__ __forceinline__ void gemm_phase(PG8_LAS unsigned char* lds, const Gemm g, const Sched& S, const Epi& E) {
    const int tid = threadIdx.x, wid = __builtin_amdgcn_readfirstlane(tid >> 6), lane = tid & 63, wr = wid >> 2, wc = wid & 3, fr = lane & 15, fq = lane >> 4;
    const int K = g.K, nt = K / BK;
    unsigned voffA[2], voffB[2];
#pragma unroll
    for (int i = 0; i < 2; ++i) { int R, C; stage_rc(tid * 16 + i * 8192, R, C); const int Rb = Epi::PERM ? ((R & ~31) + perm32(R & 31)) : R;
        voffA[i] = (unsigned)(R * g.lda + C) * 2u; voffB[i] = (unsigned)(Rb * K + C) * 2u; }
    const size_t kstep = (size_t)(BK * 2);
    const size_t hstepA = (size_t)HALF * g.lda * 2, hstepB = (size_t)HALF * K * 2;
    const size_t tstepA = 2 * hstepA, tstepB = 2 * hstepB;
    const unsigned ldsw = (unsigned)wid * 1024u;
    const int aoff = lds_byte(wr * 64 + fr, fq * 8), boff = lds_byte(wc * 32 + fr, fq * 8);
#define PG8_SA(b, h) (((b) * 2 + (h)) * HTB)
#define PG8_SB(b, h) ((4 + (b) * 2 + (h)) * HTB)
#define PG8_STAGE(bufoff, gbase, voff) do { _Pragma("unroll") for (int _i = 0; _i < 2; ++_i) \
        __builtin_amdgcn_global_load_lds((const unsigned*)((const char*)(gbase) + (voff)[_i]), (PG8_LAS unsigned*)(lds + (bufoff) + ldsw + _i * 8192), 16, 0, 0); } while (0)
#define PG8_LDA(dst, b, h) do { _Pragma("unroll") for (int m = 0; m < 4; ++m) _Pragma("unroll") for (int k = 0; k < 2; ++k) dst[m][k] = *(const PG8_LAS bf16x8*)(lds + PG8_SA(b, h) + aoff + m * 2048 + k * 1024); } while (0)
#define PG8_LDB(dst, b, h) do { _Pragma("unroll") for (int n = 0; n < 2; ++n) _Pragma("unroll") for (int k = 0; k < 2; ++k) dst[n][k] = *(const PG8_LAS bf16x8*)(lds + PG8_SB(b, h) + boff + n * 2048 + k * 1024); } while (0)
#define PG8_MMA(ai, bj, At, Bt) do { __builtin_amdgcn_s_setprio(1); _Pragma("unroll") for (int m = 0; m < 4; ++m) _Pragma("unroll") for (int n = 0; n < 2; ++n) _Pragma("unroll") for (int k = 0; k < 2; ++k) \
        acc[ai][bj][m][n] = __builtin_amdgcn_mfma_f32_16x16x32_bf16(Bt[n][k], At[m][k], acc[ai][bj][m][n], 0, 0, 0); __builtin_amdgcn_s_setprio(0); } while (0)
#define PG8_APTR(u) ((const char*)((u).sel ? g.A1 : g.A0) + (size_t)(u).pm * tstepA)
#define PG8_BPTR(u) ((const char*)((u).sel ? g.B1 : g.B0) + (size_t)(u).pn * tstepB)
#define PG8_WAIT_V(n) asm volatile("s_waitcnt vmcnt(" #n ")" ::: "memory")
#define PG8_WAIT_L(n) asm volatile("s_waitcnt lgkmcnt(" #n ")" ::: "memory")
#define PG8_BAR __builtin_amdgcn_s_barrier()
#define PG8_SCHED __builtin_amdgcn_sched_barrier(0)
    Unit cur, nxt; int ui = 0;
    if (!S.next(0, cur)) return;
    f32x4 acc[2][2][4][2];
#pragma unroll
    for (int a = 0; a < 2; ++a)
#pragma unroll
        for (int b = 0; b < 2; ++b)
#pragma unroll
            for (int m = 0; m < 4; ++m)
#pragma unroll
                for (int n = 0; n < 2; ++n) acc[a][b][m][n] = (f32x4){0.f, 0.f, 0.f, 0.f};
    bf16x8 At[4][2], B0[2][2], B1[2][2];
    const char* cA = PG8_APTR(cur); const char* cB = PG8_BPTR(cur);
    if constexpr (SP2) {
        PG8_STAGE(PG8_SB(0, 0), cB, voffB); PG8_STAGE(PG8_SB(0, 1), cB + hstepB, voffB); PG8_STAGE(PG8_SA(0, 0), cA, voffA); PG8_STAGE(PG8_SA(0, 1), cA + hstepA, voffA);
        if (wr == 1) PG8_BAR;
        PG8_WAIT_V(2); PG8_BAR;
        PG8_STAGE(PG8_SB(1, 0), cB + kstep, voffB); PG8_STAGE(PG8_SA(1, 0), cA + kstep, voffA); PG8_STAGE(PG8_SB(1, 1), cB + hstepB + kstep, voffB);
        PG8_WAIT_V(6); PG8_BAR;
    } else {
        PG8_STAGE(PG8_SB(0, 0), cB, voffB); PG8_STAGE(PG8_SA(0, 0), cA, voffA); PG8_STAGE(PG8_SB(0, 1), cB + hstepB, voffB); PG8_STAGE(PG8_SA(0, 1), cA + hstepA, voffA);
        if (wr == 1) PG8_BAR;
        PG8_WAIT_V(4); PG8_BAR;
        PG8_STAGE(PG8_SB(1, 0), cB + kstep, voffB); PG8_STAGE(PG8_SA(1, 0), cA + kstep, voffA); PG8_STAGE(PG8_SB(1, 1), cB + hstepB + kstep, voffB);
        PG8_WAIT_V(6); PG8_BAR;
    }
    for (;;) {
        const bool has_next = S.next(ui + 1, nxt);
        const char* nA = has_next ? PG8_APTR(nxt) : cA; const char* nB = has_next ? PG8_BPTR(nxt) : cB;
        for (int t = 0; t < nt; t += 2) {
            const bool last = (t == nt - 2);
            const char* a1 = cA + (size_t)(t + 1) * kstep;
            const char* a2 = last ? nA : cA + (size_t)(t + 2) * kstep; const char* b2 = last ? nB : cB + (size_t)(t + 2) * kstep;
            const char* a3 = a2 + kstep; const char* b3 = b2 + kstep;
            if constexpr (SP2) {
            PG8_LDB(B0, 0, 0); PG8_LDB(B1, 0, 1); PG8_SCHED; PG8_LDA(At, 0, 0); PG8_STAGE(PG8_SA(1, 1), a1 + hstepA, voffA);
            PG8_WAIT_V(8); PG8_WAIT_L(0); PG8_BAR; PG8_MMA(0, 0, At, B0); PG8_MMA(0, 1, At, B1); PG8_BAR; PG8_SCHED;
            PG8_LDA(At, 0, 1); PG8_STAGE(PG8_SB(0, 0), b2, voffB); PG8_STAGE(PG8_SB(0, 1), b2 + hstepB, voffB); PG8_STAGE(PG8_SA(0, 0), a2, voffA);
            PG8_WAIT_V(8); PG8_WAIT_L(0); PG8_BAR; PG8_MMA(1, 0, At, B0); PG8_MMA(1, 1, At, B1); PG8_BAR; PG8_SCHED;
            PG8_LDB(B0, 1, 0); PG8_LDB(B1, 1, 1); PG8_SCHED; PG8_LDA(At, 1, 0); PG8_STAGE(PG8_SA(0, 1), a2 + hstepA, voffA);
            PG8_WAIT_V(8); PG8_WAIT_L(0); PG8_BAR; PG8_MMA(0, 0, At, B0); PG8_MMA(0, 1, At, B1); PG8_BAR; PG8_SCHED;
            PG8_LDA(At, 1, 1); PG8_STAGE(PG8_SB(1, 0), b3, voffB); PG8_STAGE(PG8_SB(1, 1), b3 + hstepB, voffB); PG8_STAGE(PG8_SA(1, 0), a3, voffA);
            PG8_WAIT_V(8); PG8_WAIT_L(0); PG8_BAR; PG8_MMA(1, 0, At, B0); PG8_MMA(1, 1, At, B1); PG8_BAR; PG8_SCHED;
            } else {
            PG8_LDB(B0, 0, 0); PG8_SCHED; PG8_LDA(At, 0, 0); PG8_STAGE(PG8_SA(1, 1), a1 + hstepA, voffA);
            PG8_WAIT_L(8); PG8_BAR; PG8_WAIT_L(0); PG8_MMA(0, 0, At, B0); PG8_BAR; PG8_SCHED;
            PG8_LDB(B1, 0, 1); PG8_STAGE(PG8_SB(0, 0), b2, voffB);
            PG8_BAR; PG8_WAIT_L(0); PG8_MMA(0, 1, At, B1); PG8_BAR;
            PG8_LDA(At, 0, 1); PG8_STAGE(PG8_SA(0, 0), a2, voffA);
            PG8_BAR; PG8_WAIT_L(0); PG8_MMA(1, 0, At, B0); PG8_BAR; PG8_SCHED;
            PG8_STAGE(PG8_SB(0, 1), b2 + hstepB, voffB);
            PG8_WAIT_V(6); PG8_BAR; PG8_MMA(1, 1, At, B1); PG8_BAR;
            PG8_LDB(B0, 1, 0); PG8_SCHED; PG8_LDA(At, 1, 0); PG8_STAGE(PG8_SA(0, 1), a2 + hstepA, voffA);
            PG8_WAIT_L(8); PG8_BAR; PG8_WAIT_L(0); PG8_MMA(0, 0, At, B0); PG8_BAR; PG8_SCHED;
            PG8_LDB(B1, 1, 1); PG8_STAGE(PG8_SB(1, 0), b3, voffB);
            PG8_BAR; PG8_WAIT_L(0); PG8_MMA(0, 1, At, B1); PG8_BAR;
            PG8_LDA(At, 1, 1); PG8_STAGE(PG8_SA(1, 0), a3, voffA);
            PG8_BAR; PG8_WAIT_L(0); PG8_MMA(1, 0, At, B0); PG8_BAR; PG8_SCHED;
            PG8_STAGE(PG8_SB(1, 1), b3 + hstepB, voffB);
            PG8_WAIT_V(6); PG8_BAR; PG8_MMA(1, 1, At, B1); PG8_BAR;
            }
        }
        if constexpr (ALIGN_EPI) { if (wr == 0) PG8_BAR; }
        const bool keep = E(acc, cur, wr, wc, fr, fq);
        if (!has_next) break;
        if (!keep) {
#pragma unroll
        for (int a = 0; a < 2; ++a)
#pragma unroll
            for (int b = 0; b < 2; ++b)
#pragma unroll
                for (int m = 0; m < 4; ++m)
#pragma unroll
                    for (int n = 0; n < 2; ++n) acc[a][b][m][n] = (f32x4){0.f, 0.f, 0.f, 0.f};
        }
        cur = nxt; cA = nA; cB = nB; ++ui;
        if constexpr (ALIGN_EPI) { if (wr == 1) PG8_BAR; }
    }
    PG8_WAIT_V(0);
    if constexpr (!ALIGN_EPI) { if (wr == 0) PG8_BAR; }
    PG8_BAR;
#undef PG8_SA
#undef PG8_SB
#undef PG8_STAGE
#undef PG8_LDA
#undef PG8_LDB
#undef PG8_MMA
#undef PG8_APTR
#undef PG8_BPTR
#undef PG8_WAIT_V
#undef PG8_WAIT_L
#undef PG8_BAR
#undef PG8_SCHED
}
}

constexpr int NWAVES = 8;
constexpr int T = 8192, D = 1024, NBP = 8, NBS = 2, NB = NBP + NBS, M = NB * T;
constexpr int A_HEADS = 8, A_HD = 64, A_W = 512, RANK = 64;
constexpr int A_COLS = 2304, B_COLS = 5120, G_COLS = 2048, IN_COLS = 9472, AG_COLS = A_COLS + G_COLS;
constexpr int B_QKV = 1536, B_W = 512, B_HD = 128;
constexpr float RMS_EPS = 1e-6f, GN_EPS = 64e-5f;
constexpr size_t MiB = 1u << 20;
constexpr size_t WS_CTL = 0, CTL_ZERO_BYTES = 65536;
constexpr size_t WS_MOD = 1 * MiB;
constexpr size_t WS_BTAB = 1 * MiB + 128 * 1024;
constexpr size_t WS_WB = 2 * MiB;
constexpr size_t WS_WAG = 12 * MiB;
constexpr size_t WS_WOA = 21 * MiB, WS_WOB = 22 * MiB, WS_WO = 23 * MiB;
constexpr size_t WS_BON = 26 * MiB;
constexpr size_t WS_R = 32 * MiB;
constexpr size_t WS_PA = WS_R, WS_PG = WS_R + 360 * MiB;
constexpr size_t WS_Y = 832 * MiB;
constexpr size_t WS_END = 992 * MiB;
constexpr int CW_BAR = 4096;
constexpr int OS_H = 0, OS_YA = 2048, OS_YB = 3072, OROW = 4096;
constexpr int RING_OFF = 0, RING_BYTES = 131072;
constexpr int LDSCTL_OFF = RING_BYTES, MISC_OFF = LDSCTL_OFF + 320;
constexpr int LDS_BYTES = 147456;

#define GAS __attribute__((address_space(1)))
#define LAS __attribute__((address_space(3)))
typedef unsigned short bf16;
typedef unsigned v4u __attribute__((ext_vector_type(4)));
typedef unsigned v2u __attribute__((ext_vector_type(2)));
typedef float f32x4 __attribute__((ext_vector_type(4)));
typedef short bf16x8 __attribute__((ext_vector_type(8)));
typedef GAS unsigned gu32;
#define RLX_AGENT __ATOMIC_RELAXED, __HIP_MEMORY_SCOPE_AGENT
#define LDS_WAIT() asm volatile("s_waitcnt lgkmcnt(0)" ::: "memory")
#define VM_WAIT() asm volatile("s_waitcnt vmcnt(0)" ::: "memory")
__device__ __forceinline__ unsigned f2bf(float f) { unsigned u = __builtin_bit_cast(unsigned, f); return (u + 0x7fffu + ((u >> 16) & 1u)) >> 16; }
__device__ __forceinline__ unsigned pk2(float lo, float hi) { return f2bf(lo) | (f2bf(hi) << 16); }
__device__ __forceinline__ float bf2f(unsigned short h) { return __builtin_bit_cast(float, (unsigned)h << 16); }
__device__ __forceinline__ float bflo(unsigned w) { return __builtin_bit_cast(float, w << 16); }
__device__ __forceinline__ float bfhi(unsigned w) { return __builtin_bit_cast(float, w & 0xffff0000u); }
__device__ __forceinline__ float sigmoidf_(float v) { return __builtin_amdgcn_rcpf(1.f + __expf(-v)); }
__device__ __forceinline__ float siluf_(float v) { return v * sigmoidf_(v); }
__device__ __forceinline__ float wave_sum(float v) {
#pragma unroll
    for (int o = 1; o < 64; o <<= 1) v += __shfl_xor(v, o);
    return v;
}
__device__ __forceinline__ float wave_max(float v) {
#pragma unroll
    for (int o = 1; o < 64; o <<= 1) v = fmaxf(v, __shfl_xor(v, o));
    return v;
}

#define XB_TMO      128
#define XB_XCNT(j)  (256  + 64 * (j))
#define XB_XSUB(j)  (1280 + 64 * (j))
#define XB_XGEN(j)  (2304 + 64 * (j))
#define XB_TOP      3328
#define XB_TOPGEN   3392
#define XCD_BAR_WORDS 3456
#define XB_SPIN_CAP (1u << 22)
__device__ __forceinline__ unsigned xb_ld(unsigned* p)              { return __hip_atomic_load(p, __ATOMIC_RELAXED, __HIP_MEMORY_SCOPE_AGENT); }
__device__ __forceinline__ unsigned xb_add(unsigned* p, unsigned v) { return __hip_atomic_fetch_add(p, v, __ATOMIC_RELAXED, __HIP_MEMORY_SCOPE_AGENT); }
__device__ __forceinline__ unsigned xb_xcc_id() { return (unsigned)__builtin_amdgcn_s_getreg((3 << 11) | 20) & 0xFu; }
#define XB_SPIN(cond, bar) do { unsigned _sp = 0; while (cond) { __builtin_amdgcn_s_sleep(1); \
    if ((++_sp & 255u) == 0u) { if (xb_ld(&(bar)[XB_TMO])) break; if (_sp > XB_SPIN_CAP) { atomicAdd(&(bar)[XB_TMO], 1u); break; } } } } while (0)
struct XcdBarrier { unsigned* bar; unsigned x; volatile LAS unsigned* st; };
__device__ __forceinline__ XcdBarrier xcd_barrier_post(unsigned* bar, volatile LAS unsigned* st) {
    XcdBarrier b; b.bar = bar; b.x = xb_xcc_id(); b.st = st;
    if (threadIdx.x == 0) (void)xb_add(&bar[XB_XCNT(b.x)], 1u);
    return b;
}
__device__ __forceinline__ void xcd_barrier_complete(unsigned* bar, unsigned x, unsigned& nloc, unsigned& nx) {
    const unsigned G = gridDim.x * gridDim.y * gridDim.z;
    unsigned sum, cnt, mine, sp = 0u;
    for (;;) {
        sum = 0u; cnt = 0u; mine = 0u;
#pragma unroll
        for (unsigned j = 0; j < 16; ++j) { const unsigned c = xb_ld(&bar[XB_XCNT(j)]); sum += c; cnt += (c > 0u) ? 1u : 0u; mine = (j == x) ? c : mine; }
        if (sum == G) break;
        __builtin_amdgcn_s_sleep(1);
        if ((++sp & 255u) == 0u) { if (xb_ld(&bar[XB_TMO])) break; if (sp > XB_SPIN_CAP) { atomicAdd(&bar[XB_TMO], 1u); break; } }
    }
    nloc = mine > 0u ? mine : 1u; nx = cnt > 0u ? cnt : 1u;
}
__device__ __forceinline__ void xcd_barrier(const XcdBarrier& b) {
    asm volatile("s_waitcnt vmcnt(0)" ::: "memory");
    __syncthreads();
    if (threadIdx.x == 0) {
        unsigned* bar = b.bar;
        __builtin_amdgcn_s_waitcnt(0);
        unsigned nloc = b.st[0], nx = b.st[1];
        if (nloc == 0u) { xcd_barrier_complete(bar, b.x, nloc, nx); b.st[0] = nloc; b.st[1] = nx; }
        const unsigned old = xb_add(&bar[XB_XSUB(b.x)], 1u);
        const unsigned gen = old / nloc;
        if (old + 1u == (gen + 1u) * nloc) {
            __builtin_amdgcn_fence(__ATOMIC_RELEASE, "agent");
            asm volatile("s_waitcnt vmcnt(0)" ::: "memory");
            const unsigned og = xb_add(&bar[XB_TOP], 1u);
            const unsigned tg = og / nx;
            if (og + 1u == (tg + 1u) * nx) xb_add(&bar[XB_TOPGEN], 1u);
            else XB_SPIN(xb_ld(&bar[XB_TOPGEN]) == tg, bar);
            __builtin_amdgcn_fence(__ATOMIC_ACQUIRE, "agent");
            xb_add(&bar[XB_XGEN(b.x)], 1u);
            asm volatile("s_waitcnt vmcnt(0)" ::: "memory");
        } else {
            XB_SPIN(xb_ld(&bar[XB_XGEN(b.x)]) == gen, bar);
            __builtin_amdgcn_fence(__ATOMIC_ACQUIRE, "agent");
            asm volatile("s_waitcnt vmcnt(0)" ::: "memory");
        }
    }
    __syncthreads();
}

struct Frame {
    LAS unsigned char* lds;
    volatile LAS unsigned* MISC;
    int tid, lane, wave;
    int vcu, G;
    const float *xp, *xs, *cp, *cs, *rel_bias, *norm_w, *w_ada, *b_ada, *w_in, *shift_mu, *w0, *w2, *a0, *a2, *k_k, *k_a, *r_k, *lnx_w, *lnx_b, *q_gain, *k_gain, *w_out_a, *w_out_b, *w_out;
    unsigned char* out;
    unsigned char* ws;
};
__device__ __forceinline__ const float* xrow_ptr(const Frame& F, int m) { return m < NBP * T ? F.xp + (size_t)m * D : F.xs + (size_t)(m - NBP * T) * D; }

namespace pg8 {
struct EpiPB {
    static constexpr bool PERM = true;
    bf16_t* O;
    __device__ __forceinline__ bool operator()(const f32x4 (&acc)[2][2][4][2], const Unit& u, int wr, int wc, int fr, int fq) const {
        const int row0 = u.pm * BM + wr * 64 + fr, col0 = u.pn * BM + wc * 32 + 8 * fq; const bool act = u.pn >= 18;
#pragma unroll
        for (int ai = 0; ai < 2; ++ai)
#pragma unroll
            for (int m = 0; m < 4; ++m) { bf16_t* rowp = O + (size_t)(row0 + ai * HALF + m * 16) * B_COLS + col0;
#pragma unroll
                for (int bj = 0; bj < 2; ++bj) { f32x4 v0 = acc[ai][bj][m][0], v1 = acc[ai][bj][m][1];
                    if (act) {
#pragma unroll
                        for (int e = 0; e < 4; ++e) { v0[e] = siluf_(v0[e]); v1[e] = siluf_(v1[e]); } }
                    u32x4 w; w.x = cvt_pk_bf16(v0[0], v0[1]); w.y = cvt_pk_bf16(v0[2], v0[3]); w.z = cvt_pk_bf16(v1[0], v1[1]); w.w = cvt_pk_bf16(v1[2], v1[3]);
                    *(u32x4*)(rowp + bj * HALF) = w; } }
        return false;
    }
};
struct EpiAG {
    static constexpr bool PERM = true;
    bf16_t* PA; bf16_t* PG;
    __device__ __forceinline__ bool operator()(const f32x4 (&acc)[2][2][4][2], const Unit& u, int wr, int wc, int fr, int fq) const {
        const bool isg = u.pn >= 9; bf16_t* base = isg ? PG : PA; const int ldc = isg ? G_COLS : A_COLS; const int pn = isg ? u.pn - 9 : u.pn;
        const int row0 = u.pm * BM + wr * 64 + fr, col0 = pn * BM + wc * 32 + 8 * fq;
#pragma unroll
        for (int ai = 0; ai < 2; ++ai)
#pragma unroll
            for (int m = 0; m < 4; ++m) { bf16_t* rowp = base + (size_t)(row0 + ai * HALF + m * 16) * ldc + col0;
#pragma unroll
                for (int bj = 0; bj < 2; ++bj) { const f32x4 v0 = acc[ai][bj][m][0], v1 = acc[ai][bj][m][1];
                    u32x4 w; w.x = cvt_pk_bf16(v0[0], v0[1]); w.y = cvt_pk_bf16(v0[2], v0[3]); w.z = cvt_pk_bf16(v1[0], v1[1]); w.w = cvt_pk_bf16(v1[2], v1[3]);
                    *(u32x4*)(rowp + bj * HALF) = w; } }
        return false;
    }
};
struct EpiMerge {
    static constexpr bool PERM = true;
    const bf16_t* PG; bf16_t* O;
    __device__ __forceinline__ bool operator()(f32x4 (&acc)[2][2][4][2], const Unit& u, int wr, int wc, int fr, int fq) const {
        const int row0 = u.pm * BM + wr * 64 + fr, col0 = u.pn * BM + wc * 32 + 8 * fq;
#pragma unroll
        for (int ai = 0; ai < 2; ++ai)
#pragma unroll
            for (int m = 0; m < 4; ++m) { const size_t row = (size_t)(row0 + ai * HALF + m * 16);
#pragma unroll
                for (int bj = 0; bj < 2; ++bj) { const int col = col0 + bj * HALF;
                    const u32x4 gb8 = *(const u32x4*)(PG + row * G_COLS + D + col);
                    float zb[8] = {bflo(gb8.x), bfhi(gb8.x), bflo(gb8.y), bfhi(gb8.y), bflo(gb8.z), bfhi(gb8.z), bflo(gb8.w), bfhi(gb8.w)};
                    if (u.sel == 0) {
                        const u32x4 ga8 = *(const u32x4*)(PG + row * G_COLS + col);
                        float za[8] = {bflo(ga8.x), bfhi(ga8.x), bflo(ga8.y), bfhi(ga8.y), bflo(ga8.z), bfhi(ga8.z), bflo(ga8.w), bfhi(ga8.w)};
#pragma unroll
                        for (int e = 0; e < 8; ++e) { const float ea = __expf(-fminf(fmaxf(za[e], -30.f), 30.f)), eb = __expf(-fminf(fmaxf(zb[e], -30.f), 30.f));
                            const float r = (1.f + eb) * __builtin_amdgcn_rcpf(1.f + ea); acc[ai][bj][m][e >> 2][e & 3] *= r; }
                    } else {
                        float o[8];
#pragma unroll
                        for (int e = 0; e < 8; ++e) { const float eb = __expf(-fminf(fmaxf(zb[e], -30.f), 30.f)); o[e] = acc[ai][bj][m][e >> 2][e & 3] * __builtin_amdgcn_rcpf(1.f + eb); }
                        u32x4 w; w.x = cvt_pk_bf16(o[0], o[1]); w.y = cvt_pk_bf16(o[2], o[3]); w.z = cvt_pk_bf16(o[4], o[5]); w.w = cvt_pk_bf16(o[6], o[7]);
                        *(u32x4*)(O + row * D + col) = w;
                    } } }
        return u.sel == 0;
    }
};
struct EpiOut {
    static constexpr bool PERM = false;
    const float* xp; const float* xs; const float* mod; float* out;
    __device__ __forceinline__ bool operator()(const f32x4 (&acc)[2][2][4][2], const Unit& u, int wr, int wc, int fr, int fq) const {
        const int rowt = u.pm * BM, b = rowt >> 13; const float* xb = rowt < NBP * T ? xp + (size_t)rowt * D : xs + (size_t)(rowt - NBP * T) * D;
        const int rl0 = wr * 64 + fr, col0 = u.pn * BM + wc * 32 + 4 * fq; const float* gt = mod + b * 3072 + 2048;
#pragma unroll
        for (int bj = 0; bj < 2; ++bj)
#pragma unroll
            for (int n = 0; n < 2; ++n) { const int col = col0 + bj * HALF + n * 16; const f32x4 g4 = *(const f32x4*)(gt + col);
#pragma unroll
                for (int ai = 0; ai < 2; ++ai)
#pragma unroll
                    for (int m = 0; m < 4; ++m) { const int rl = rl0 + ai * HALF + m * 16; const f32x4 x4 = *(const f32x4*)(xb + (size_t)rl * D + col);
                        *(f32x4*)(out + (size_t)(rowt + rl) * D + col) = x4 + g4 * acc[ai][bj][m][n]; } }
        return false;
    }
};
}

__device__ __forceinline__ void p0_transpose_item(const float* W, int K, int N, bf16* WT, int k0, int n0, int drow0, LAS float* scr, int lane) {
#pragma unroll 8
    for (int i = 0; i < 32; ++i) { const int kk = 2 * i + (lane >> 5); scr[kk * 33 + (lane & 31)] = W[(size_t)(k0 + kk) * N + n0 + (lane & 31)]; }
    LDS_WAIT(); asm volatile("" ::: "memory");
    const int c = lane & 7;
#pragma unroll
    for (int j = 0; j < 4; ++j) { const int n = (lane >> 3) + 8 * j; const LAS float* s = scr + (8 * c) * 33 + n;
        v4u o; o.x = pk2(s[0 * 33], s[1 * 33]); o.y = pk2(s[2 * 33], s[3 * 33]); o.z = pk2(s[4 * 33], s[5 * 33]); o.w = pk2(s[6 * 33], s[7 * 33]);
        *(GAS v4u*)(WT + (size_t)(drow0 + n) * K + k0 + 8 * c) = o; }
    LDS_WAIT(); asm volatile("" ::: "memory");
}
__device__ __forceinline__ int t5_bucket(int rel) {
    const int n = rel < 0 ? -rel : rel; int ret = rel > 0 ? 16 : 0;
    const float lf = logf((float)(n > 1 ? n : 1) / 8.0f) / 4.852030263919617f * 8.0f;
    int large = 8 + (int)lf; large = large < 15 ? large : 15;
    return ret + (n < 8 ? n : large);
}
__device__ __forceinline__ void p0a(Frame& F) {
    float* mod = (float*)(F.ws + WS_MOD);
    if (blockIdx.x < 48) {
        LAS float* sc = (LAS float*)F.lds;
        LAS float* part = (LAS float*)(F.lds + 40960);
        for (int i = F.tid; i < NB * D; i += NWAVES * 64) { const int b = i >> 10, k = i & 1023; const float cv = b < NBP ? F.cp[b * D + k] : F.cs[(b - NBP) * D + k]; sc[i] = siluf_(cv); }
        __syncthreads();
        const int j = blockIdx.x * 64 + F.lane; float a[NB];
#pragma unroll
        for (int b = 0; b < NB; ++b) a[b] = 0.f;
        for (int k = F.wave * 128; k < F.wave * 128 + 128; ++k) { const float w = F.w_ada[(size_t)k * 3072 + j];
#pragma unroll
            for (int b = 0; b < NB; ++b) a[b] += sc[b * D + k] * w; }
#pragma unroll
        for (int b = 0; b < NB; ++b) part[(F.wave * NB + b) * 64 + F.lane] = a[b];
        __syncthreads();
        for (int i = F.tid; i < NB * 64; i += NWAVES * 64) { const int b = i >> 6, l = i & 63; float s = F.b_ada[blockIdx.x * 64 + l];
#pragma unroll
            for (int w = 0; w < NWAVES; ++w) s += part[(w * NB + b) * 64 + l];
            mod[b * 3072 + blockIdx.x * 64 + l] = s; }
        __syncthreads();
    }
    if (blockIdx.x == 255 % gridDim.x) {
        float* bt = (float*)(F.ws + WS_BTAB);
        for (int i = F.tid; i < 12 * 129; i += NWAVES * 64) { const int gh = i / 129, r = i % 129, gi = gh >> 2; const int rel = (r - 64) * (1 << (2 * gi));
            bt[i] = F.rel_bias[t5_bucket(rel) * 12 + gh]; }
    }
    LAS float* scr = (LAS float*)(F.lds + RING_OFF + F.wave * 16384);
    const int gw = F.vcu * NWAVES + F.wave, NGW = F.G * NWAVES;
    constexpr int I_IN = (D / 64) * (IN_COLS / 32), I_OA = (A_W / 64) * (D / 32), I_OB = (B_W / 64) * (D / 32), I_O = (D / 64) * (D / 32);
    constexpr int NITEMS = I_IN + I_OA + I_OB + I_O;
    for (int it = gw; it < NITEMS; it += NGW) {
        int r = it;
        if (r < I_IN) { const int nblk = IN_COLS / 32, kb = r / nblk, nb = r % nblk, n0 = nb * 32;
            bf16* dst; int drow;
            if (n0 < A_COLS) { dst = (bf16*)(F.ws + WS_WAG); drow = n0; }
            else if (n0 < A_COLS + B_COLS) { dst = (bf16*)(F.ws + WS_WB); drow = n0 - A_COLS; }
            else { dst = (bf16*)(F.ws + WS_WAG); drow = A_COLS + (n0 - A_COLS - B_COLS); }
            p0_transpose_item(F.w_in, D, IN_COLS, dst, kb * 64, n0, drow, scr, F.lane); continue; }
        r -= I_IN;
        if (r < I_OA) { const int nblk = D / 32, kb = r / nblk, nb = r % nblk; p0_transpose_item(F.w_out_a, A_W, D, (bf16*)(F.ws + WS_WOA), kb * 64, nb * 32, nb * 32, scr, F.lane); continue; }
        r -= I_OA;
        if (r < I_OB) { const int nblk = D / 32, kb = r / nblk, nb = r % nblk; p0_transpose_item(F.w_out_b, B_W, D, (bf16*)(F.ws + WS_WOB), kb * 64, nb * 32, nb * 32, scr, F.lane); continue; }
        r -= I_OB;
        { const int nblk = D / 32, kb = r / nblk, nb = r % nblk; p0_transpose_item(F.w_out, D, D, (bf16*)(F.ws + WS_WO), kb * 64, nb * 32, nb * 32, scr, F.lane); }
    }
}
__device__ __forceinline__ void p0b(Frame& F) {
    const float* mod = (const float*)(F.ws + WS_MOD);
    const int gw = F.vcu * NWAVES + F.wave, NGW = F.G * NWAVES;
    for (int m = gw; m < M; m += NGW) {
        const int b = m >> 13; const f32x4* xr = (const f32x4*)xrow_ptr(F, m) + F.lane;
        f32x4 v[4]; float s = 0.f;
#pragma unroll
        for (int j = 0; j < 4; ++j) { v[j] = xr[64 * j]; s += (v[j].x * v[j].x + v[j].y * v[j].y) + (v[j].z * v[j].z + v[j].w * v[j].w); }
        const float rs = 1.f / sqrtf(wave_sum(s) * (1.f / D) + RMS_EPS);
        v2u* o8 = (v2u*)(F.out + (size_t)m * OROW + OS_H) + F.lane;
#pragma unroll
        for (int j = 0; j < 4; ++j) { const int col = 4 * (F.lane + 64 * j);
            const f32x4 nw = *(const f32x4*)(F.norm_w + col), sh = *(const f32x4*)(mod + b * 3072 + col), sc = *(const f32x4*)(mod + b * 3072 + 1024 + col);
            const f32x4 h = v[j] * rs * nw * (sc + 1.f) + sh;
            v2u w; w.x = pk2(h.x, h.y); w.y = pk2(h.z, h.w); o8[64 * j] = w; }
    }
}
__device__ __forceinline__ void attn_baseline(Frame& F) {
    const bf16* pb = (const bf16*)(F.ws + WS_R); const float* btab = (const float*)(F.ws + WS_BTAB);
    LAS float* qq = (LAS float*)(F.lds + F.wave * 2048);
    LAS float* sc = qq + 128;
    const int gw = F.vcu * NWAVES + F.wave, NGW = F.G * NWAVES, lane = F.lane;
    const float g0 = F.q_gain[2 * lane] * F.k_gain[2 * lane] * 0.08838834764831845f, g1 = F.q_gain[2 * lane + 1] * F.k_gain[2 * lane + 1] * 0.08838834764831845f;
    for (int task = gw; task < M * 4; task += NGW) {
        const int m = task >> 2, hh = task & 3, b = m >> 13, t = m & (T - 1);
        float m_run = -1e30f, l_run = 0.f, o0 = 0.f, o1 = 0.f;
        for (int gi = 0; gi < 3; ++gi) {
            const int lg = 2 * gi, L = T >> lg, pos = t >> lg, res = t & ((1 << lg) - 1), head = gi * 4 + hh;
            { const unsigned q2 = *(const unsigned*)(pb + (size_t)m * B_COLS + head * 128 + 2 * lane); const float qa = bflo(q2), qb = bfhi(q2);
              const float rq = 1.f / sqrtf(wave_sum(qa * qa + qb * qb) * (1.f / 128.f) + RMS_EPS);
              LDS_WAIT(); qq[2 * lane] = qa * rq * g0; qq[2 * lane + 1] = qb * rq * g1; LDS_WAIT(); }
            float sv[3];
#pragma unroll
            for (int pass = 0; pass < 3; ++pass) {
                const int rel = -64 + pass * 64 + lane, kp = pos + rel; const bool valid = (pass < 2 || lane == 0) && kp >= 0 && kp < L;
                float s = -1e30f;
                if (valid) { const int kt = (kp << lg) + res; const bf16* krow = pb + (size_t)(b * T + kt) * B_COLS + B_QKV + head * 128;
                    float dot = 0.f, ks = 0.f;
#pragma unroll
                    for (int c = 0; c < 16; ++c) { const v4u k8 = *(const v4u*)(krow + 8 * c); const f32x4 qa = *(const LAS f32x4*)(qq + 8 * c), qb = *(const LAS f32x4*)(qq + 8 * c + 4);
                        const float k0 = bflo(k8.x), k1 = bfhi(k8.x), k2 = bflo(k8.y), k3 = bfhi(k8.y), k4 = bflo(k8.z), k5 = bfhi(k8.z), k6 = bflo(k8.w), k7 = bfhi(k8.w);
                        dot += qa.x * k0 + qa.y * k1 + qa.z * k2 + qa.w * k3 + qb.x * k4 + qb.y * k5 + qb.z * k6 + qb.w * k7;
                        ks += k0 * k0 + k1 * k1 + k2 * k2 + k3 * k3 + k4 * k4 + k5 * k5 + k6 * k6 + k7 * k7; }
                    s = dot / sqrtf(ks * (1.f / 128.f) + RMS_EPS) + btab[head * 129 + rel + 64]; }
                sv[pass] = s; }
            const float mg = wave_max(fmaxf(fmaxf(sv[0], sv[1]), sv[2]));
            const float mnew = fmaxf(m_run, mg), alpha = __expf(m_run - mnew); l_run *= alpha; o0 *= alpha; o1 *= alpha; m_run = mnew;
            float ps = 0.f;
#pragma unroll
            for (int pass = 0; pass < 3; ++pass) { const float p = sv[pass] > -1e29f ? __expf(sv[pass] - mnew) : 0.f; ps += p; sc[pass * 64 + lane] = p; }
            l_run += wave_sum(ps);
            LDS_WAIT();
#pragma unroll 8
            for (int j = 0; j < 129; ++j) { const int kp = pos + j - 64; const bool ok = kp >= 0 && kp < L; const int kpc = kp < 0 ? 0 : (kp >= L ? L - 1 : kp);
                const float p = ok ? sc[j] : 0.f; const int kt = (kpc << lg) + res;
                const unsigned v2 = *(const unsigned*)(pb + (size_t)(b * T + kt) * B_COLS + 2 * B_QKV + head * 128 + 2 * lane);
                o0 += p * bflo(v2); o1 += p * bfhi(v2); }
        }
        const unsigned g2 = *(const unsigned*)(pb + (size_t)m * B_COLS + 3 * B_QKV + hh * 128 + 2 * lane);
        const float il = 1.f / l_run;
        *(unsigned*)(F.out + (size_t)m * OROW + OS_YB + (hh * 128 + 2 * lane) * 2) = pk2(o0 * il * bflo(g2), o1 * il * bfhi(g2));
    }
}
__device__ __forceinline__ float shift3(const bf16* p0, int col, bool hp, bool hn, float m0, float m1, float mc) {
    const float x0 = bf2f(p0[col]); const float xm = hp ? bf2f(p0[col - A_COLS]) : 0.f; const float xn = hn ? bf2f(p0[col + A_COLS]) : 0.f;
    return x0 * mc + m0 * xm + m1 * xn;
}
__device__ __forceinline__ void rwkv_scan_baseline(Frame& F) {
    if (blockIdx.x >= 2 * NB * A_HEADS) return;
    const int chain = blockIdx.x, d = chain / (NB * A_HEADS), rem = chain % (NB * A_HEADS), b = rem >> 3, hd = rem & 7;
    const bf16* pa = (const bf16*)(F.ws + WS_PA); bf16* ybuf = (bf16*)(F.ws + WS_Y) + (size_t)d * M * A_W; float* bon = (float*)(F.ws + WS_BON) + (size_t)d * M * 8;
    LAS float* SR = (LAS float*)(F.lds);
    LAS float* SW = SR + 2048; LAS float* SK = SW + 2048; LAS float* SV = SK + 2048; LAS float* SA = SV + 2048; LAS float* SB = SA + 2048; LAS float* YST = SB + 2048;
    LAS float* STG = YST + 2048 + F.wave * 128;
    LAS float* W2H = (LAS float*)(F.lds + 65536);
    LAS float* A2H = W2H + 4096;
    const int lane = F.lane, wave = F.wave, j = lane, ch = hd * 64 + j;
    for (int i = F.tid; i < 4096; i += NWAVES * 64) { const int jr = i >> 6, jo = i & 63; W2H[i] = F.w2[((size_t)d * RANK + jr) * A_W + hd * 64 + jo]; A2H[i] = F.a2[((size_t)d * RANK + jr) * A_W + hd * 64 + jo]; }
    const int cr = ch, ck = A_W + ch, cv = 2 * A_W + ch, cw = 4 * A_W + d * RANK + j, ca = 4 * A_W + 2 * RANK + d * RANK + j;
    const float mr0 = F.shift_mu[cr], mr1 = F.shift_mu[A_COLS + cr], mk0 = F.shift_mu[ck], mk1 = F.shift_mu[A_COLS + ck], mv0 = F.shift_mu[cv], mv1 = F.shift_mu[A_COLS + cv];
    const float mw0 = F.shift_mu[cw], mw1 = F.shift_mu[A_COLS + cw], ma0 = F.shift_mu[ca], ma1 = F.shift_mu[A_COLS + ca];
    const float w0j = F.w0[d * A_W + ch], a0j = F.a0[d * A_W + ch], kkj = F.k_k[ch], kaj = F.k_a[ch], rkj = F.r_k[ch];
    const int row = wave * 8 + (lane >> 3), kq = lane & 7;
    float S[8];
#pragma unroll
    for (int e = 0; e < 8; ++e) S[e] = 0.f;
    __syncthreads();
    for (int blk = 0; blk < T / 32; ++blk) {
        for (int q = 0; q < 4; ++q) {
            const int i = q * 8 + wave, s = blk * 32 + i, t = d ? T - 1 - s : s; const bool hp = t > 0, hn = t < T - 1;
            const bf16* p0 = pa + (size_t)(b * T + t) * A_COLS;
            const float rs = shift3(p0, cr, hp, hn, mr0, mr1, 1.f - mr0 - mr1), ks = shift3(p0, ck, hp, hn, mk0, mk1, 1.f - mk0 - mk1), vs = shift3(p0, cv, hp, hn, mv0, mv1, 1.f - mv0 - mv1);
            const float wsv = shift3(p0, cw, hp, hn, mw0, mw1, 1.f - mw0 - mw1), asv = shift3(p0, ca, hp, hn, ma0, ma1, 1.f - ma0 - ma1);
            LDS_WAIT(); STG[j] = tanhf(wsv); STG[64 + j] = asv; LDS_WAIT();
            float wl = w0j, al = a0j;
#pragma unroll 8
            for (int jr = 0; jr < 64; ++jr) { wl += STG[jr] * W2H[jr * 64 + j]; al += STG[64 + jr] * A2H[jr * 64 + j]; }
            const float xneg = -wl, sp = xneg > 20.f ? xneg : log1pf(expf(xneg)); const float wlog = -sp - 0.5f; const float dec = expf(-expf(wlog));
            const float av = 1.f / (1.f + expf(-al));
            const float kkv = ks * kkj; const float nrm = fmaxf(sqrtf(wave_sum(kkv * kkv)), 1e-12f); const float kkn = kkv / nrm;
            const float kd = ks * (1.f + (av - 1.f) * kaj), bd = kkn * av;
            const float bsum = wave_sum(rs * kd * rkj); if (lane == 0) bon[(size_t)(b * T + t) * 8 + hd] = bsum;
            SR[i * 64 + j] = rs; SW[i * 64 + j] = dec; SK[i * 64 + j] = kd; SV[i * 64 + j] = vs; SA[i * 64 + j] = -kkn; SB[i * 64 + j] = bd;
        }
        __syncthreads();
        for (int i = 0; i < 32; ++i) {
            const f32x4 w0 = *(const LAS f32x4*)(SW + i * 64 + 8 * kq), w1 = *(const LAS f32x4*)(SW + i * 64 + 8 * kq + 4);
            const f32x4 a0v = *(const LAS f32x4*)(SA + i * 64 + 8 * kq), a1v = *(const LAS f32x4*)(SA + i * 64 + 8 * kq + 4);
            const f32x4 b0 = *(const LAS f32x4*)(SB + i * 64 + 8 * kq), b1 = *(const LAS f32x4*)(SB + i * 64 + 8 * kq + 4);
            const f32x4 k0 = *(const LAS f32x4*)(SK + i * 64 + 8 * kq), k1 = *(const LAS f32x4*)(SK + i * 64 + 8 * kq + 4);
            const f32x4 r0 = *(const LAS f32x4*)(SR + i * 64 + 8 * kq), r1 = *(const LAS f32x4*)(SR + i * 64 + 8 * kq + 4);
            const float vv = SV[i * 64 + row];
            float sa = (S[0] * a0v.x + S[1] * a0v.y) + (S[2] * a0v.z + S[3] * a0v.w) + (S[4] * a1v.x + S[5] * a1v.y) + (S[6] * a1v.z + S[7] * a1v.w);
            sa += __shfl_xor(sa, 1); sa += __shfl_xor(sa, 2); sa += __shfl_xor(sa, 4);
            S[0] = S[0] * w0.x + (sa * b0.x + vv * k0.x); S[1] = S[1] * w0.y + (sa * b0.y + vv * k0.y); S[2] = S[2] * w0.z + (sa * b0.z + vv * k0.z); S[3] = S[3] * w0.w + (sa * b0.w + vv * k0.w);
            S[4] = S[4] * w1.x + (sa * b1.x + vv * k1.x); S[5] = S[5] * w1.y + (sa * b1.y + vv * k1.y); S[6] = S[6] * w1.z + (sa * b1.z + vv * k1.z); S[7] = S[7] * w1.w + (sa * b1.w + vv * k1.w);
            float y = (S[0] * r0.x + S[1] * r0.y) + (S[2] * r0.z + S[3] * r0.w) + (S[4] * r1.x + S[5] * r1.y) + (S[6] * r1.z + S[7] * r1.w);
            y += __shfl_xor(y, 1); y += __shfl_xor(y, 2); y += __shfl_xor(y, 4);
            if (kq == 0) YST[i * 64 + row] = y;
        }
        __syncthreads();
        { const int idx = F.tid * 4, i = idx >> 6, v0 = idx & 63, s = blk * 32 + i, t = d ? T - 1 - s : s;
          const f32x4 y4 = *(const LAS f32x4*)(YST + idx); v2u w; w.x = pk2(y4.x, y4.y); w.y = pk2(y4.z, y4.w);
          *(v2u*)(ybuf + (size_t)(b * T + t) * A_W + hd * 64 + v0) = w; }
    }
}
__device__ __forceinline__ void rwkv_post_baseline(Frame& F) {
    const bf16* pa = (const bf16*)(F.ws + WS_PA); const bf16* y0 = (const bf16*)(F.ws + WS_Y); const bf16* y1 = y0 + (size_t)M * A_W;
    const float* bon0 = (const float*)(F.ws + WS_BON); const float* bon1 = bon0 + (size_t)M * 8;
    const int gw = F.vcu * NWAVES + F.wave, NGW = F.G * NWAVES, lane = F.lane;
    for (int task = gw; task < M * 8; task += NGW) {
        const int m = task >> 3, hd = task & 7, t = m & (T - 1), ch = hd * 64 + lane; const bool hp = t > 0, hn = t < T - 1;
        const float y = bf2f(y0[(size_t)m * A_W + ch]) + bf2f(y1[(size_t)m * A_W + ch]);
        const float mean = wave_sum(y) * (1.f / 64.f), dv = y - mean, var = wave_sum(dv * dv) * (1.f / 64.f);
        const float yn = dv / sqrtf(var + GN_EPS) * F.lnx_w[ch] + F.lnx_b[ch];
        const float bsum = bon0[(size_t)m * 8 + hd] + bon1[(size_t)m * 8 + hd];
        const bf16* p0 = pa + (size_t)m * A_COLS; const int cv = 2 * A_W + ch, cg = 3 * A_W + ch;
        const float mv0 = F.shift_mu[cv], mv1 = F.shift_mu[A_COLS + cv], mg0 = F.shift_mu[cg], mg1 = F.shift_mu[A_COLS + cg];
        const float vs = shift3(p0, cv, hp, hn, mv0, mv1, 1.f - mv0 - mv1), gs = shift3(p0, cg, hp, hn, mg0, mg1, 1.f - mg0 - mg1);
        const float ya = (yn + bsum * vs) * (gs / (1.f + expf(-gs)));
        *(bf16*)(F.out + (size_t)m * OROW + OS_YA + ch * 2) = (bf16)f2bf(ya);
    }
}

struct Args { const float* in[24]; unsigned char* out; unsigned char* ws; };
__global__ void __launch_bounds__(NWAVES * 64, 2) hybrid_fwd(Args args) {
    extern __shared__ __attribute__((aligned(16))) unsigned char lds[];
    Frame F;
    F.lds = (LAS unsigned char*)lds;
    F.MISC = (volatile LAS unsigned*)(F.lds + MISC_OFF);
    F.tid = threadIdx.x; F.lane = F.tid & 63; F.wave = __builtin_amdgcn_readfirstlane(F.tid >> 6);
    F.G = gridDim.x; { const int bx = blockIdx.x; F.vcu = (F.G % 8 == 0) ? (bx % 8) * (F.G / 8) + bx / 8 : bx; }
    F.xp = args.in[0]; F.xs = args.in[1]; F.cp = args.in[2]; F.cs = args.in[3]; F.rel_bias = args.in[4]; F.norm_w = args.in[5]; F.w_ada = args.in[6]; F.b_ada = args.in[7];
    F.w_in = args.in[8]; F.shift_mu = args.in[9]; F.w0 = args.in[10]; F.w2 = args.in[11]; F.a0 = args.in[12]; F.a2 = args.in[13]; F.k_k = args.in[14]; F.k_a = args.in[15];
    F.r_k = args.in[16]; F.lnx_w = args.in[17]; F.lnx_b = args.in[18]; F.q_gain = args.in[19]; F.k_gain = args.in[20]; F.w_out_a = args.in[21]; F.w_out_b = args.in[22]; F.w_out = args.in[23];
    F.out = args.out; F.ws = args.ws;
    for (int u = F.tid; u < (LDS_BYTES - LDSCTL_OFF) / 4; u += NWAVES * 64) ((LAS unsigned*)(F.lds + LDSCTL_OFF))[u] = 0u;
    __syncthreads();
    XcdBarrier bar = xcd_barrier_post((unsigned*)(F.ws + WS_CTL) + CW_BAR, F.MISC + 8);
#define GRID_BAR() xcd_barrier(bar)
    typedef pg8::bf16_t bt;
    p0a(F); GRID_BAR();
    p0b(F); GRID_BAR();
    { pg8::Gemm g{(const bt*)(F.out + OS_H), (const bt*)(F.ws + WS_WB), nullptr, nullptr, OROW / 2, D}; pg8::Order S; S.init(M, B_COLS, F.G, (int)blockIdx.x, 1);
      pg8::EpiPB E{(bt*)(F.ws + WS_R)};
      pg8::gemm_phase<pg8::EpiPB, pg8::Order, true, true>(F.lds + RING_OFF, g, S, E); }
    GRID_BAR();
    attn_baseline(F); GRID_BAR();
    { pg8::Gemm g{(const bt*)(F.out + OS_H), (const bt*)(F.ws + WS_WAG), nullptr, nullptr, OROW / 2, D}; pg8::Order S; S.init(M, AG_COLS, F.G, (int)blockIdx.x, 1);
      pg8::EpiAG E{(bt*)(F.ws + WS_PA), (bt*)(F.ws + WS_PG)};
      pg8::gemm_phase<pg8::EpiAG, pg8::Order, true, true>(F.lds + RING_OFF, g, S, E); }
    GRID_BAR();
    rwkv_scan_baseline(F); GRID_BAR();
    rwkv_post_baseline(F); GRID_BAR();
    { pg8::Gemm g{(const bt*)(F.out + OS_YA), (const bt*)(F.ws + WS_WOA), (const bt*)(F.out + OS_YB), (const bt*)(F.ws + WS_WOB), OROW / 2, A_W}; pg8::Order S; S.init(M, D, F.G, (int)blockIdx.x, 2);
      pg8::EpiMerge E{(const bt*)(F.ws + WS_PG), (bt*)(F.ws + WS_Y)};
      pg8::gemm_phase<pg8::EpiMerge, pg8::Order, true, true>(F.lds + RING_OFF, g, S, E); }
    GRID_BAR();
    { pg8::Gemm g{(const bt*)(F.ws + WS_Y), (const bt*)(F.ws + WS_WO), nullptr, nullptr, D, D}; pg8::Order S; S.init(M, D, F.G, (int)blockIdx.x, 1);
      pg8::EpiOut E{F.xp, F.xs, (const float*)(F.ws + WS_MOD), (float*)F.out};
      pg8::gemm_phase<pg8::EpiOut, pg8::Order, true, true>(F.lds + RING_OFF, g, S, E); }
}

extern "C" void kernel_launch(void* const* d_in, const int* in_sizes, int n_in, void* d_out, int out_size, void* d_ws, size_t ws_size, hipStream_t stream) {
    static int grid = 0;
    if (grid == 0) {
        if (n_in != 24 || out_size != M * D || ws_size < WS_END) { fprintf(stderr, "kernel_launch: unexpected shapes: n_in %d out %d ws %zu (need %zu)\n", n_in, out_size, ws_size, (size_t)WS_END); grid = -1; return; }
        int dev = 0, cus = 0, per_cu = 0;
        if (hipGetDevice(&dev) != hipSuccess || hipDeviceGetAttribute(&cus, hipDeviceAttributeMultiprocessorCount, dev) != hipSuccess) { grid = -1; return; }
        if (hipFuncSetAttribute((const void*)hybrid_fwd, hipFuncAttributeMaxDynamicSharedMemorySize, LDS_BYTES) != hipSuccess) { fprintf(stderr, "kernel_launch: hipFuncSetAttribute failed\n"); grid = -1; return; }
        if (hipOccupancyMaxActiveBlocksPerMultiprocessor(&per_cu, (const void*)hybrid_fwd, NWAVES * 64, LDS_BYTES) != hipSuccess || per_cu < 1) { fprintf(stderr, "kernel_launch: occupancy query says %d\n", per_cu); }
        (void)hipGetLastError();
        grid = cus;
    }
    if (grid < 0) return;
    if (hipMemsetAsync((char*)d_ws + WS_CTL, 0, CTL_ZERO_BYTES, stream) != hipSuccess) return;
    Args a{};
    for (int i = 0; i < 24; ++i) a.in[i] = (const float*)d_in[i];
    a.out = (unsigned char*)d_out; a.ws = (unsigned char*)d_ws;
    hipLaunchKernelGGL(hybrid_fwd, dim3(grid), dim3(NWAVES * 64), LDS_BYTES, stream, a);
}
```

```cpp
#include <hip/hip_runtime.h>
#include <cstdio>
#include <cstdint>
namespace pg8 {
#define PG8_LAS __attribute__((address_space(3)))
typedef unsigned short bf16_t;
typedef short bf16x8 __attribute__((ext_vector_type(8)));
typedef float f32x4 __attribute__((ext_vector_type(4)));
typedef unsigned u32x4 __attribute__((ext_vector_type(4)));
constexpr int BM = 256, BK = 64, HALF = 128, HTB = HALF * BK * 2  , STAGE_BYTES = 8 * HTB, NXCD = 8, WGM = 8;

__host__ __device__ __forceinline__ int lds_byte(int r, int c) { const int st = (r >> 4) * 2 + (c >> 5), rr = r & 15, cc = c & 31, ob = rr * 64 + cc * 2; return st * 1024 + (ob ^ (((ob >> 9) & 1) << 5)); }
__host__ __device__ __forceinline__ void stage_rc(int b, int& R, int& C) { const int st = b / 1024, sb = b % 1024, swz = sb ^ (((sb >> 9) & 1) << 5); R = (st >> 1) * 16 + swz / 64; C = (st & 1) * 32 + (swz % 64) / 2; }
__host__ __device__ __forceinline__ int perm32(int rho) { const int n = rho >> 4, i = rho & 15; return 8 * (i >> 2) + 4 * n + (i & 3); }

struct Unit { int pm, pn, sel; };
struct Gemm { const bf16_t* A0; const bf16_t* B0; const bf16_t* A1; const bf16_t* B1; int lda; int K; };

struct Order {
    int nM, nN, nwg, G, c, CH;
    __host__ __device__ void init(int M, int N, int G_, int c_, int CH_) { nM = M / BM; nN = N / BM; nwg = nM * nN; G = G_; c = c_; CH = CH_; }
    __host__ __device__ bool next(int i, Unit& u) const {
        const int ti = (CH == 2) ? (i >> 1) : i; u.sel = (CH == 2) ? (i & 1) : 0;
        const long L = (long)ti * G + c; if (L >= nwg) return false;
        int wgid = (int)L; { const int q = nwg / NXCD, r = nwg % NXCD, xcd = wgid % NXCD, off = wgid / NXCD; wgid = (xcd < r ? xcd * (q + 1) : r * (q + 1) + (xcd - r) * q) + off; }
        const int nig = WGM * nN, gid = wgid / nig, fm = gid * WGM, gsz = (nM - fm) < WGM ? (nM - fm) : WGM;
        u.pm = fm + ((wgid % nig) % gsz); u.pn = (wgid % nig) / gsz; return true;
    }
};
__device__ __forceinline__ unsigned cvt_pk_bf16(float lo, float hi) { unsigned r; asm volatile("v_cvt_pk_bf16_f32 %0, %1, %2" : "=v"(r) : "v"(lo), "v"(hi)); return r; }
template <class Epi, class Sched, bool ALIGN_EPI = false, bool SP2 = false>
__device__ __forceinline__ void gemm_phase(PG8_LAS unsigned char* lds, const Gemm g, const Sched& S, const Epi& E) {
    int tid = threadIdx.x; asm volatile("" : "+v"(tid));
    const int wid = __builtin_amdgcn_readfirstlane(tid >> 6), lane = tid & 63, wr = wid >> 2, wc = wid & 3, fr = lane & 15, fq = lane >> 4;
    const int K = g.K, nt = K / BK;
    unsigned voffA[2], voffB[2];
#pragma unroll
    for (int i = 0; i < 2; ++i) { int R, C; stage_rc(tid * 16 + i * 8192, R, C); const int Rb = Epi::PERM ? ((R & ~31) + perm32(R & 31)) : R;
        voffA[i] = (unsigned)(R * g.lda + C) * 2u; voffB[i] = (unsigned)(Rb * K + C) * 2u; }
    const size_t kstep = (size_t)(BK * 2);
    const size_t hstepA = (size_t)HALF * g.lda * 2, hstepB = (size_t)HALF * K * 2;
    const size_t tstepA = 2 * hstepA, tstepB = 2 * hstepB;
    const unsigned ldsw = (unsigned)wid * 1024u;
    const int aoff = lds_byte(wr * 64 + fr, fq * 8), boff = lds_byte(wc * 32 + fr, fq * 8);
#define PG8_SA(b, h) (((b) * 2 + (h)) * HTB)
#define PG8_SB(b, h) ((4 + (b) * 2 + (h)) * HTB)
#define PG8_STAGE(bufoff, gbase, voff) do { _Pragma("unroll") for (int _i = 0; _i < 2; ++_i) \
        __builtin_amdgcn_global_load_lds((const unsigned*)((const char*)(gbase) + (voff)[_i]), (PG8_LAS unsigned*)(lds + (bufoff) + ldsw + _i * 8192), 16, 0, 0); } while (0)
#define PG8_LDA(dst, b, h) do { _Pragma("unroll") for (int m = 0; m < 4; ++m) _Pragma("unroll") for (int k = 0; k < 2; ++k) dst[m][k] = *(const PG8_LAS bf16x8*)(lds + PG8_SA(b, h) + aoff + m * 2048 + k * 1024); } while (0)
#define PG8_LDB(dst, b, h) do { _Pragma("unroll") for (int n = 0; n < 2; ++n) _Pragma("unroll") for (int k = 0; k < 2; ++k) dst[n][k] = *(const PG8_LAS bf16x8*)(lds + PG8_SB(b, h) + boff + n * 2048 + k * 1024); } while (0)
#define PG8_MMA(ai, bj, At, Bt) do { __builtin_amdgcn_s_setprio(1); _Pragma("unroll") for (int m = 0; m < 4; ++m) _Pragma("unroll") for (int n = 0; n < 2; ++n) _Pragma("unroll") for (int k = 0; k < 2; ++k) \
        acc[ai][bj][m][n] = __builtin_amdgcn_mfma_f32_16x16x32_bf16(Bt[n][k], At[m][k], acc[ai][bj][m][n], 0, 0, 0); __builtin_amdgcn_s_setprio(0); } while (0)
#define PG8_APTR(u) ((const char*)((u).sel ? g.A1 : g.A0) + (size_t)(u).pm * tstepA)
#define PG8_BPTR(u) ((const char*)((u).sel ? g.B1 : g.B0) + (size_t)(u).pn * tstepB)
#define PG8_WAIT_V(n) asm volatile("s_waitcnt vmcnt(" #n ")" ::: "memory")
#define PG8_WAIT_L(n) asm volatile("s_waitcnt lgkmcnt(" #n ")" ::: "memory")
#define PG8_BAR __builtin_amdgcn_s_barrier()
#define PG8_SCHED __builtin_amdgcn_sched_barrier(0)
    Unit cur, nxt; int ui = 0;
    if (!S.next(0, cur)) return;
    f32x4 acc[2][2][4][2];
#pragma unroll
    for (int a = 0; a < 2; ++a)
#pragma unroll
        for (int b = 0; b < 2; ++b)
#pragma unroll
            for (int m = 0; m < 4; ++m)
#pragma unroll
                for (int n = 0; n < 2; ++n) acc[a][b][m][n] = (f32x4){0.f, 0.f, 0.f, 0.f};
    bf16x8 At[4][2], B0[2][2], B1[2][2];
    const char* cA = PG8_APTR(cur); const char* cB = PG8_BPTR(cur);
    if constexpr (SP2) {
        PG8_STAGE(PG8_SB(0, 0), cB, voffB); PG8_STAGE(PG8_SB(0, 1), cB + hstepB, voffB); PG8_STAGE(PG8_SA(0, 0), cA, voffA); PG8_STAGE(PG8_SA(0, 1), cA + hstepA, voffA);
        if (wr == 1) PG8_BAR;
        PG8_WAIT_V(2); PG8_BAR;
        PG8_STAGE(PG8_SB(1, 0), cB + kstep, voffB); PG8_STAGE(PG8_SA(1, 0), cA + kstep, voffA); PG8_STAGE(PG8_SB(1, 1), cB + hstepB + kstep, voffB);
        PG8_WAIT_V(6); PG8_BAR;
    } else {
        PG8_STAGE(PG8_SB(0, 0), cB, voffB); PG8_STAGE(PG8_SA(0, 0), cA, voffA); PG8_STAGE(PG8_SB(0, 1), cB + hstepB, voffB); PG8_STAGE(PG8_SA(0, 1), cA + hstepA, voffA);
        if (wr == 1) PG8_BAR;
        PG8_WAIT_V(4); PG8_BAR;
        PG8_STAGE(PG8_SB(1, 0), cB + kstep, voffB); PG8_STAGE(PG8_SA(1, 0), cA + kstep, voffA); PG8_STAGE(PG8_SB(1, 1), cB + hstepB + kstep, voffB);
        PG8_WAIT_V(6); PG8_BAR;
    }
    for (;;) {
        const bool has_next = S.next(ui + 1, nxt);
        const char* nA = has_next ? PG8_APTR(nxt) : cA; const char* nB = has_next ? PG8_BPTR(nxt) : cB;
        for (int t = 0; t < nt; t += 2) {
            const bool last = (t == nt - 2);
            const char* a1 = cA + (size_t)(t + 1) * kstep;
            const char* a2 = last ? nA : cA + (size_t)(t + 2) * kstep; const char* b2 = last ? nB : cB + (size_t)(t + 2) * kstep;
            const char* a3 = a2 + kstep; const char* b3 = b2 + kstep;
            if constexpr (SP2) {
            PG8_LDB(B0, 0, 0); PG8_LDB(B1, 0, 1); PG8_SCHED; PG8_LDA(At, 0, 0); PG8_STAGE(PG8_SA(1, 1), a1 + hstepA, voffA);
            PG8_WAIT_V(8); PG8_WAIT_L(0); PG8_BAR; PG8_MMA(0, 0, At, B0); PG8_MMA(0, 1, At, B1); PG8_BAR; PG8_SCHED;
            PG8_LDA(At, 0, 1); PG8_STAGE(PG8_SB(0, 0), b2, voffB); PG8_STAGE(PG8_SB(0, 1), b2 + hstepB, voffB); PG8_STAGE(PG8_SA(0, 0), a2, voffA);
            PG8_WAIT_V(8); PG8_WAIT_L(0); PG8_BAR; PG8_MMA(1, 0, At, B0); PG8_MMA(1, 1, At, B1); PG8_BAR; PG8_SCHED;
            PG8_LDB(B0, 1, 0); PG8_LDB(B1, 1, 1); PG8_SCHED; PG8_LDA(At, 1, 0); PG8_STAGE(PG8_SA(0, 1), a2 + hstepA, voffA);
            PG8_WAIT_V(8); PG8_WAIT_L(0); PG8_BAR; PG8_MMA(0, 0, At, B0); PG8_MMA(0, 1, At, B1); PG8_BAR; PG8_SCHED;
            PG8_LDA(At, 1, 1); PG8_STAGE(PG8_SB(1, 0), b3, voffB); PG8_STAGE(PG8_SB(1, 1), b3 + hstepB, voffB); PG8_STAGE(PG8_SA(1, 0), a3, voffA);
            PG8_WAIT_V(8); PG8_WAIT_L(0); PG8_BAR; PG8_MMA(1, 0, At, B0); PG8_MMA(1, 1, At, B1); PG8_BAR; PG8_SCHED;
            } else {
            PG8_LDB(B0, 0, 0); PG8_SCHED; PG8_LDA(At, 0, 0); PG8_STAGE(PG8_SA(1, 1), a1 + hstepA, voffA);
            PG8_WAIT_L(8); PG8_BAR; PG8_WAIT_L(0); PG8_MMA(0, 0, At, B0); PG8_BAR; PG8_SCHED;
            PG8_LDB(B1, 0, 1); PG8_STAGE(PG8_SB(0, 0), b2, voffB);
            PG8_BAR; PG8_WAIT_L(0); PG8_MMA(0, 1, At, B1); PG8_BAR;
            PG8_LDA(At, 0, 1); PG8_STAGE(PG8_SA(0, 0), a2, voffA);
            PG8_BAR; PG8_WAIT_L(0); PG8_MMA(1, 0, At, B0); PG8_BAR; PG8_SCHED;
            PG8_STAGE(PG8_SB(0, 1), b2 + hstepB, voffB);
            PG8_WAIT_V(6); PG8_BAR; PG8_MMA(1, 1, At, B1); PG8_BAR;
            PG8_LDB(B0, 1, 0); PG8_SCHED; PG8_LDA(At, 1, 0); PG8_STAGE(PG8_SA(0, 1), a2 + hstepA, voffA);
            PG8_WAIT_L(8); PG8_BAR; PG8_WAIT_L(0); PG8_MMA(0, 0, At, B0); PG8_BAR; PG8_SCHED;
            PG8_LDB(B1, 1, 1); PG8_STAGE(PG8_SB(1, 0), b3, voffB);
            PG8_BAR; PG8_WAIT_L(0); PG8_MMA(0, 1, At, B1); PG8_BAR;
            PG8_LDA(At, 1, 1); PG8_STAGE(PG8_SA(1, 0), a3, voffA);
            PG8_BAR; PG8_WAIT_L(0); PG8_MMA(1, 0, At, B0); PG8_BAR; PG8_SCHED;
            PG8_STAGE(PG8_SB(1, 1), b3 + hstepB, voffB);
            PG8_WAIT_V(6); PG8_BAR; PG8_MMA(1, 1, At, B1); PG8_BAR;
            }
        }
        if constexpr (ALIGN_EPI) { if (wr == 0) PG8_BAR; }
        const bool keep = E(acc, cur, wr, wc, fr, fq);
        if (!has_next) break;
        if (!keep) {
#pragma unroll
        for (int a = 0; a < 2; ++a)
#pragma unroll
            for (int b = 0; b < 2; ++b)
#pragma unroll
                for (int m = 0; m < 4; ++m)
#pragma unroll
                    for (int n = 0; n < 2; ++n) acc[a][b][m][n] = (f32x4){0.f, 0.f, 0.f, 0.f};
        }
        cur = nxt; cA = nA; cB = nB; ++ui;
        if constexpr (ALIGN_EPI) { if (wr == 1) PG8_BAR; }
    }
    PG8_WAIT_V(0);
    if constexpr (!ALIGN_EPI) { if (wr == 0) PG8_BAR; }
    PG8_BAR;
#undef PG8_SA
#undef PG8_SB
#undef PG8_STAGE
#undef PG8_LDA
#undef PG8_LDB
#undef PG8_MMA
#undef PG8_APTR
#undef PG8_BPTR
#undef PG8_WAIT_V
#undef PG8_WAIT_L
#undef PG8_BAR
#undef PG8_SCHED
}
}

constexpr int NWAVES = 8;
constexpr int T = 8192, D = 1024, NBP = 8, NBS = 2, NB = NBP + NBS, M = NB * T;
constexpr int A_HEADS = 8, A_HD = 64, A_W = 512, RANK = 64;
constexpr int A_COLS = 2304, B_COLS = 5120, G_COLS = 2048, IN_COLS = 9472, AG_COLS = A_COLS + G_COLS;
constexpr int B_QKV = 1536, B_W = 512, B_HD = 128;
constexpr float RMS_EPS = 1e-6f, GN_EPS = 64e-5f;
constexpr size_t MiB = 1u << 20;
constexpr size_t WS_CTL = 0, CTL_ZERO_BYTES = 65536;
constexpr size_t WS_MOD = 1 * MiB;
constexpr size_t WS_BTAB = 1 * MiB + 128 * 1024;
constexpr size_t WS_WB = 2 * MiB;
constexpr size_t WS_WAG = 12 * MiB;
constexpr size_t WS_WOA = 21 * MiB, WS_WOB = 22 * MiB, WS_WO = 23 * MiB;
constexpr size_t WS_BON = 26 * MiB;
constexpr size_t WS_R = 32 * MiB;
constexpr size_t WS_PA = WS_R, WS_PG = WS_R + 360 * MiB;
constexpr size_t WS_Y = 832 * MiB;
constexpr size_t WS_END = 992 * MiB;
constexpr int CW_BAR = 4096;
constexpr int OS_H = 0, OS_YA = 2048, OS_YB = 3072, OROW = 4096;
constexpr int RING_OFF = 0, RING_BYTES = 131072;
constexpr int LDSCTL_OFF = RING_BYTES, MISC_OFF = LDSCTL_OFF + 320;
constexpr int EPI_OFF = RING_BYTES + 1024;
constexpr int LDS_BYTES = 147456;

#define GAS __attribute__((address_space(1)))
#define LAS __attribute__((address_space(3)))
typedef unsigned short bf16;
typedef unsigned v4u __attribute__((ext_vector_type(4)));
typedef unsigned v2u __attribute__((ext_vector_type(2)));
typedef float f32x4 __attribute__((ext_vector_type(4)));
typedef short bf16x8 __attribute__((ext_vector_type(8)));
typedef GAS unsigned gu32;
#define RLX_AGENT __ATOMIC_RELAXED, __HIP_MEMORY_SCOPE_AGENT
#define LDS_WAIT() asm volatile("s_waitcnt lgkmcnt(0)" ::: "memory")
#define VM_WAIT() asm volatile("s_waitcnt vmcnt(0)" ::: "memory")
__device__ __forceinline__ unsigned f2bf(float f) { unsigned u = __builtin_bit_cast(unsigned, f); return (u + 0x7fffu + ((u >> 16) & 1u)) >> 16; }
__device__ __forceinline__ unsigned pk2(float lo, float hi) { return f2bf(lo) | (f2bf(hi) << 16); }
__device__ __forceinline__ float bf2f(unsigned short h) { return __builtin_bit_cast(float, (unsigned)h << 16); }
__device__ __forceinline__ float bflo(unsigned w) { return __builtin_bit_cast(float, w << 16); }
__device__ __forceinline__ float bfhi(unsigned w) { return __builtin_bit_cast(float, w & 0xffff0000u); }
__device__ __forceinline__ float sigmoidf_(float v) { return __builtin_amdgcn_rcpf(1.f + __expf(-v)); }
__device__ __forceinline__ float siluf_(float v) { return v * sigmoidf_(v); }
__device__ __forceinline__ float wave_sum(float v) {
#pragma unroll
    for (int o = 1; o < 64; o <<= 1) v += __shfl_xor(v, o);
    return v;
}
__device__ __forceinline__ float wave_max(float v) {
#pragma unroll
    for (int o = 1; o < 64; o <<= 1) v = fmaxf(v, __shfl_xor(v, o));
    return v;
}

#define XB_TMO      128
#define XB_XCNT(j)  (256  + 64 * (j))
#define XB_XSUB(j)  (1280 + 64 * (j))
#define XB_XGEN(j)  (2304 + 64 * (j))
#define XB_TOP      3328
#define XB_TOPGEN   3392
#define XCD_BAR_WORDS 3456
#define XB_SPIN_CAP (1u << 22)
__device__ __forceinline__ unsigned xb_ld(unsigned* p)              { return __hip_atomic_load(p, __ATOMIC_RELAXED, __HIP_MEMORY_SCOPE_AGENT); }
__device__ __forceinline__ unsigned xb_add(unsigned* p, unsigned v) { return __hip_atomic_fetch_add(p, v, __ATOMIC_RELAXED, __HIP_MEMORY_SCOPE_AGENT); }
__device__ __forceinline__ unsigned xb_xcc_id() { return (unsigned)__builtin_amdgcn_s_getreg((3 << 11) | 20) & 0xFu; }
#define XB_SPIN(cond, bar) do { unsigned _sp = 0; while (cond) { __builtin_amdgcn_s_sleep(1); \
    if ((++_sp & 255u) == 0u) { if (xb_ld(&(bar)[XB_TMO])) break; if (_sp > XB_SPIN_CAP) { atomicAdd(&(bar)[XB_TMO], 1u); break; } } } } while (0)
struct XcdBarrier { unsigned* bar; unsigned x; volatile LAS unsigned* st; };
__device__ __forceinline__ XcdBarrier xcd_barrier_post(unsigned* bar, volatile LAS unsigned* st) {
    XcdBarrier b; b.bar = bar; b.x = xb_xcc_id(); b.st = st;
    if (threadIdx.x == 0) (void)xb_add(&bar[XB_XCNT(b.x)], 1u);
    return b;
}
__device__ __forceinline__ void xcd_barrier_complete(unsigned* bar, unsigned x, unsigned& nloc, unsigned& nx) {
    const unsigned G = gridDim.x * gridDim.y * gridDim.z;
    unsigned sum, cnt, mine, sp = 0u;
    for (;;) {
        sum = 0u; cnt = 0u; mine = 0u;
#pragma unroll
        for (unsigned j = 0; j < 16; ++j) { const unsigned c = xb_ld(&bar[XB_XCNT(j)]); sum += c; cnt += (c > 0u) ? 1u : 0u; mine = (j == x) ? c : mine; }
        if (sum == G) break;
        __builtin_amdgcn_s_sleep(1);
        if ((++sp & 255u) == 0u) { if (xb_ld(&bar[XB_TMO])) break; if (sp > XB_SPIN_CAP) { atomicAdd(&bar[XB_TMO], 1u); break; } }
    }
    nloc = mine > 0u ? mine : 1u; nx = cnt > 0u ? cnt : 1u;
}
__device__ __forceinline__ void xcd_barrier(const XcdBarrier& b) {
    asm volatile("s_waitcnt vmcnt(0)" ::: "memory");
    __syncthreads();
    if (threadIdx.x == 0) {
        unsigned* bar = b.bar;
        __builtin_amdgcn_s_waitcnt(0);
        unsigned nloc = b.st[0], nx = b.st[1];
        if (nloc == 0u) { xcd_barrier_complete(bar, b.x, nloc, nx); b.st[0] = nloc; b.st[1] = nx; }
        const unsigned old = xb_add(&bar[XB_XSUB(b.x)], 1u);
        const unsigned gen = old / nloc;
        if (old + 1u == (gen + 1u) * nloc) {
            __builtin_amdgcn_fence(__ATOMIC_RELEASE, "agent");
            asm volatile("s_waitcnt vmcnt(0)" ::: "memory");
            const unsigned og = xb_add(&bar[XB_TOP], 1u);
            const unsigned tg = og / nx;
            if (og + 1u == (tg + 1u) * nx) xb_add(&bar[XB_TOPGEN], 1u);
            else XB_SPIN(xb_ld(&bar[XB_TOPGEN]) == tg, bar);
            __builtin_amdgcn_fence(__ATOMIC_ACQUIRE, "agent");
            xb_add(&bar[XB_XGEN(b.x)], 1u);
            asm volatile("s_waitcnt vmcnt(0)" ::: "memory");
        } else {
            XB_SPIN(xb_ld(&bar[XB_XGEN(b.x)]) == gen, bar);
            __builtin_amdgcn_fence(__ATOMIC_ACQUIRE, "agent");
            asm volatile("s_waitcnt vmcnt(0)" ::: "memory");
        }
    }
    __syncthreads();
}

struct Frame {
    LAS unsigned char* lds;
    volatile LAS unsigned* MISC;
    int tid, lane, wave;
    int vcu, G;
    const float *xp, *xs, *cp, *cs, *rel_bias, *norm_w, *w_ada, *b_ada, *w_in, *shift_mu, *w0, *w2, *a0, *a2, *k_k, *k_a, *r_k, *lnx_w, *lnx_b, *q_gain, *k_gain, *w_out_a, *w_out_b, *w_out;
    unsigned char* out;
    unsigned char* ws;
};
__device__ __forceinline__ const float* xrow_ptr(const Frame& F, int m) { return m < NBP * T ? F.xp + (size_t)m * D : F.xs + (size_t)(m - NBP * T) * D; }

namespace pg8 {
struct EpiPB {
    static constexpr bool PERM = true;
    bf16_t* O; const float* qg; const float* kg; PG8_LAS float* P;
    __device__ __forceinline__ bool operator()(f32x4 (&acc)[2][2][4][2], const Unit& u, int wr, int wc, int fr, int fq) const {
        const int row0 = u.pm * BM + wr * 64 + fr, col0 = u.pn * BM + wc * 32 + 8 * fq;
        if (u.pn < 12) {
#pragma unroll
            for (int ai = 0; ai < 2; ++ai)
#pragma unroll
                for (int m = 0; m < 4; ++m) {
#pragma unroll
                    for (int bj = 0; bj < 2; ++bj) { const f32x4 a = acc[ai][bj][m][0], b = acc[ai][bj][m][1];
                        float s = (a[0] * a[0] + a[1] * a[1]) + (a[2] * a[2] + a[3] * a[3]) + (b[0] * b[0] + b[1] * b[1]) + (b[2] * b[2] + b[3] * b[3]);
                        s += __shfl_xor(s, 16); s += __shfl_xor(s, 32);
                        if (fq == 0) P[((ai * HALF + wr * 64 + m * 16 + fr) * 2 + bj) * 4 + wc] = s; }
                    asm volatile("" ::: "memory"); }
            asm volatile("s_waitcnt lgkmcnt(0)" ::: "memory"); __builtin_amdgcn_s_barrier(); asm volatile("" ::: "memory");
            const bool isq = u.pn < 6; const float* gp = (isq ? qg : kg) + wc * 32 + 8 * fq; const float gs = isq ? 0.08838834764831845f * 1.4426950408889634f : 1.f;
            float gn[8];
#pragma unroll
            for (int e = 0; e < 8; ++e) gn[e] = gp[e] * gs;
#pragma unroll
            for (int ai = 0; ai < 2; ++ai)
#pragma unroll
                for (int m = 0; m < 4; ++m)
#pragma unroll
                    for (int bj = 0; bj < 2; ++bj) { const f32x4 p4 = *(const PG8_LAS f32x4*)(P + ((ai * HALF + wr * 64 + m * 16 + fr) * 2 + bj) * 4);
                        const float rs = 1.0f / sqrtf(((p4[0] + p4[1]) + (p4[2] + p4[3])) * (1.f / 128.f) + 1e-6f);
#pragma unroll
                        for (int e = 0; e < 4; ++e) { acc[ai][bj][m][0][e] *= rs * gn[e]; acc[ai][bj][m][1][e] *= rs * gn[4 + e]; }
                        asm volatile("" ::: "memory"); }
        }
        const bool act = u.pn >= 18;
#pragma unroll
        for (int ai = 0; ai < 2; ++ai)
#pragma unroll
            for (int m = 0; m < 4; ++m) { bf16_t* rowp = O + (size_t)(row0 + ai * HALF + m * 16) * B_COLS + col0;
#pragma unroll
                for (int bj = 0; bj < 2; ++bj) { f32x4 v0 = acc[ai][bj][m][0], v1 = acc[ai][bj][m][1];
                    if (act) {
#pragma unroll
                        for (int e = 0; e < 4; ++e) { v0[e] = siluf_(v0[e]); v1[e] = siluf_(v1[e]); } }
                    u32x4 w; w.x = cvt_pk_bf16(v0[0], v0[1]); w.y = cvt_pk_bf16(v0[2], v0[3]); w.z = cvt_pk_bf16(v1[0], v1[1]); w.w = cvt_pk_bf16(v1[2], v1[3]);
                    *(u32x4*)(rowp + bj * HALF) = w; } }
        return false;
    }
};
struct EpiAG {
    static constexpr bool PERM = true;
    bf16_t* PA; bf16_t* PG;
    __device__ __forceinline__ bool operator()(const f32x4 (&acc)[2][2][4][2], const Unit& u, int wr, int wc, int fr, int fq) const {
        const bool isg = u.pn >= 9; bf16_t* base = isg ? PG : PA; const int ldc = isg ? G_COLS : A_COLS; const int pn = isg ? u.pn - 9 : u.pn;
        const int row0 = u.pm * BM + wr * 64 + fr, col0 = pn * BM + wc * 32 + 8 * fq;
#pragma unroll
        for (int ai = 0; ai < 2; ++ai)
#pragma unroll
            for (int m = 0; m < 4; ++m) { bf16_t* rowp = base + (size_t)(row0 + ai * HALF + m * 16) * ldc + col0;
#pragma unroll
                for (int bj = 0; bj < 2; ++bj) { const f32x4 v0 = acc[ai][bj][m][0], v1 = acc[ai][bj][m][1];
                    u32x4 w; w.x = cvt_pk_bf16(v0[0], v0[1]); w.y = cvt_pk_bf16(v0[2], v0[3]); w.z = cvt_pk_bf16(v1[0], v1[1]); w.w = cvt_pk_bf16(v1[2], v1[3]);
                    *(u32x4*)(rowp + bj * HALF) = w; } }
        return false;
    }
};
struct EpiMerge {
    static constexpr bool PERM = true;
    const bf16_t* PG; bf16_t* O;
    __device__ __forceinline__ bool operator()(f32x4 (&acc)[2][2][4][2], const Unit& u, int wr, int wc, int fr, int fq) const {
        const int row0 = u.pm * BM + wr * 64 + fr, col0 = u.pn * BM + wc * 32 + 8 * fq;
#pragma unroll
        for (int ai = 0; ai < 2; ++ai)
#pragma unroll
            for (int m = 0; m < 4; ++m) { const size_t row = (size_t)(row0 + ai * HALF + m * 16);
#pragma unroll
                for (int bj = 0; bj < 2; ++bj) { const int col = col0 + bj * HALF;
                    const u32x4 gb8 = *(const u32x4*)(PG + row * G_COLS + D + col);
                    float zb[8] = {bflo(gb8.x), bfhi(gb8.x), bflo(gb8.y), bfhi(gb8.y), bflo(gb8.z), bfhi(gb8.z), bflo(gb8.w), bfhi(gb8.w)};
                    if (u.sel == 0) {
                        const u32x4 ga8 = *(const u32x4*)(PG + row * G_COLS + col);
                        float za[8] = {bflo(ga8.x), bfhi(ga8.x), bflo(ga8.y), bfhi(ga8.y), bflo(ga8.z), bfhi(ga8.z), bflo(ga8.w), bfhi(ga8.w)};
#pragma unroll
                        for (int e = 0; e < 8; ++e) { const float ea = __expf(-fminf(fmaxf(za[e], -30.f), 30.f)), eb = __expf(-fminf(fmaxf(zb[e], -30.f), 30.f));
                            const float r = (1.f + eb) * __builtin_amdgcn_rcpf(1.f + ea); acc[ai][bj][m][e >> 2][e & 3] *= r; }
                    } else {
                        float o[8];
#pragma unroll
                        for (int e = 0; e < 8; ++e) { const float eb = __expf(-fminf(fmaxf(zb[e], -30.f), 30.f)); o[e] = acc[ai][bj][m][e >> 2][e & 3] * __builtin_amdgcn_rcpf(1.f + eb); }
                        u32x4 w; w.x = cvt_pk_bf16(o[0], o[1]); w.y = cvt_pk_bf16(o[2], o[3]); w.z = cvt_pk_bf16(o[4], o[5]); w.w = cvt_pk_bf16(o[6], o[7]);
                        *(u32x4*)(O + row * D + col) = w;
                    } } }
        return u.sel == 0;
    }
};
struct EpiOut {
    static constexpr bool PERM = false;
    const float* xp; const float* xs; const float* mod; float* out;
    __device__ __forceinline__ bool operator()(const f32x4 (&acc)[2][2][4][2], const Unit& u, int wr, int wc, int fr, int fq) const {
        const int rowt = u.pm * BM, b = rowt >> 13; const float* xb = rowt < NBP * T ? xp + (size_t)rowt * D : xs + (size_t)(rowt - NBP * T) * D;
        const int rl0 = wr * 64 + fr, col0 = u.pn * BM + wc * 32 + 4 * fq; const float* gt = mod + b * 3072 + 2048;
#pragma unroll
        for (int bj = 0; bj < 2; ++bj)
#pragma unroll
            for (int n = 0; n < 2; ++n) { const int col = col0 + bj * HALF + n * 16; const f32x4 g4 = *(const f32x4*)(gt + col);
#pragma unroll
                for (int ai = 0; ai < 2; ++ai)
#pragma unroll
                    for (int m = 0; m < 4; ++m) { const int rl = rl0 + ai * HALF + m * 16; const f32x4 x4 = *(const f32x4*)(xb + (size_t)rl * D + col);
                        *(f32x4*)(out + (size_t)(rowt + rl) * D + col) = x4 + g4 * acc[ai][bj][m][n]; } }
        return false;
    }
};
}

__device__ __forceinline__ void p0_transpose_item(const float* W, int K, int N, bf16* WT, int k0, int n0, int drow0, LAS float* scr, int lane) {
#pragma unroll 8
    for (int i = 0; i < 32; ++i) { const int kk = 2 * i + (lane >> 5); scr[kk * 33 + (lane & 31)] = W[(size_t)(k0 + kk) * N + n0 + (lane & 31)]; }
    LDS_WAIT(); asm volatile("" ::: "memory");
    const int c = lane & 7;
#pragma unroll
    for (int j = 0; j < 4; ++j) { const int n = (lane >> 3) + 8 * j; const LAS float* s = scr + (8 * c) * 33 + n;
        v4u o; o.x = pk2(s[0 * 33], s[1 * 33]); o.y = pk2(s[2 * 33], s[3 * 33]); o.z = pk2(s[4 * 33], s[5 * 33]); o.w = pk2(s[6 * 33], s[7 * 33]);
        *(GAS v4u*)(WT + (size_t)(drow0 + n) * K + k0 + 8 * c) = o; }
    LDS_WAIT(); asm volatile("" ::: "memory");
}
__device__ __forceinline__ int t5_bucket(int rel) {
    const int n = rel < 0 ? -rel : rel; int ret = rel > 0 ? 16 : 0;
    const float lf = logf((float)(n > 1 ? n : 1) / 8.0f) / 4.852030263919617f * 8.0f;
    int large = 8 + (int)lf; large = large < 15 ? large : 15;
    return ret + (n < 8 ? n : large);
}
__device__ __forceinline__ void p0a(Frame& F) {
    float* mod = (float*)(F.ws + WS_MOD);
    if (blockIdx.x < 48) {
        LAS float* sc = (LAS float*)F.lds;
        LAS float* part = (LAS float*)(F.lds + 40960);
        for (int i = F.tid; i < NB * D; i += NWAVES * 64) { const int b = i >> 10, k = i & 1023; const float cv = b < NBP ? F.cp[b * D + k] : F.cs[(b - NBP) * D + k]; sc[i] = siluf_(cv); }
        __syncthreads();
        const int j = blockIdx.x * 64 + F.lane; float a[NB];
#pragma unroll
        for (int b = 0; b < NB; ++b) a[b] = 0.f;
        for (int k = F.wave * 128; k < F.wave * 128 + 128; ++k) { const float w = F.w_ada[(size_t)k * 3072 + j];
#pragma unroll
            for (int b = 0; b < NB; ++b) a[b] += sc[b * D + k] * w; }
#pragma unroll
        for (int b = 0; b < NB; ++b) part[(F.wave * NB + b) * 64 + F.lane] = a[b];
        __syncthreads();
        for (int i = F.tid; i < NB * 64; i += NWAVES * 64) { const int b = i >> 6, l = i & 63; float s = F.b_ada[blockIdx.x * 64 + l];
#pragma unroll
            for (int w = 0; w < NWAVES; ++w) s += part[(w * NB + b) * 64 + l];
            mod[b * 3072 + blockIdx.x * 64 + l] = s; }
        __syncthreads();
    }
    if (blockIdx.x == 255 % gridDim.x) {
        float* bt = (float*)(F.ws + WS_BTAB);
        for (int i = F.tid; i < 12 * 129; i += NWAVES * 64) { const int gh = i / 129, r = i % 129, gi = gh >> 2; const int rel = (r - 64) * (1 << (2 * gi));
            bt[i] = F.rel_bias[t5_bucket(rel) * 12 + gh] * 1.4426950408889634f; }
    }
    LAS float* scr = (LAS float*)(F.lds + RING_OFF + F.wave * 16384);
    const int gw = F.vcu * NWAVES + F.wave, NGW = F.G * NWAVES;
    constexpr int I_IN = (D / 64) * (IN_COLS / 32), I_OA = (A_W / 64) * (D / 32), I_OB = (B_W / 64) * (D / 32), I_O = (D / 64) * (D / 32);
    constexpr int NITEMS = I_IN + I_OA + I_OB + I_O;
    for (int it = gw; it < NITEMS; it += NGW) {
        int r = it;
        if (r < I_IN) { const int nblk = IN_COLS / 32, kb = r / nblk, nb = r % nblk, n0 = nb * 32;
            bf16* dst; int drow;
            if (n0 < A_COLS) { dst = (bf16*)(F.ws + WS_WAG); drow = n0; }
            else if (n0 < A_COLS + B_COLS) { dst = (bf16*)(F.ws + WS_WB); drow = n0 - A_COLS; }
            else { dst = (bf16*)(F.ws + WS_WAG); drow = A_COLS + (n0 - A_COLS - B_COLS); }
            p0_transpose_item(F.w_in, D, IN_COLS, dst, kb * 64, n0, drow, scr, F.lane); continue; }
        r -= I_IN;
        if (r < I_OA) { const int nblk = D / 32, kb = r / nblk, nb = r % nblk; p0_transpose_item(F.w_out_a, A_W, D, (bf16*)(F.ws + WS_WOA), kb * 64, nb * 32, nb * 32, scr, F.lane); continue; }
        r -= I_OA;
        if (r < I_OB) { const int nblk = D / 32, kb = r / nblk, nb = r % nblk; p0_transpose_item(F.w_out_b, B_W, D, (bf16*)(F.ws + WS_WOB), kb * 64, nb * 32, nb * 32, scr, F.lane); continue; }
        r -= I_OB;
        { const int nblk = D / 32, kb = r / nblk, nb = r % nblk; p0_transpose_item(F.w_out, D, D, (bf16*)(F.ws + WS_WO), kb * 64, nb * 32, nb * 32, scr, F.lane); }
    }
}
__device__ __forceinline__ void p0b(Frame& F) {
    const float* mod = (const float*)(F.ws + WS_MOD);
    const int gw = F.vcu * NWAVES + F.wave, NGW = F.G * NWAVES;
    for (int m = gw; m < M; m += NGW) {
        const int b = m >> 13; const f32x4* xr = (const f32x4*)xrow_ptr(F, m) + F.lane;
        f32x4 v[4]; float s = 0.f;
#pragma unroll
        for (int j = 0; j < 4; ++j) { v[j] = xr[64 * j]; s += (v[j].x * v[j].x + v[j].y * v[j].y) + (v[j].z * v[j].z + v[j].w * v[j].w); }
        const float rs = 1.f / sqrtf(wave_sum(s) * (1.f / D) + RMS_EPS);
        v2u* o8 = (v2u*)(F.out + (size_t)m * OROW + OS_H) + F.lane;
#pragma unroll
        for (int j = 0; j < 4; ++j) { const int col = 4 * (F.lane + 64 * j);
            const f32x4 nw = *(const f32x4*)(F.norm_w + col), sh = *(const f32x4*)(mod + b * 3072 + col), sc = *(const f32x4*)(mod + b * 3072 + 1024 + col);
            const f32x4 h = v[j] * rs * nw * (sc + 1.f) + sh;
            v2u w; w.x = pk2(h.x, h.y); w.y = pk2(h.z, h.w); o8[64 * j] = w; }
    }
}
__device__ __forceinline__ void attn_baseline(Frame& F) {
    const bf16* pb = (const bf16*)(F.ws + WS_R); const float* btab = (const float*)(F.ws + WS_BTAB);
    LAS float* qq = (LAS float*)(F.lds + F.wave * 2048);
    LAS float* sc = qq + 128;
    const int gw = F.vcu * NWAVES + F.wave, NGW = F.G * NWAVES, lane = F.lane;
    for (int task = gw; task < M * 4; task += NGW) {
        const int m = task >> 2, hh = task & 3, b = m >> 13, t = m & (T - 1);
        float m_run = -1e30f, l_run = 0.f, o0 = 0.f, o1 = 0.f;
        for (int gi = 0; gi < 3; ++gi) {
            const int lg = 2 * gi, L = T >> lg, pos = t >> lg, res = t & ((1 << lg) - 1), head = gi * 4 + hh;
            { const unsigned q2 = *(const unsigned*)(pb + (size_t)m * B_COLS + head * 128 + 2 * lane); const float qa = bflo(q2), qb = bfhi(q2);
              LDS_WAIT(); qq[2 * lane] = qa; qq[2 * lane + 1] = qb; LDS_WAIT(); }
            float sv[3];
#pragma unroll
            for (int pass = 0; pass < 3; ++pass) {
                const int rel = -64 + pass * 64 + lane, kp = pos + rel; const bool valid = (pass < 2 || lane == 0) && kp >= 0 && kp < L;
                float s = -1e30f;
                if (valid) { const int kt = (kp << lg) + res; const bf16* krow = pb + (size_t)(b * T + kt) * B_COLS + B_QKV + head * 128;
                    float dot = 0.f;
#pragma unroll
                    for (int c = 0; c < 16; ++c) { const v4u k8 = *(const v4u*)(krow + 8 * c); const f32x4 qa = *(const LAS f32x4*)(qq + 8 * c), qb = *(const LAS f32x4*)(qq + 8 * c + 4);
                        const float k0 = bflo(k8.x), k1 = bfhi(k8.x), k2 = bflo(k8.y), k3 = bfhi(k8.y), k4 = bflo(k8.z), k5 = bfhi(k8.z), k6 = bflo(k8.w), k7 = bfhi(k8.w);
                        dot += qa.x * k0 + qa.y * k1 + qa.z * k2 + qa.w * k3 + qb.x * k4 + qb.y * k5 + qb.z * k6 + qb.w * k7;
                    }
                    s = dot + btab[head * 129 + rel + 64]; }
                sv[pass] = s; }
            const float mg = wave_max(fmaxf(fmaxf(sv[0], sv[1]), sv[2]));
            const float mnew = fmaxf(m_run, mg), alpha = exp2f(m_run - mnew); l_run *= alpha; o0 *= alpha; o1 *= alpha; m_run = mnew;
            float ps = 0.f;
#pragma unroll
            for (int pass = 0; pass < 3; ++pass) { const float p = sv[pass] > -1e29f ? exp2f(sv[pass] - mnew) : 0.f; ps += p; sc[pass * 64 + lane] = p; }
            l_run += wave_sum(ps);
            LDS_WAIT();
#pragma unroll 8
            for (int j = 0; j < 129; ++j) { const int kp = pos + j - 64; const bool ok = kp >= 0 && kp < L; const int kpc = kp < 0 ? 0 : (kp >= L ? L - 1 : kp);
                const float p = ok ? sc[j] : 0.f; const int kt = (kpc << lg) + res;
                const unsigned v2 = *(const unsigned*)(pb + (size_t)(b * T + kt) * B_COLS + 2 * B_QKV + head * 128 + 2 * lane);
                o0 += p * bflo(v2); o1 += p * bfhi(v2); }
        }
        const unsigned g2 = *(const unsigned*)(pb + (size_t)m * B_COLS + 3 * B_QKV + hh * 128 + 2 * lane);
        const float il = 1.f / l_run;
        *(unsigned*)(F.out + (size_t)m * OROW + OS_YB + (hh * 128 + 2 * lane) * 2) = pk2(o0 * il * bflo(g2), o1 * il * bfhi(g2));
    }
}

typedef short v4i16_t __attribute__((ext_vector_type(4)));
typedef float f32x4a __attribute__((ext_vector_type(4)));
constexpr int AT_K = 0, AT_V = 65536, AT_BT = RING_BYTES + 9216 + 1024;
constexpr size_t WS_LSE = WS_Y;
__device__ __forceinline__ void attn_unit_geom(int u, int& b, int& gi, int& hh, int& res, int& blk) {
    const int sub = u & 63; int r = u >> 6; hh = r & 3; r >>= 2; gi = r % 3; b = r / 3;
    if (gi == 0) { res = 0; blk = sub; } else if (gi == 1) { res = sub >> 4; blk = sub & 15; } else { res = sub >> 2; blk = sub & 3; }
}
__device__ __forceinline__ void attn_dma_k(Frame& F, const bf16* pb, int b, int lg, int L, int res, int head, int q0) {
    const int lane = F.lane;
#pragma unroll
    for (int ii = 0; ii < 8; ++ii) { const int i = F.wave * 8 + ii, row = 4 * i + (lane >> 4); int kp = q0 - 64 + row; kp = kp < 0 ? 0 : (kp >= L ? L - 1 : kp);
        const int c = (lane & 15) ^ (row & 15);
        const bf16* src = pb + (size_t)(b * T + (kp << lg) + res) * B_COLS + B_QKV + head * 128 + c * 8;
        __builtin_amdgcn_global_load_lds((const unsigned*)src, (LAS unsigned*)(F.lds + AT_K + i * 1024), 16, 0, 0); }
}
__device__ __forceinline__ void attn_dma_v(Frame& F, const bf16* pb, int b, int lg, int L, int res, int head, int q0) {
    const int lane = F.lane;
#pragma unroll
    for (int jj = 0; jj < 8; ++jj) { const int j = F.wave * 8 + jj, dblk = j >> 4, kgrp = j & 15, key = 16 * kgrp + (lane >> 2); int kp = q0 - 64 + key; kp = kp < 0 ? 0 : (kp >= L ? L - 1 : kp);
        const bf16* src = pb + (size_t)(b * T + (kp << lg) + res) * B_COLS + 2 * B_QKV + head * 128 + dblk * 32 + (lane & 3) * 8;
        __builtin_amdgcn_global_load_lds((const unsigned*)src, (LAS unsigned*)(F.lds + AT_V + dblk * 16384 + kgrp * 1024), 16, 0, 0); }
}
__device__ __forceinline__ void attn_mfma(Frame& F) {
    bf16* pb = (bf16*)(F.ws + WS_R); const float* btab = (const float*)(F.ws + WS_BTAB); float* lse = (float*)(F.ws + WS_LSE);
    int lane = F.lane; asm volatile("" : "+v"(lane));
    const int w = F.wave, qi = lane & 15, g = lane >> 4;
    LAS float* btp = (LAS float*)(F.lds + AT_BT);
    const int NU = NB * 3 * 4 * 64, per = (NU + F.G - 1) / F.G; const int u0 = F.vcu * per, u1 = (u0 + per < NU) ? u0 + per : NU;
    if (u0 >= u1) return;
    int koff[4];
#pragma unroll
    for (int ks = 0; ks < 4; ++ks) koff[ks] = AT_K + w * 4096 + qi * 256 + (((4 * ks + g) ^ qi) << 4);
    const int q4 = qi >> 2, p4 = qi & 3, kr = 4 * g + q4;
    const int voff = AT_V + w * 1024 + (kr >> 3) * 512 + (kr & 7) * 64 + 8 * p4;
    int b, gi, hh, res, blk; attn_unit_geom(u0, b, gi, hh, res, blk);
    { const int lg = 2 * gi; attn_dma_k(F, pb, b, lg, T >> lg, res, gi * 4 + hh, blk * 128); }
    for (int u = u0; u < u1; ++u) {
        attn_unit_geom(u, b, gi, hh, res, blk);
        const int lg = 2 * gi, L = T >> lg, head = gi * 4 + hh, q0 = blk * 128;
        if (F.tid < 176) { const int i = F.tid - 16; btp[F.tid] = (i >= 0 && i <= 128) ? btab[head * 129 + i] : -1e30f; }
        bf16* qrow = pb + (size_t)(b * T + ((q0 + 16 * w + qi) << lg) + res) * B_COLS + head * 128;
        bf16x8 qf[4];
#pragma unroll
        for (int ks = 0; ks < 4; ++ks) qf[ks] = *(const bf16x8*)(qrow + 32 * ks + 8 * g);
        asm volatile("s_waitcnt vmcnt(0) lgkmcnt(0)" ::: "memory"); __builtin_amdgcn_s_barrier(); asm volatile("" ::: "memory");
        attn_dma_v(F, pb, b, lg, L, res, head, q0);
        f32x4a S[9];
#pragma unroll
        for (int kb = 0; kb < 9; ++kb) { S[kb] = (f32x4a){0.f, 0.f, 0.f, 0.f};
#pragma unroll
            for (int ks = 0; ks < 4; ++ks) { const bf16x8 kf = *(const LAS bf16x8*)(F.lds + koff[ks] + kb * 4096);
                S[kb] = __builtin_amdgcn_mfma_f32_16x16x32_bf16(kf, qf[ks], S[kb], 0, 0, 0); } }
        const bool edge = (q0 == 0) || (q0 + 128 >= L);
        float mx = -1e30f;
#pragma unroll
        for (int kb = 0; kb < 9; ++kb)
#pragma unroll
            for (int r = 0; r < 4; ++r) { const int kw = 16 * kb + 4 * g + r; float sv = S[kb][r] + btp[kw - qi + 16];
                if (edge) { const int kp = q0 + 16 * w + kw - 64; if (kp < 0 || kp >= L) sv = -1e30f; }
                S[kb][r] = sv; mx = fmaxf(mx, sv); }
        mx = fmaxf(mx, __shfl_xor(mx, 16)); mx = fmaxf(mx, __shfl_xor(mx, 32));
        float ls = 0.f;
#pragma unroll
        for (int kb = 0; kb < 9; ++kb)
#pragma unroll
            for (int r = 0; r < 4; ++r) { const float p = __builtin_amdgcn_exp2f(S[kb][r] - mx); S[kb][r] = p; ls += p; }
        ls += __shfl_xor(ls, 16); ls += __shfl_xor(ls, 32);
        bf16x8 pf[5];
#pragma unroll
        for (int c = 0; c < 5; ++c) { v4u t; t.x = pg8::cvt_pk_bf16(S[2 * c][0], S[2 * c][1]); t.y = pg8::cvt_pk_bf16(S[2 * c][2], S[2 * c][3]);
            if (c < 4) { t.z = pg8::cvt_pk_bf16(S[2 * c + 1][0], S[2 * c + 1][1]); t.w = pg8::cvt_pk_bf16(S[2 * c + 1][2], S[2 * c + 1][3]); } else { t.z = 0u; t.w = 0u; }
            pf[c] = __builtin_bit_cast(bf16x8, t); }
        asm volatile("s_waitcnt vmcnt(0) lgkmcnt(0)" ::: "memory"); __builtin_amdgcn_s_barrier(); asm volatile("" ::: "memory");
        if (u + 1 < u1) { int b2, gi2, hh2, res2, blk2; attn_unit_geom(u + 1, b2, gi2, hh2, res2, blk2); const int lg2 = 2 * gi2; attn_dma_k(F, pb, b2, lg2, T >> lg2, res2, gi2 * 4 + hh2, blk2 * 128); }
        const float il = 1.f / ls;
#pragma unroll
        for (int db = 0; db < 8; ++db) { f32x4a o = (f32x4a){0.f, 0.f, 0.f, 0.f};
#pragma unroll
            for (int c = 0; c < 5; ++c) { const int off = voff + (db >> 1) * 16384 + (db & 1) * 32 + c * 2048;
                const v4i16_t lo = __builtin_amdgcn_ds_read_tr16_b64_v4i16((LAS v4i16_t*)(F.lds + off));
                const v4i16_t hi = __builtin_amdgcn_ds_read_tr16_b64_v4i16((LAS v4i16_t*)(F.lds + off + (c < 4 ? 1024 : 0)));
                const bf16x8 vf = (bf16x8){lo[0], lo[1], lo[2], lo[3], hi[0], hi[1], hi[2], hi[3]};
                o = __builtin_amdgcn_mfma_f32_16x16x32_bf16(vf, pf[c], o, 0, 0, 0); }
            v2u wv; wv.x = pg8::cvt_pk_bf16(o[0] * il, o[1] * il); wv.y = pg8::cvt_pk_bf16(o[2] * il, o[3] * il);
            *(v2u*)(qrow + 16 * db + 4 * g) = wv; }
        if (g == 0) lse[(size_t)(b * T + ((q0 + 16 * w + qi) << lg) + res) * 12 + head] = mx + __builtin_amdgcn_logf(ls);
    }
    asm volatile("s_waitcnt vmcnt(0) lgkmcnt(0)" ::: "memory"); __builtin_amdgcn_s_barrier();
}
__device__ __forceinline__ void attn_combine(Frame& F) {
    const bf16* pb = (const bf16*)(F.ws + WS_R); const float* lse = (const float*)(F.ws + WS_LSE);
    const int gw = F.vcu * NWAVES + F.wave, NGW = F.G * NWAVES, lane = F.lane, hh = lane >> 4, d0 = (lane & 15) * 8;
    for (int m = gw; m < M; m += NGW) {
        const bf16* row = pb + (size_t)m * B_COLS;
        const float l0 = lse[(size_t)m * 12 + hh], l1 = lse[(size_t)m * 12 + 4 + hh], l2 = lse[(size_t)m * 12 + 8 + hh];
        const float mxl = fmaxf(l0, fmaxf(l1, l2)); float w0 = exp2f(l0 - mxl), w1 = exp2f(l1 - mxl), w2 = exp2f(l2 - mxl); const float iw = 1.f / (w0 + w1 + w2); w0 *= iw; w1 *= iw; w2 *= iw;
        const v4u a = *(const v4u*)(row + hh * 128 + d0), bq = *(const v4u*)(row + (4 + hh) * 128 + d0), c = *(const v4u*)(row + (8 + hh) * 128 + d0), gt = *(const v4u*)(row + 3 * B_QKV + hh * 128 + d0);
        v4u o;
        o.x = pk2((w0 * bflo(a.x) + w1 * bflo(bq.x) + w2 * bflo(c.x)) * bflo(gt.x), (w0 * bfhi(a.x) + w1 * bfhi(bq.x) + w2 * bfhi(c.x)) * bfhi(gt.x));
        o.y = pk2((w0 * bflo(a.y) + w1 * bflo(bq.y) + w2 * bflo(c.y)) * bflo(gt.y), (w0 * bfhi(a.y) + w1 * bfhi(bq.y) + w2 * bfhi(c.y)) * bfhi(gt.y));
        o.z = pk2((w0 * bflo(a.z) + w1 * bflo(bq.z) + w2 * bflo(c.z)) * bflo(gt.z), (w0 * bfhi(a.z) + w1 * bfhi(bq.z) + w2 * bfhi(c.z)) * bfhi(gt.z));
        o.w = pk2((w0 * bflo(a.w) + w1 * bflo(bq.w) + w2 * bflo(c.w)) * bflo(gt.w), (w0 * bfhi(a.w) + w1 * bfhi(bq.w) + w2 * bfhi(c.w)) * bfhi(gt.w));
        *(v4u*)(F.out + (size_t)m * OROW + OS_YB + (hh * 128 + d0) * 2) = o;
    }
}
__device__ __forceinline__ float shift3(const bf16* p0, int col, bool hp, bool hn, float m0, float m1, float mc) {
    const float x0 = bf2f(p0[col]); const float xm = hp ? bf2f(p0[col - A_COLS]) : 0.f; const float xn = hn ? bf2f(p0[col + A_COLS]) : 0.f;
    return x0 * mc + m0 * xm + m1 * xn;
}
__device__ __forceinline__ void rwkv_scan_baseline(Frame& F) {
    if (blockIdx.x >= 2 * NB * A_HEADS) return;
    const int chain = blockIdx.x, d = chain / (NB * A_HEADS), rem = chain % (NB * A_HEADS), b = rem >> 3, hd = rem & 7;
    const bf16* pa = (const bf16*)(F.ws + WS_PA); bf16* ybuf = (bf16*)(F.ws + WS_Y) + (size_t)d * M * A_W; float* bon = (float*)(F.ws + WS_BON) + (size_t)d * M * 8;
    LAS float* SR = (LAS float*)(F.lds);
    LAS float* SW = SR + 2048; LAS float* SK = SW + 2048; LAS float* SV = SK + 2048; LAS float* SA = SV + 2048; LAS float* SB = SA + 2048; LAS float* YST = SB + 2048;
    LAS float* STG = YST + 2048 + F.wave * 128;
    LAS float* W2H = (LAS float*)(F.lds + 65536);
    LAS float* A2H = W2H + 4096;
    const int lane = F.lane, wave = F.wave, j = lane, ch = hd * 64 + j;
    for (int i = F.tid; i < 4096; i += NWAVES * 64) { const int jr = i >> 6, jo = i & 63; W2H[i] = F.w2[((size_t)d * RANK + jr) * A_W + hd * 64 + jo]; A2H[i] = F.a2[((size_t)d * RANK + jr) * A_W + hd * 64 + jo]; }
    const int cr = ch, ck = A_W + ch, cv = 2 * A_W + ch, cw = 4 * A_W + d * RANK + j, ca = 4 * A_W + 2 * RANK + d * RANK + j;
    const float mr0 = F.shift_mu[cr], mr1 = F.shift_mu[A_COLS + cr], mk0 = F.shift_mu[ck], mk1 = F.shift_mu[A_COLS + ck], mv0 = F.shift_mu[cv], mv1 = F.shift_mu[A_COLS + cv];
    const float mw0 = F.shift_mu[cw], mw1 = F.shift_mu[A_COLS + cw], ma0 = F.shift_mu[ca], ma1 = F.shift_mu[A_COLS + ca];
    const float w0j = F.w0[d * A_W + ch], a0j = F.a0[d * A_W + ch], kkj = F.k_k[ch], kaj = F.k_a[ch], rkj = F.r_k[ch];
    const int row = wave * 8 + (lane >> 3), kq = lane & 7;
    float S[8];
#pragma unroll
    for (int e = 0; e < 8; ++e) S[e] = 0.f;
    __syncthreads();
    for (int blk = 0; blk < T / 32; ++blk) {
        for (int q = 0; q < 4; ++q) {
            const int i = q * 8 + wave, s = blk * 32 + i, t = d ? T - 1 - s : s; const bool hp = t > 0, hn = t < T - 1;
            const bf16* p0 = pa + (size_t)(b * T + t) * A_COLS;
            const float rs = shift3(p0, cr, hp, hn, mr0, mr1, 1.f - mr0 - mr1), ks = shift3(p0, ck, hp, hn, mk0, mk1, 1.f - mk0 - mk1), vs = shift3(p0, cv, hp, hn, mv0, mv1, 1.f - mv0 - mv1);
            const float wsv = shift3(p0, cw, hp, hn, mw0, mw1, 1.f - mw0 - mw1), asv = shift3(p0, ca, hp, hn, ma0, ma1, 1.f - ma0 - ma1);
            LDS_WAIT(); STG[j] = tanhf(wsv); STG[64 + j] = asv; LDS_WAIT();
            float wl = w0j, al = a0j;
#pragma unroll 8
            for (int jr = 0; jr < 64; ++jr) { wl += STG[jr] * W2H[jr * 64 + j]; al += STG[64 + jr] * A2H[jr * 64 + j]; }
            const float xneg = -wl, sp = xneg > 20.f ? xneg : log1pf(expf(xneg)); const float wlog = -sp - 0.5f; const float dec = expf(-expf(wlog));
            const float av = 1.f / (1.f + expf(-al));
            const float kkv = ks * kkj; const float nrm = fmaxf(sqrtf(wave_sum(kkv * kkv)), 1e-12f); const float kkn = kkv / nrm;
            const float kd = ks * (1.f + (av - 1.f) * kaj), bd = kkn * av;
            const float bsum = wave_sum(rs * kd * rkj); if (lane == 0) bon[(size_t)(b * T + t) * 8 + hd] = bsum;
            SR[i * 64 + j] = rs; SW[i * 64 + j] = dec; SK[i * 64 + j] = kd; SV[i * 64 + j] = vs; SA[i * 64 + j] = -kkn; SB[i * 64 + j] = bd;
        }
        __syncthreads();
        for (int i = 0; i < 32; ++i) {
            const f32x4 w0 = *(const LAS f32x4*)(SW + i * 64 + 8 * kq), w1 = *(const LAS f32x4*)(SW + i * 64 + 8 * kq + 4);
            const f32x4 a0v = *(const LAS f32x4*)(SA + i * 64 + 8 * kq), a1v = *(const LAS f32x4*)(SA + i * 64 + 8 * kq + 4);
            const f32x4 b0 = *(const LAS f32x4*)(SB + i * 64 + 8 * kq), b1 = *(const LAS f32x4*)(SB + i * 64 + 8 * kq + 4);
            const f32x4 k0 = *(const LAS f32x4*)(SK + i * 64 + 8 * kq), k1 = *(const LAS f32x4*)(SK + i * 64 + 8 * kq + 4);
            const f32x4 r0 = *(const LAS f32x4*)(SR + i * 64 + 8 * kq), r1 = *(const LAS f32x4*)(SR + i * 64 + 8 * kq + 4);
            const float vv = SV[i * 64 + row];
            float sa = (S[0] * a0v.x + S[1] * a0v.y) + (S[2] * a0v.z + S[3] * a0v.w) + (S[4] * a1v.x + S[5] * a1v.y) + (S[6] * a1v.z + S[7] * a1v.w);
            sa += __shfl_xor(sa, 1); sa += __shfl_xor(sa, 2); sa += __shfl_xor(sa, 4);
            S[0] = S[0] * w0.x + (sa * b0.x + vv * k0.x); S[1] = S[1] * w0.y + (sa * b0.y + vv * k0.y); S[2] = S[2] * w0.z + (sa * b0.z + vv * k0.z); S[3] = S[3] * w0.w + (sa * b0.w + vv * k0.w);
            S[4] = S[4] * w1.x + (sa * b1.x + vv * k1.x); S[5] = S[5] * w1.y + (sa * b1.y + vv * k1.y); S[6] = S[6] * w1.z + (sa * b1.z + vv * k1.z); S[7] = S[7] * w1.w + (sa * b1.w + vv * k1.w);
            float y = (S[0] * r0.x + S[1] * r0.y) + (S[2] * r0.z + S[3] * r0.w) + (S[4] * r1.x + S[5] * r1.y) + (S[6] * r1.z + S[7] * r1.w);
            y += __shfl_xor(y, 1); y += __shfl_xor(y, 2); y += __shfl_xor(y, 4);
            if (kq == 0) YST[i * 64 + row] = y;
        }
        __syncthreads();
        { const int idx = F.tid * 4, i = idx >> 6, v0 = idx & 63, s = blk * 32 + i, t = d ? T - 1 - s : s;
          const f32x4 y4 = *(const LAS f32x4*)(YST + idx); v2u w; w.x = pk2(y4.x, y4.y); w.y = pk2(y4.z, y4.w);
          *(v2u*)(ybuf + (size_t)(b * T + t) * A_W + hd * 64 + v0) = w; }
    }
}
__device__ __forceinline__ void rwkv_post_baseline(Frame& F) {
    const bf16* pa = (const bf16*)(F.ws + WS_PA); const bf16* y0 = (const bf16*)(F.ws + WS_Y); const bf16* y1 = y0 + (size_t)M * A_W;
    const float* bon0 = (const float*)(F.ws + WS_BON); const float* bon1 = bon0 + (size_t)M * 8;
    const int gw = F.vcu * NWAVES + F.wave, NGW = F.G * NWAVES, lane = F.lane;
    for (int task = gw; task < M * 8; task += NGW) {
        const int m = task >> 3, hd = task & 7, t = m & (T - 1), ch = hd * 64 + lane; const bool hp = t > 0, hn = t < T - 1;
        const float y = bf2f(y0[(size_t)m * A_W + ch]) + bf2f(y1[(size_t)m * A_W + ch]);
        const float mean = wave_sum(y) * (1.f / 64.f), dv = y - mean, var = wave_sum(dv * dv) * (1.f / 64.f);
        const float yn = dv / sqrtf(var + GN_EPS) * F.lnx_w[ch] + F.lnx_b[ch];
        const float bsum = bon0[(size_t)m * 8 + hd] + bon1[(size_t)m * 8 + hd];
        const bf16* p0 = pa + (size_t)m * A_COLS; const int cv = 2 * A_W + ch, cg = 3 * A_W + ch;
        const float mv0 = F.shift_mu[cv], mv1 = F.shift_mu[A_COLS + cv], mg0 = F.shift_mu[cg], mg1 = F.shift_mu[A_COLS + cg];
        const float vs = shift3(p0, cv, hp, hn, mv0, mv1, 1.f - mv0 - mv1), gs = shift3(p0, cg, hp, hn, mg0, mg1, 1.f - mg0 - mg1);
        const float ya = (yn + bsum * vs) * (gs / (1.f + expf(-gs)));
        *(bf16*)(F.out + (size_t)m * OROW + OS_YA + ch * 2) = (bf16)f2bf(ya);
    }
}

struct Args { const float* in[24]; unsigned char* out; unsigned char* ws; };
__global__ void __launch_bounds__(NWAVES * 64, 2) hybrid_fwd(Args args) {
    extern __shared__ __attribute__((aligned(16))) unsigned char lds[];
    Frame F;
    F.lds = (LAS unsigned char*)lds;
    F.MISC = (volatile LAS unsigned*)(F.lds + MISC_OFF);
    F.tid = threadIdx.x; F.lane = F.tid & 63; F.wave = __builtin_amdgcn_readfirstlane(F.tid >> 6);
    F.G = gridDim.x; { const int bx = blockIdx.x; F.vcu = (F.G % 8 == 0) ? (bx % 8) * (F.G / 8) + bx / 8 : bx; }
    F.xp = args.in[0]; F.xs = args.in[1]; F.cp = args.in[2]; F.cs = args.in[3]; F.rel_bias = args.in[4]; F.norm_w = args.in[5]; F.w_ada = args.in[6]; F.b_ada = args.in[7];
    F.w_in = args.in[8]; F.shift_mu = args.in[9]; F.w0 = args.in[10]; F.w2 = args.in[11]; F.a0 = args.in[12]; F.a2 = args.in[13]; F.k_k = args.in[14]; F.k_a = args.in[15];
    F.r_k = args.in[16]; F.lnx_w = args.in[17]; F.lnx_b = args.in[18]; F.q_gain = args.in[19]; F.k_gain = args.in[20]; F.w_out_a = args.in[21]; F.w_out_b = args.in[22]; F.w_out = args.in[23];
    F.out = args.out; F.ws = args.ws;
    for (int u = F.tid; u < (LDS_BYTES - LDSCTL_OFF) / 4; u += NWAVES * 64) ((LAS unsigned*)(F.lds + LDSCTL_OFF))[u] = 0u;
    __syncthreads();
    XcdBarrier bar = xcd_barrier_post((unsigned*)(F.ws + WS_CTL) + CW_BAR, F.MISC + 8);
#define GRID_BAR() xcd_barrier(bar)
    typedef pg8::bf16_t bt;
    p0a(F); GRID_BAR();
    p0b(F); GRID_BAR();
    { pg8::Gemm g{(const bt*)(F.out + OS_H), (const bt*)(F.ws + WS_WB), nullptr, nullptr, OROW / 2, D}; pg8::Order S; S.init(M, B_COLS, F.G, (int)blockIdx.x, 1);
      pg8::EpiPB E{(bt*)(F.ws + WS_R), F.q_gain, F.k_gain, (LAS float*)(F.lds + EPI_OFF)};
      pg8::gemm_phase<pg8::EpiPB, pg8::Order, true, true>(F.lds + RING_OFF, g, S, E); }
    GRID_BAR();
    attn_mfma(F); GRID_BAR();
    attn_combine(F); GRID_BAR();
    { pg8::Gemm g{(const bt*)(F.out + OS_H), (const bt*)(F.ws + WS_WAG), nullptr, nullptr, OROW / 2, D}; pg8::Order S; S.init(M, AG_COLS, F.G, (int)blockIdx.x, 1);
      pg8::EpiAG E{(bt*)(F.ws + WS_PA), (bt*)(F.ws + WS_PG)};
      pg8::gemm_phase<pg8::EpiAG, pg8::Order, true, true>(F.lds + RING_OFF, g, S, E); }
    GRID_BAR();
    rwkv_scan_baseline(F); GRID_BAR();
    rwkv_post_baseline(F); GRID_BAR();
    { pg8::Gemm g{(const bt*)(F.out + OS_YA), (const bt*)(F.ws + WS_WOA), (const bt*)(F.out + OS_YB), (const bt*)(F.ws + WS_WOB), OROW / 2, A_W}; pg8::Order S; S.init(M, D, F.G, (int)blockIdx.x, 2);
      pg8::EpiMerge E{(const bt*)(F.ws + WS_PG), (bt*)(F.ws + WS_Y)};
      pg8::gemm_phase<pg8::EpiMerge, pg8::Order, true, true>(F.lds + RING_OFF, g, S, E); }
    GRID_BAR();
    { pg8::Gemm g{(const bt*)(F.ws + WS_Y), (const bt*)(F.ws + WS_WO), nullptr, nullptr, D, D}; pg8::Order S; S.init(M, D, F.G, (int)blockIdx.x, 1);
      pg8::EpiOut E{F.xp, F.xs, (const float*)(F.ws + WS_MOD), (float*)F.out};
      pg8::gemm_phase<pg8::EpiOut, pg8::Order, true, true>(F.lds + RING_OFF, g, S, E); }
}

extern "C" void kernel_launch(void* const* d_in, const int* in_sizes, int n_in, void* d_out, int out_size, void* d_ws, size_t ws_size, hipStream_t stream) {
    static int grid = 0;
    if (grid == 0) {
        if (n_in != 24 || out_size != M * D || ws_size < WS_END) { fprintf(stderr, "kernel_launch: unexpected shapes: n_in %d out %d ws %zu (need %zu)\n", n_in, out_size, ws_size, (size_t)WS_END); grid = -1; return; }
        int dev = 0, cus = 0, per_cu = 0;
        if (hipGetDevice(&dev) != hipSuccess || hipDeviceGetAttribute(&cus, hipDeviceAttributeMultiprocessorCount, dev) != hipSuccess) { grid = -1; return; }
        if (hipFuncSetAttribute((const void*)hybrid_fwd, hipFuncAttributeMaxDynamicSharedMemorySize, LDS_BYTES) != hipSuccess) { fprintf(stderr, "kernel_launch: hipFuncSetAttribute failed\n"); grid = -1; return; }
        if (hipOccupancyMaxActiveBlocksPerMultiprocessor(&per_cu, (const void*)hybrid_fwd, NWAVES * 64, LDS_BYTES) != hipSuccess || per_cu < 1) { fprintf(stderr, "kernel_launch: occupancy query says %d\n", per_cu); }
        (void)hipGetLastError();
        grid = cus;
    }
    if (grid < 0) return;
    if (hipMemsetAsync((char*)d_ws + WS_CTL, 0, CTL_ZERO_BYTES, stream) != hipSuccess) return;
    Args a{};
    for (int i = 0; i < 24; ++i) a.in[i] = (const float*)d_in[i];
    a.out = (unsigned char*)d_out; a.ws = (unsigned char*)d_ws;
    hipLaunchKernelGGL(hybrid_fwd, dim3(grid), dim3(NWAVES * 64), LDS_BYTES, stream, a);
}
```

```cpp
#include <hip/hip_runtime.h>
#include <cstdio>
#include <cstdint>
namespace pg8 {
#define PG8_LAS __attribute__((address_space(3)))
typedef unsigned short bf16_t;
typedef short bf16x8 __attribute__((ext_vector_type(8)));
typedef float f32x4 __attribute__((ext_vector_type(4)));
typedef unsigned u32x4 __attribute__((ext_vector_type(4)));
constexpr int BM = 256, BK = 64, HALF = 128, HTB = HALF * BK * 2  , STAGE_BYTES = 8 * HTB, NXCD = 8, WGM = 8;

__host__ __device__ __forceinline__ int lds_byte(int r, int c) { const int st = (r >> 4) * 2 + (c >> 5), rr = r & 15, cc = c & 31, ob = rr * 64 + cc * 2; return st * 1024 + (ob ^ (((ob >> 9) & 1) << 5)); }
__host__ __device__ __forceinline__ void stage_rc(int b, int& R, int& C) { const int st = b / 1024, sb = b % 1024, swz = sb ^ (((sb >> 9) & 1) << 5); R = (st >> 1) * 16 + swz / 64; C = (st & 1) * 32 + (swz % 64) / 2; }
__host__ __device__ __forceinline__ int perm32(int rho) { const int n = rho >> 4, i = rho & 15; return 8 * (i >> 2) + 4 * n + (i & 3); }

struct Unit { int pm, pn, sel; };
struct Gemm { const bf16_t* A0; const bf16_t* B0; const bf16_t* A1; const bf16_t* B1; int lda; int K; };

struct Order {
    int nM, nN, nwg, G, c, CH;
    __host__ __device__ void init(int M, int N, int G_, int c_, int CH_) { nM = M / BM; nN = N / BM; nwg = nM * nN; G = G_; c = c_; CH = CH_; }
    __host__ __device__ bool next(int i, Unit& u) const {
        const int ti = (CH == 2) ? (i >> 1) : i; u.sel = (CH == 2) ? (i & 1) : 0;
        const long L = (long)ti * G + c; if (L >= nwg) return false;
        int wgid = (int)L; { const int q = nwg / NXCD, r = nwg % NXCD, xcd = wgid % NXCD, off = wgid / NXCD; wgid = (xcd < r ? xcd * (q + 1) : r * (q + 1) + (xcd - r) * q) + off; }
        const int nig = WGM * nN, gid = wgid / nig, fm = gid * WGM, gsz = (nM - fm) < WGM ? (nM - fm) : WGM;
        u.pm = fm + ((wgid % nig) % gsz); u.pn = (wgid % nig) / gsz; return true;
    }
};
__device__ __forceinline__ unsigned cvt_pk_bf16(float lo, float hi) { unsigned r; asm volatile("v_cvt_pk_bf16_f32 %0, %1, %2" : "=v"(r) : "v"(lo), "v"(hi)); return r; }
template <class Epi, class Sched, bool ALIGN_EPI = false, bool SP2 = false>
__device__ __forceinline__ void gemm_phase(PG8_LAS unsigned char* lds, const Gemm g, const Sched& S, const Epi& E) {
    int tid = threadIdx.x; asm volatile("" : "+v"(tid));
    const int wid = __builtin_amdgcn_readfirstlane(tid >> 6), lane = tid & 63, wr = wid >> 2, wc = wid & 3, fr = lane & 15, fq = lane >> 4;
    const int K = g.K, nt = K / BK;
    unsigned voffA[2], voffB[2];
#pragma unroll
    for (int i = 0; i < 2; ++i) { int R, C; stage_rc(tid * 16 + i * 8192, R, C); const int Rb = Epi::PERM ? ((R & ~31) + perm32(R & 31)) : R;
        voffA[i] = (unsigned)(R * g.lda + C) * 2u; voffB[i] = (unsigned)(Rb * K + C) * 2u; }
    const size_t kstep = (size_t)(BK * 2);
    const size_t hstepA = (size_t)HALF * g.lda * 2, hstepB = (size_t)HALF * K * 2;
    const size_t tstepA = 2 * hstepA, tstepB = 2 * hstepB;
    const unsigned ldsw = (unsigned)wid * 1024u;
    const int aoff = lds_byte(wr * 64 + fr, fq * 8), boff = lds_byte(wc * 32 + fr, fq * 8);
#define PG8_SA(b, h) (((b) * 2 + (h)) * HTB)
#define PG8_SB(b, h) ((4 + (b) * 2 + (h)) * HTB)
#define PG8_STAGE(bufoff, gbase, voff) do { _Pragma("unroll") for (int _i = 0; _i < 2; ++_i) \
        __builtin_amdgcn_global_load_lds((const unsigned*)((const char*)(gbase) + (voff)[_i]), (PG8_LAS unsigned*)(lds + (bufoff) + ldsw + _i * 8192), 16, 0, 0); } while (0)
#define PG8_LDA(dst, b, h) do { _Pragma("unroll") for (int m = 0; m < 4; ++m) _Pragma("unroll") for (int k = 0; k < 2; ++k) dst[m][k] = *(const PG8_LAS bf16x8*)(lds + PG8_SA(b, h) + aoff + m * 2048 + k * 1024); } while (0)
#define PG8_LDB(dst, b, h) do { _Pragma("unroll") for (int n = 0; n < 2; ++n) _Pragma("unroll") for (int k = 0; k < 2; ++k) dst[n][k] = *(const PG8_LAS bf16x8*)(lds + PG8_SB(b, h) + boff + n * 2048 + k * 1024); } while (0)
#define PG8_MMA(ai, bj, At, Bt) do { __builtin_amdgcn_s_setprio(1); _Pragma("unroll") for (int m = 0; m < 4; ++m) _Pragma("unroll") for (int n = 0; n < 2; ++n) _Pragma("unroll") for (int k = 0; k < 2; ++k) \
        acc[ai][bj][m][n] = __builtin_amdgcn_mfma_f32_16x16x32_bf16(Bt[n][k], At[m][k], acc[ai][bj][m][n], 0, 0, 0); __builtin_amdgcn_s_setprio(0); } while (0)
#define PG8_APTR(u) ((const char*)((u).sel ? g.A1 : g.A0) + (size_t)(u).pm * tstepA)
#define PG8_BPTR(u) ((const char*)((u).sel ? g.B1 : g.B0) + (size_t)(u).pn * tstepB)
#define PG8_WAIT_V(n) asm volatile("s_waitcnt vmcnt(" #n ")" ::: "memory")
#define PG8_WAIT_L(n) asm volatile("s_waitcnt lgkmcnt(" #n ")" ::: "memory")
#define PG8_BAR __builtin_amdgcn_s_barrier()
#define PG8_SCHED __builtin_amdgcn_sched_barrier(0)
    Unit cur, nxt; int ui = 0;
    if (!S.next(0, cur)) return;
    f32x4 acc[2][2][4][2];
#pragma unroll
    for (int a = 0; a < 2; ++a)
#pragma unroll
        for (int b = 0; b < 2; ++b)
#pragma unroll
            for (int m = 0; m < 4; ++m)
#pragma unroll
                for (int n = 0; n < 2; ++n) acc[a][b][m][n] = (f32x4){0.f, 0.f, 0.f, 0.f};
    bf16x8 At[4][2], B0[2][2], B1[2][2];
    const char* cA = PG8_APTR(cur); const char* cB = PG8_BPTR(cur);
    if constexpr (SP2) {
        PG8_STAGE(PG8_SB(0, 0), cB, voffB); PG8_STAGE(PG8_SB(0, 1), cB + hstepB, voffB); PG8_STAGE(PG8_SA(0, 0), cA, voffA); PG8_STAGE(PG8_SA(0, 1), cA + hstepA, voffA);
        if (wr == 1) PG8_BAR;
        PG8_WAIT_V(2); PG8_BAR;
        PG8_STAGE(PG8_SB(1, 0), cB + kstep, voffB); PG8_STAGE(PG8_SA(1, 0), cA + kstep, voffA); PG8_STAGE(PG8_SB(1, 1), cB + hstepB + kstep, voffB);
        PG8_WAIT_V(6); PG8_BAR;
    } else {
        PG8_STAGE(PG8_SB(0, 0), cB, voffB); PG8_STAGE(PG8_SA(0, 0), cA, voffA); PG8_STAGE(PG8_SB(0, 1), cB + hstepB, voffB); PG8_STAGE(PG8_SA(0, 1), cA + hstepA, voffA);
        if (wr == 1) PG8_BAR;
        PG8_WAIT_V(4); PG8_BAR;
        PG8_STAGE(PG8_SB(1, 0), cB + kstep, voffB); PG8_STAGE(PG8_SA(1, 0), cA + kstep, voffA); PG8_STAGE(PG8_SB(1, 1), cB + hstepB + kstep, voffB);
        PG8_WAIT_V(6); PG8_BAR;
    }
    for (;;) {
        const bool has_next = S.next(ui + 1, nxt);
        const char* nA = has_next ? PG8_APTR(nxt) : cA; const char* nB = has_next ? PG8_BPTR(nxt) : cB;
        for (int t = 0; t < nt; t += 2) {
            const bool last = (t == nt - 2);
            const char* a1 = cA + (size_t)(t + 1) * kstep;
            const char* a2 = last ? nA : cA + (size_t)(t + 2) * kstep; const char* b2 = last ? nB : cB + (size_t)(t + 2) * kstep;
            const char* a3 = a2 + kstep; const char* b3 = b2 + kstep;
            if constexpr (SP2) {
            PG8_LDB(B0, 0, 0); PG8_LDB(B1, 0, 1); PG8_SCHED; PG8_LDA(At, 0, 0); PG8_STAGE(PG8_SA(1, 1), a1 + hstepA, voffA);
            PG8_WAIT_V(8); PG8_WAIT_L(0); PG8_BAR; PG8_MMA(0, 0, At, B0); PG8_MMA(0, 1, At, B1); PG8_BAR; PG8_SCHED;
            PG8_LDA(At, 0, 1); PG8_STAGE(PG8_SB(0, 0), b2, voffB); PG8_STAGE(PG8_SB(0, 1), b2 + hstepB, voffB); PG8_STAGE(PG8_SA(0, 0), a2, voffA);
            PG8_WAIT_V(8); PG8_WAIT_L(0); PG8_BAR; PG8_MMA(1, 0, At, B0); PG8_MMA(1, 1, At, B1); PG8_BAR; PG8_SCHED;
            PG8_LDB(B0, 1, 0); PG8_LDB(B1, 1, 1); PG8_SCHED; PG8_LDA(At, 1, 0); PG8_STAGE(PG8_SA(0, 1), a2 + hstepA, voffA);
            PG8_WAIT_V(8); PG8_WAIT_L(0); PG8_BAR; PG8_MMA(0, 0, At, B0); PG8_MMA(0, 1, At, B1); PG8_BAR; PG8_SCHED;
            PG8_LDA(At, 1, 1); PG8_STAGE(PG8_SB(1, 0), b3, voffB); PG8_STAGE(PG8_SB(1, 1), b3 + hstepB, voffB); PG8_STAGE(PG8_SA(1, 0), a3, voffA);
            PG8_WAIT_V(8); PG8_WAIT_L(0); PG8_BAR; PG8_MMA(1, 0, At, B0); PG8_MMA(1, 1, At, B1); PG8_BAR; PG8_SCHED;
            } else {
            PG8_LDB(B0, 0, 0); PG8_SCHED; PG8_LDA(At, 0, 0); PG8_STAGE(PG8_SA(1, 1), a1 + hstepA, voffA);
            PG8_WAIT_L(8); PG8_BAR; PG8_WAIT_L(0); PG8_MMA(0, 0, At, B0); PG8_BAR; PG8_SCHED;
            PG8_LDB(B1, 0, 1); PG8_STAGE(PG8_SB(0, 0), b2, voffB);
            PG8_BAR; PG8_WAIT_L(0); PG8_MMA(0, 1, At, B1); PG8_BAR;
            PG8_LDA(At, 0, 1); PG8_STAGE(PG8_SA(0, 0), a2, voffA);
            PG8_BAR; PG8_WAIT_L(0); PG8_MMA(1, 0, At, B0); PG8_BAR; PG8_SCHED;
            PG8_STAGE(PG8_SB(0, 1), b2 + hstepB, voffB);
            PG8_WAIT_V(6); PG8_BAR; PG8_MMA(1, 1, At, B1); PG8_BAR;
            PG8_LDB(B0, 1, 0); PG8_SCHED; PG8_LDA(At, 1, 0); PG8_STAGE(PG8_SA(0, 1), a2 + hstepA, voffA);
            PG8_WAIT_L(8); PG8_BAR; PG8_WAIT_L(0); PG8_MMA(0, 0, At, B0); PG8_BAR; PG8_SCHED;
            PG8_LDB(B1, 1, 1); PG8_STAGE(PG8_SB(1, 0), b3, voffB);
            PG8_BAR; PG8_WAIT_L(0); PG8_MMA(0, 1, At, B1); PG8_BAR;
            PG8_LDA(At, 1, 1); PG8_STAGE(PG8_SA(1, 0), a3, voffA);
            PG8_BAR; PG8_WAIT_L(0); PG8_MMA(1, 0, At, B0); PG8_BAR; PG8_SCHED;
            PG8_STAGE(PG8_SB(1, 1), b3 + hstepB, voffB);
            PG8_WAIT_V(6); PG8_BAR; PG8_MMA(1, 1, At, B1); PG8_BAR;
            }
        }
        if constexpr (ALIGN_EPI) { if (wr == 0) PG8_BAR; }
        const bool keep = E(acc, cur, wr, wc, fr, fq);
        if (!has_next) break;
        if (!keep) {
#pragma unroll
        for (int a = 0; a < 2; ++a)
#pragma unroll
            for (int b = 0; b < 2; ++b)
#pragma unroll
                for (int m = 0; m < 4; ++m)
#pragma unroll
                    for (int n = 0; n < 2; ++n) acc[a][b][m][n] = (f32x4){0.f, 0.f, 0.f, 0.f};
        }
        cur = nxt; cA = nA; cB = nB; ++ui;
        if constexpr (ALIGN_EPI) { if (wr == 1) PG8_BAR; }
    }
    PG8_WAIT_V(0);
    if constexpr (!ALIGN_EPI) { if (wr == 0) PG8_BAR; }
    PG8_BAR;
#undef PG8_SA
#undef PG8_SB
#undef PG8_STAGE
#undef PG8_LDA
#undef PG8_LDB
#undef PG8_MMA
#undef PG8_APTR
#undef PG8_BPTR
#undef PG8_WAIT_V
#undef PG8_WAIT_L
#undef PG8_BAR
#undef PG8_SCHED
}
}

constexpr int NWAVES = 8;
constexpr int T = 8192, D = 1024, NBP = 8, NBS = 2, NB = NBP + NBS, M = NB * T;
constexpr int A_HEADS = 8, A_HD = 64, A_W = 512, RANK = 64;
constexpr int A_COLS = 2304, B_COLS = 5120, G_COLS = 2048, IN_COLS = 9472, AG_COLS = A_COLS + G_COLS;
constexpr int B_QKV = 1536, B_W = 512, B_HD = 128;
constexpr float RMS_EPS = 1e-6f, GN_EPS = 64e-5f;
constexpr size_t MiB = 1u << 20;
constexpr size_t WS_CTL = 0, CTL_ZERO_BYTES = 65536;
constexpr size_t WS_MOD = 1 * MiB;
constexpr size_t WS_BTAB = 1 * MiB + 128 * 1024;
constexpr size_t WS_WB = 2 * MiB;
constexpr size_t WS_WAG = 12 * MiB;
constexpr size_t WS_WOA = 21 * MiB, WS_WOB = 22 * MiB, WS_WO = 23 * MiB;
constexpr size_t WS_BON = 26 * MiB;
constexpr size_t WS_R = 32 * MiB;
constexpr size_t WS_PA = WS_R, WS_PG = WS_R + 360 * MiB;
constexpr size_t WS_Y = 832 * MiB;
constexpr size_t WS_END = 992 * MiB;
constexpr int CW_BAR = 4096;
constexpr int OS_H = 0, OS_YA = 2048, OS_YB = 3072, OROW = 4096;
constexpr int RING_OFF = 0, RING_BYTES = 131072;
constexpr int LDSCTL_OFF = RING_BYTES, MISC_OFF = LDSCTL_OFF + 320;
constexpr int EPI_OFF = RING_BYTES + 1024;
constexpr int LDS_BYTES = 147456;

#define GAS __attribute__((address_space(1)))
#define LAS __attribute__((address_space(3)))
typedef unsigned short bf16;
typedef unsigned v4u __attribute__((ext_vector_type(4)));
typedef unsigned v2u __attribute__((ext_vector_type(2)));
typedef float f32x4 __attribute__((ext_vector_type(4)));
typedef short bf16x8 __attribute__((ext_vector_type(8)));
typedef GAS unsigned gu32;
#define RLX_AGENT __ATOMIC_RELAXED, __HIP_MEMORY_SCOPE_AGENT
#define LDS_WAIT() asm volatile("s_waitcnt lgkmcnt(0)" ::: "memory")
#define VM_WAIT() asm volatile("s_waitcnt vmcnt(0)" ::: "memory")
__device__ __forceinline__ unsigned f2bf(float f) { unsigned u = __builtin_bit_cast(unsigned, f); return (u + 0x7fffu + ((u >> 16) & 1u)) >> 16; }
__device__ __forceinline__ unsigned pk2(float lo, float hi) { return f2bf(lo) | (f2bf(hi) << 16); }
typedef float f32x2_t __attribute__((ext_vector_type(2))); typedef __bf16 bf16x2_t __attribute__((ext_vector_type(2)));
__device__ __forceinline__ unsigned cvtpk(float lo, float hi) { f32x2_t v = {lo, hi}; bf16x2_t b = __builtin_convertvector(v, bf16x2_t); return __builtin_bit_cast(unsigned, b); }
__device__ __forceinline__ float bf2f(unsigned short h) { return __builtin_bit_cast(float, (unsigned)h << 16); }
__device__ __forceinline__ float bflo(unsigned w) { return __builtin_bit_cast(float, w << 16); }
__device__ __forceinline__ float bfhi(unsigned w) { return __builtin_bit_cast(float, w & 0xffff0000u); }
__device__ __forceinline__ float sigmoidf_(float v) { return __builtin_amdgcn_rcpf(1.f + __expf(-v)); }
__device__ __forceinline__ float siluf_(float v) { return v * sigmoidf_(v); }
__device__ __forceinline__ float wave_sum(float v) {
#pragma unroll
    for (int o = 1; o < 64; o <<= 1) v += __shfl_xor(v, o);
    return v;
}
__device__ __forceinline__ float wave_max(float v) {
#pragma unroll
    for (int o = 1; o < 64; o <<= 1) v = fmaxf(v, __shfl_xor(v, o));
    return v;
}

#define XB_TMO      128
#define XB_XCNT(j)  (256  + 64 * (j))
#define XB_XSUB(j)  (1280 + 64 * (j))
#define XB_XGEN(j)  (2304 + 64 * (j))
#define XB_TOP      3328
#define XB_TOPGEN   3392
#define XCD_BAR_WORDS 3456
#define XB_SPIN_CAP (1u << 22)
__device__ __forceinline__ unsigned xb_ld(unsigned* p)              { return __hip_atomic_load(p, __ATOMIC_RELAXED, __HIP_MEMORY_SCOPE_AGENT); }
__device__ __forceinline__ unsigned xb_add(unsigned* p, unsigned v) { return __hip_atomic_fetch_add(p, v, __ATOMIC_RELAXED, __HIP_MEMORY_SCOPE_AGENT); }
__device__ __forceinline__ unsigned xb_xcc_id() { return (unsigned)__builtin_amdgcn_s_getreg((3 << 11) | 20) & 0xFu; }
#define XB_SPIN(cond, bar) do { unsigned _sp = 0; while (cond) { __builtin_amdgcn_s_sleep(1); \
    if ((++_sp & 255u) == 0u) { if (xb_ld(&(bar)[XB_TMO])) break; if (_sp > XB_SPIN_CAP) { atomicAdd(&(bar)[XB_TMO], 1u); break; } } } } while (0)
struct XcdBarrier { unsigned* bar; unsigned x; volatile LAS unsigned* st; };
__device__ __forceinline__ XcdBarrier xcd_barrier_post(unsigned* bar, volatile LAS unsigned* st) {
    XcdBarrier b; b.bar = bar; b.x = xb_xcc_id(); b.st = st;
    if (threadIdx.x == 0) (void)xb_add(&bar[XB_XCNT(b.x)], 1u);
    return b;
}
__device__ __forceinline__ void xcd_barrier_complete(unsigned* bar, unsigned x, unsigned& nloc, unsigned& nx) {
    const unsigned G = gridDim.x * gridDim.y * gridDim.z;
    unsigned sum, cnt, mine, sp = 0u;
    for (;;) {
        sum = 0u; cnt = 0u; mine = 0u;
#pragma unroll
        for (unsigned j = 0; j < 16; ++j) { const unsigned c = xb_ld(&bar[XB_XCNT(j)]); sum += c; cnt += (c > 0u) ? 1u : 0u; mine = (j == x) ? c : mine; }
        if (sum == G) break;
        __builtin_amdgcn_s_sleep(1);
        if ((++sp & 255u) == 0u) { if (xb_ld(&bar[XB_TMO])) break; if (sp > XB_SPIN_CAP) { atomicAdd(&bar[XB_TMO], 1u); break; } }
    }
    nloc = mine > 0u ? mine : 1u; nx = cnt > 0u ? cnt : 1u;
}
__device__ __forceinline__ void xcd_barrier(const XcdBarrier& b) {
    asm volatile("s_waitcnt vmcnt(0)" ::: "memory");
    __syncthreads();
    if (threadIdx.x == 0) {
        unsigned* bar = b.bar;
        __builtin_amdgcn_s_waitcnt(0);
        unsigned nloc = b.st[0], nx = b.st[1];
        if (nloc == 0u) { xcd_barrier_complete(bar, b.x, nloc, nx); b.st[0] = nloc; b.st[1] = nx; }
        const unsigned old = xb_add(&bar[XB_XSUB(b.x)], 1u);
        const unsigned gen = old / nloc;
        if (old + 1u == (gen + 1u) * nloc) {
            __builtin_amdgcn_fence(__ATOMIC_RELEASE, "agent");
            asm volatile("s_waitcnt vmcnt(0)" ::: "memory");
            const unsigned og = xb_add(&bar[XB_TOP], 1u);
            const unsigned tg = og / nx;
            if (og + 1u == (tg + 1u) * nx) xb_add(&bar[XB_TOPGEN], 1u);
            else XB_SPIN(xb_ld(&bar[XB_TOPGEN]) == tg, bar);
            __builtin_amdgcn_fence(__ATOMIC_ACQUIRE, "agent");
            xb_add(&bar[XB_XGEN(b.x)], 1u);
            asm volatile("s_waitcnt vmcnt(0)" ::: "memory");
        } else {
            XB_SPIN(xb_ld(&bar[XB_XGEN(b.x)]) == gen, bar);
            __builtin_amdgcn_fence(__ATOMIC_ACQUIRE, "agent");
            asm volatile("s_waitcnt vmcnt(0)" ::: "memory");
        }
    }
    __syncthreads();
}

struct Frame {
    LAS unsigned char* lds;
    volatile LAS unsigned* MISC;
    int tid, lane, wave;
    int vcu, G;
    const float *xp, *xs, *cp, *cs, *rel_bias, *norm_w, *w_ada, *b_ada, *w_in, *shift_mu, *w0, *w2, *a0, *a2, *k_k, *k_a, *r_k, *lnx_w, *lnx_b, *q_gain, *k_gain, *w_out_a, *w_out_b, *w_out;
    unsigned char* out;
    unsigned char* ws;
};
__device__ __forceinline__ const float* xrow_ptr(const Frame& F, int m) { return m < NBP * T ? F.xp + (size_t)m * D : F.xs + (size_t)(m - NBP * T) * D; }

namespace pg8 {
struct EpiPB {
    static constexpr bool PERM = true;
    bf16_t* O; const float* qg; const float* kg; PG8_LAS float* P;
    __device__ __forceinline__ bool operator()(f32x4 (&acc)[2][2][4][2], const Unit& u, int wr, int wc, int fr, int fq) const {
        const int row0 = u.pm * BM + wr * 64 + fr, col0 = u.pn * BM + wc * 32 + 8 * fq;
        if (u.pn < 12) {
#pragma unroll
            for (int ai = 0; ai < 2; ++ai)
#pragma unroll
                for (int m = 0; m < 4; ++m) {
#pragma unroll
                    for (int bj = 0; bj < 2; ++bj) { const f32x4 a = acc[ai][bj][m][0], b = acc[ai][bj][m][1];
                        float s = (a[0] * a[0] + a[1] * a[1]) + (a[2] * a[2] + a[3] * a[3]) + (b[0] * b[0] + b[1] * b[1]) + (b[2] * b[2] + b[3] * b[3]);
                        s += __shfl_xor(s, 16); s += __shfl_xor(s, 32);
                        if (fq == 0) P[((ai * HALF + wr * 64 + m * 16 + fr) * 2 + bj) * 4 + wc] = s; }
                    asm volatile("" ::: "memory"); }
            asm volatile("s_waitcnt lgkmcnt(0)" ::: "memory"); __builtin_amdgcn_s_barrier(); asm volatile("" ::: "memory");
            const bool isq = u.pn < 6; const float* gp = (isq ? qg : kg) + wc * 32 + 8 * fq; const float gs = isq ? 0.08838834764831845f * 1.4426950408889634f : 1.f;
            float gn[8];
#pragma unroll
            for (int e = 0; e < 8; ++e) gn[e] = gp[e] * gs;
#pragma unroll
            for (int ai = 0; ai < 2; ++ai)
#pragma unroll
                for (int m = 0; m < 4; ++m)
#pragma unroll
                    for (int bj = 0; bj < 2; ++bj) { const f32x4 p4 = *(const PG8_LAS f32x4*)(P + ((ai * HALF + wr * 64 + m * 16 + fr) * 2 + bj) * 4);
                        const float rs = 1.0f / sqrtf(((p4[0] + p4[1]) + (p4[2] + p4[3])) * (1.f / 128.f) + 1e-6f);
#pragma unroll
                        for (int e = 0; e < 4; ++e) { acc[ai][bj][m][0][e] *= rs * gn[e]; acc[ai][bj][m][1][e] *= rs * gn[4 + e]; }
                        asm volatile("" ::: "memory"); }
        }
        const bool act = u.pn >= 18;
#pragma unroll
        for (int ai = 0; ai < 2; ++ai)
#pragma unroll
            for (int m = 0; m < 4; ++m) { bf16_t* rowp = O + (size_t)(row0 + ai * HALF + m * 16) * B_COLS + col0;
#pragma unroll
                for (int bj = 0; bj < 2; ++bj) { f32x4 v0 = acc[ai][bj][m][0], v1 = acc[ai][bj][m][1];
                    if (act) {
#pragma unroll
                        for (int e = 0; e < 4; ++e) { v0[e] = siluf_(v0[e]); v1[e] = siluf_(v1[e]); } }
                    u32x4 w; w.x = cvt_pk_bf16(v0[0], v0[1]); w.y = cvt_pk_bf16(v0[2], v0[3]); w.z = cvt_pk_bf16(v1[0], v1[1]); w.w = cvt_pk_bf16(v1[2], v1[3]);
                    *(u32x4*)(rowp + bj * HALF) = w; } }
        return false;
    }
};
struct EpiAG {
    static constexpr bool PERM = true;
    bf16_t* PA; bf16_t* PG;
    __device__ __forceinline__ bool operator()(const f32x4 (&acc)[2][2][4][2], const Unit& u, int wr, int wc, int fr, int fq) const {
        const bool isg = u.pn >= 9; bf16_t* base = isg ? PG : PA; const int ldc = isg ? G_COLS : A_COLS; const int pn = isg ? u.pn - 9 : u.pn;
        const int row0 = u.pm * BM + wr * 64 + fr, col0 = pn * BM + wc * 32 + 8 * fq;
#pragma unroll
        for (int ai = 0; ai < 2; ++ai)
#pragma unroll
            for (int m = 0; m < 4; ++m) { bf16_t* rowp = base + (size_t)(row0 + ai * HALF + m * 16) * ldc + col0;
#pragma unroll
                for (int bj = 0; bj < 2; ++bj) { const f32x4 v0 = acc[ai][bj][m][0], v1 = acc[ai][bj][m][1];
                    u32x4 w; w.x = cvt_pk_bf16(v0[0], v0[1]); w.y = cvt_pk_bf16(v0[2], v0[3]); w.z = cvt_pk_bf16(v1[0], v1[1]); w.w = cvt_pk_bf16(v1[2], v1[3]);
                    *(u32x4*)(rowp + bj * HALF) = w; } }
        return false;
    }
};
struct EpiMerge {
    static constexpr bool PERM = true;
    const bf16_t* PG; bf16_t* O;
    __device__ __forceinline__ bool operator()(f32x4 (&acc)[2][2][4][2], const Unit& u, int wr, int wc, int fr, int fq) const {
        const int row0 = u.pm * BM + wr * 64 + fr, col0 = u.pn * BM + wc * 32 + 8 * fq;
#pragma unroll
        for (int ai = 0; ai < 2; ++ai)
#pragma unroll
            for (int m = 0; m < 4; ++m) { const size_t row = (size_t)(row0 + ai * HALF + m * 16);
#pragma unroll
                for (int bj = 0; bj < 2; ++bj) { const int col = col0 + bj * HALF;
                    const u32x4 gb8 = *(const u32x4*)(PG + row * G_COLS + D + col);
                    float zb[8] = {bflo(gb8.x), bfhi(gb8.x), bflo(gb8.y), bfhi(gb8.y), bflo(gb8.z), bfhi(gb8.z), bflo(gb8.w), bfhi(gb8.w)};
                    if (u.sel == 0) {
                        const u32x4 ga8 = *(const u32x4*)(PG + row * G_COLS + col);
                        float za[8] = {bflo(ga8.x), bfhi(ga8.x), bflo(ga8.y), bfhi(ga8.y), bflo(ga8.z), bfhi(ga8.z), bflo(ga8.w), bfhi(ga8.w)};
#pragma unroll
                        for (int e = 0; e < 8; ++e) { const float ea = __expf(-fminf(fmaxf(za[e], -30.f), 30.f)), eb = __expf(-fminf(fmaxf(zb[e], -30.f), 30.f));
                            const float r = (1.f + eb) * __builtin_amdgcn_rcpf(1.f + ea); acc[ai][bj][m][e >> 2][e & 3] *= r; }
                    } else {
                        float o[8];
#pragma unroll
                        for (int e = 0; e < 8; ++e) { const float eb = __expf(-fminf(fmaxf(zb[e], -30.f), 30.f)); o[e] = acc[ai][bj][m][e >> 2][e & 3] * __builtin_amdgcn_rcpf(1.f + eb); }
                        u32x4 w; w.x = cvt_pk_bf16(o[0], o[1]); w.y = cvt_pk_bf16(o[2], o[3]); w.z = cvt_pk_bf16(o[4], o[5]); w.w = cvt_pk_bf16(o[6], o[7]);
                        *(u32x4*)(O + row * D + col) = w;
                    } } }
        return u.sel == 0;
    }
};
struct EpiOut {
    static constexpr bool PERM = false;
    const float* xp; const float* xs; const float* mod; float* out;
    __device__ __forceinline__ bool operator()(const f32x4 (&acc)[2][2][4][2], const Unit& u, int wr, int wc, int fr, int fq) const {
        const int rowt = u.pm * BM, b = rowt >> 13; const float* xb = rowt < NBP * T ? xp + (size_t)rowt * D : xs + (size_t)(rowt - NBP * T) * D;
        const int rl0 = wr * 64 + fr, col0 = u.pn * BM + wc * 32 + 4 * fq; const float* gt = mod + b * 3072 + 2048;
#pragma unroll
        for (int bj = 0; bj < 2; ++bj)
#pragma unroll
            for (int n = 0; n < 2; ++n) { const int col = col0 + bj * HALF + n * 16; const f32x4 g4 = *(const f32x4*)(gt + col);
#pragma unroll
                for (int ai = 0; ai < 2; ++ai)
#pragma unroll
                    for (int m = 0; m < 4; ++m) { const int rl = rl0 + ai * HALF + m * 16; const f32x4 x4 = *(const f32x4*)(xb + (size_t)rl * D + col);
                        *(f32x4*)(out + (size_t)(rowt + rl) * D + col) = x4 + g4 * acc[ai][bj][m][n]; } }
        return false;
    }
};
}

__device__ __forceinline__ void p0_transpose_item(const float* W, int K, int N, bf16* WT, int k0, int n0, int drow0, LAS float* scr, int lane) {
#pragma unroll 8
    for (int i = 0; i < 32; ++i) { const int kk = 2 * i + (lane >> 5); scr[kk * 33 + (lane & 31)] = W[(size_t)(k0 + kk) * N + n0 + (lane & 31)]; }
    LDS_WAIT(); asm volatile("" ::: "memory");
    const int c = lane & 7;
#pragma unroll
    for (int j = 0; j < 4; ++j) { const int n = (lane >> 3) + 8 * j; const LAS float* s = scr + (8 * c) * 33 + n;
        v4u o; o.x = pk2(s[0 * 33], s[1 * 33]); o.y = pk2(s[2 * 33], s[3 * 33]); o.z = pk2(s[4 * 33], s[5 * 33]); o.w = pk2(s[6 * 33], s[7 * 33]);
        *(GAS v4u*)(WT + (size_t)(drow0 + n) * K + k0 + 8 * c) = o; }
    LDS_WAIT(); asm volatile("" ::: "memory");
}
__device__ __forceinline__ int t5_bucket(int rel) {
    const int n = rel < 0 ? -rel : rel; int ret = rel > 0 ? 16 : 0;
    const float lf = logf((float)(n > 1 ? n : 1) / 8.0f) / 4.852030263919617f * 8.0f;
    int large = 8 + (int)lf; large = large < 15 ? large : 15;
    return ret + (n < 8 ? n : large);
}
__device__ __forceinline__ void p0a(Frame& F) {
    float* mod = (float*)(F.ws + WS_MOD);
    if (blockIdx.x < 48) {
        LAS float* sc = (LAS float*)F.lds;
        LAS float* part = (LAS float*)(F.lds + 40960);
        for (int i = F.tid; i < NB * D; i += NWAVES * 64) { const int b = i >> 10, k = i & 1023; const float cv = b < NBP ? F.cp[b * D + k] : F.cs[(b - NBP) * D + k]; sc[i] = siluf_(cv); }
        __syncthreads();
        const int j = blockIdx.x * 64 + F.lane; float a[NB];
#pragma unroll
        for (int b = 0; b < NB; ++b) a[b] = 0.f;
        for (int k = F.wave * 128; k < F.wave * 128 + 128; ++k) { const float w = F.w_ada[(size_t)k * 3072 + j];
#pragma unroll
            for (int b = 0; b < NB; ++b) a[b] += sc[b * D + k] * w; }
#pragma unroll
        for (int b = 0; b < NB; ++b) part[(F.wave * NB + b) * 64 + F.lane] = a[b];
        __syncthreads();
        for (int i = F.tid; i < NB * 64; i += NWAVES * 64) { const int b = i >> 6, l = i & 63; float s = F.b_ada[blockIdx.x * 64 + l];
#pragma unroll
            for (int w = 0; w < NWAVES; ++w) s += part[(w * NB + b) * 64 + l];
            mod[b * 3072 + blockIdx.x * 64 + l] = s; }
        __syncthreads();
    }
    if (blockIdx.x == 255 % gridDim.x) {
        float* bt = (float*)(F.ws + WS_BTAB);
        for (int i = F.tid; i < 12 * 129; i += NWAVES * 64) { const int gh = i / 129, r = i % 129, gi = gh >> 2; const int rel = (r - 64) * (1 << (2 * gi));
            bt[i] = F.rel_bias[t5_bucket(rel) * 12 + gh] * 1.4426950408889634f; }
    }
    LAS float* scr = (LAS float*)(F.lds + RING_OFF + F.wave * 16384);
    const int gw = F.vcu * NWAVES + F.wave, NGW = F.G * NWAVES;
    constexpr int I_IN = (D / 64) * (IN_COLS / 32), I_OA = (A_W / 64) * (D / 32), I_OB = (B_W / 64) * (D / 32), I_O = (D / 64) * (D / 32);
    constexpr int NITEMS = I_IN + I_OA + I_OB + I_O;
    for (int it = gw; it < NITEMS; it += NGW) {
        int r = it;
        if (r < I_IN) { const int nblk = IN_COLS / 32, kb = r / nblk, nb = r % nblk, n0 = nb * 32;
            bf16* dst; int drow;
            if (n0 < A_COLS) { dst = (bf16*)(F.ws + WS_WAG); drow = n0; }
            else if (n0 < A_COLS + B_COLS) { dst = (bf16*)(F.ws + WS_WB); drow = n0 - A_COLS; }
            else { dst = (bf16*)(F.ws + WS_WAG); drow = A_COLS + (n0 - A_COLS - B_COLS); }
            p0_transpose_item(F.w_in, D, IN_COLS, dst, kb * 64, n0, drow, scr, F.lane); continue; }
        r -= I_IN;
        if (r < I_OA) { const int nblk = D / 32, kb = r / nblk, nb = r % nblk; p0_transpose_item(F.w_out_a, A_W, D, (bf16*)(F.ws + WS_WOA), kb * 64, nb * 32, nb * 32, scr, F.lane); continue; }
        r -= I_OA;
        if (r < I_OB) { const int nblk = D / 32, kb = r / nblk, nb = r % nblk; p0_transpose_item(F.w_out_b, B_W, D, (bf16*)(F.ws + WS_WOB), kb * 64, nb * 32, nb * 32, scr, F.lane); continue; }
        r -= I_OB;
        { const int nblk = D / 32, kb = r / nblk, nb = r % nblk; p0_transpose_item(F.w_out, D, D, (bf16*)(F.ws + WS_WO), kb * 64, nb * 32, nb * 32, scr, F.lane); }
    }
}
__device__ __forceinline__ void p0b(Frame& F) {
    const float* mod = (const float*)(F.ws + WS_MOD);
    const int gw = F.vcu * NWAVES + F.wave, NGW = F.G * NWAVES;
    for (int m = gw; m < M; m += NGW) {
        const int b = m >> 13; const f32x4* xr = (const f32x4*)xrow_ptr(F, m) + F.lane;
        f32x4 v[4]; float s = 0.f;
#pragma unroll
        for (int j = 0; j < 4; ++j) { v[j] = xr[64 * j]; s += (v[j].x * v[j].x + v[j].y * v[j].y) + (v[j].z * v[j].z + v[j].w * v[j].w); }
        const float rs = 1.f / sqrtf(wave_sum(s) * (1.f / D) + RMS_EPS);
        v2u* o8 = (v2u*)(F.out + (size_t)m * OROW + OS_H) + F.lane;
#pragma unroll
        for (int j = 0; j < 4; ++j) { const int col = 4 * (F.lane + 64 * j);
            const f32x4 nw = *(const f32x4*)(F.norm_w + col), sh = *(const f32x4*)(mod + b * 3072 + col), sc = *(const f32x4*)(mod + b * 3072 + 1024 + col);
            const f32x4 h = v[j] * rs * nw * (sc + 1.f) + sh;
            v2u w; w.x = pk2(h.x, h.y); w.y = pk2(h.z, h.w); o8[64 * j] = w; }
    }
}
__device__ __forceinline__ void attn_baseline(Frame& F) {
    const bf16* pb = (const bf16*)(F.ws + WS_R); const float* btab = (const float*)(F.ws + WS_BTAB);
    LAS float* qq = (LAS float*)(F.lds + F.wave * 2048);
    LAS float* sc = qq + 128;
    const int gw = F.vcu * NWAVES + F.wave, NGW = F.G * NWAVES, lane = F.lane;
    for (int task = gw; task < M * 4; task += NGW) {
        const int m = task >> 2, hh = task & 3, b = m >> 13, t = m & (T - 1);
        float m_run = -1e30f, l_run = 0.f, o0 = 0.f, o1 = 0.f;
        for (int gi = 0; gi < 3; ++gi) {
            const int lg = 2 * gi, L = T >> lg, pos = t >> lg, res = t & ((1 << lg) - 1), head = gi * 4 + hh;
            { const unsigned q2 = *(const unsigned*)(pb + (size_t)m * B_COLS + head * 128 + 2 * lane); const float qa = bflo(q2), qb = bfhi(q2);
              LDS_WAIT(); qq[2 * lane] = qa; qq[2 * lane + 1] = qb; LDS_WAIT(); }
            float sv[3];
#pragma unroll
            for (int pass = 0; pass < 3; ++pass) {
                const int rel = -64 + pass * 64 + lane, kp = pos + rel; const bool valid = (pass < 2 || lane == 0) && kp >= 0 && kp < L;
                float s = -1e30f;
                if (valid) { const int kt = (kp << lg) + res; const bf16* krow = pb + (size_t)(b * T + kt) * B_COLS + B_QKV + head * 128;
                    float dot = 0.f;
#pragma unroll
                    for (int c = 0; c < 16; ++c) { const v4u k8 = *(const v4u*)(krow + 8 * c); const f32x4 qa = *(const LAS f32x4*)(qq + 8 * c), qb = *(const LAS f32x4*)(qq + 8 * c + 4);
                        const float k0 = bflo(k8.x), k1 = bfhi(k8.x), k2 = bflo(k8.y), k3 = bfhi(k8.y), k4 = bflo(k8.z), k5 = bfhi(k8.z), k6 = bflo(k8.w), k7 = bfhi(k8.w);
                        dot += qa.x * k0 + qa.y * k1 + qa.z * k2 + qa.w * k3 + qb.x * k4 + qb.y * k5 + qb.z * k6 + qb.w * k7;
                    }
                    s = dot + btab[head * 129 + rel + 64]; }
                sv[pass] = s; }
            const float mg = wave_max(fmaxf(fmaxf(sv[0], sv[1]), sv[2]));
            const float mnew = fmaxf(m_run, mg), alpha = exp2f(m_run - mnew); l_run *= alpha; o0 *= alpha; o1 *= alpha; m_run = mnew;
            float ps = 0.f;
#pragma unroll
            for (int pass = 0; pass < 3; ++pass) { const float p = sv[pass] > -1e29f ? exp2f(sv[pass] - mnew) : 0.f; ps += p; sc[pass * 64 + lane] = p; }
            l_run += wave_sum(ps);
            LDS_WAIT();
#pragma unroll 8
            for (int j = 0; j < 129; ++j) { const int kp = pos + j - 64; const bool ok = kp >= 0 && kp < L; const int kpc = kp < 0 ? 0 : (kp >= L ? L - 1 : kp);
                const float p = ok ? sc[j] : 0.f; const int kt = (kpc << lg) + res;
                const unsigned v2 = *(const unsigned*)(pb + (size_t)(b * T + kt) * B_COLS + 2 * B_QKV + head * 128 + 2 * lane);
                o0 += p * bflo(v2); o1 += p * bfhi(v2); }
        }
        const unsigned g2 = *(const unsigned*)(pb + (size_t)m * B_COLS + 3 * B_QKV + hh * 128 + 2 * lane);
        const float il = 1.f / l_run;
        *(unsigned*)(F.out + (size_t)m * OROW + OS_YB + (hh * 128 + 2 * lane) * 2) = pk2(o0 * il * bflo(g2), o1 * il * bfhi(g2));
    }
}

typedef short v4i16_t __attribute__((ext_vector_type(4)));
typedef float f32x4a __attribute__((ext_vector_type(4)));
constexpr int AT_K = 0, AT_V = 65536, AT_BT = RING_BYTES + 9216 + 1024;
constexpr size_t WS_LSE = WS_Y;
__device__ __forceinline__ void attn_unit_geom(int u, int& b, int& gi, int& hh, int& res, int& blk) {
    const int sub = u & 63; int r = u >> 6; hh = r & 3; r >>= 2; gi = r % 3; b = r / 3;
    if (gi == 0) { res = 0; blk = sub; } else if (gi == 1) { res = sub >> 4; blk = sub & 15; } else { res = sub >> 2; blk = sub & 3; }
}
__device__ __forceinline__ void attn_dma_k(Frame& F, const bf16* pb, int b, int lg, int L, int res, int head, int q0) {
    const int lane = F.lane;
#pragma unroll
    for (int ii = 0; ii < 8; ++ii) { const int i = F.wave * 8 + ii, row = 4 * i + (lane >> 4); int kp = q0 - 64 + row; kp = kp < 0 ? 0 : (kp >= L ? L - 1 : kp);
        const int c = (lane & 15) ^ (row & 15);
        const bf16* src = pb + (size_t)(b * T + (kp << lg) + res) * B_COLS + B_QKV + head * 128 + c * 8;
        __builtin_amdgcn_global_load_lds((const unsigned*)src, (LAS unsigned*)(F.lds + AT_K + i * 1024), 16, 0, 0); }
}
__device__ __forceinline__ void attn_dma_v(Frame& F, const bf16* pb, int b, int lg, int L, int res, int head, int q0) {
    const int lane = F.lane;
#pragma unroll
    for (int jj = 0; jj < 8; ++jj) { const int j = F.wave * 8 + jj, dblk = j >> 4, kgrp = j & 15, key = 16 * kgrp + (lane >> 2); int kp = q0 - 64 + key; kp = kp < 0 ? 0 : (kp >= L ? L - 1 : kp);
        const bf16* src = pb + (size_t)(b * T + (kp << lg) + res) * B_COLS + 2 * B_QKV + head * 128 + dblk * 32 + (lane & 3) * 8;
        __builtin_amdgcn_global_load_lds((const unsigned*)src, (LAS unsigned*)(F.lds + AT_V + dblk * 16384 + kgrp * 1024), 16, 0, 0); }
}
__device__ __forceinline__ void attn_mfma(Frame& F) {
    bf16* pb = (bf16*)(F.ws + WS_R); const float* btab = (const float*)(F.ws + WS_BTAB); float* lse = (float*)(F.ws + WS_LSE);
    int lane = F.lane; asm volatile("" : "+v"(lane));
    const int w = F.wave, qi = lane & 15, g = lane >> 4;
    LAS float* btp = (LAS float*)(F.lds + AT_BT);
    const int NU = NB * 3 * 4 * 64, per = (NU + F.G - 1) / F.G; const int u0 = F.vcu * per, u1 = (u0 + per < NU) ? u0 + per : NU;
    if (u0 >= u1) return;
    int koff[4];
#pragma unroll
    for (int ks = 0; ks < 4; ++ks) koff[ks] = AT_K + w * 4096 + qi * 256 + (((4 * ks + g) ^ qi) << 4);
    const int q4 = qi >> 2, p4 = qi & 3, kr = 4 * g + q4;
    const int voff = AT_V + w * 1024 + (kr >> 3) * 512 + (kr & 7) * 64 + 8 * p4;
    int b, gi, hh, res, blk; attn_unit_geom(u0, b, gi, hh, res, blk);
    { const int lg = 2 * gi; attn_dma_k(F, pb, b, lg, T >> lg, res, gi * 4 + hh, blk * 128); }
    for (int u = u0; u < u1; ++u) {
        attn_unit_geom(u, b, gi, hh, res, blk);
        const int lg = 2 * gi, L = T >> lg, head = gi * 4 + hh, q0 = blk * 128;
        if (F.tid < 176) { const int i = F.tid - 16; btp[F.tid] = (i >= 0 && i <= 128) ? btab[head * 129 + i] : -1e30f; }
        bf16* qrow = pb + (size_t)(b * T + ((q0 + 16 * w + qi) << lg) + res) * B_COLS + head * 128;
        bf16x8 qf[4];
#pragma unroll
        for (int ks = 0; ks < 4; ++ks) qf[ks] = *(const bf16x8*)(qrow + 32 * ks + 8 * g);
        asm volatile("s_waitcnt vmcnt(0) lgkmcnt(0)" ::: "memory"); __builtin_amdgcn_s_barrier(); asm volatile("" ::: "memory");
        attn_dma_v(F, pb, b, lg, L, res, head, q0);
        f32x4a S[9];
#pragma unroll
        for (int kb = 0; kb < 9; ++kb) { S[kb] = (f32x4a){0.f, 0.f, 0.f, 0.f};
#pragma unroll
            for (int ks = 0; ks < 4; ++ks) { const bf16x8 kf = *(const LAS bf16x8*)(F.lds + koff[ks] + kb * 4096);
                S[kb] = __builtin_amdgcn_mfma_f32_16x16x32_bf16(kf, qf[ks], S[kb], 0, 0, 0); } }
        const bool edge = (q0 == 0) || (q0 + 128 >= L);
        float mx = -1e30f;
#pragma unroll
        for (int kb = 0; kb < 9; ++kb)
#pragma unroll
            for (int r = 0; r < 4; ++r) { const int kw = 16 * kb + 4 * g + r; float sv = S[kb][r] + btp[kw - qi + 16];
                if (edge) { const int kp = q0 + 16 * w + kw - 64; if (kp < 0 || kp >= L) sv = -1e30f; }
                S[kb][r] = sv; mx = fmaxf(mx, sv); }
        mx = fmaxf(mx, __shfl_xor(mx, 16)); mx = fmaxf(mx, __shfl_xor(mx, 32));
        float ls = 0.f;
#pragma unroll
        for (int kb = 0; kb < 9; ++kb)
#pragma unroll
            for (int r = 0; r < 4; ++r) { const float p = __builtin_amdgcn_exp2f(S[kb][r] - mx); S[kb][r] = p; ls += p; }
        ls += __shfl_xor(ls, 16); ls += __shfl_xor(ls, 32);
        bf16x8 pf[5];
#pragma unroll
        for (int c = 0; c < 5; ++c) { v4u t; t.x = cvtpk(S[2 * c][0], S[2 * c][1]); t.y = cvtpk(S[2 * c][2], S[2 * c][3]);
            if (c < 4) { t.z = cvtpk(S[2 * c + 1][0], S[2 * c + 1][1]); t.w = cvtpk(S[2 * c + 1][2], S[2 * c + 1][3]); } else { t.z = 0u; t.w = 0u; }
            pf[c] = __builtin_bit_cast(bf16x8, t); }
        asm volatile("s_waitcnt vmcnt(0) lgkmcnt(0)" ::: "memory"); __builtin_amdgcn_s_barrier(); asm volatile("" ::: "memory");
        if (u + 1 < u1) { int b2, gi2, hh2, res2, blk2; attn_unit_geom(u + 1, b2, gi2, hh2, res2, blk2); const int lg2 = 2 * gi2; attn_dma_k(F, pb, b2, lg2, T >> lg2, res2, gi2 * 4 + hh2, blk2 * 128); }
        const float il = 1.f / ls;
#pragma unroll
        for (int db = 0; db < 8; ++db) { f32x4a o = (f32x4a){0.f, 0.f, 0.f, 0.f};
#pragma unroll
            for (int c = 0; c < 5; ++c) { const int off = voff + (db >> 1) * 16384 + (db & 1) * 32 + c * 2048;
                const v4i16_t lo = __builtin_amdgcn_ds_read_tr16_b64_v4i16((LAS v4i16_t*)(F.lds + off));
                const v4i16_t hi = __builtin_amdgcn_ds_read_tr16_b64_v4i16((LAS v4i16_t*)(F.lds + off + (c < 4 ? 1024 : 0)));
                const bf16x8 vf = (bf16x8){lo[0], lo[1], lo[2], lo[3], hi[0], hi[1], hi[2], hi[3]};
                o = __builtin_amdgcn_mfma_f32_16x16x32_bf16(vf, pf[c], o, 0, 0, 0); }
            v2u wv; wv.x = cvtpk(o[0] * il, o[1] * il); wv.y = cvtpk(o[2] * il, o[3] * il);
            *(v2u*)(qrow + 16 * db + 4 * g) = wv; }
        if (g == 0) lse[(size_t)(b * T + ((q0 + 16 * w + qi) << lg) + res) * 12 + head] = mx + __builtin_amdgcn_logf(ls);
    }
    asm volatile("s_waitcnt vmcnt(0) lgkmcnt(0)" ::: "memory"); __builtin_amdgcn_s_barrier();
}
__device__ __forceinline__ void attn_combine(Frame& F) {
    const bf16* pb = (const bf16*)(F.ws + WS_R); const float* lse = (const float*)(F.ws + WS_LSE);
    const int gw = F.vcu * NWAVES + F.wave, NGW = F.G * NWAVES, lane = F.lane, hh = lane >> 4, d0 = (lane & 15) * 8;
    for (int m = gw; m < M; m += NGW) {
        const bf16* row = pb + (size_t)m * B_COLS;
        const float l0 = lse[(size_t)m * 12 + hh], l1 = lse[(size_t)m * 12 + 4 + hh], l2 = lse[(size_t)m * 12 + 8 + hh];
        const float mxl = fmaxf(l0, fmaxf(l1, l2)); float w0 = exp2f(l0 - mxl), w1 = exp2f(l1 - mxl), w2 = exp2f(l2 - mxl); const float iw = 1.f / (w0 + w1 + w2); w0 *= iw; w1 *= iw; w2 *= iw;
        const v4u a = *(const v4u*)(row + hh * 128 + d0), bq = *(const v4u*)(row + (4 + hh) * 128 + d0), c = *(const v4u*)(row + (8 + hh) * 128 + d0), gt = *(const v4u*)(row + 3 * B_QKV + hh * 128 + d0);
        v4u o;
        o.x = pk2((w0 * bflo(a.x) + w1 * bflo(bq.x) + w2 * bflo(c.x)) * bflo(gt.x), (w0 * bfhi(a.x) + w1 * bfhi(bq.x) + w2 * bfhi(c.x)) * bfhi(gt.x));
        o.y = pk2((w0 * bflo(a.y) + w1 * bflo(bq.y) + w2 * bflo(c.y)) * bflo(gt.y), (w0 * bfhi(a.y) + w1 * bfhi(bq.y) + w2 * bfhi(c.y)) * bfhi(gt.y));
        o.z = pk2((w0 * bflo(a.z) + w1 * bflo(bq.z) + w2 * bflo(c.z)) * bflo(gt.z), (w0 * bfhi(a.z) + w1 * bfhi(bq.z) + w2 * bfhi(c.z)) * bfhi(gt.z));
        o.w = pk2((w0 * bflo(a.w) + w1 * bflo(bq.w) + w2 * bflo(c.w)) * bflo(gt.w), (w0 * bfhi(a.w) + w1 * bfhi(bq.w) + w2 * bfhi(c.w)) * bfhi(gt.w));
        *(v4u*)(F.out + (size_t)m * OROW + OS_YB + (hh * 128 + d0) * 2) = o;
    }
}
__device__ __forceinline__ float shift3(const bf16* p0, int col, bool hp, bool hn, float m0, float m1, float mc) {
    const float x0 = bf2f(p0[col]); const float xm = hp ? bf2f(p0[col - A_COLS]) : 0.f; const float xn = hn ? bf2f(p0[col + A_COLS]) : 0.f;
    return x0 * mc + m0 * xm + m1 * xn;
}
__device__ __forceinline__ void rwkv_scan_baseline(Frame& F) {
    if (blockIdx.x >= 2 * NB * A_HEADS) return;
    const int chain = blockIdx.x, d = chain / (NB * A_HEADS), rem = chain % (NB * A_HEADS), b = rem >> 3, hd = rem & 7;
    const bf16* pa = (const bf16*)(F.ws + WS_PA); bf16* ybuf = (bf16*)(F.ws + WS_Y) + (size_t)d * M * A_W; float* bon = (float*)(F.ws + WS_BON) + (size_t)d * M * 8;
    LAS float* SR = (LAS float*)(F.lds);
    LAS float* SW = SR + 2048; LAS float* SK = SW + 2048; LAS float* SV = SK + 2048; LAS float* SA = SV + 2048; LAS float* SB = SA + 2048; LAS float* YST = SB + 2048;
    LAS float* STG = YST + 2048 + F.wave * 128;
    LAS float* W2H = (LAS float*)(F.lds + 65536);
    LAS float* A2H = W2H + 4096;
    const int lane = F.lane, wave = F.wave, j = lane, ch = hd * 64 + j;
    for (int i = F.tid; i < 4096; i += NWAVES * 64) { const int jr = i >> 6, jo = i & 63; W2H[i] = F.w2[((size_t)d * RANK + jr) * A_W + hd * 64 + jo]; A2H[i] = F.a2[((size_t)d * RANK + jr) * A_W + hd * 64 + jo]; }
    const int cr = ch, ck = A_W + ch, cv = 2 * A_W + ch, cw = 4 * A_W + d * RANK + j, ca = 4 * A_W + 2 * RANK + d * RANK + j;
    const float mr0 = F.shift_mu[cr], mr1 = F.shift_mu[A_COLS + cr], mk0 = F.shift_mu[ck], mk1 = F.shift_mu[A_COLS + ck], mv0 = F.shift_mu[cv], mv1 = F.shift_mu[A_COLS + cv];
    const float mw0 = F.shift_mu[cw], mw1 = F.shift_mu[A_COLS + cw], ma0 = F.shift_mu[ca], ma1 = F.shift_mu[A_COLS + ca];
    const float w0j = F.w0[d * A_W + ch], a0j = F.a0[d * A_W + ch], kkj = F.k_k[ch], kaj = F.k_a[ch], rkj = F.r_k[ch];
    const int row = wave * 8 + (lane >> 3), kq = lane & 7;
    float S[8];
#pragma unroll
    for (int e = 0; e < 8; ++e) S[e] = 0.f;
    __syncthreads();
    for (int blk = 0; blk < T / 32; ++blk) {
        for (int q = 0; q < 4; ++q) {
            const int i = q * 8 + wave, s = blk * 32 + i, t = d ? T - 1 - s : s; const bool hp = t > 0, hn = t < T - 1;
            const bf16* p0 = pa + (size_t)(b * T + t) * A_COLS;
            const float rs = shift3(p0, cr, hp, hn, mr0, mr1, 1.f - mr0 - mr1), ks = shift3(p0, ck, hp, hn, mk0, mk1, 1.f - mk0 - mk1), vs = shift3(p0, cv, hp, hn, mv0, mv1, 1.f - mv0 - mv1);
            const float wsv = shift3(p0, cw, hp, hn, mw0, mw1, 1.f - mw0 - mw1), asv = shift3(p0, ca, hp, hn, ma0, ma1, 1.f - ma0 - ma1);
            LDS_WAIT(); STG[j] = tanhf(wsv); STG[64 + j] = asv; LDS_WAIT();
            float wl = w0j, al = a0j;
#pragma unroll 8
            for (int jr = 0; jr < 64; ++jr) { wl += STG[jr] * W2H[jr * 64 + j]; al += STG[64 + jr] * A2H[jr * 64 + j]; }
            const float xneg = -wl, sp = xneg > 20.f ? xneg : log1pf(expf(xneg)); const float wlog = -sp - 0.5f; const float dec = expf(-expf(wlog));
            const float av = 1.f / (1.f + expf(-al));
            const float kkv = ks * kkj; const float nrm = fmaxf(sqrtf(wave_sum(kkv * kkv)), 1e-12f); const float kkn = kkv / nrm;
            const float kd = ks * (1.f + (av - 1.f) * kaj), bd = kkn * av;
            const float bsum = wave_sum(rs * kd * rkj); if (lane == 0) bon[(size_t)(b * T + t) * 8 + hd] = bsum;
            SR[i * 64 + j] = rs; SW[i * 64 + j] = dec; SK[i * 64 + j] = kd; SV[i * 64 + j] = vs; SA[i * 64 + j] = -kkn; SB[i * 64 + j] = bd;
        }
        __syncthreads();
        for (int i = 0; i < 32; ++i) {
            const f32x4 w0 = *(const LAS f32x4*)(SW + i * 64 + 8 * kq), w1 = *(const LAS f32x4*)(SW + i * 64 + 8 * kq + 4);
            const f32x4 a0v = *(const LAS f32x4*)(SA + i * 64 + 8 * kq), a1v = *(const LAS f32x4*)(SA + i * 64 + 8 * kq + 4);
            const f32x4 b0 = *(const LAS f32x4*)(SB + i * 64 + 8 * kq), b1 = *(const LAS f32x4*)(SB + i * 64 + 8 * kq + 4);
            const f32x4 k0 = *(const LAS f32x4*)(SK + i * 64 + 8 * kq), k1 = *(const LAS f32x4*)(SK + i * 64 + 8 * kq + 4);
            const f32x4 r0 = *(const LAS f32x4*)(SR + i * 64 + 8 * kq), r1 = *(const LAS f32x4*)(SR + i * 64 + 8 * kq + 4);
            const float vv = SV[i * 64 + row];
            float sa = (S[0] * a0v.x + S[1] * a0v.y) + (S[2] * a0v.z + S[3] * a0v.w) + (S[4] * a1v.x + S[5] * a1v.y) + (S[6] * a1v.z + S[7] * a1v.w);
            sa += __shfl_xor(sa, 1); sa += __shfl_xor(sa, 2); sa += __shfl_xor(sa, 4);
            S[0] = S[0] * w0.x + (sa * b0.x + vv * k0.x); S[1] = S[1] * w0.y + (sa * b0.y + vv * k0.y); S[2] = S[2] * w0.z + (sa * b0.z + vv * k0.z); S[3] = S[3] * w0.w + (sa * b0.w + vv * k0.w);
            S[4] = S[4] * w1.x + (sa * b1.x + vv * k1.x); S[5] = S[5] * w1.y + (sa * b1.y + vv * k1.y); S[6] = S[6] * w1.z + (sa * b1.z + vv * k1.z); S[7] = S[7] * w1.w + (sa * b1.w + vv * k1.w);
            float y = (S[0] * r0.x + S[1] * r0.y) + (S[2] * r0.z + S[3] * r0.w) + (S[4] * r1.x + S[5] * r1.y) + (S[6] * r1.z + S[7] * r1.w);
            y += __shfl_xor(y, 1); y += __shfl_xor(y, 2); y += __shfl_xor(y, 4);
            if (kq == 0) YST[i * 64 + row] = y;
        }
        __syncthreads();
        { const int idx = F.tid * 4, i = idx >> 6, v0 = idx & 63, s = blk * 32 + i, t = d ? T - 1 - s : s;
          const f32x4 y4 = *(const LAS f32x4*)(YST + idx); v2u w; w.x = pk2(y4.x, y4.y); w.y = pk2(y4.z, y4.w);
          *(v2u*)(ybuf + (size_t)(b * T + t) * A_W + hd * 64 + v0) = w; }
    }
}

typedef float f32x4r __attribute__((ext_vector_type(4)));
constexpr int RS = 144, RM = 64 * RS;
constexpr int R_AT = 0 * RM, R_RT = 1 * RM, R_BW = 2 * RM, R_KU = 3 * RM, R_BT = 4 * RM, R_KT = 5 * RM, R_VT = 6 * RM, R_AAB = 7 * RM, R_AAK = 8 * RM, R_ARB = 9 * RM, R_ARK = 10 * RM, R_HT = 11 * RM;
constexpr int R_W2T = 12 * RM, R_A2T = 13 * RM;
constexpr int R_WLF = R_AAB, R_ALF = R_ARB, FS = 272;
constexpr int R_TI = 132096, TIS = 48, R_PC = R_TI + 3072, R_BLK = R_PC + 256;
__device__ __forceinline__ bf16x8 ldfrag(LAS unsigned char* lds, int mat, int row0, int k0, int r, int g) { return *(const LAS bf16x8*)(lds + mat + (row0 + r) * RS + (k0 + 8 * g) * 2); }
__device__ __forceinline__ void storeT(LAS unsigned char* lds, int mat, const f32x4r& d, int row0, int col0, int r, int g) {
    v2u w; w.x = cvtpk(d[0], d[1]); w.y = cvtpk(d[2], d[3]); *(LAS v2u*)(lds + mat + (col0 + r) * RS + (row0 + 4 * g) * 2) = w; }
__device__ __forceinline__ bf16x8 pack2(const f32x4r& a, const f32x4r& b) { v4u t; t.x = cvtpk(a[0], a[1]); t.y = cvtpk(a[2], a[3]); t.z = cvtpk(b[0], b[1]); t.w = cvtpk(b[2], b[3]); return __builtin_bit_cast(bf16x8, t); }
__device__ __forceinline__ bf16x8 pack1(const f32x4r& a) { v4u t; t.x = cvtpk(a[0], a[1]); t.y = cvtpk(a[2], a[3]); t.z = 0u; t.w = 0u; return __builtin_bit_cast(bf16x8, t); }
__device__ __forceinline__ bf16x8 ld2x4(LAS unsigned char* lds, int off0, int off1) { const v2u a = *(const LAS v2u*)(lds + off0), b = *(const LAS v2u*)(lds + off1); v4u t; t.x = a.x; t.y = a.y; t.z = b.x; t.w = b.y; return __builtin_bit_cast(bf16x8, t); }
#define MF16(a, b, c) __builtin_amdgcn_mfma_f32_16x16x32_bf16((a), (b), (c), 0, 0, 0)
#define WGBAR() do { asm volatile("s_waitcnt lgkmcnt(0)" ::: "memory"); __builtin_amdgcn_s_barrier(); asm volatile("" ::: "memory"); } while (0)
__device__ __forceinline__ void rwkv_chunked(Frame& F) {
    if (blockIdx.x >= 2 * NB * A_HEADS) return;
    const int chain = blockIdx.x, d = chain / (NB * A_HEADS), rem = chain % (NB * A_HEADS), b = rem >> 3, hd = rem & 7;
    const bf16* pa = (const bf16*)(F.ws + WS_PA); bf16* ybuf = (bf16*)(F.ws + WS_Y) + (size_t)d * M * A_W; float* bon = (float*)(F.ws + WS_BON) + (size_t)d * M * 8;
    LAS unsigned char* L = F.lds;
    int lane = F.lane; asm volatile("" : "+v"(lane));
    const int w = F.wave, j = lane, ch = hd * 64 + j;
    int r, g;
#define RELANE() do { int ln_ = lane; asm volatile("" : "+v"(ln_)); r = ln_ & 15; g = ln_ >> 4; } while (0)
    for (int i = F.tid; i < 4096; i += NWAVES * 64) { const int jo = i >> 6, jr = i & 63;
        *(LAS bf16*)(L + R_W2T + jo * RS + jr * 2) = (bf16)f2bf(F.w2[((size_t)d * RANK + jr) * A_W + hd * 64 + jo]);
        *(LAS bf16*)(L + R_A2T + jo * RS + jr * 2) = (bf16)f2bf(F.a2[((size_t)d * RANK + jr) * A_W + hd * 64 + jo]); }
    for (int i = F.tid; i < RM / 4; i += NWAVES * 64) ((LAS unsigned*)(L + R_HT))[i] = 0u;
    const int cr = ch, ck = A_W + ch, cv = 2 * A_W + ch, cw = 4 * A_W + d * RANK + j, ca = 4 * A_W + 2 * RANK + d * RANK + j;
    const float mr0 = F.shift_mu[cr], mr1 = F.shift_mu[A_COLS + cr], mk0 = F.shift_mu[ck], mk1 = F.shift_mu[A_COLS + ck], mv0 = F.shift_mu[cv], mv1 = F.shift_mu[A_COLS + cv];
    const float mw0 = F.shift_mu[cw], mw1 = F.shift_mu[A_COLS + cw], ma0 = F.shift_mu[ca], ma1 = F.shift_mu[A_COLS + ca];
    const float w0j = F.w0[d * A_W + ch], a0j = F.a0[d * A_W + ch], kkj = F.k_k[ch], kaj = F.k_a[ch], rkj = F.r_k[ch];
    const int vt = w & 3;
    f32x4r Hs[4];
#pragma unroll
    for (int i = 0; i < 4; ++i) Hs[i] = (f32x4r){0.f, 0.f, 0.f, 0.f};
    WGBAR();
    for (int c = 0; c < T / 64; ++c) {
        float rs[8], ks[8], vs[8], kn[8];
        { const int tlo = d ? T - 1 - (c * 64 + 8 * w + 7) : c * 64 + 8 * w;
          float xr[10], xk[10], xv[10], xw[10], xa[10];
#pragma unroll
          for (int k = 0; k < 10; ++k) { const int tk = tlo - 1 + k; const bool ok = tk >= 0 && tk < T; const bf16* p0 = pa + (size_t)(b * T + (ok ? tk : tlo)) * A_COLS;
              const float zr = bf2f(p0[cr]), zk = bf2f(p0[ck]), zv = bf2f(p0[cv]), zw = bf2f(p0[cw]), za = bf2f(p0[ca]);
              xr[k] = ok ? zr : 0.f; xk[k] = ok ? zk : 0.f; xv[k] = ok ? zv : 0.f; xw[k] = ok ? zw : 0.f; xa[k] = ok ? za : 0.f; }
#pragma unroll
          for (int q = 0; q < 8; ++q) { const int i = 8 * w + q;
#define SH3(x, m0, m1) (d ? ((x)[8 - q] * (1.f - (m0) - (m1)) + (m0) * (x)[7 - q] + (m1) * (x)[9 - q]) : ((x)[q + 1] * (1.f - (m0) - (m1)) + (m0) * (x)[q] + (m1) * (x)[q + 2]))
              rs[q] = SH3(xr, mr0, mr1); ks[q] = SH3(xk, mk0, mk1); vs[q] = SH3(xv, mv0, mv1);
              const float wsv = SH3(xw, mw0, mw1), asv = SH3(xa, ma0, ma1);
#undef SH3
              *(LAS bf16*)(L + R_BW + i * RS + j * 2) = (bf16)f2bf(tanhf(wsv)); *(LAS bf16*)(L + R_KU + i * RS + j * 2) = (bf16)f2bf(asv);
              const float kkv = ks[q] * kkj; const float nrm = fmaxf(sqrtf(wave_sum(kkv * kkv)), 1e-12f); kn[q] = kkv / nrm; } }
        WGBAR();
        RELANE();
        { const int it = w >> 1;
          bf16x8 ta[2], aa[2];
#pragma unroll
          for (int k2 = 0; k2 < 2; ++k2) { ta[k2] = ldfrag(L, R_BW, 16 * it, 32 * k2, r, g); aa[k2] = ldfrag(L, R_KU, 16 * it, 32 * k2, r, g); }
#pragma unroll
          for (int j2 = 0; j2 < 2; ++j2) { const int jt = 2 * (w & 1) + j2; f32x4r dw = (f32x4r){0.f, 0.f, 0.f, 0.f}, da = dw;
#pragma unroll
              for (int k2 = 0; k2 < 2; ++k2) { dw = MF16(ta[k2], ldfrag(L, R_W2T, 16 * jt, 32 * k2, r, g), dw); da = MF16(aa[k2], ldfrag(L, R_A2T, 16 * jt, 32 * k2, r, g), da); }
#pragma unroll
              for (int e = 0; e < 4; ++e) { *(LAS float*)(L + R_WLF + (16 * it + 4 * g + e) * FS + (16 * jt + r) * 4) = dw[e]; *(LAS float*)(L + R_ALF + (16 * it + 4 * g + e) * FS + (16 * jt + r) * 4) = da[e]; } } }
        WGBAR();
        float lw[8], av[8], cl[8]; float run = 0.f;
#pragma unroll
        for (int q = 0; q < 8; ++q) { const int i = 8 * w + q; const float wl = w0j + *(const LAS float*)(L + R_WLF + i * FS + j * 4), al = a0j + *(const LAS float*)(L + R_ALF + i * FS + j * 4);
            const float xneg = -wl, sp = xneg > 20.f ? xneg : log1pf(__expf(xneg)); lw[q] = -__expf(-sp - 0.5f); av[q] = 1.f / (1.f + __expf(-al)); run += lw[q]; cl[q] = run; }
        *(LAS float*)(L + R_BLK + (w * 64 + j) * 4) = run;
        WGBAR();
        { float off = 0.f, tot = 0.f;
#pragma unroll
          for (int w2 = 0; w2 < 8; ++w2) { const float bt = *(const LAS float*)(L + R_BLK + (w2 * 64 + j) * 4); off += (w2 < w) ? bt : 0.f; tot += bt; }
          if (w == 0) *(LAS float*)(L + R_PC + j * 4) = __expf(tot);
          unsigned bt8[8], kt8[8], vt8[8];
#pragma unroll
          for (int q = 0; q < 8; ++q) { const int i = 8 * w + q, s = c * 64 + i, t = d ? T - 1 - s : s; const float cq = off + cl[q];
              const float kd = ks[q] * (1.f + (av[q] - 1.f) * kaj), bd = kn[q] * av[q];
              const float bsum = wave_sum(rs[q] * kd * rkj); if (lane == 0) bon[(size_t)(b * T + t) * 8 + hd] = bsum;
              const float ep = __expf(cq), em = __expf(-cq), ex = __expf(cq - lw[q]);
              const unsigned at = f2bf(-kn[q] * ex), rt = f2bf(rs[q] * ep); bt8[q] = f2bf(bd * em); kt8[q] = f2bf(kd * em); vt8[q] = f2bf(vs[q]);
              *(LAS bf16*)(L + R_AT + i * RS + j * 2) = (bf16)at; *(LAS bf16*)(L + R_RT + i * RS + j * 2) = (bf16)rt;
              *(LAS bf16*)(L + R_BW + i * RS + j * 2) = (bf16)bt8[q]; *(LAS bf16*)(L + R_KU + i * RS + j * 2) = (bf16)kt8[q]; }
          v4u o; o.x = bt8[0] | (bt8[1] << 16); o.y = bt8[2] | (bt8[3] << 16); o.z = bt8[4] | (bt8[5] << 16); o.w = bt8[6] | (bt8[7] << 16); *(LAS v4u*)(L + R_BT + j * RS + 16 * w) = o;
          o.x = kt8[0] | (kt8[1] << 16); o.y = kt8[2] | (kt8[3] << 16); o.z = kt8[4] | (kt8[5] << 16); o.w = kt8[6] | (kt8[7] << 16); *(LAS v4u*)(L + R_KT + j * RS + 16 * w) = o;
          o.x = vt8[0] | (vt8[1] << 16); o.y = vt8[2] | (vt8[3] << 16); o.z = vt8[4] | (vt8[5] << 16); o.w = vt8[6] | (vt8[7] << 16); *(LAS v4u*)(L + R_VT + j * RS + 16 * w) = o; }
        WGBAR();
        RELANE();
        { const int mat = w >> 1, p = w & 1; const int ym = (mat & 1) ? R_KU : R_BW, xm = (mat & 2) ? R_RT : R_AT, dm = R_AAB + mat * RM; const bool incl = mat >= 2;
#pragma unroll
          for (int i = 0; i < 8; ++i) { const int ts = (i >> 2) ? 3 - p : p, tt = i & 3; f32x4r dd = (f32x4r){0.f, 0.f, 0.f, 0.f};
              if (ts <= tt) {
#pragma unroll
                  for (int k2 = 0; k2 < 2; ++k2) dd = MF16(ldfrag(L, ym, 16 * ts, 32 * k2, r, g), ldfrag(L, xm, 16 * tt, 32 * k2, r, g), dd);
                  if (ts == tt) {
#pragma unroll
                      for (int e = 0; e < 4; ++e) { const int sl = 4 * g + e; if (incl ? (sl > r) : (sl >= r)) dd[e] = 0.f; } } }
              storeT(L, dm, dd, 16 * ts, 16 * tt, r, g); } }
        WGBAR();
        RELANE();
        f32x4r Ya[4], Ua[4], KV[4];
        if (w == 0) {
            const int blk = lane >> 4, cc = lane & 15; float tc[16];
#pragma unroll
            for (int rr = 0; rr < 16; ++rr) { float acc = (rr == cc) ? 1.f : 0.f;
                if (rr > 0) { const v4u a0 = *(const LAS v4u*)(L + R_AAB + (16 * blk + rr) * RS + 32 * blk), a1 = *(const LAS v4u*)(L + R_AAB + (16 * blk + rr) * RS + 32 * blk + 16);
                    const float ar[16] = {bflo(a0.x), bfhi(a0.x), bflo(a0.y), bfhi(a0.y), bflo(a0.z), bfhi(a0.z), bflo(a0.w), bfhi(a0.w), bflo(a1.x), bfhi(a1.x), bflo(a1.y), bfhi(a1.y), bflo(a1.z), bfhi(a1.z), bflo(a1.w), bfhi(a1.w)};
#pragma unroll
                    for (int ss = 0; ss < 16; ++ss) if (ss < rr) acc += ar[ss] * tc[ss]; }
                tc[rr] = acc; *(LAS bf16*)(L + R_TI + (16 * blk + rr) * TIS + cc * 2) = (bf16)f2bf(acc); }
        }
        if (w < 4) {
#pragma unroll
            for (int i = 0; i < 4; ++i) { Ya[i] = (f32x4r){0.f, 0.f, 0.f, 0.f};
#pragma unroll
                for (int k2 = 0; k2 < 2; ++k2) Ya[i] = MF16(ldfrag(L, R_ARK, 16 * i, 32 * k2, r, g), ldfrag(L, R_VT, 16 * vt, 32 * k2, r, g), Ya[i]); }
        } else {
#pragma unroll
            for (int i = 0; i < 4; ++i) { Ua[i] = (f32x4r){0.f, 0.f, 0.f, 0.f}; KV[i] = Ua[i];
#pragma unroll
                for (int k2 = 0; k2 < 2; ++k2) { const bf16x8 vf = ldfrag(L, R_VT, 16 * vt, 32 * k2, r, g);
                    Ua[i] = MF16(ldfrag(L, R_AAK, 16 * i, 32 * k2, r, g), vf, Ua[i]); KV[i] = MF16(ldfrag(L, R_KT, 16 * i, 32 * k2, r, g), vf, KV[i]); } }
        }
        WGBAR();
        RELANE();
        { f32x4r X[4];
          if (w < 4) {
#pragma unroll
              for (int i = 0; i < 4; ++i)
#pragma unroll
                  for (int e = 0; e < 4; ++e) X[i][e] = bf2f(*(const LAS bf16*)(L + R_AT + (16 * i + 4 * g + e) * RS + (16 * w + r) * 2));
          } else {
#pragma unroll
              for (int i = 0; i < 4; ++i) X[i] = Ua[i];
          }
          const f32x4r z4 = (f32x4r){0.f, 0.f, 0.f, 0.f};
#define TIF(i) ld2x4(L, R_TI + (16 * (i) + r) * TIS + 8 * g, R_TI + (16 * (i) + r) * TIS + 8 * g)
#define ABF(i, j0) ld2x4(L, R_AAB + (16 * (i) + r) * RS + (16 * (j0) + 4 * g) * 2, R_AAB + (16 * (i) + r) * RS + (16 * ((j0) + 1) + 4 * g) * 2)
          X[0] = MF16(TIF(0), pack1(X[0]), z4);
          X[1] = MF16(ABF(1, 0), pack1(X[0]), X[1]); X[1] = MF16(TIF(1), pack1(X[1]), z4);
          X[2] = MF16(ABF(2, 0), pack2(X[0], X[1]), X[2]); X[2] = MF16(TIF(2), pack1(X[2]), z4);
          X[3] = MF16(ABF(3, 0), pack2(X[0], X[1]), X[3]); X[3] = MF16(ABF(3, 2), pack1(X[2]), X[3]); X[3] = MF16(TIF(3), pack1(X[3]), z4);
#undef TIF
#undef ABF
          if (w < 4) {
#pragma unroll
              for (int i = 0; i < 4; ++i)
#pragma unroll
                  for (int e = 0; e < 4; ++e) *(LAS bf16*)(L + R_BW + (16 * i + 4 * g + e) * RS + (16 * w + r) * 2) = (bf16)f2bf(X[i][e]);
          } else {
#pragma unroll
              for (int i = 0; i < 4; ++i) Ua[i] = X[i];
          } }
        WGBAR();
        RELANE();
        if (w < 4) {
#pragma unroll
            for (int i = 0; i < 4; ++i)
#pragma unroll
                for (int k2 = 0; k2 < 2; ++k2) Ya[i] = MF16(ldfrag(L, R_RT, 16 * i, 32 * k2, r, g), ldfrag(L, R_HT, 16 * vt, 32 * k2, r, g), Ya[i]);
        } else {
#pragma unroll
            for (int i = 0; i < 4; ++i) {
#pragma unroll
                for (int k2 = 0; k2 < 2; ++k2) Ua[i] = MF16(ldfrag(L, R_BW, 16 * i, 32 * k2, r, g), ldfrag(L, R_HT, 16 * vt, 32 * k2, r, g), Ua[i]);
                storeT(L, R_KU, Ua[i], 16 * i, 16 * vt, r, g); }
        }
        WGBAR();
        RELANE();
        if (w < 4) {
#pragma unroll
            for (int i = 0; i < 4; ++i) {
#pragma unroll
                for (int k2 = 0; k2 < 2; ++k2) Ya[i] = MF16(ldfrag(L, R_ARB, 16 * i, 32 * k2, r, g), ldfrag(L, R_KU, 16 * vt, 32 * k2, r, g), Ya[i]);
#pragma unroll
                for (int e = 0; e < 4; ++e) { const int s = c * 64 + 16 * i + 4 * g + e, t = d ? T - 1 - s : s; ybuf[(size_t)(b * T + t) * A_W + hd * 64 + 16 * vt + r] = (bf16)f2bf(Ya[i][e]); } }
        } else {
#pragma unroll
            for (int i = 0; i < 4; ++i) { f32x4r acc = Hs[i] + KV[i];
#pragma unroll
                for (int k2 = 0; k2 < 2; ++k2) acc = MF16(ldfrag(L, R_BT, 16 * i, 32 * k2, r, g), ldfrag(L, R_KU, 16 * vt, 32 * k2, r, g), acc);
                const f32x4r pc = *(const LAS f32x4r*)(L + R_PC + (16 * i + 4 * g) * 4);
                Hs[i] = acc * pc; storeT(L, R_HT, Hs[i], 16 * i, 16 * vt, r, g); }
        }
        WGBAR();
    }
}
__device__ __forceinline__ void rwkv_post_baseline(Frame& F) {
    const bf16* pa = (const bf16*)(F.ws + WS_PA); const bf16* y0 = (const bf16*)(F.ws + WS_Y); const bf16* y1 = y0 + (size_t)M * A_W;
    const float* bon0 = (const float*)(F.ws + WS_BON); const float* bon1 = bon0 + (size_t)M * 8;
    const int gw = F.vcu * NWAVES + F.wave, NGW = F.G * NWAVES, lane = F.lane;
    for (int task = gw; task < M * 8; task += NGW) {
        const int m = task >> 3, hd = task & 7, t = m & (T - 1), ch = hd * 64 + lane; const bool hp = t > 0, hn = t < T - 1;
        const float y = bf2f(y0[(size_t)m * A_W + ch]) + bf2f(y1[(size_t)m * A_W + ch]);
        const float mean = wave_sum(y) * (1.f / 64.f), dv = y - mean, var = wave_sum(dv * dv) * (1.f / 64.f);
        const float yn = dv / sqrtf(var + GN_EPS) * F.lnx_w[ch] + F.lnx_b[ch];
        const float bsum = bon0[(size_t)m * 8 + hd] + bon1[(size_t)m * 8 + hd];
        const bf16* p0 = pa + (size_t)m * A_COLS; const int cv = 2 * A_W + ch, cg = 3 * A_W + ch;
        const float mv0 = F.shift_mu[cv], mv1 = F.shift_mu[A_COLS + cv], mg0 = F.shift_mu[cg], mg1 = F.shift_mu[A_COLS + cg];
        const float vs = shift3(p0, cv, hp, hn, mv0, mv1, 1.f - mv0 - mv1), gs = shift3(p0, cg, hp, hn, mg0, mg1, 1.f - mg0 - mg1);
        const float ya = (yn + bsum * vs) * (gs / (1.f + expf(-gs)));
        *(bf16*)(F.out + (size_t)m * OROW + OS_YA + ch * 2) = (bf16)f2bf(ya);
    }
}

struct Args { const float* in[24]; unsigned char* out; unsigned char* ws; };
__global__ void __launch_bounds__(NWAVES * 64, 2) hybrid_fwd(Args args) {
    extern __shared__ __attribute__((aligned(16))) unsigned char lds[];
    Frame F;
    F.lds = (LAS unsigned char*)lds;
    F.MISC = (volatile LAS unsigned*)(F.lds + MISC_OFF);
    F.tid = threadIdx.x; F.lane = F.tid & 63; F.wave = __builtin_amdgcn_readfirstlane(F.tid >> 6);
    F.G = gridDim.x; { const int bx = blockIdx.x; F.vcu = (F.G % 8 == 0) ? (bx % 8) * (F.G / 8) + bx / 8 : bx; }
    F.xp = args.in[0]; F.xs = args.in[1]; F.cp = args.in[2]; F.cs = args.in[3]; F.rel_bias = args.in[4]; F.norm_w = args.in[5]; F.w_ada = args.in[6]; F.b_ada = args.in[7];
    F.w_in = args.in[8]; F.shift_mu = args.in[9]; F.w0 = args.in[10]; F.w2 = args.in[11]; F.a0 = args.in[12]; F.a2 = args.in[13]; F.k_k = args.in[14]; F.k_a = args.in[15];
    F.r_k = args.in[16]; F.lnx_w = args.in[17]; F.lnx_b = args.in[18]; F.q_gain = args.in[19]; F.k_gain = args.in[20]; F.w_out_a = args.in[21]; F.w_out_b = args.in[22]; F.w_out = args.in[23];
    F.out = args.out; F.ws = args.ws;
    for (int u = F.tid; u < (LDS_BYTES - LDSCTL_OFF) / 4; u += NWAVES * 64) ((LAS unsigned*)(F.lds + LDSCTL_OFF))[u] = 0u;
    __syncthreads();
    XcdBarrier bar = xcd_barrier_post((unsigned*)(F.ws + WS_CTL) + CW_BAR, F.MISC + 8);
#define GRID_BAR() xcd_barrier(bar)
    typedef pg8::bf16_t bt;
    p0a(F); GRID_BAR();
    p0b(F); GRID_BAR();
    { pg8::Gemm g{(const bt*)(F.out + OS_H), (const bt*)(F.ws + WS_WB), nullptr, nullptr, OROW / 2, D}; pg8::Order S; S.init(M, B_COLS, F.G, (int)blockIdx.x, 1);
      pg8::EpiPB E{(bt*)(F.ws + WS_R), F.q_gain, F.k_gain, (LAS float*)(F.lds + EPI_OFF)};
      pg8::gemm_phase<pg8::EpiPB, pg8::Order, true, true>(F.lds + RING_OFF, g, S, E); }
    GRID_BAR();
    attn_mfma(F); GRID_BAR();
    attn_combine(F); GRID_BAR();
    { pg8::Gemm g{(const bt*)(F.out + OS_H), (const bt*)(F.ws + WS_WAG), nullptr, nullptr, OROW / 2, D}; pg8::Order S; S.init(M, AG_COLS, F.G, (int)blockIdx.x, 1);
      pg8::EpiAG E{(bt*)(F.ws + WS_PA), (bt*)(F.ws + WS_PG)};
      pg8::gemm_phase<pg8::EpiAG, pg8::Order, true, true>(F.lds + RING_OFF, g, S, E); }
    GRID_BAR();
    rwkv_chunked(F); GRID_BAR();
    rwkv_post_baseline(F); GRID_BAR();
    { pg8::Gemm g{(const bt*)(F.out + OS_YA), (const bt*)(F.ws + WS_WOA), (const bt*)(F.out + OS_YB), (const bt*)(F.ws + WS_WOB), OROW / 2, A_W}; pg8::Order S; S.init(M, D, F.G, (int)blockIdx.x, 2);
      pg8::EpiMerge E{(const bt*)(F.ws + WS_PG), (bt*)(F.ws + WS_Y)};
      pg8::gemm_phase<pg8::EpiMerge, pg8::Order, true, true>(F.lds + RING_OFF, g, S, E); }
    GRID_BAR();
    { pg8::Gemm g{(const bt*)(F.ws + WS_Y), (const bt*)(F.ws + WS_WO), nullptr, nullptr, D, D}; pg8::Order S; S.init(M, D, F.G, (int)blockIdx.x, 1);
      pg8::EpiOut E{F.xp, F.xs, (const float*)(F.ws + WS_MOD), (float*)F.out};
      pg8::gemm_phase<pg8::EpiOut, pg8::Order, true, true>(F.lds + RING_OFF, g, S, E); }
}

extern "C" void kernel_launch(void* const* d_in, const int* in_sizes, int n_in, void* d_out, int out_size, void* d_ws, size_t ws_size, hipStream_t stream) {
    static int grid = 0;
    if (grid == 0) {
        if (n_in != 24 || out_size != M * D || ws_size < WS_END) { fprintf(stderr, "kernel_launch: unexpected shapes: n_in %d out %d ws %zu (need %zu)\n", n_in, out_size, ws_size, (size_t)WS_END); grid = -1; return; }
        int dev = 0, cus = 0, per_cu = 0;
        if (hipGetDevice(&dev) != hipSuccess || hipDeviceGetAttribute(&cus, hipDeviceAttributeMultiprocessorCount, dev) != hipSuccess) { grid = -1; return; }
        if (hipFuncSetAttribute((const void*)hybrid_fwd, hipFuncAttributeMaxDynamicSharedMemorySize, LDS_BYTES) != hipSuccess) { fprintf(stderr, "kernel_launch: hipFuncSetAttribute failed\n"); grid = -1; return; }
        if (hipOccupancyMaxActiveBlocksPerMultiprocessor(&per_cu, (const void*)hybrid_fwd, NWAVES * 64, LDS_BYTES) != hipSuccess || per_cu < 1) { fprintf(stderr, "kernel_launch: occupancy query says %d\n", per_cu); }
        (void)hipGetLastError();
        grid = cus;
    }
    if (grid < 0) return;
    if (hipMemsetAsync((char*)d_ws + WS_CTL, 0, CTL_ZERO_BYTES, stream) != hipSuccess) return;
    Args a{};
    for (int i = 0; i < 24; ++i) a.in[i] = (const float*)d_in[i];
    a.out = (unsigned char*)d_out; a.ws = (unsigned char*)d_ws;
    hipLaunchKernelGGL(hybrid_fwd, dim3(grid), dim3(NWAVES * 64), LDS_BYTES, stream, a);
}
```

```cpp
#include <hip/hip_runtime.h>
#include <cstdio>
#include <cstdint>
namespace pg8 {
#define PG8_LAS __attribute__((address_space(3)))
typedef unsigned short bf16_t;
typedef short bf16x8 __attribute__((ext_vector_type(8)));
typedef float f32x4 __attribute__((ext_vector_type(4)));
typedef unsigned u32x4 __attribute__((ext_vector_type(4)));
constexpr int BM = 256, BK = 64, HALF = 128, HTB = HALF * BK * 2  , STAGE_BYTES = 8 * HTB, NXCD = 8, WGM = 8;

__host__ __device__ __forceinline__ int lds_byte(int r, int c) { const int st = (r >> 4) * 2 + (c >> 5), rr = r & 15, cc = c & 31, ob = rr * 64 + cc * 2; return st * 1024 + (ob ^ (((ob >> 9) & 1) << 5)); }
__host__ __device__ __forceinline__ void stage_rc(int b, int& R, int& C) { const int st = b / 1024, sb = b % 1024, swz = sb ^ (((sb >> 9) & 1) << 5); R = (st >> 1) * 16 + swz / 64; C = (st & 1) * 32 + (swz % 64) / 2; }
__host__ __device__ __forceinline__ int perm32(int rho) { const int n = rho >> 4, i = rho & 15; return 8 * (i >> 2) + 4 * n + (i & 3); }

struct Unit { int pm, pn, sel; };
struct Gemm { const bf16_t* A0; const bf16_t* B0; const bf16_t* A1; const bf16_t* B1; int lda; int K; };

struct Order {
    int nM, nN, nwg, G, c, CH;
    __host__ __device__ void init(int M, int N, int G_, int c_, int CH_) { nM = M / BM; nN = N / BM; nwg = nM * nN; G = G_; c = c_; CH = CH_; }
    __host__ __device__ bool next(int i, Unit& u) const {
        const int ti = (CH == 2) ? (i >> 1) : i; u.sel = (CH == 2) ? (i & 1) : 0;
        const long L = (long)ti * G + c; if (L >= nwg) return false;
        int wgid = (int)L; { const int q = nwg / NXCD, r = nwg % NXCD, xcd = wgid % NXCD, off = wgid / NXCD; wgid = (xcd < r ? xcd * (q + 1) : r * (q + 1) + (xcd - r) * q) + off; }
        const int nig = WGM * nN, gid = wgid / nig, fm = gid * WGM, gsz = (nM - fm) < WGM ? (nM - fm) : WGM;
        u.pm = fm + ((wgid % nig) % gsz); u.pn = (wgid % nig) / gsz; return true;
    }
};
__device__ __forceinline__ unsigned cvt_pk_bf16(float lo, float hi) { unsigned r; asm volatile("v_cvt_pk_bf16_f32 %0, %1, %2" : "=v"(r) : "v"(lo), "v"(hi)); return r; }
template <class Epi, class Sched, bool ALIGN_EPI = false, bool SP2 = false>
__device__ __forceinline__ void gemm_phase(PG8_LAS unsigned char* lds, const Gemm g, const Sched& S, const Epi& E, const int wave_id) {
    int tid = wave_id * 64 + (int)__builtin_amdgcn_mbcnt_hi(~0u, __builtin_amdgcn_mbcnt_lo(~0u, 0u)); asm volatile("" : "+v"(tid));
    const int wid = wave_id, lane = tid & 63, wr = wid >> 2, wc = wid & 3, fr = lane & 15, fq = lane >> 4;
    const int K = g.K, nt = K / BK;
    unsigned voffA[2], voffB[2];
#pragma unroll
    for (int i = 0; i < 2; ++i) { int R, C; stage_rc(tid * 16 + i * 8192, R, C); const int Rb = Epi::PERM ? ((R & ~31) + perm32(R & 31)) : R;
        voffA[i] = (unsigned)(R * g.lda + C) * 2u; voffB[i] = (unsigned)(Rb * K + C) * 2u; }
    const size_t kstep = (size_t)(BK * 2);
    const size_t hstepA = (size_t)HALF * g.lda * 2, hstepB = (size_t)HALF * K * 2;
    const size_t tstepA = 2 * hstepA, tstepB = 2 * hstepB;
    const unsigned ldsw = (unsigned)wid * 1024u;
    const int aoff = lds_byte(wr * 64 + fr, fq * 8), boff = lds_byte(wc * 32 + fr, fq * 8);
#define PG8_SA(b, h) (((b) * 2 + (h)) * HTB)
#define PG8_SB(b, h) ((4 + (b) * 2 + (h)) * HTB)
#define PG8_STAGE(bufoff, gbase, voff) do { _Pragma("unroll") for (int _i = 0; _i < 2; ++_i) \
        __builtin_amdgcn_global_load_lds((const unsigned*)((const char*)(gbase) + (voff)[_i]), (PG8_LAS unsigned*)(lds + (bufoff) + ldsw + _i * 8192), 16, 0, 0); } while (0)
#define PG8_LDA(dst, b, h) do { _Pragma("unroll") for (int m = 0; m < 4; ++m) _Pragma("unroll") for (int k = 0; k < 2; ++k) dst[m][k] = *(const PG8_LAS bf16x8*)(lds + PG8_SA(b, h) + aoff + m * 2048 + k * 1024); } while (0)
#define PG8_LDB(dst, b, h) do { _Pragma("unroll") for (int n = 0; n < 2; ++n) _Pragma("unroll") for (int k = 0; k < 2; ++k) dst[n][k] = *(const PG8_LAS bf16x8*)(lds + PG8_SB(b, h) + boff + n * 2048 + k * 1024); } while (0)
#define PG8_MMA(ai, bj, At, Bt) do { __builtin_amdgcn_s_setprio(1); _Pragma("unroll") for (int m = 0; m < 4; ++m) _Pragma("unroll") for (int n = 0; n < 2; ++n) _Pragma("unroll") for (int k = 0; k < 2; ++k) \
        acc[ai][bj][m][n] = __builtin_amdgcn_mfma_f32_16x16x32_bf16(Bt[n][k], At[m][k], acc[ai][bj][m][n], 0, 0, 0); __builtin_amdgcn_s_setprio(0); } while (0)
#define PG8_APTR(u) ((const char*)((u).sel ? g.A1 : g.A0) + (size_t)(u).pm * tstepA)
#define PG8_BPTR(u) ((const char*)((u).sel ? g.B1 : g.B0) + (size_t)(u).pn * tstepB)
#define PG8_WAIT_V(n) asm volatile("s_waitcnt vmcnt(" #n ")" ::: "memory")
#define PG8_WAIT_L(n) asm volatile("s_waitcnt lgkmcnt(" #n ")" ::: "memory")
#define PG8_BAR __builtin_amdgcn_s_barrier()
#define PG8_SCHED __builtin_amdgcn_sched_barrier(0)
    Unit cur, nxt; int ui = 0;
    if (!S.next(0, cur)) return;
#ifdef PROBE_G
    unsigned long long pg_epi = 0; const unsigned long long pg_start = __builtin_amdgcn_s_memtime();
#endif
    f32x4 acc[2][2][4][2];
#pragma unroll
    for (int a = 0; a < 2; ++a)
#pragma unroll
        for (int b = 0; b < 2; ++b)
#pragma unroll
            for (int m = 0; m < 4; ++m)
#pragma unroll
                for (int n = 0; n < 2; ++n) acc[a][b][m][n] = (f32x4){0.f, 0.f, 0.f, 0.f};
    bf16x8 At[4][2], B0[2][2], B1[2][2];
    const char* cA = PG8_APTR(cur); const char* cB = PG8_BPTR(cur);
    if constexpr (SP2) {
        PG8_STAGE(PG8_SB(0, 0), cB, voffB); PG8_STAGE(PG8_SB(0, 1), cB + hstepB, voffB); PG8_STAGE(PG8_SA(0, 0), cA, voffA); PG8_STAGE(PG8_SA(0, 1), cA + hstepA, voffA);
        if (wr == 1) PG8_BAR;
        PG8_WAIT_V(2); PG8_BAR;
        PG8_STAGE(PG8_SB(1, 0), cB + kstep, voffB); PG8_STAGE(PG8_SA(1, 0), cA + kstep, voffA); PG8_STAGE(PG8_SB(1, 1), cB + hstepB + kstep, voffB);
        PG8_WAIT_V(6); PG8_BAR;
    } else {
        PG8_STAGE(PG8_SB(0, 0), cB, voffB); PG8_STAGE(PG8_SA(0, 0), cA, voffA); PG8_STAGE(PG8_SB(0, 1), cB + hstepB, voffB); PG8_STAGE(PG8_SA(0, 1), cA + hstepA, voffA);
        if (wr == 1) PG8_BAR;
        PG8_WAIT_V(4); PG8_BAR;
        PG8_STAGE(PG8_SB(1, 0), cB + kstep, voffB); PG8_STAGE(PG8_SA(1, 0), cA + kstep, voffA); PG8_STAGE(PG8_SB(1, 1), cB + hstepB + kstep, voffB);
        PG8_WAIT_V(6); PG8_BAR;
    }
    for (;;) {
        const bool has_next = S.next(ui + 1, nxt);
        const char* nA = has_next ? PG8_APTR(nxt) : cA; const char* nB = has_next ? PG8_BPTR(nxt) : cB;
        for (int t = 0; t < nt; t += 2) {
            const bool last = (t == nt - 2);
            const char* a1 = cA + (size_t)(t + 1) * kstep;
            const char* a2 = last ? nA : cA + (size_t)(t + 2) * kstep; const char* b2 = last ? nB : cB + (size_t)(t + 2) * kstep;
            const char* a3 = a2 + kstep; const char* b3 = b2 + kstep;
            if constexpr (SP2) {
            PG8_LDB(B0, 0, 0); PG8_LDB(B1, 0, 1); PG8_SCHED; PG8_LDA(At, 0, 0); PG8_STAGE(PG8_SA(1, 1), a1 + hstepA, voffA);
            PG8_WAIT_V(8); PG8_WAIT_L(0); PG8_BAR; PG8_MMA(0, 0, At, B0); PG8_MMA(0, 1, At, B1); PG8_BAR; PG8_SCHED;
            PG8_LDA(At, 0, 1); PG8_STAGE(PG8_SB(0, 0), b2, voffB); PG8_STAGE(PG8_SB(0, 1), b2 + hstepB, voffB); PG8_STAGE(PG8_SA(0, 0), a2, voffA);
            PG8_WAIT_V(8); PG8_WAIT_L(0); PG8_BAR; PG8_MMA(1, 0, At, B0); PG8_MMA(1, 1, At, B1); PG8_BAR; PG8_SCHED;
            PG8_LDB(B0, 1, 0); PG8_LDB(B1, 1, 1); PG8_SCHED; PG8_LDA(At, 1, 0); PG8_STAGE(PG8_SA(0, 1), a2 + hstepA, voffA);
            PG8_WAIT_V(8); PG8_WAIT_L(0); PG8_BAR; PG8_MMA(0, 0, At, B0); PG8_MMA(0, 1, At, B1); PG8_BAR; PG8_SCHED;
            PG8_LDA(At, 1, 1); PG8_STAGE(PG8_SB(1, 0), b3, voffB); PG8_STAGE(PG8_SB(1, 1), b3 + hstepB, voffB); PG8_STAGE(PG8_SA(1, 0), a3, voffA);
            PG8_WAIT_V(8); PG8_WAIT_L(0); PG8_BAR; PG8_MMA(1, 0, At, B0); PG8_MMA(1, 1, At, B1); PG8_BAR; PG8_SCHED;
            } else {
            PG8_LDB(B0, 0, 0); PG8_SCHED; PG8_LDA(At, 0, 0); PG8_STAGE(PG8_SA(1, 1), a1 + hstepA, voffA);
            PG8_WAIT_L(8); PG8_BAR; PG8_WAIT_L(0); PG8_MMA(0, 0, At, B0); PG8_BAR; PG8_SCHED;
            PG8_LDB(B1, 0, 1); PG8_STAGE(PG8_SB(0, 0), b2, voffB);
            PG8_BAR; PG8_WAIT_L(0); PG8_MMA(0, 1, At, B1); PG8_BAR;
            PG8_LDA(At, 0, 1); PG8_STAGE(PG8_SA(0, 0), a2, voffA);
            PG8_BAR; PG8_WAIT_L(0); PG8_MMA(1, 0, At, B0); PG8_BAR; PG8_SCHED;
            PG8_STAGE(PG8_SB(0, 1), b2 + hstepB, voffB);
            PG8_WAIT_V(6); PG8_BAR; PG8_MMA(1, 1, At, B1); PG8_BAR;
            PG8_LDB(B0, 1, 0); PG8_SCHED; PG8_LDA(At, 1, 0); PG8_STAGE(PG8_SA(0, 1), a2 + hstepA, voffA);
            PG8_WAIT_L(8); PG8_BAR; PG8_WAIT_L(0); PG8_MMA(0, 0, At, B0); PG8_BAR; PG8_SCHED;
            PG8_LDB(B1, 1, 1); PG8_STAGE(PG8_SB(1, 0), b3, voffB);
            PG8_BAR; PG8_WAIT_L(0); PG8_MMA(0, 1, At, B1); PG8_BAR;
            PG8_LDA(At, 1, 1); PG8_STAGE(PG8_SA(1, 0), a3, voffA);
            PG8_BAR; PG8_WAIT_L(0); PG8_MMA(1, 0, At, B0); PG8_BAR; PG8_SCHED;
            PG8_STAGE(PG8_SB(1, 1), b3 + hstepB, voffB);
            PG8_WAIT_V(6); PG8_BAR; PG8_MMA(1, 1, At, B1); PG8_BAR;
            }
        }
        if constexpr (ALIGN_EPI) { if (wr == 0) PG8_BAR; }
#ifdef PROBE_G
        const unsigned long long pg_t0 = __builtin_amdgcn_s_memtime();
#endif
        const bool keep = E(acc, cur, wr, wc, fr, fq);
#ifdef PROBE_G
        pg_epi += __builtin_amdgcn_s_memtime() - pg_t0;
#endif
        if (!has_next) break;
        if (!keep) {
#pragma unroll
        for (int a = 0; a < 2; ++a)
#pragma unroll
            for (int b = 0; b < 2; ++b)
#pragma unroll
                for (int m = 0; m < 4; ++m)
#pragma unroll
                    for (int n = 0; n < 2; ++n) acc[a][b][m][n] = (f32x4){0.f, 0.f, 0.f, 0.f};
        }
        cur = nxt; cA = nA; cB = nB; ++ui;
        if constexpr (ALIGN_EPI) { if (wr == 1) PG8_BAR; }
    }
#ifdef PROBE_G
    if (E.dbg && blockIdx.x == 0 && threadIdx.x == 0) { const double tot = (double)(__builtin_amdgcn_s_memtime() - pg_start);
        E.dbg[0] = (PROBE_G == 1) ? (float)(tot / (double)(ui + 1) / 262144.0) : (float)((double)pg_epi / tot); }
#endif
    PG8_WAIT_V(0);
    if constexpr (!ALIGN_EPI) { if (wr == 0) PG8_BAR; }
    PG8_BAR;
#undef PG8_SA
#undef PG8_SB
#undef PG8_STAGE
#undef PG8_LDA
#undef PG8_LDB
#undef PG8_MMA
#undef PG8_APTR
#undef PG8_BPTR
#undef PG8_WAIT_V
#undef PG8_WAIT_L
#undef PG8_BAR
#undef PG8_SCHED
}
}

constexpr int NWAVES = 8;
constexpr int T = 8192, D = 1024, NBP = 8, NBS = 2, NB = NBP + NBS, M = NB * T;
constexpr int A_HEADS = 8, A_HD = 64, A_W = 512, RANK = 64;
constexpr int A_COLS = 2304, B_COLS = 5120, G_COLS = 2048, IN_COLS = 9472, AG_COLS = A_COLS + G_COLS;
constexpr int B_QKV = 1536, B_W = 512, B_HD = 128;
constexpr float RMS_EPS = 1e-6f, GN_EPS = 64e-5f;
constexpr size_t MiB = 1u << 20;
constexpr size_t WS_CTL = 0, CTL_ZERO_BYTES = 65536;
constexpr size_t WS_MOD = 1 * MiB;
constexpr size_t WS_BTAB = 1 * MiB + 128 * 1024;
constexpr size_t WS_WB = 2 * MiB;
constexpr size_t WS_WAG = 12 * MiB;
constexpr size_t WS_WOA = 21 * MiB, WS_WOB = 22 * MiB, WS_WO = 23 * MiB;
constexpr size_t WS_BON = 26 * MiB;
constexpr size_t WS_R = 32 * MiB;
constexpr size_t WS_PA = WS_R, WS_PG = WS_R + 360 * MiB;
constexpr size_t WS_Y = 832 * MiB;
constexpr size_t WS_END = 992 * MiB;
constexpr int CW_BAR = 4096;
constexpr int OS_H = 0, OS_YA = 2048, OS_YB = 3072, OROW = 4096;
constexpr int RING_OFF = 0, RING_BYTES = 131072;
constexpr int LDSCTL_OFF = RING_BYTES, MISC_OFF = LDSCTL_OFF + 320;
constexpr int EPI_OFF = RING_BYTES + 1024;
constexpr int LDS_BYTES = 147456;

#define GAS __attribute__((address_space(1)))
#define LAS __attribute__((address_space(3)))
typedef unsigned short bf16;
typedef unsigned v4u __attribute__((ext_vector_type(4)));
typedef unsigned v2u __attribute__((ext_vector_type(2)));
typedef float f32x4 __attribute__((ext_vector_type(4)));
typedef short bf16x8 __attribute__((ext_vector_type(8)));
typedef GAS unsigned gu32;
#define RLX_AGENT __ATOMIC_RELAXED, __HIP_MEMORY_SCOPE_AGENT
#define LDS_WAIT() asm volatile("s_waitcnt lgkmcnt(0)" ::: "memory")
#define VM_WAIT() asm volatile("s_waitcnt vmcnt(0)" ::: "memory")
__device__ __forceinline__ unsigned f2bf(float f) { unsigned u = __builtin_bit_cast(unsigned, f); return (u + 0x7fffu + ((u >> 16) & 1u)) >> 16; }
__device__ __forceinline__ unsigned pk2(float lo, float hi) { return f2bf(lo) | (f2bf(hi) << 16); }
typedef float f32x2_t __attribute__((ext_vector_type(2))); typedef __bf16 bf16x2_t __attribute__((ext_vector_type(2)));
__device__ __forceinline__ unsigned cvtpk(float lo, float hi) { f32x2_t v = {lo, hi}; bf16x2_t b = __builtin_convertvector(v, bf16x2_t); return __builtin_bit_cast(unsigned, b); }
__device__ __forceinline__ float bf2f(unsigned short h) { return __builtin_bit_cast(float, (unsigned)h << 16); }
__device__ __forceinline__ float bflo(unsigned w) { return __builtin_bit_cast(float, w << 16); }
__device__ __forceinline__ float bfhi(unsigned w) { return __builtin_bit_cast(float, w & 0xffff0000u); }
__device__ __forceinline__ float sigmoidf_(float v) { return __builtin_amdgcn_rcpf(1.f + __expf(-v)); }
__device__ __forceinline__ float siluf_(float v) { return v * sigmoidf_(v); }
__device__ __forceinline__ int lane_id() { return (int)__builtin_amdgcn_mbcnt_hi(~0u, __builtin_amdgcn_mbcnt_lo(~0u, 0u)); }
__device__ __forceinline__ float wave_sum(float v) {
#pragma unroll
    for (int o = 1; o < 64; o <<= 1) v += __shfl_xor(v, o);
    return v;
}
__device__ __forceinline__ float wave_max(float v) {
#pragma unroll
    for (int o = 1; o < 64; o <<= 1) v = fmaxf(v, __shfl_xor(v, o));
    return v;
}

#define XB_TMO      128
#define XB_XCNT(j)  (256  + 64 * (j))
#define XB_XSUB(j)  (1280 + 64 * (j))
#define XB_XGEN(j)  (2304 + 64 * (j))
#define XB_TOP      3328
#define XB_TOPGEN   3392
#define XCD_BAR_WORDS 3456
#define XB_SPIN_CAP (1u << 22)
__device__ __forceinline__ unsigned xb_ld(unsigned* p)              { return __hip_atomic_load(p, __ATOMIC_RELAXED, __HIP_MEMORY_SCOPE_AGENT); }
__device__ __forceinline__ unsigned xb_add(unsigned* p, unsigned v) { return __hip_atomic_fetch_add(p, v, __ATOMIC_RELAXED, __HIP_MEMORY_SCOPE_AGENT); }
__device__ __forceinline__ unsigned xb_xcc_id() { return (unsigned)__builtin_amdgcn_s_getreg((3 << 11) | 20) & 0xFu; }
#define XB_SPIN(cond, bar) do { unsigned _sp = 0; while (cond) { __builtin_amdgcn_s_sleep(1); \
    if ((++_sp & 255u) == 0u) { if (xb_ld(&(bar)[XB_TMO])) break; if (_sp > XB_SPIN_CAP) { atomicAdd(&(bar)[XB_TMO], 1u); break; } } } } while (0)
struct XcdBarrier { unsigned* bar; unsigned x; volatile LAS unsigned* st; };
__device__ __forceinline__ XcdBarrier xcd_barrier_post(unsigned* bar, volatile LAS unsigned* st) {
    XcdBarrier b; b.bar = bar; b.x = xb_xcc_id(); b.st = st;
    if (threadIdx.x == 0) (void)xb_add(&bar[XB_XCNT(b.x)], 1u);
    return b;
}
__device__ __forceinline__ void xcd_barrier_complete(unsigned* bar, unsigned x, unsigned& nloc, unsigned& nx) {
    const unsigned G = gridDim.x * gridDim.y * gridDim.z;
    unsigned sum, cnt, mine, sp = 0u;
    for (;;) {
        sum = 0u; cnt = 0u; mine = 0u;
#pragma unroll
        for (unsigned j = 0; j < 16; ++j) { const unsigned c = xb_ld(&bar[XB_XCNT(j)]); sum += c; cnt += (c > 0u) ? 1u : 0u; mine = (j == x) ? c : mine; }
        if (sum == G) break;
        __builtin_amdgcn_s_sleep(1);
        if ((++sp & 255u) == 0u) { if (xb_ld(&bar[XB_TMO])) break; if (sp > XB_SPIN_CAP) { atomicAdd(&bar[XB_TMO], 1u); break; } }
    }
    nloc = mine > 0u ? mine : 1u; nx = cnt > 0u ? cnt : 1u;
}
__device__ __forceinline__ void xcd_barrier(const XcdBarrier& b) {
    asm volatile("s_waitcnt vmcnt(0)" ::: "memory");
    __syncthreads();
    if (threadIdx.x == 0) {
        unsigned* bar = b.bar;
        __builtin_amdgcn_s_waitcnt(0);
        unsigned nloc = b.st[0], nx = b.st[1];
        if (nloc == 0u) { xcd_barrier_complete(bar, b.x, nloc, nx); b.st[0] = nloc; b.st[1] = nx; }
        const unsigned old = xb_add(&bar[XB_XSUB(b.x)], 1u);
        const unsigned gen = old / nloc;
        if (old + 1u == (gen + 1u) * nloc) {
            __builtin_amdgcn_fence(__ATOMIC_RELEASE, "agent");
            asm volatile("s_waitcnt vmcnt(0)" ::: "memory");
            const unsigned og = xb_add(&bar[XB_TOP], 1u);
            const unsigned tg = og / nx;
            if (og + 1u == (tg + 1u) * nx) xb_add(&bar[XB_TOPGEN], 1u);
            else XB_SPIN(xb_ld(&bar[XB_TOPGEN]) == tg, bar);
            __builtin_amdgcn_fence(__ATOMIC_ACQUIRE, "agent");
            xb_add(&bar[XB_XGEN(b.x)], 1u);
            asm volatile("s_waitcnt vmcnt(0)" ::: "memory");
        } else {
            XB_SPIN(xb_ld(&bar[XB_XGEN(b.x)]) == gen, bar);
            __builtin_amdgcn_fence(__ATOMIC_ACQUIRE, "agent");
            asm volatile("s_waitcnt vmcnt(0)" ::: "memory");
        }
    }
    __syncthreads();
}

struct Frame {
    LAS unsigned char* lds;
    volatile LAS unsigned* MISC;
    int wave;
    __device__ __forceinline__ int lane_() const { return lane_id(); }
    int vcu, G;
    unsigned char* out;
    unsigned char* ws;
};
enum { I_XP = 0, I_XS, I_CP, I_CS, I_RELB, I_NORMW, I_WADA, I_BADA, I_WIN, I_MU, I_W0, I_W2, I_A0, I_A2, I_KK, I_KA, I_RK, I_LNW, I_LNB, I_QG, I_KG, I_WOA, I_WOB, I_WO };
__device__ __forceinline__ int kopaque() { int z = 0; asm volatile("" : "+s"(z)); return z; }
__device__ __forceinline__ const float* kin(int k, int kof) { return ((const float* const __attribute__((address_space(4)))*)__builtin_amdgcn_kernarg_segment_ptr())[k + kof]; }
__device__ __forceinline__ const float* xrow_ptr(const float* xp, const float* xs, int m) { return m < NBP * T ? xp + (size_t)m * D : xs + (size_t)(m - NBP * T) * D; }

namespace pg8 {
struct EpiPB {
    static constexpr bool PERM = true;
    bf16_t* O; const float* qg; const float* kg; PG8_LAS float* P; float* dbg;
    __device__ __forceinline__ bool operator()(f32x4 (&acc)[2][2][4][2], const Unit& u, int wr, int wc, int fr, int fq) const {
        const int row0 = u.pm * BM + wr * 64 + fr, col0 = u.pn * BM + wc * 32 + 8 * fq;
        if (u.pn < 12) {
#pragma unroll
            for (int ai = 0; ai < 2; ++ai)
#pragma unroll
                for (int m = 0; m < 4; ++m) {
#pragma unroll
                    for (int bj = 0; bj < 2; ++bj) { const f32x4 a = acc[ai][bj][m][0], b = acc[ai][bj][m][1];
                        float s = (a[0] * a[0] + a[1] * a[1]) + (a[2] * a[2] + a[3] * a[3]) + (b[0] * b[0] + b[1] * b[1]) + (b[2] * b[2] + b[3] * b[3]);
                        s += __shfl_xor(s, 16); s += __shfl_xor(s, 32);
                        if (fq == 0) P[((ai * HALF + wr * 64 + m * 16 + fr) * 2 + bj) * 4 + wc] = s; }
                    asm volatile("" ::: "memory"); }
            asm volatile("s_waitcnt lgkmcnt(0)" ::: "memory"); __builtin_amdgcn_s_barrier(); asm volatile("" ::: "memory");
            const bool isq = u.pn < 6; const float* gp = (isq ? qg : kg) + wc * 32 + 8 * fq; const float gs = isq ? 0.08838834764831845f * 1.4426950408889634f : 1.f;
            float gn[8];
#pragma unroll
            for (int e = 0; e < 8; ++e) gn[e] = gp[e] * gs;
#pragma unroll
            for (int ai = 0; ai < 2; ++ai)
#pragma unroll
                for (int m = 0; m < 4; ++m)
#pragma unroll
                    for (int bj = 0; bj < 2; ++bj) { const f32x4 p4 = *(const PG8_LAS f32x4*)(P + ((ai * HALF + wr * 64 + m * 16 + fr) * 2 + bj) * 4);
                        const float rs = 1.0f / sqrtf(((p4[0] + p4[1]) + (p4[2] + p4[3])) * (1.f / 128.f) + 1e-6f);
#pragma unroll
                        for (int e = 0; e < 4; ++e) { acc[ai][bj][m][0][e] *= rs * gn[e]; acc[ai][bj][m][1][e] *= rs * gn[4 + e]; }
                        asm volatile("" ::: "memory"); }
        }
        const bool act = u.pn >= 18;
#pragma unroll
        for (int ai = 0; ai < 2; ++ai)
#pragma unroll
            for (int m = 0; m < 4; ++m) { bf16_t* rowp = O + (size_t)(row0 + ai * HALF + m * 16) * B_COLS + col0;
#pragma unroll
                for (int bj = 0; bj < 2; ++bj) { f32x4 v0 = acc[ai][bj][m][0], v1 = acc[ai][bj][m][1];
                    if (act) {
#pragma unroll
                        for (int e = 0; e < 4; ++e) { v0[e] = siluf_(v0[e]); v1[e] = siluf_(v1[e]); } }
                    u32x4 w; w.x = cvt_pk_bf16(v0[0], v0[1]); w.y = cvt_pk_bf16(v0[2], v0[3]); w.z = cvt_pk_bf16(v1[0], v1[1]); w.w = cvt_pk_bf16(v1[2], v1[3]);
                    *(u32x4*)(rowp + bj * HALF) = w; } }
        return false;
    }
};
struct EpiAG {
    static constexpr bool PERM = true;
    bf16_t* PA; bf16_t* PG; float* dbg;
    __device__ __forceinline__ bool operator()(const f32x4 (&acc)[2][2][4][2], const Unit& u, int wr, int wc, int fr, int fq) const {
        const bool isg = u.pn >= 9; bf16_t* base = isg ? PG : PA; const int ldc = isg ? G_COLS : A_COLS; const int pn = isg ? u.pn - 9 : u.pn;
        const int row0 = u.pm * BM + wr * 64 + fr, col0 = pn * BM + wc * 32 + 8 * fq;
#pragma unroll
        for (int ai = 0; ai < 2; ++ai)
#pragma unroll
            for (int m = 0; m < 4; ++m) { bf16_t* rowp = base + (size_t)(row0 + ai * HALF + m * 16) * ldc + col0;
#pragma unroll
                for (int bj = 0; bj < 2; ++bj) { const f32x4 v0 = acc[ai][bj][m][0], v1 = acc[ai][bj][m][1];
                    u32x4 w; w.x = cvt_pk_bf16(v0[0], v0[1]); w.y = cvt_pk_bf16(v0[2], v0[3]); w.z = cvt_pk_bf16(v1[0], v1[1]); w.w = cvt_pk_bf16(v1[2], v1[3]);
                    *(u32x4*)(rowp + bj * HALF) = w; } }
        return false;
    }
};
struct EpiMerge {
    static constexpr bool PERM = true;
    const bf16_t* PG; bf16_t* O; float* dbg;
    __device__ __forceinline__ bool operator()(f32x4 (&acc)[2][2][4][2], const Unit& u, int wr, int wc, int fr, int fq) const {
        const int row0 = u.pm * BM + wr * 64 + fr, col0 = u.pn * BM + wc * 32 + 8 * fq;
#pragma unroll
        for (int ai = 0; ai < 2; ++ai)
#pragma unroll
            for (int m = 0; m < 4; ++m) { const size_t row = (size_t)(row0 + ai * HALF + m * 16);
#pragma unroll
                for (int bj = 0; bj < 2; ++bj) { const int col = col0 + bj * HALF;
                    const u32x4 gb8 = *(const u32x4*)(PG + row * G_COLS + D + col);
                    float zb[8] = {bflo(gb8.x), bfhi(gb8.x), bflo(gb8.y), bfhi(gb8.y), bflo(gb8.z), bfhi(gb8.z), bflo(gb8.w), bfhi(gb8.w)};
                    if (u.sel == 0) {
                        const u32x4 ga8 = *(const u32x4*)(PG + row * G_COLS + col);
                        float za[8] = {bflo(ga8.x), bfhi(ga8.x), bflo(ga8.y), bfhi(ga8.y), bflo(ga8.z), bfhi(ga8.z), bflo(ga8.w), bfhi(ga8.w)};
#pragma unroll
                        for (int e = 0; e < 8; ++e) { const float ea = __expf(-fminf(fmaxf(za[e], -30.f), 30.f)), eb = __expf(-fminf(fmaxf(zb[e], -30.f), 30.f));
                            const float r = (1.f + eb) * __builtin_amdgcn_rcpf(1.f + ea); acc[ai][bj][m][e >> 2][e & 3] *= r; }
                    } else {
                        float o[8];
#pragma unroll
                        for (int e = 0; e < 8; ++e) { const float eb = __expf(-fminf(fmaxf(zb[e], -30.f), 30.f)); o[e] = acc[ai][bj][m][e >> 2][e & 3] * __builtin_amdgcn_rcpf(1.f + eb); }
                        u32x4 w; w.x = cvt_pk_bf16(o[0], o[1]); w.y = cvt_pk_bf16(o[2], o[3]); w.z = cvt_pk_bf16(o[4], o[5]); w.w = cvt_pk_bf16(o[6], o[7]);
                        *(u32x4*)(O + row * D + col) = w;
                    } } }
        return u.sel == 0;
    }
};
struct EpiOut {
    static constexpr bool PERM = false;
    const float* xp; const float* xs; const float* mod; float* out; float* dbg;
    __device__ __forceinline__ bool operator()(const f32x4 (&acc)[2][2][4][2], const Unit& u, int wr, int wc, int fr, int fq) const {
        const int rowt = u.pm * BM, b = rowt >> 13; const float* xb = rowt < NBP * T ? xp + (size_t)rowt * D : xs + (size_t)(rowt - NBP * T) * D;
        const int rl0 = wr * 64 + fr, col0 = u.pn * BM + wc * 32 + 4 * fq; const float* gt = mod + b * 3072 + 2048;
#pragma unroll
        for (int bj = 0; bj < 2; ++bj)
#pragma unroll
            for (int n = 0; n < 2; ++n) { const int col = col0 + bj * HALF + n * 16; const f32x4 g4 = *(const f32x4*)(gt + col);
#pragma unroll
                for (int ai = 0; ai < 2; ++ai)
#pragma unroll
                    for (int m = 0; m < 4; ++m) { const int rl = rl0 + ai * HALF + m * 16; const f32x4 x4 = *(const f32x4*)(xb + (size_t)rl * D + col);
                        *(f32x4*)(out + (size_t)(rowt + rl) * D + col) = x4 + g4 * acc[ai][bj][m][n]; } }
        return false;
    }
};
}

__device__ __forceinline__ void p0_transpose_item(const float* W, int K, int N, bf16* WT, int k0, int n0, int drow0, LAS float* scr, int lane) {
#pragma unroll 8
    for (int i = 0; i < 32; ++i) { const int kk = 2 * i + (lane >> 5); scr[kk * 33 + (lane & 31)] = W[(size_t)(k0 + kk) * N + n0 + (lane & 31)]; }
    LDS_WAIT(); asm volatile("" ::: "memory");
    const int c = lane & 7;
#pragma unroll
    for (int j = 0; j < 4; ++j) { const int n = (lane >> 3) + 8 * j; const LAS float* s = scr + (8 * c) * 33 + n;
        v4u o; o.x = pk2(s[0 * 33], s[1 * 33]); o.y = pk2(s[2 * 33], s[3 * 33]); o.z = pk2(s[4 * 33], s[5 * 33]); o.w = pk2(s[6 * 33], s[7 * 33]);
        *(GAS v4u*)(WT + (size_t)(drow0 + n) * K + k0 + 8 * c) = o; }
    LDS_WAIT(); asm volatile("" ::: "memory");
}
__device__ __forceinline__ int t5_bucket(int rel) {
    const int n = rel < 0 ? -rel : rel; int ret = rel > 0 ? 16 : 0;
    const float lf = logf((float)(n > 1 ? n : 1) / 8.0f) / 4.852030263919617f * 8.0f;
    int large = 8 + (int)lf; large = large < 15 ? large : 15;
    return ret + (n < 8 ? n : large);
}
__device__ __forceinline__ void p0a(Frame& F) {
    const int ko = kopaque(); const float *cp_ = kin(I_CP, ko), *cs_ = kin(I_CS, ko), *w_ada = kin(I_WADA, ko), *b_ada = kin(I_BADA, ko), *rel_bias = kin(I_RELB, ko), *w_in = kin(I_WIN, ko), *w_out_a = kin(I_WOA, ko), *w_out_b = kin(I_WOB, ko), *w_out = kin(I_WO, ko);
    float* mod = (float*)(F.ws + WS_MOD);
    if (blockIdx.x < 48) {
        LAS float* sc = (LAS float*)F.lds;
        LAS float* part = (LAS float*)(F.lds + 40960);
        for (int i = (F.wave * 64 + lane_id()); i < NB * D; i += NWAVES * 64) { const int b = i >> 10, k = i & 1023; const float cv = b < NBP ? cp_[b * D + k] : cs_[(b - NBP) * D + k]; sc[i] = siluf_(cv); }
        __syncthreads();
        const int j = blockIdx.x * 64 + lane_id(); float a[NB];
#pragma unroll
        for (int b = 0; b < NB; ++b) a[b] = 0.f;
        for (int k = F.wave * 128; k < F.wave * 128 + 128; ++k) { const float w = w_ada[(size_t)k * 3072 + j];
#pragma unroll
            for (int b = 0; b < NB; ++b) a[b] += sc[b * D + k] * w; }
#pragma unroll
        for (int b = 0; b < NB; ++b) part[(F.wave * NB + b) * 64 + lane_id()] = a[b];
        __syncthreads();
        for (int i = (F.wave * 64 + lane_id()); i < NB * 64; i += NWAVES * 64) { const int b = i >> 6, l = i & 63; float s = b_ada[blockIdx.x * 64 + l];
#pragma unroll
            for (int w = 0; w < NWAVES; ++w) s += part[(w * NB + b) * 64 + l];
            mod[b * 3072 + blockIdx.x * 64 + l] = s; }
        __syncthreads();
    }
    if (blockIdx.x == 255 % gridDim.x) {
        float* bt = (float*)(F.ws + WS_BTAB);
        for (int i = (F.wave * 64 + lane_id()); i < 12 * 129; i += NWAVES * 64) { const int gh = i / 129, r = i % 129, gi = gh >> 2; const int rel = (r - 64) * (1 << (2 * gi));
            bt[i] = rel_bias[t5_bucket(rel) * 12 + gh] * 1.4426950408889634f; }
    }
    LAS float* scr = (LAS float*)(F.lds + RING_OFF + F.wave * 16384);
    const int gw = F.vcu * NWAVES + F.wave, NGW = F.G * NWAVES;
    constexpr int I_IN = (D / 64) * (IN_COLS / 32), I_OA = (A_W / 64) * (D / 32), I_OB = (B_W / 64) * (D / 32), I_O = (D / 64) * (D / 32);
    constexpr int NITEMS = I_IN + I_OA + I_OB + I_O;
    for (int it = gw; it < NITEMS; it += NGW) {
        int r = it;
        if (r < I_IN) { const int nblk = IN_COLS / 32, kb = r / nblk, nb = r % nblk, n0 = nb * 32;
            bf16* dst; int drow;
            if (n0 < A_COLS) { dst = (bf16*)(F.ws + WS_WAG); drow = n0; }
            else if (n0 < A_COLS + B_COLS) { dst = (bf16*)(F.ws + WS_WB); drow = n0 - A_COLS; }
            else { dst = (bf16*)(F.ws + WS_WAG); drow = A_COLS + (n0 - A_COLS - B_COLS); }
            p0_transpose_item(w_in, D, IN_COLS, dst, kb * 64, n0, drow, scr, lane_id()); continue; }
        r -= I_IN;
        if (r < I_OA) { const int nblk = D / 32, kb = r / nblk, nb = r % nblk; p0_transpose_item(w_out_a, A_W, D, (bf16*)(F.ws + WS_WOA), kb * 64, nb * 32, nb * 32, scr, lane_id()); continue; }
        r -= I_OA;
        if (r < I_OB) { const int nblk = D / 32, kb = r / nblk, nb = r % nblk; p0_transpose_item(w_out_b, B_W, D, (bf16*)(F.ws + WS_WOB), kb * 64, nb * 32, nb * 32, scr, lane_id()); continue; }
        r -= I_OB;
        { const int nblk = D / 32, kb = r / nblk, nb = r % nblk; p0_transpose_item(w_out, D, D, (bf16*)(F.ws + WS_WO), kb * 64, nb * 32, nb * 32, scr, lane_id()); }
    }
}
__device__ __forceinline__ void p0b(Frame& F) {
    const int ko = kopaque(); const float *xp = kin(I_XP, ko), *xs = kin(I_XS, ko), *norm_w = kin(I_NORMW, ko);
    const float* mod = (const float*)(F.ws + WS_MOD);
    const int gw = F.vcu * NWAVES + F.wave, NGW = F.G * NWAVES;
    for (int m = gw; m < M; m += NGW) {
        const int b = m >> 13; const f32x4* xr = (const f32x4*)xrow_ptr(xp, xs, m) + lane_id();
        f32x4 v[4]; float s = 0.f;
#pragma unroll
        for (int j = 0; j < 4; ++j) { v[j] = xr[64 * j]; s += (v[j].x * v[j].x + v[j].y * v[j].y) + (v[j].z * v[j].z + v[j].w * v[j].w); }
        const float rs = 1.f / sqrtf(wave_sum(s) * (1.f / D) + RMS_EPS);
        v2u* o8 = (v2u*)(F.out + (size_t)m * OROW + OS_H) + lane_id();
#pragma unroll
        for (int j = 0; j < 4; ++j) { const int col = 4 * (lane_id() + 64 * j);
            const f32x4 nw = *(const f32x4*)(norm_w + col), sh = *(const f32x4*)(mod + b * 3072 + col), sc = *(const f32x4*)(mod + b * 3072 + 1024 + col);
            const f32x4 h = v[j] * rs * nw * (sc + 1.f) + sh;
            v2u w; w.x = pk2(h.x, h.y); w.y = pk2(h.z, h.w); o8[64 * j] = w; }
    }
}

typedef short v4i16_t __attribute__((ext_vector_type(4)));
typedef float f32x4a __attribute__((ext_vector_type(4)));
constexpr int AT_K = 0, AT_V = 65536, AT_BT = RING_BYTES + 9216 + 1024;
constexpr size_t WS_LSE = WS_Y;
__device__ __forceinline__ void attn_unit_geom(int u, int& b, int& gi, int& hh, int& res, int& blk) {
    const int sub = u & 63; int r = u >> 6; hh = r & 3; r >>= 2; gi = r % 3; b = r / 3;
    if (gi == 0) { res = 0; blk = sub; } else if (gi == 1) { res = sub >> 4; blk = sub & 15; } else { res = sub >> 2; blk = sub & 3; }
}
__device__ __forceinline__ void attn_dma_k(Frame& F, const bf16* pb, int b, int lg, int L, int res, int head, int q0) {
    const int lane = lane_id();
#pragma unroll
    for (int ii = 0; ii < 8; ++ii) { const int i = F.wave * 8 + ii, row = 4 * i + (lane >> 4); int kp = q0 - 64 + row; kp = kp < 0 ? 0 : (kp >= L ? L - 1 : kp);
        const int c = (lane & 15) ^ (row & 15);
        const bf16* src = pb + (size_t)(b * T + (kp << lg) + res) * B_COLS + B_QKV + head * 128 + c * 8;
        __builtin_amdgcn_global_load_lds((const unsigned*)src, (LAS unsigned*)(F.lds + AT_K + i * 1024), 16, 0, 0); }
}
__device__ __forceinline__ void attn_dma_v(Frame& F, const bf16* pb, int b, int lg, int L, int res, int head, int q0) {
    const int lane = lane_id();
#pragma unroll
    for (int jj = 0; jj < 8; ++jj) { const int j = F.wave * 8 + jj, dblk = j >> 4, kgrp = j & 15, key = 16 * kgrp + (lane >> 2); int kp = q0 - 64 + key; kp = kp < 0 ? 0 : (kp >= L ? L - 1 : kp);
        const bf16* src = pb + (size_t)(b * T + (kp << lg) + res) * B_COLS + 2 * B_QKV + head * 128 + dblk * 32 + (lane & 3) * 8;
        __builtin_amdgcn_global_load_lds((const unsigned*)src, (LAS unsigned*)(F.lds + AT_V + dblk * 16384 + kgrp * 1024), 16, 0, 0); }
}
__device__ __forceinline__ void attn_mfma(Frame& F, bool dry = false) {
    bf16* pb = (bf16*)(F.ws + WS_R); const float* btab = (const float*)(F.ws + WS_BTAB); float* lse = (float*)(F.ws + WS_LSE);
    int lane = lane_id(); asm volatile("" : "+v"(lane));
    const int w = F.wave, qi = lane & 15, g = lane >> 4;
    LAS float* btp = (LAS float*)(F.lds + AT_BT);
    const int NU = NB * 3 * 4 * 64, per = (NU + F.G - 1) / F.G; const int u0 = F.vcu * per, u1 = (u0 + per < NU) ? u0 + per : NU;
    if (u0 >= u1) return;
#ifdef PROBE_AT
    const unsigned long long pat_t0 = __builtin_amdgcn_s_memtime();
#endif
    int koff[4];
#pragma unroll
    for (int ks = 0; ks < 4; ++ks) koff[ks] = AT_K + w * 4096 + qi * 256 + (((4 * ks + g) ^ qi) << 4);
    const int q4 = qi >> 2, p4 = qi & 3, kr = 4 * g + q4;
    const int voff = AT_V + w * 1024 + (kr >> 3) * 512 + (kr & 7) * 64 + 8 * p4;
    int b, gi, hh, res, blk; attn_unit_geom(u0, b, gi, hh, res, blk);
    { const int lg = 2 * gi; attn_dma_k(F, pb, b, lg, T >> lg, res, gi * 4 + hh, blk * 128); }
    for (int u = u0; u < u1; ++u) {
        attn_unit_geom(u, b, gi, hh, res, blk);
        const int lg = 2 * gi, L = T >> lg, head = gi * 4 + hh, q0 = blk * 128;
        if ((F.wave * 64 + lane_id()) < 176) { const int i = (F.wave * 64 + lane_id()) - 16; btp[(F.wave * 64 + lane_id())] = (i >= 0 && i <= 128) ? btab[head * 129 + i] : -1e30f; }
        bf16* qrow = pb + (size_t)(b * T + ((q0 + 16 * w + qi) << lg) + res) * B_COLS + head * 128;
        bf16x8 qf[4];
#pragma unroll
        for (int ks = 0; ks < 4; ++ks) qf[ks] = *(const bf16x8*)(qrow + 32 * ks + 8 * g);
        asm volatile("s_waitcnt vmcnt(0) lgkmcnt(0)" ::: "memory"); __builtin_amdgcn_s_barrier(); asm volatile("" ::: "memory");
        attn_dma_v(F, pb, b, lg, L, res, head, q0);
        f32x4a S[9];
#pragma unroll
        for (int kb = 0; kb < 9; ++kb) { S[kb] = (f32x4a){0.f, 0.f, 0.f, 0.f};
#pragma unroll
            for (int ks = 0; ks < 4; ++ks) { const bf16x8 kf = *(const LAS bf16x8*)(F.lds + koff[ks] + kb * 4096);
                S[kb] = __builtin_amdgcn_mfma_f32_16x16x32_bf16(kf, qf[ks], S[kb], 0, 0, 0); } }
        const bool edge = (q0 == 0) || (q0 + 128 >= L);
        float mx = -1e30f;
#pragma unroll
        for (int kb = 0; kb < 9; ++kb)
#pragma unroll
            for (int r = 0; r < 4; ++r) { const int kw = 16 * kb + 4 * g + r; float sv = S[kb][r] + btp[kw - qi + 16];
                if (edge) { const int kp = q0 + 16 * w + kw - 64; if (kp < 0 || kp >= L) sv = -1e30f; }
                S[kb][r] = sv; mx = fmaxf(mx, sv); }
        mx = fmaxf(mx, __shfl_xor(mx, 16)); mx = fmaxf(mx, __shfl_xor(mx, 32));
        float ls = 0.f;
#pragma unroll
        for (int kb = 0; kb < 9; ++kb)
#pragma unroll
            for (int r = 0; r < 4; ++r) { const float p = __builtin_amdgcn_exp2f(S[kb][r] - mx); S[kb][r] = p; ls += p; }
        ls += __shfl_xor(ls, 16); ls += __shfl_xor(ls, 32);
        bf16x8 pf[5];
#pragma unroll
        for (int c = 0; c < 5; ++c) { v4u t; t.x = cvtpk(S[2 * c][0], S[2 * c][1]); t.y = cvtpk(S[2 * c][2], S[2 * c][3]);
            if (c < 4) { t.z = cvtpk(S[2 * c + 1][0], S[2 * c + 1][1]); t.w = cvtpk(S[2 * c + 1][2], S[2 * c + 1][3]); } else { t.z = 0u; t.w = 0u; }
            pf[c] = __builtin_bit_cast(bf16x8, t); }
        asm volatile("s_waitcnt vmcnt(0) lgkmcnt(0)" ::: "memory"); __builtin_amdgcn_s_barrier(); asm volatile("" ::: "memory");
        if (u + 1 < u1) { int b2, gi2, hh2, res2, blk2; attn_unit_geom(u + 1, b2, gi2, hh2, res2, blk2); const int lg2 = 2 * gi2; attn_dma_k(F, pb, b2, lg2, T >> lg2, res2, gi2 * 4 + hh2, blk2 * 128); }
        const float il = 1.f / ls;
#pragma unroll
        for (int db = 0; db < 8; ++db) { f32x4a o = (f32x4a){0.f, 0.f, 0.f, 0.f};
#pragma unroll
            for (int c = 0; c < 5; ++c) { const int off = voff + (db >> 1) * 16384 + (db & 1) * 32 + c * 2048;
                const v4i16_t lo = __builtin_amdgcn_ds_read_tr16_b64_v4i16((LAS v4i16_t*)(F.lds + off));
                const v4i16_t hi = __builtin_amdgcn_ds_read_tr16_b64_v4i16((LAS v4i16_t*)(F.lds + off + (c < 4 ? 1024 : 0)));
                const bf16x8 vf = (bf16x8){lo[0], lo[1], lo[2], lo[3], hi[0], hi[1], hi[2], hi[3]};
                o = __builtin_amdgcn_mfma_f32_16x16x32_bf16(vf, pf[c], o, 0, 0, 0); }
            v2u wv; wv.x = cvtpk(o[0] * il, o[1] * il); wv.y = cvtpk(o[2] * il, o[3] * il);
            *(v2u*)((dry ? (bf16*)(F.ws + WS_Y) + (size_t)((F.wave * 64 + lane_id()) >> 2) * B_COLS : qrow) + 16 * db + 4 * g) = wv; }
        if (g == 0 && !dry) lse[(size_t)(b * T + ((q0 + 16 * w + qi) << lg) + res) * 12 + head] = mx + __builtin_amdgcn_logf(ls);
    }
    asm volatile("s_waitcnt vmcnt(0) lgkmcnt(0)" ::: "memory"); __builtin_amdgcn_s_barrier();
#ifdef PROBE_AT
    if (blockIdx.x == 0 && (F.wave * 64 + lane_id()) == 0) ((float*)(F.ws + WS_CTL + 32768))[0] = (float)((double)(((__builtin_amdgcn_s_memtime() - pat_t0) / (unsigned long long)(u1 - u0) + 1024ull) >> 11 << 11) / 65536.0);
#endif
}
__device__ __forceinline__ void attn_combine(Frame& F) {
    const bf16* pb = (const bf16*)(F.ws + WS_R); const float* lse = (const float*)(F.ws + WS_LSE);
    const int gw = F.vcu * NWAVES + F.wave, NGW = F.G * NWAVES, lane = lane_id(), hh = lane >> 4, d0 = (lane & 15) * 8;
    for (int m = gw; m < M; m += NGW) {
        const bf16* row = pb + (size_t)m * B_COLS;
        const float l0 = lse[(size_t)m * 12 + hh], l1 = lse[(size_t)m * 12 + 4 + hh], l2 = lse[(size_t)m * 12 + 8 + hh];
        const float mxl = fmaxf(l0, fmaxf(l1, l2)); float w0 = exp2f(l0 - mxl), w1 = exp2f(l1 - mxl), w2 = exp2f(l2 - mxl); const float iw = 1.f / (w0 + w1 + w2); w0 *= iw; w1 *= iw; w2 *= iw;
        const v4u a = *(const v4u*)(row + hh * 128 + d0), bq = *(const v4u*)(row + (4 + hh) * 128 + d0), c = *(const v4u*)(row + (8 + hh) * 128 + d0), gt = *(const v4u*)(row + 3 * B_QKV + hh * 128 + d0);
        v4u o;
        o.x = pk2((w0 * bflo(a.x) + w1 * bflo(bq.x) + w2 * bflo(c.x)) * bflo(gt.x), (w0 * bfhi(a.x) + w1 * bfhi(bq.x) + w2 * bfhi(c.x)) * bfhi(gt.x));
        o.y = pk2((w0 * bflo(a.y) + w1 * bflo(bq.y) + w2 * bflo(c.y)) * bflo(gt.y), (w0 * bfhi(a.y) + w1 * bfhi(bq.y) + w2 * bfhi(c.y)) * bfhi(gt.y));
        o.z = pk2((w0 * bflo(a.z) + w1 * bflo(bq.z) + w2 * bflo(c.z)) * bflo(gt.z), (w0 * bfhi(a.z) + w1 * bfhi(bq.z) + w2 * bfhi(c.z)) * bfhi(gt.z));
        o.w = pk2((w0 * bflo(a.w) + w1 * bflo(bq.w) + w2 * bflo(c.w)) * bflo(gt.w), (w0 * bfhi(a.w) + w1 * bfhi(bq.w) + w2 * bfhi(c.w)) * bfhi(gt.w));
        *(v4u*)(F.out + (size_t)m * OROW + OS_YB + (hh * 128 + d0) * 2) = o;
    }
}

#ifdef PROBE_TA
#define STAMP(k) do { if ((k) == PROBE_TA) pt_a = __builtin_amdgcn_s_memtime(); if ((k) == PROBE_TB) pt_sel += __builtin_amdgcn_s_memtime() - pt_a; } while (0)
#else
#define STAMP(k) do { } while (0)
#endif
#ifndef REP_S0
#define REP_S0 1
#define REP_S12 1
#define REP_S3 1
#define REP_S45 1
#endif
typedef float f32x4r __attribute__((ext_vector_type(4)));
constexpr int RS = 144, RM = 64 * RS;
constexpr int R_AT = 0 * RM, R_RT = 1 * RM, R_BW = 2 * RM, R_KU = 3 * RM, R_BT = 4 * RM, R_KT = 5 * RM, R_VT = 6 * RM, R_AAB = 7 * RM, R_AAK = 8 * RM, R_ARB = 9 * RM, R_ARK = 10 * RM, R_HT = 11 * RM;
constexpr int R_W2T = 12 * RM, R_A2T = 13 * RM;
constexpr int R_WLF = R_AT, R_ALF = R_BT, FS = 272;
constexpr int R_TI = 132096, TIS = 48, R_PC = R_TI + 3072, R_BLK = R_PC + 256, R_AD = R_BLK + 2048;
__device__ __forceinline__ bf16x8 ldfrag(LAS unsigned char* lds, int mat, int row0, int k0, int r, int g) { return *(const LAS bf16x8*)(lds + mat + (row0 + r) * RS + (k0 + 8 * g) * 2); }
__device__ __forceinline__ void storeT(LAS unsigned char* lds, int mat, const f32x4r& d, int row0, int col0, int r, int g) {
    v2u w; w.x = cvtpk(d[0], d[1]); w.y = cvtpk(d[2], d[3]); *(LAS v2u*)(lds + mat + (col0 + r) * RS + (row0 + 4 * g) * 2) = w; }
__device__ __forceinline__ bf16x8 pack2(const f32x4r& a, const f32x4r& b) { v4u t; t.x = cvtpk(a[0], a[1]); t.y = cvtpk(a[2], a[3]); t.z = cvtpk(b[0], b[1]); t.w = cvtpk(b[2], b[3]); return __builtin_bit_cast(bf16x8, t); }
__device__ __forceinline__ bf16x8 pack1(const f32x4r& a) { v4u t; t.x = cvtpk(a[0], a[1]); t.y = cvtpk(a[2], a[3]); t.z = 0u; t.w = 0u; return __builtin_bit_cast(bf16x8, t); }
__device__ __forceinline__ bf16x8 ld2x4(LAS unsigned char* lds, int off0, int off1) { const v2u a = *(const LAS v2u*)(lds + off0), b = *(const LAS v2u*)(lds + off1); v4u t; t.x = a.x; t.y = a.y; t.z = b.x; t.w = b.y; return __builtin_bit_cast(bf16x8, t); }
#define MF16(a, b, c) __builtin_amdgcn_mfma_f32_16x16x32_bf16((a), (b), (c), 0, 0, 0)
#define WGBAR() do { asm volatile("s_waitcnt lgkmcnt(0)" ::: "memory"); __builtin_amdgcn_s_barrier(); asm volatile("" ::: "memory"); } while (0)
template <int CTRL> __device__ __forceinline__ float dppf(float x) { return __builtin_bit_cast(float, __builtin_amdgcn_update_dpp(0, __builtin_bit_cast(int, x), CTRL, 0xF, 0xF, true)); }
__device__ __forceinline__ float row16_sum(float v) { v += dppf<0xB1>(v); v += dppf<0x4E>(v); v += dppf<0x141>(v); v += dppf<0x140>(v); return v; }
__device__ __forceinline__ float wave_sum_dpp(float v) { v = row16_sum(v);
    return (__builtin_bit_cast(float, __builtin_amdgcn_readlane(__builtin_bit_cast(int, v), 0)) + __builtin_bit_cast(float, __builtin_amdgcn_readlane(__builtin_bit_cast(int, v), 16)))
         + (__builtin_bit_cast(float, __builtin_amdgcn_readlane(__builtin_bit_cast(int, v), 32)) + __builtin_bit_cast(float, __builtin_amdgcn_readlane(__builtin_bit_cast(int, v), 48))); }
__device__ __forceinline__ void reduce8(const float (&v)[8], float (&s)[8], float& v0, float& v1, int lane) {
    const bool b0 = lane & 1, b1 = lane & 2; float r1[4], r2[2];
#pragma unroll
    for (int i = 0; i < 4; ++i) { const float keep = b0 ? v[2 * i + 1] : v[2 * i], send = b0 ? v[2 * i] : v[2 * i + 1]; r1[i] = keep + dppf<0xB1>(send); }
#pragma unroll
    for (int i = 0; i < 2; ++i) { const float keep = b1 ? r1[2 * i + 1] : r1[2 * i], send = b1 ? r1[2 * i] : r1[2 * i + 1]; r2[i] = keep + dppf<0x4E>(send); }
#pragma unroll
    for (int i = 0; i < 2; ++i) { float x = r2[i]; x += dppf<0x124>(x); x += dppf<0x128>(x);
        x += __builtin_bit_cast(float, __builtin_amdgcn_ds_swizzle(__builtin_bit_cast(int, x), 0x401F));
        x += __shfl_xor(x, 32);
        r2[i] = x; }
    v0 = r2[0]; v1 = r2[1];
#pragma unroll
    for (int q = 0; q < 8; ++q) s[q] = __builtin_bit_cast(float, __builtin_amdgcn_readlane(__builtin_bit_cast(int, r2[q >> 2]), q & 3));
}
__device__ __forceinline__ float fast_tanh(float x) { const float e = __expf(2.f * x); return 1.f - 2.f * __builtin_amdgcn_rcpf(e + 1.f); }
__device__ __forceinline__ void rwkv_load_rows(__amdgpu_buffer_rsrc_t rsrc, int b, int d, int c, int w, unsigned o_r, unsigned o_k, unsigned o_v, unsigned o_w, unsigned o_a, unsigned short (&xr)[10], unsigned short (&xk)[10], unsigned short (&xv)[10], unsigned short (&xw)[10], unsigned short (&xa)[10]) {
    const int s0 = c * 64 + 8 * w - 1;
#pragma unroll
    for (int k = 0; k < 10; ++k) { const int s = s0 + k; int tk = d ? T - 1 - s : s; tk = tk < 0 ? 0 : (tk > T - 1 ? T - 1 : tk);
        const int so = __builtin_amdgcn_readfirstlane((b * T + tk) * (A_COLS * 2));
        xr[k] = __builtin_amdgcn_raw_buffer_load_b16(rsrc, o_r, so, 0); xk[k] = __builtin_amdgcn_raw_buffer_load_b16(rsrc, o_k, so, 0); xv[k] = __builtin_amdgcn_raw_buffer_load_b16(rsrc, o_v, so, 0);
        xw[k] = __builtin_amdgcn_raw_buffer_load_b16(rsrc, o_w, so, 0); xa[k] = __builtin_amdgcn_raw_buffer_load_b16(rsrc, o_a, so, 0); }
}
__device__ __forceinline__ void rwkv_chunked(Frame& F) {
    if (blockIdx.x >= 2 * NB * A_HEADS) return;
    const int chain = blockIdx.x, d = chain / (NB * A_HEADS), rem = chain % (NB * A_HEADS), b = rem >> 3, hd = rem & 7;
    const bf16* pa = (const bf16*)(F.ws + WS_PA); bf16* ybuf = (bf16*)(F.ws + WS_Y) + (size_t)d * M * A_W; float* bon = (float*)(F.ws + WS_BON) + (size_t)d * M * 8;
    const int ko = kopaque(); const float *w2_ = kin(I_W2, ko), *a2_ = kin(I_A2, ko), *mu_ = kin(I_MU, ko), *w0_ = kin(I_W0, ko), *a0_ = kin(I_A0, ko), *kk_ = kin(I_KK, ko), *ka_ = kin(I_KA, ko), *rk_ = kin(I_RK, ko);
    LAS unsigned char* L = F.lds;
    int lane = lane_id(); asm volatile("" : "+v"(lane));
    const int w = F.wave, j = lane, ch = hd * 64 + j;
    int r, g;
#define RELANE() do { int ln_ = lane; asm volatile("" : "+v"(ln_)); r = ln_ & 15; g = ln_ >> 4; } while (0)
    for (int i = (F.wave * 64 + lane_id()); i < 4096; i += NWAVES * 64) { const int jo = i >> 6, jr = i & 63;
        *(LAS bf16*)(L + R_W2T + jo * RS + jr * 2) = (bf16)f2bf(w2_[((size_t)d * RANK + jr) * A_W + hd * 64 + jo]);
        *(LAS bf16*)(L + R_A2T + jo * RS + jr * 2) = (bf16)f2bf(a2_[((size_t)d * RANK + jr) * A_W + hd * 64 + jo]); }
    for (int i = (F.wave * 64 + lane_id()); i < 5 * RM / 4; i += NWAVES * 64) ((LAS unsigned*)(L + R_AAB))[i] = 0u;
    const int cr = ch, ck = A_W + ch, cv = 2 * A_W + ch, cw = 4 * A_W + d * RANK + j, ca = 4 * A_W + 2 * RANK + d * RANK + j;
    const float mr0 = mu_[cr], mr1 = mu_[A_COLS + cr], mk0 = mu_[ck], mk1 = mu_[A_COLS + ck], mv0 = mu_[cv], mv1 = mu_[A_COLS + cv];
    const float mw0 = mu_[cw], mw1 = mu_[A_COLS + cw], ma0 = mu_[ca], ma1 = mu_[A_COLS + ca];
    const __amdgpu_buffer_rsrc_t rsrc = __builtin_amdgcn_make_buffer_rsrc((void*)pa, 0, M * A_COLS * 2, 0x00020000);
    const unsigned o_r = cr * 2, o_k = ck * 2, o_v = cv * 2, o_w = cw * 2, o_a = ca * 2;
    const float sr0 = d ? mr1 : mr0, sr1 = d ? mr0 : mr1, sk0 = d ? mk1 : mk0, sk1 = d ? mk0 : mk1, sv0 = d ? mv1 : mv0, sv1 = d ? mv0 : mv1, sw0 = d ? mw1 : mw0, sw1 = d ? mw0 : mw1, sa0 = d ? ma1 : ma0, sa1 = d ? ma0 : ma1;
    const float w0j = w0_[d * A_W + ch], a0j = a0_[d * A_W + ch], kkj = kk_[ch], kaj = ka_[ch], rkj = rk_[ch];
    const int vt = w & 3;
    f32x4r Hs[4];
#pragma unroll
    for (int i = 0; i < 4; ++i) Hs[i] = (f32x4r){0.f, 0.f, 0.f, 0.f};
    unsigned short xr[10], xk[10], xv[10], xw[10], xa[10];
    rwkv_load_rows(rsrc, b, d, 0, w, o_r, o_k, o_v, o_w, o_a, xr, xk, xv, xw, xa);
    WGBAR();
#ifdef PROBE_TA
    unsigned long long pt_a = 0, pt_sel = 0; const unsigned long long pt_t0 = __builtin_amdgcn_s_memtime();
#endif
    for (int c = 0; c < T / 64; ++c) {
        STAMP(0);
        float rs[8], ks[8], vs[8], kn[8];
        for (int rep0_ = 0; rep0_ < REP_S0; ++rep0_) {
        if (REP_S0 > 1 && rep0_ > 0) rwkv_load_rows(rsrc, b, d, c, w, o_r, o_k, o_v, o_w, o_a, xr, xk, xv, xw, xa);
#pragma unroll
        for (int q = 0; q < 8; ++q) { const int i = 8 * w + q; const bool okp = (c * 64 + 8 * w) > 0, okn = (c * 64 + 8 * w + 8) < T;
#define XV(x, k) ((((k) == 0 && !okp) || ((k) == 9 && !okn)) ? 0.f : bf2f((x)[k]))
#define SH3(x, m0, m1) (XV(x, q + 1) * (1.f - (m0) - (m1)) + (m0) * XV(x, q) + (m1) * XV(x, q + 2))
            rs[q] = SH3(xr, sr0, sr1); ks[q] = SH3(xk, sk0, sk1); vs[q] = SH3(xv, sv0, sv1);
            const float wsv = SH3(xw, sw0, sw1), asv = SH3(xa, sa0, sa1);
#undef XV
#undef SH3
            { const unsigned pk = cvtpk(fast_tanh(wsv), asv); *(LAS bf16*)(L + R_BW + i * RS + j * 2) = (bf16)pk; *(LAS bf16*)(L + R_KU + i * RS + j * 2) = (bf16)(pk >> 16); }
            kn[q] = ks[q] * kkj; }
        { float sq[8], n2[8], d0_, d1_;
#pragma unroll
          for (int q = 0; q < 8; ++q) sq[q] = kn[q] * kn[q];
          reduce8(sq, n2, d0_, d1_, lane);
#pragma unroll
          for (int q = 0; q < 8; ++q) kn[q] *= __builtin_amdgcn_rsqf(fmaxf(n2[q], 1e-24f)); }
        WGBAR();
        STAMP(1);
        RELANE();
        { const int it = w >> 1;
          bf16x8 ta[2], aa[2];
#pragma unroll
          for (int k2 = 0; k2 < 2; ++k2) { ta[k2] = ldfrag(L, R_BW, 16 * it, 32 * k2, r, g); aa[k2] = ldfrag(L, R_KU, 16 * it, 32 * k2, r, g); }
#pragma unroll
          for (int j2 = 0; j2 < 2; ++j2) { const int jt = 2 * (w & 1) + j2; f32x4r dw = (f32x4r){0.f, 0.f, 0.f, 0.f}, da = dw;
#pragma unroll
              for (int k2 = 0; k2 < 2; ++k2) { dw = MF16(ta[k2], ldfrag(L, R_W2T, 16 * jt, 32 * k2, r, g), dw); da = MF16(aa[k2], ldfrag(L, R_A2T, 16 * jt, 32 * k2, r, g), da); }
#pragma unroll
              for (int e = 0; e < 4; ++e) { *(LAS float*)(L + R_WLF + (16 * it + 4 * g + e) * FS + (16 * jt + r) * 4) = dw[e]; *(LAS float*)(L + R_ALF + (16 * it + 4 * g + e) * FS + (16 * jt + r) * 4) = da[e]; } } }
        WGBAR();
        STAMP(2);
        float av[8], cp[8]; float run = 1.f;
#pragma unroll
        for (int q = 0; q < 8; ++q) { const int i = 8 * w + q; const float wl = w0j + *(const LAS float*)(L + R_WLF + i * FS + j * 4), al = a0j + *(const LAS float*)(L + R_ALF + i * FS + j * 4);
            const float xneg = -wl, sp = xneg > 20.f ? xneg : __logf(1.f + __expf(xneg)); const float dec = __expf(-__expf(-sp - 0.5f)); av[q] = __builtin_amdgcn_rcpf(1.f + __expf(-al)); run *= dec; cp[q] = run; }
        *(LAS float*)(L + R_BLK + (w * 64 + j) * 4) = run;
        WGBAR();
        STAMP(3);
        { float off = 1.f, tot = 1.f;
#pragma unroll
          for (int w2 = 0; w2 < 8; ++w2) { const float bt = *(const LAS float*)(L + R_BLK + (w2 * 64 + j) * 4); off *= (w2 < w) ? bt : 1.f; tot *= bt; }
          if (w == 0) *(LAS float*)(L + R_PC + j * 4) = tot;
          { float bp[8], bs[8], b0_, b1_;
#pragma unroll
            for (int q = 0; q < 8; ++q) bp[q] = rs[q] * (ks[q] * (1.f + (av[q] - 1.f) * kaj)) * rkj;
            reduce8(bp, bs, b0_, b1_, lane);
            if (lane < 4) { const int s0_ = c * 64 + 8 * w + lane, s1_ = s0_ + 4; const int t0_ = d ? T - 1 - s0_ : s0_, t1_ = d ? T - 1 - s1_ : s1_;
                bon[(size_t)(b * T + t0_) * 8 + hd] = b0_; bon[(size_t)(b * T + t1_) * 8 + hd] = b1_; } }
          unsigned pb_[4], pk_[4], pv_[4];
#pragma unroll
          for (int q2 = 0; q2 < 4; ++q2) { const int qa = 2 * q2, qb = qa + 1, i0 = 8 * w + qa;
              const float pta = off * cp[qa], ptb = off * cp[qb], pma = (qa == 0) ? off : off * cp[qa > 0 ? qa - 1 : 0], pmb = pta, ema = __builtin_amdgcn_rcpf(pta), emb = __builtin_amdgcn_rcpf(ptb);
              const float kda = ks[qa] * (1.f + (av[qa] - 1.f) * kaj), kdb = ks[qb] * (1.f + (av[qb] - 1.f) * kaj), bda = kn[qa] * av[qa], bdb = kn[qb] * av[qb];
              const unsigned pa_ = cvtpk(-kn[qa] * pma, -kn[qb] * pmb), pr_ = cvtpk(rs[qa] * pta, rs[qb] * ptb); pb_[q2] = cvtpk(bda * ema, bdb * emb); pk_[q2] = cvtpk(kda * ema, kdb * emb); pv_[q2] = cvtpk(vs[qa], vs[qb]);
              *(LAS bf16*)(L + R_AT + i0 * RS + j * 2) = (bf16)pa_; *(LAS bf16*)(L + R_AT + (i0 + 1) * RS + j * 2) = (bf16)(pa_ >> 16);
              *(LAS bf16*)(L + R_RT + i0 * RS + j * 2) = (bf16)pr_; *(LAS bf16*)(L + R_RT + (i0 + 1) * RS + j * 2) = (bf16)(pr_ >> 16);
              *(LAS bf16*)(L + R_BW + i0 * RS + j * 2) = (bf16)pb_[q2]; *(LAS bf16*)(L + R_BW + (i0 + 1) * RS + j * 2) = (bf16)(pb_[q2] >> 16);
              *(LAS bf16*)(L + R_KU + i0 * RS + j * 2) = (bf16)pk_[q2]; *(LAS bf16*)(L + R_KU + (i0 + 1) * RS + j * 2) = (bf16)(pk_[q2] >> 16); }
          *(LAS v4u*)(L + R_BT + j * RS + 16 * w) = (v4u){pb_[0], pb_[1], pb_[2], pb_[3]};
          *(LAS v4u*)(L + R_KT + j * RS + 16 * w) = (v4u){pk_[0], pk_[1], pk_[2], pk_[3]};
          *(LAS v4u*)(L + R_VT + j * RS + 16 * w) = (v4u){pv_[0], pv_[1], pv_[2], pv_[3]}; }
        WGBAR();
        }
        STAMP(4);
        if (c + 1 < T / 64) rwkv_load_rows(rsrc, b, d, c + 1, w, o_r, o_k, o_v, o_w, o_a, xr, xk, xv, xw, xa);
        STAMP(5);
        RELANE();
        float tc[16];
        f32x4r A0[4], KV[4];
        for (int rep1_ = 0; rep1_ < REP_S12; ++rep1_) {
        if (w == 0) {
#pragma unroll
            for (int i = 0; i < 4; ++i) { f32x4r dd = (f32x4r){0.f, 0.f, 0.f, 0.f};
#pragma unroll
                for (int k2 = 0; k2 < 2; ++k2) dd = MF16(ldfrag(L, R_BW, 16 * i, 32 * k2, r, g), ldfrag(L, R_AT, 16 * i, 32 * k2, r, g), dd);
#pragma unroll
                for (int e = 0; e < 4; ++e) if (4 * g + e >= r) dd[e] = 0.f;
                storeT(L, R_AAB, dd, 16 * i, 16 * i, r, g);
                *(LAS f32x4r*)(L + R_AD + i * 1024 + r * 64 + 16 * g) = dd; }
            asm volatile("s_waitcnt lgkmcnt(0)" ::: "memory");
            const int blk = lane >> 4, cc = lane & 15;
#pragma unroll
            for (int rr = 0; rr < 8; ++rr) { float acc = (rr == cc) ? 1.f : 0.f;
#pragma unroll
                for (int s4 = 0; s4 < (rr + 3) / 4; ++s4) { const f32x4r a4 = *(const LAS f32x4r*)(L + R_AD + blk * 1024 + rr * 64 + s4 * 16);
#pragma unroll
                    for (int e = 0; e < 4; ++e) if (4 * s4 + e < rr) acc += a4[e] * tc[4 * s4 + e]; }
                tc[rr] = acc; *(LAS bf16*)(L + R_TI + (16 * blk + rr) * TIS + cc * 2) = (bf16)f2bf(acc); }
        } else {
#pragma unroll
            for (int kb = 0; kb < 3; ++kb) {
                bf16x8 fa[2][2], fb[2][2]; int dmv[2], tsv[2], ttv[2]; bool inc[2], val[2];
#pragma unroll
                for (int k = 0; k < 2; ++k) { const int jb = w - 1 + 7 * (2 * kb + k); val[k] = jb < 36; const int jc = val[k] ? jb : 0;
                    int mat, idx; if (jc < 6) { mat = 0; idx = (0x865321 >> (4 * jc)) & 15; } else { const int q = jc - 6; mat = 1 + q / 10; idx = q - 10 * (mat - 1); }
                    const int ts = (int)((0x3221110000ull >> (4 * idx)) & 15), tt = (int)((0x3323213210ull >> (4 * idx)) & 15);
                    const int ym = (mat & 1) ? R_KU : R_BW, xm = (mat & 2) ? R_RT : R_AT; dmv[k] = R_AAB + mat * RM; inc[k] = mat >= 2; tsv[k] = ts; ttv[k] = tt;
#pragma unroll
                    for (int k2 = 0; k2 < 2; ++k2) { fa[k][k2] = ldfrag(L, ym, 16 * ts, 32 * k2, r, g); fb[k][k2] = ldfrag(L, xm, 16 * tt, 32 * k2, r, g); } }
#pragma unroll
                for (int k = 0; k < 2; ++k) { f32x4r dd = (f32x4r){0.f, 0.f, 0.f, 0.f};
#pragma unroll
                    for (int k2 = 0; k2 < 2; ++k2) dd = MF16(fa[k][k2], fb[k][k2], dd);
                    if (tsv[k] == ttv[k]) {
#pragma unroll
                        for (int e = 0; e < 4; ++e) { const int sl = 4 * g + e; if (inc[k] ? (sl > r) : (sl >= r)) dd[e] = 0.f; } }
                    if (val[k]) storeT(L, dmv[k], dd, 16 * tsv[k], 16 * ttv[k], r, g); }
            }
        }
        WGBAR();
        STAMP(6);
        RELANE();
        if (w == 0) {
            const int blk = lane >> 4, cc = lane & 15;
#pragma unroll
            for (int rr = 8; rr < 16; ++rr) { float acc = (rr == cc) ? 1.f : 0.f;
#pragma unroll
                for (int s4 = 0; s4 < (rr + 3) / 4; ++s4) { const f32x4r a4 = *(const LAS f32x4r*)(L + R_AD + blk * 1024 + rr * 64 + s4 * 16);
#pragma unroll
                    for (int e = 0; e < 4; ++e) if (4 * s4 + e < rr) acc += a4[e] * tc[4 * s4 + e]; }
                tc[rr] = acc; *(LAS bf16*)(L + R_TI + (16 * blk + rr) * TIS + cc * 2) = (bf16)f2bf(acc); }
        } else if (w < 4) {
#pragma unroll
            for (int i = 0; i < 4; ++i) { A0[i] = (f32x4r){0.f, 0.f, 0.f, 0.f};
#pragma unroll
                for (int k2 = 0; k2 < 2; ++k2) A0[i] = MF16(ldfrag(L, R_VT, 16 * vt, 32 * k2, r, g), ldfrag(L, R_ARK, 16 * i, 32 * k2, r, g), A0[i]); }
        } else {
#pragma unroll
            for (int i = 0; i < 4; ++i) { A0[i] = (f32x4r){0.f, 0.f, 0.f, 0.f}; KV[i] = A0[i];
#pragma unroll
                for (int k2 = 0; k2 < 2; ++k2) { const bf16x8 vf = ldfrag(L, R_VT, 16 * vt, 32 * k2, r, g);
                    A0[i] = MF16(ldfrag(L, R_AAK, 16 * i, 32 * k2, r, g), vf, A0[i]); KV[i] = MF16(ldfrag(L, R_KT, 16 * i, 32 * k2, r, g), vf, KV[i]); } }
        }
        WGBAR();
        }
        STAMP(7);
        RELANE();
        f32x4r Usv[4];
#pragma unroll
        for (int i = 0; i < 4; ++i) Usv[i] = A0[i];
        for (int rep3_ = 0; rep3_ < REP_S3; ++rep3_) {
#pragma unroll
          for (int i = 0; i < 4; ++i) A0[i] = Usv[i];
        { f32x4r X[4];
          if (w < 4) {
#pragma unroll
              for (int i = 0; i < 4; ++i)
#pragma unroll
                  for (int e = 0; e < 4; ++e) X[i][e] = bf2f(*(const LAS bf16*)(L + R_AT + (16 * i + 4 * g + e) * RS + (16 * w + r) * 2));
          } else {
#pragma unroll
              for (int i = 0; i < 4; ++i) X[i] = A0[i];
          }
          const f32x4r z4 = (f32x4r){0.f, 0.f, 0.f, 0.f};
#define TIF(i) ld2x4(L, R_TI + (16 * (i) + r) * TIS + 8 * g, R_TI + (16 * (i) + r) * TIS + 8 * g)
#define ABF(i, j0) ld2x4(L, R_AAB + (16 * (i) + r) * RS + (16 * (j0) + 4 * g) * 2, R_AAB + (16 * (i) + r) * RS + (16 * ((j0) + 1) + 4 * g) * 2)
          X[0] = MF16(TIF(0), pack1(X[0]), z4);
          X[1] = MF16(ABF(1, 0), pack1(X[0]), X[1]); X[1] = MF16(TIF(1), pack1(X[1]), z4);
          X[2] = MF16(ABF(2, 0), pack2(X[0], X[1]), X[2]); X[2] = MF16(TIF(2), pack1(X[2]), z4);
          X[3] = MF16(ABF(3, 0), pack2(X[0], X[1]), X[3]); X[3] = MF16(ABF(3, 2), pack1(X[2]), X[3]); X[3] = MF16(TIF(3), pack1(X[3]), z4);
#undef TIF
#undef ABF
          if (w < 4) {
#pragma unroll
              for (int i = 0; i < 4; ++i)
#pragma unroll
                  for (int e = 0; e < 4; e += 2) { const unsigned pk = cvtpk(X[i][e], X[i][e + 1]);
                      *(LAS bf16*)(L + R_BW + (16 * i + 4 * g + e) * RS + (16 * w + r) * 2) = (bf16)pk; *(LAS bf16*)(L + R_BW + (16 * i + 4 * g + e + 1) * RS + (16 * w + r) * 2) = (bf16)(pk >> 16); }
          } else {
#pragma unroll
              for (int i = 0; i < 4; ++i) A0[i] = X[i];
          } }
        WGBAR();
        }
        STAMP(8);
        RELANE();
        f32x4r Ysv[4], Hsv[4];
#pragma unroll
        for (int i = 0; i < 4; ++i) { Ysv[i] = A0[i]; Hsv[i] = Hs[i]; }
        for (int rep4_ = 0; rep4_ < REP_S45; ++rep4_) {
#pragma unroll
        for (int i = 0; i < 4; ++i) { A0[i] = Ysv[i]; Hs[i] = Hsv[i]; }
        if (w < 4) {
            if (w == 0) {
#pragma unroll
                for (int i = 0; i < 4; ++i) { A0[i] = (f32x4r){0.f, 0.f, 0.f, 0.f};
#pragma unroll
                    for (int k2 = 0; k2 < 2; ++k2) A0[i] = MF16(ldfrag(L, R_VT, 0, 32 * k2, r, g), ldfrag(L, R_ARK, 16 * i, 32 * k2, r, g), A0[i]); } }
#pragma unroll
            for (int i = 0; i < 4; ++i)
#pragma unroll
                for (int k2 = 0; k2 < 2; ++k2) A0[i] = MF16(ldfrag(L, R_HT, 16 * vt, 32 * k2, r, g), ldfrag(L, R_RT, 16 * i, 32 * k2, r, g), A0[i]);
        } else {
#pragma unroll
            for (int i = 0; i < 4; ++i) {
#pragma unroll
                for (int k2 = 0; k2 < 2; ++k2) A0[i] = MF16(ldfrag(L, R_BW, 16 * i, 32 * k2, r, g), ldfrag(L, R_HT, 16 * vt, 32 * k2, r, g), A0[i]);
                storeT(L, R_KU, A0[i], 16 * i, 16 * vt, r, g); }
        }
        WGBAR();
        STAMP(9);
        RELANE();
        if (w < 4) {
#pragma unroll
            for (int i = 0; i < 4; ++i) {
#pragma unroll
                for (int k2 = 0; k2 < 2; ++k2) A0[i] = MF16(ldfrag(L, R_KU, 16 * vt, 32 * k2, r, g), ldfrag(L, R_ARB, 16 * i, 32 * k2, r, g), A0[i]);
                const int s = c * 64 + 16 * i + r, t = d ? T - 1 - s : s; v2u yw; yw.x = cvtpk(A0[i][0], A0[i][1]); yw.y = cvtpk(A0[i][2], A0[i][3]);
                *(v2u*)(ybuf + (size_t)(b * T + t) * A_W + hd * 64 + 16 * vt + 4 * g) = yw; }
        } else {
#pragma unroll
            for (int i = 0; i < 4; ++i) { f32x4r acc = Hs[i] + KV[i];
#pragma unroll
                for (int k2 = 0; k2 < 2; ++k2) acc = MF16(ldfrag(L, R_BT, 16 * i, 32 * k2, r, g), ldfrag(L, R_KU, 16 * vt, 32 * k2, r, g), acc);
                const f32x4r pc = *(const LAS f32x4r*)(L + R_PC + (16 * i + 4 * g) * 4);
                Hs[i] = acc * pc; storeT(L, R_HT, Hs[i], 16 * i, 16 * vt, r, g); }
        }
        WGBAR();
        if (rep4_ + 1 < REP_S45) {
#pragma unroll
            for (int i = 0; i < 4; ++i) if (w >= 4) storeT(L, R_HT, Hsv[i], 16 * i, 16 * vt, r, g);
            WGBAR(); }
        }
        STAMP(10);
    }
#ifdef PROBE_TA
    if (blockIdx.x == 0 && (F.wave * 64 + lane_id()) == 0) { float* pf = (float*)(F.ws + WS_CTL + 32768); pf[0] = (float)((double)pt_sel / (double)(__builtin_amdgcn_s_memtime() - pt_t0)); }
#endif
#undef RELANE
}
__device__ __forceinline__ void rwkv_post(Frame& F) {
    const bf16* pa = (const bf16*)(F.ws + WS_PA); const bf16* y0 = (const bf16*)(F.ws + WS_Y); const bf16* y1 = y0 + (size_t)M * A_W;
    const float* bon0 = (const float*)(F.ws + WS_BON); const float* bon1 = bon0 + (size_t)M * 8;
    const int ko = kopaque(); const float *lnx_w = kin(I_LNW, ko), *lnx_b = kin(I_LNB, ko), *mu_ = kin(I_MU, ko);
    int lane = lane_id(); asm volatile("" : "+v"(lane));
    const int gw = F.vcu * NWAVES + F.wave, NGW = F.G * NWAVES, hd = lane >> 3, c0 = lane * 8;
    float lw_[8], lb_[8], mv0[8], mv1[8], mg0[8], mg1[8];
#pragma unroll
    for (int e = 0; e < 8; ++e) { lw_[e] = lnx_w[c0 + e]; lb_[e] = lnx_b[c0 + e]; mv0[e] = mu_[2 * A_W + c0 + e]; mv1[e] = mu_[A_COLS + 2 * A_W + c0 + e];
        mg0[e] = mu_[3 * A_W + c0 + e]; mg1[e] = mu_[A_COLS + 3 * A_W + c0 + e]; }
    for (int m = gw; m < M; m += NGW) {
        const int t = m & (T - 1); const bool hp = t > 0, hn = t < T - 1;
        const v4u a = *(const v4u*)(y0 + (size_t)m * A_W + c0), bq = *(const v4u*)(y1 + (size_t)m * A_W + c0);
        const bf16* p0 = pa + (size_t)m * A_COLS;
        const v4u vc = *(const v4u*)(p0 + 2 * A_W + c0), gc = *(const v4u*)(p0 + 3 * A_W + c0);
        const v4u z = (v4u){0u, 0u, 0u, 0u};
        const v4u vp = hp ? *(const v4u*)(p0 - A_COLS + 2 * A_W + c0) : z, gp = hp ? *(const v4u*)(p0 - A_COLS + 3 * A_W + c0) : z;
        const v4u vn = hn ? *(const v4u*)(p0 + A_COLS + 2 * A_W + c0) : z, gn = hn ? *(const v4u*)(p0 + A_COLS + 3 * A_W + c0) : z;
        const float bsum = bon0[(size_t)m * 8 + hd] + bon1[(size_t)m * 8 + hd];
        float y[8]; const unsigned aw[4] = {a.x, a.y, a.z, a.w}, bw[4] = {bq.x, bq.y, bq.z, bq.w};
        float s1 = 0.f;
#pragma unroll
        for (int e = 0; e < 4; ++e) { y[2 * e] = bflo(aw[e]) + bflo(bw[e]); y[2 * e + 1] = bfhi(aw[e]) + bfhi(bw[e]); s1 += y[2 * e] + y[2 * e + 1]; }
        s1 += dppf<0xB1>(s1); s1 += dppf<0x4E>(s1); s1 += dppf<0x141>(s1);
        const float mean = s1 * (1.f / 64.f); float s2 = 0.f;
#pragma unroll
        for (int e = 0; e < 8; ++e) { y[e] -= mean; s2 += y[e] * y[e]; }
        s2 += dppf<0xB1>(s2); s2 += dppf<0x4E>(s2); s2 += dppf<0x141>(s2);
        const float rstd = __builtin_amdgcn_rsqf(s2 * (1.f / 64.f) + GN_EPS);
        const unsigned vcw[4] = {vc.x, vc.y, vc.z, vc.w}, vpw[4] = {vp.x, vp.y, vp.z, vp.w}, vnw[4] = {vn.x, vn.y, vn.z, vn.w}, gcw[4] = {gc.x, gc.y, gc.z, gc.w}, gpw[4] = {gp.x, gp.y, gp.z, gp.w}, gnw[4] = {gn.x, gn.y, gn.z, gn.w};
        float o[8];
#pragma unroll
        for (int e = 0; e < 8; ++e) { const int k = e >> 1; const bool hi = e & 1;
            const float v0 = hi ? bfhi(vcw[k]) : bflo(vcw[k]), vm = hi ? bfhi(vpw[k]) : bflo(vpw[k]), vx = hi ? bfhi(vnw[k]) : bflo(vnw[k]);
            const float g0 = hi ? bfhi(gcw[k]) : bflo(gcw[k]), gm = hi ? bfhi(gpw[k]) : bflo(gpw[k]), gx = hi ? bfhi(gnw[k]) : bflo(gnw[k]);
            const float vs = v0 * (1.f - mv0[e] - mv1[e]) + mv0[e] * vm + mv1[e] * vx, gs = g0 * (1.f - mg0[e] - mg1[e]) + mg0[e] * gm + mg1[e] * gx;
            o[e] = (y[e] * rstd * lw_[e] + lb_[e] + bsum * vs) * siluf_(gs); }
        v4u ov; ov.x = cvtpk(o[0], o[1]); ov.y = cvtpk(o[2], o[3]); ov.z = cvtpk(o[4], o[5]); ov.w = cvtpk(o[6], o[7]);
        *(v4u*)(F.out + (size_t)m * OROW + OS_YA + c0 * 2) = ov;
    }
}
struct Args { const float* in[24]; unsigned char* out; unsigned char* ws; };
__global__ void __launch_bounds__(NWAVES * 64, 2) hybrid_fwd(Args args) {
    extern __shared__ __attribute__((aligned(16))) unsigned char lds[];
    Frame F;
    F.lds = (LAS unsigned char*)lds;
    F.MISC = (volatile LAS unsigned*)(F.lds + MISC_OFF);
    F.wave = __builtin_amdgcn_readfirstlane((int)threadIdx.x >> 6);
    F.G = gridDim.x; { const int bx = blockIdx.x; F.vcu = (F.G % 8 == 0) ? (bx % 8) * (F.G / 8) + bx / 8 : bx; }
    F.out = args.out; F.ws = args.ws;
    for (int u = (F.wave * 64 + lane_id()); u < (LDS_BYTES - LDSCTL_OFF) / 4; u += NWAVES * 64) ((LAS unsigned*)(F.lds + LDSCTL_OFF))[u] = 0u;
    __syncthreads();
    XcdBarrier bar = xcd_barrier_post((unsigned*)(F.ws + WS_CTL) + CW_BAR, F.MISC + 8);
#define GRID_BAR() xcd_barrier(bar)
#ifdef PROBE_G
#define PGDBG(k) ((k) == PROBE_GSEL ? (float*)(F.ws + WS_CTL + 32768) : (float*)nullptr)
#else
#define PGDBG(k) ((float*)nullptr)
#endif
    typedef pg8::bf16_t bt;
    p0a(F); GRID_BAR();
    p0b(F); GRID_BAR();
    { pg8::Gemm g{(const bt*)(F.out + OS_H), (const bt*)(F.ws + WS_WB), nullptr, nullptr, OROW / 2, D}; pg8::Order S; S.init(M, B_COLS, F.G, (int)blockIdx.x, 1);
      const int ko = kopaque(); pg8::EpiPB E{(bt*)(F.ws + WS_R), kin(I_QG, ko), kin(I_KG, ko), (LAS float*)(F.lds + EPI_OFF), PGDBG(0)};
      pg8::gemm_phase<pg8::EpiPB, pg8::Order, true, true>(F.lds + RING_OFF, g, S, E, F.wave); }
    GRID_BAR();
    attn_mfma(F); GRID_BAR();
    attn_combine(F); GRID_BAR();
    { pg8::Gemm g{(const bt*)(F.out + OS_H), (const bt*)(F.ws + WS_WAG), nullptr, nullptr, OROW / 2, D}; pg8::Order S; S.init(M, AG_COLS, F.G, (int)blockIdx.x, 1);
      pg8::EpiAG E{(bt*)(F.ws + WS_PA), (bt*)(F.ws + WS_PG), PGDBG(1)};
      pg8::gemm_phase<pg8::EpiAG, pg8::Order, true, true>(F.lds + RING_OFF, g, S, E, F.wave); }
    GRID_BAR();
    rwkv_chunked(F); GRID_BAR();
    rwkv_post(F); GRID_BAR();
    { pg8::Gemm g{(const bt*)(F.out + OS_YA), (const bt*)(F.ws + WS_WOA), (const bt*)(F.out + OS_YB), (const bt*)(F.ws + WS_WOB), OROW / 2, A_W}; pg8::Order S; S.init(M, D, F.G, (int)blockIdx.x, 2);
      pg8::EpiMerge E{(const bt*)(F.ws + WS_PG), (bt*)(F.ws + WS_Y), PGDBG(2)};
      pg8::gemm_phase<pg8::EpiMerge, pg8::Order, true, true>(F.lds + RING_OFF, g, S, E, F.wave); }
    GRID_BAR();
    { pg8::Gemm g{(const bt*)(F.ws + WS_Y), (const bt*)(F.ws + WS_WO), nullptr, nullptr, D, D}; pg8::Order S; S.init(M, D, F.G, (int)blockIdx.x, 1);
      const int ko = kopaque(); pg8::EpiOut E{kin(I_XP, ko), kin(I_XS, ko), (const float*)(F.ws + WS_MOD), (float*)F.out, PGDBG(3)};
      pg8::gemm_phase<pg8::EpiOut, pg8::Order, true, true>(F.lds + RING_OFF, g, S, E, F.wave); }
#if defined(PROBE_TA) || defined(PROBE_G) || defined(PROBE_AT)
    GRID_BAR();
    { const float f = ((const float*)(F.ws + WS_CTL + 32768))[0]; float* o = (float*)F.out;
      for (int i = blockIdx.x * 512 + (F.wave * 64 + lane_id()); i < 655 * 1024; i += gridDim.x * 512) o[i] *= (1.f + f); }
#endif
}

extern "C" void kernel_launch(void* const* d_in, const int* in_sizes, int n_in, void* d_out, int out_size, void* d_ws, size_t ws_size, hipStream_t stream) {
    static int grid = 0;
    if (grid == 0) {
        if (n_in != 24 || out_size != M * D || ws_size < WS_END) { fprintf(stderr, "kernel_launch: unexpected shapes: n_in %d out %d ws %zu (need %zu)\n", n_in, out_size, ws_size, (size_t)WS_END); grid = -1; return; }
        int dev = 0, cus = 0, per_cu = 0;
        if (hipGetDevice(&dev) != hipSuccess || hipDeviceGetAttribute(&cus, hipDeviceAttributeMultiprocessorCount, dev) != hipSuccess) { grid = -1; return; }
        if (hipFuncSetAttribute((const void*)hybrid_fwd, hipFuncAttributeMaxDynamicSharedMemorySize, LDS_BYTES) != hipSuccess) { fprintf(stderr, "kernel_launch: hipFuncSetAttribute failed\n"); grid = -1; return; }
        if (hipOccupancyMaxActiveBlocksPerMultiprocessor(&per_cu, (const void*)hybrid_fwd, NWAVES * 64, LDS_BYTES) != hipSuccess || per_cu < 1) { fprintf(stderr, "kernel_launch: occupancy query says %d\n", per_cu); }
        (void)hipGetLastError();
        grid = cus;
    }
    if (grid < 0) return;
    if (hipMemsetAsync((char*)d_ws + WS_CTL, 0, CTL_ZERO_BYTES, stream) != hipSuccess) return;
    Args a{};
    for (int i = 0; i < 24; ++i) a.in[i] = (const float*)d_in[i];
    a.out = (unsigned char*)d_out; a.ws = (unsigned char*)d_ws;
    hipLaunchKernelGGL(hybrid_fwd, dim3(grid), dim3(NWAVES * 64), LDS_BYTES, stream, a);
}
```

```cpp
#include <hip/hip_runtime.h>
#include <cstdio>
#include <cstdint>
namespace pg8 {
#define PG8_LAS __attribute__((address_space(3)))
typedef unsigned short bf16_t;
typedef short bf16x8 __attribute__((ext_vector_type(8)));
typedef float f32x4 __attribute__((ext_vector_type(4)));
typedef unsigned u32x4 __attribute__((ext_vector_type(4)));
constexpr int BM = 256, BK = 64, HALF = 128, HTB = HALF * BK * 2  , STAGE_BYTES = 8 * HTB, NXCD = 8, WGM = 8;

__host__ __device__ __forceinline__ int lds_byte(int r, int c) { const int st = (r >> 4) * 2 + (c >> 5), rr = r & 15, cc = c & 31, ob = rr * 64 + cc * 2; return st * 1024 + (ob ^ (((ob >> 9) & 1) << 5)); }
__host__ __device__ __forceinline__ void stage_rc(int b, int& R, int& C) { const int st = b / 1024, sb = b % 1024, swz = sb ^ (((sb >> 9) & 1) << 5); R = (st >> 1) * 16 + swz / 64; C = (st & 1) * 32 + (swz % 64) / 2; }
__host__ __device__ __forceinline__ int perm32(int rho) { const int n = rho >> 4, i = rho & 15; return 8 * (i >> 2) + 4 * n + (i & 3); }

struct Unit { int pm, pn, sel; };
struct Gemm { const bf16_t* A0; const bf16_t* B0; const bf16_t* A1; const bf16_t* B1; int lda; int K; };

struct Order {
    int nM, nN, nwg, G, c, CH;
    __host__ __device__ void init(int M, int N, int G_, int c_, int CH_) { nM = M / BM; nN = N / BM; nwg = nM * nN; G = G_; c = c_; CH = CH_; }
    __host__ __device__ bool next(int i, Unit& u) const {
        const int ti = (CH == 2) ? (i >> 1) : i; u.sel = (CH == 2) ? (i & 1) : 0;
        const long L = (long)ti * G + c; if (L >= nwg) return false;
        int wgid = (int)L; { const int q = nwg / NXCD, r = nwg % NXCD, xcd = wgid % NXCD, off = wgid / NXCD; wgid = (xcd < r ? xcd * (q + 1) : r * (q + 1) + (xcd - r) * q) + off; }
        const int nig = WGM * nN, gid = wgid / nig, fm = gid * WGM, gsz = (nM - fm) < WGM ? (nM - fm) : WGM;
        u.pm = fm + ((wgid % nig) % gsz); u.pn = (wgid % nig) / gsz; return true;
    }
};
__device__ __forceinline__ unsigned cvt_pk_bf16(float lo, float hi) { unsigned r; asm volatile("v_cvt_pk_bf16_f32 %0, %1, %2" : "=v"(r) : "v"(lo), "v"(hi)); return r; }
template <class Epi, class Sched, bool ALIGN_EPI = false, bool SP2 = false>
__device__ __forceinline__ void gemm_phase(PG8_LAS unsigned char* lds, const Gemm g, const Sched& S, const Epi& E, const int wave_id) {
    int tid = wave_id * 64 + (int)__builtin_amdgcn_mbcnt_hi(~0u, __builtin_amdgcn_mbcnt_lo(~0u, 0u)); asm volatile("" : "+v"(tid));
    const int wid = wave_id, lane = tid & 63, wr = wid >> 2, wc = wid & 3, fr = lane & 15, fq = lane >> 4;
    const int K = g.K, nt = K / BK;
    unsigned voffA[2], voffB[2];
#pragma unroll
    for (int i = 0; i < 2; ++i) { int R, C; stage_rc(tid * 16 + i * 8192, R, C); const int Rb = Epi::PERM ? ((R & ~31) + perm32(R & 31)) : R;
        voffA[i] = (unsigned)(R * g.lda + C) * 2u; voffB[i] = (unsigned)(Rb * K + C) * 2u; }
    const size_t kstep = (size_t)(BK * 2);
    const size_t hstepA = (size_t)HALF * g.lda * 2, hstepB = (size_t)HALF * K * 2;
    const size_t tstepA = 2 * hstepA, tstepB = 2 * hstepB;
    const unsigned ldsw = (unsigned)wid * 1024u;
    const int aoff = lds_byte(wr * 64 + fr, fq * 8), boff = lds_byte(wc * 32 + fr, fq * 8);
#define PG8_SA(b, h) (((b) * 2 + (h)) * HTB)
#define PG8_SB(b, h) ((4 + (b) * 2 + (h)) * HTB)
#define PG8_STAGE(bufoff, gbase, voff) do { _Pragma("unroll") for (int _i = 0; _i < 2; ++_i) \
        __builtin_amdgcn_global_load_lds((const unsigned*)((const char*)(gbase) + (voff)[_i]), (PG8_LAS unsigned*)(lds + (bufoff) + ldsw + _i * 8192), 16, 0, 0); } while (0)
#define PG8_LDA(dst, b, h) do { _Pragma("unroll") for (int m = 0; m < 4; ++m) _Pragma("unroll") for (int k = 0; k < 2; ++k) dst[m][k] = *(const PG8_LAS bf16x8*)(lds + PG8_SA(b, h) + aoff + m * 2048 + k * 1024); } while (0)
#define PG8_LDB(dst, b, h) do { _Pragma("unroll") for (int n = 0; n < 2; ++n) _Pragma("unroll") for (int k = 0; k < 2; ++k) dst[n][k] = *(const PG8_LAS bf16x8*)(lds + PG8_SB(b, h) + boff + n * 2048 + k * 1024); } while (0)
#define PG8_MMA(ai, bj, At, Bt) do { __builtin_amdgcn_s_setprio(1); _Pragma("unroll") for (int m = 0; m < 4; ++m) _Pragma("unroll") for (int n = 0; n < 2; ++n) _Pragma("unroll") for (int k = 0; k < 2; ++k) \
        acc[ai][bj][m][n] = __builtin_amdgcn_mfma_f32_16x16x32_bf16(Bt[n][k], At[m][k], acc[ai][bj][m][n], 0, 0, 0); __builtin_amdgcn_s_setprio(0); } while (0)
#define PG8_APTR(u) ((const char*)((u).sel ? g.A1 : g.A0) + (size_t)(u).pm * tstepA)
#define PG8_BPTR(u) ((const char*)((u).sel ? g.B1 : g.B0) + (size_t)(u).pn * tstepB)
#define PG8_WAIT_V(n) asm volatile("s_waitcnt vmcnt(" #n ")" ::: "memory")
#define PG8_WAIT_L(n) asm volatile("s_waitcnt lgkmcnt(" #n ")" ::: "memory")
#define PG8_BAR __builtin_amdgcn_s_barrier()
#define PG8_SCHED __builtin_amdgcn_sched_barrier(0)
    Unit cur, nxt; int ui = 0;
    if (!S.next(0, cur)) return;
#ifdef PROBE_G
    unsigned long long pg_epi = 0; const unsigned long long pg_start = __builtin_amdgcn_s_memtime();
#endif
    f32x4 acc[2][2][4][2];
#pragma unroll
    for (int a = 0; a < 2; ++a)
#pragma unroll
        for (int b = 0; b < 2; ++b)
#pragma unroll
            for (int m = 0; m < 4; ++m)
#pragma unroll
                for (int n = 0; n < 2; ++n) acc[a][b][m][n] = (f32x4){0.f, 0.f, 0.f, 0.f};
    bf16x8 At[4][2], B0[2][2], B1[2][2];
    const char* cA = PG8_APTR(cur); const char* cB = PG8_BPTR(cur);
    if constexpr (SP2) {
        PG8_STAGE(PG8_SB(0, 0), cB, voffB); PG8_STAGE(PG8_SB(0, 1), cB + hstepB, voffB); PG8_STAGE(PG8_SA(0, 0), cA, voffA); PG8_STAGE(PG8_SA(0, 1), cA + hstepA, voffA);
        if (wr == 1) PG8_BAR;
        PG8_WAIT_V(2); PG8_BAR;
        PG8_STAGE(PG8_SB(1, 0), cB + kstep, voffB); PG8_STAGE(PG8_SA(1, 0), cA + kstep, voffA); PG8_STAGE(PG8_SB(1, 1), cB + hstepB + kstep, voffB);
        PG8_WAIT_V(6); PG8_BAR;
    } else {
        PG8_STAGE(PG8_SB(0, 0), cB, voffB); PG8_STAGE(PG8_SA(0, 0), cA, voffA); PG8_STAGE(PG8_SB(0, 1), cB + hstepB, voffB); PG8_STAGE(PG8_SA(0, 1), cA + hstepA, voffA);
        if (wr == 1) PG8_BAR;
        PG8_WAIT_V(4); PG8_BAR;
        PG8_STAGE(PG8_SB(1, 0), cB + kstep, voffB); PG8_STAGE(PG8_SA(1, 0), cA + kstep, voffA); PG8_STAGE(PG8_SB(1, 1), cB + hstepB + kstep, voffB);
        PG8_WAIT_V(6); PG8_BAR;
    }
    for (;;) {
        const bool has_next = S.next(ui + 1, nxt);
        const char* nA = has_next ? PG8_APTR(nxt) : cA; const char* nB = has_next ? PG8_BPTR(nxt) : cB;
        for (int t = 0; t < nt; t += 2) {
            const bool last = (t == nt - 2);
            const char* a1 = cA + (size_t)(t + 1) * kstep;
            const char* a2 = last ? nA : cA + (size_t)(t + 2) * kstep; const char* b2 = last ? nB : cB + (size_t)(t + 2) * kstep;
            const char* a3 = a2 + kstep; const char* b3 = b2 + kstep;
            if constexpr (SP2) {
            PG8_LDB(B0, 0, 0); PG8_LDB(B1, 0, 1); PG8_SCHED; PG8_LDA(At, 0, 0); PG8_STAGE(PG8_SA(1, 1), a1 + hstepA, voffA);
            PG8_WAIT_V(8); PG8_WAIT_L(0); PG8_BAR; PG8_MMA(0, 0, At, B0); PG8_MMA(0, 1, At, B1); PG8_BAR; PG8_SCHED;
            PG8_LDA(At, 0, 1); PG8_STAGE(PG8_SB(0, 0), b2, voffB); PG8_STAGE(PG8_SB(0, 1), b2 + hstepB, voffB); PG8_STAGE(PG8_SA(0, 0), a2, voffA);
            PG8_WAIT_V(8); PG8_WAIT_L(0); PG8_BAR; PG8_MMA(1, 0, At, B0); PG8_MMA(1, 1, At, B1); PG8_BAR; PG8_SCHED;
            PG8_LDB(B0, 1, 0); PG8_LDB(B1, 1, 1); PG8_SCHED; PG8_LDA(At, 1, 0); PG8_STAGE(PG8_SA(0, 1), a2 + hstepA, voffA);
            PG8_WAIT_V(8); PG8_WAIT_L(0); PG8_BAR; PG8_MMA(0, 0, At, B0); PG8_MMA(0, 1, At, B1); PG8_BAR; PG8_SCHED;
            PG8_LDA(At, 1, 1); PG8_STAGE(PG8_SB(1, 0), b3, voffB); PG8_STAGE(PG8_SB(1, 1), b3 + hstepB, voffB); PG8_STAGE(PG8_SA(1, 0), a3, voffA);
            PG8_WAIT_V(8); PG8_WAIT_L(0); PG8_BAR; PG8_MMA(1, 0, At, B0); PG8_MMA(1, 1, At, B1); PG8_BAR; PG8_SCHED;
            } else {
            PG8_LDB(B0, 0, 0); PG8_SCHED; PG8_LDA(At, 0, 0); PG8_STAGE(PG8_SA(1, 1), a1 + hstepA, voffA);
            PG8_WAIT_L(8); PG8_BAR; PG8_WAIT_L(0); PG8_MMA(0, 0, At, B0); PG8_BAR; PG8_SCHED;
            PG8_LDB(B1, 0, 1); PG8_STAGE(PG8_SB(0, 0), b2, voffB);
            PG8_BAR; PG8_WAIT_L(0); PG8_MMA(0, 1, At, B1); PG8_BAR;
            PG8_LDA(At, 0, 1); PG8_STAGE(PG8_SA(0, 0), a2, voffA);
            PG8_BAR; PG8_WAIT_L(0); PG8_MMA(1, 0, At, B0); PG8_BAR; PG8_SCHED;
            PG8_STAGE(PG8_SB(0, 1), b2 + hstepB, voffB);
            PG8_WAIT_V(6); PG8_BAR; PG8_MMA(1, 1, At, B1); PG8_BAR;
            PG8_LDB(B0, 1, 0); PG8_SCHED; PG8_LDA(At, 1, 0); PG8_STAGE(PG8_SA(0, 1), a2 + hstepA, voffA);
            PG8_WAIT_L(8); PG8_BAR; PG8_WAIT_L(0); PG8_MMA(0, 0, At, B0); PG8_BAR; PG8_SCHED;
            PG8_LDB(B1, 1, 1); PG8_STAGE(PG8_SB(1, 0), b3, voffB);
            PG8_BAR; PG8_WAIT_L(0); PG8_MMA(0, 1, At, B1); PG8_BAR;
            PG8_LDA(At, 1, 1); PG8_STAGE(PG8_SA(1, 0), a3, voffA);
            PG8_BAR; PG8_WAIT_L(0); PG8_MMA(1, 0, At, B0); PG8_BAR; PG8_SCHED;
            PG8_STAGE(PG8_SB(1, 1), b3 + hstepB, voffB);
            PG8_WAIT_V(6); PG8_BAR; PG8_MMA(1, 1, At, B1); PG8_BAR;
            }
        }
        if constexpr (ALIGN_EPI) { if (wr == 0) PG8_BAR; }
#ifdef PROBE_G
        const unsigned long long pg_t0 = __builtin_amdgcn_s_memtime();
#endif
        const bool keep = E(acc, cur, wr, wc, fr, fq);
#ifdef PROBE_G
        pg_epi += __builtin_amdgcn_s_memtime() - pg_t0;
#endif
        if (!has_next) break;
        if (!keep) {
#pragma unroll
        for (int a = 0; a < 2; ++a)
#pragma unroll
            for (int b = 0; b < 2; ++b)
#pragma unroll
                for (int m = 0; m < 4; ++m)
#pragma unroll
                    for (int n = 0; n < 2; ++n) acc[a][b][m][n] = (f32x4){0.f, 0.f, 0.f, 0.f};
        }
        cur = nxt; cA = nA; cB = nB; ++ui;
        if constexpr (ALIGN_EPI) { if (wr == 1) PG8_BAR; }
    }
#ifdef PROBE_G
    if (E.dbg && blockIdx.x == 0 && threadIdx.x == 0) { const double tot = (double)(__builtin_amdgcn_s_memtime() - pg_start);
        E.dbg[0] = (PROBE_G == 1) ? (float)(tot / (double)(ui + 1) / 262144.0) : (float)((double)pg_epi / tot); }
#endif
    PG8_WAIT_V(0);
    if constexpr (!ALIGN_EPI) { if (wr == 0) PG8_BAR; }
    PG8_BAR;
#undef PG8_SA
#undef PG8_SB
#undef PG8_STAGE
#undef PG8_LDA
#undef PG8_LDB
#undef PG8_MMA
#undef PG8_APTR
#undef PG8_BPTR
#undef PG8_WAIT_V
#undef PG8_WAIT_L
#undef PG8_BAR
#undef PG8_SCHED
}
}

constexpr int NWAVES = 8;
constexpr int T = 8192, D = 1024, NBP = 8, NBS = 2, NB = NBP + NBS, M = NB * T;
constexpr int NCHAIN = 160;
#ifndef PG_MAIN_TILES
#define PG_MAIN_TILES 0
#endif
constexpr int PGM = PG_MAIN_TILES;
constexpr int A_HEADS = 8, A_HD = 64, A_W = 512, RANK = 64;
constexpr int A_COLS = 2304, B_COLS = 5120, G_COLS = 2048, IN_COLS = 9472, AG_COLS = A_COLS + G_COLS;
constexpr int B_QKV = 1536, B_W = 512, B_HD = 128;
constexpr float RMS_EPS = 1e-6f, GN_EPS = 64e-5f;
constexpr size_t MiB = 1u << 20;
constexpr size_t WS_CTL = 0, CTL_ZERO_BYTES = 65536;
constexpr size_t WS_MOD = 1 * MiB;
constexpr size_t WS_BTAB = 1 * MiB + 128 * 1024;
constexpr size_t WS_WB = 2 * MiB;
constexpr size_t WS_WAG = 12 * MiB;
constexpr size_t WS_WOA = 21 * MiB, WS_WOB = 22 * MiB, WS_WO = 23 * MiB;
constexpr size_t WS_BON = 26 * MiB;
constexpr size_t WS_R = 32 * MiB;
constexpr size_t WS_PA = WS_R, WS_PG = WS_R + 360 * MiB;
constexpr size_t WS_Y = 832 * MiB;
constexpr size_t WS_END = 992 * MiB;
constexpr int CW_BAR = 4096;
constexpr int OS_H = 0, OS_YA = 2048, OS_YB = 3072, OROW = 4096;
constexpr int RING_OFF = 0, RING_BYTES = 131072;
constexpr int LDSCTL_OFF = RING_BYTES, MISC_OFF = LDSCTL_OFF + 320;
constexpr int EPI_OFF = RING_BYTES + 1024;
constexpr int LDS_BYTES = 147456;

#define GAS __attribute__((address_space(1)))
#define LAS __attribute__((address_space(3)))
typedef unsigned short bf16;
typedef unsigned v4u __attribute__((ext_vector_type(4)));
typedef unsigned v2u __attribute__((ext_vector_type(2)));
typedef float f32x4 __attribute__((ext_vector_type(4)));
typedef short bf16x8 __attribute__((ext_vector_type(8)));
typedef GAS unsigned gu32;
#define RLX_AGENT __ATOMIC_RELAXED, __HIP_MEMORY_SCOPE_AGENT
#define LDS_WAIT() asm volatile("s_waitcnt lgkmcnt(0)" ::: "memory")
#define VM_WAIT() asm volatile("s_waitcnt vmcnt(0)" ::: "memory")
__device__ __forceinline__ unsigned f2bf(float f) { unsigned u = __builtin_bit_cast(unsigned, f); return (u + 0x7fffu + ((u >> 16) & 1u)) >> 16; }
__device__ __forceinline__ unsigned pk2(float lo, float hi) { return f2bf(lo) | (f2bf(hi) << 16); }
typedef float f32x2_t __attribute__((ext_vector_type(2))); typedef __bf16 bf16x2_t __attribute__((ext_vector_type(2)));
__device__ __forceinline__ unsigned cvtpk(float lo, float hi) { f32x2_t v = {lo, hi}; bf16x2_t b = __builtin_convertvector(v, bf16x2_t); return __builtin_bit_cast(unsigned, b); }
__device__ __forceinline__ float bf2f(unsigned short h) { return __builtin_bit_cast(float, (unsigned)h << 16); }
__device__ __forceinline__ float bflo(unsigned w) { return __builtin_bit_cast(float, w << 16); }
__device__ __forceinline__ float bfhi(unsigned w) { return __builtin_bit_cast(float, w & 0xffff0000u); }
__device__ __forceinline__ float sigmoidf_(float v) { return __builtin_amdgcn_rcpf(1.f + __expf(-v)); }
__device__ __forceinline__ float siluf_(float v) { return v * sigmoidf_(v); }
__device__ __forceinline__ int lane_id() { return (int)__builtin_amdgcn_mbcnt_hi(~0u, __builtin_amdgcn_mbcnt_lo(~0u, 0u)); }
__device__ __forceinline__ float wave_sum(float v) {
#pragma unroll
    for (int o = 1; o < 64; o <<= 1) v += __shfl_xor(v, o);
    return v;
}
__device__ __forceinline__ float wave_max(float v) {
#pragma unroll
    for (int o = 1; o < 64; o <<= 1) v = fmaxf(v, __shfl_xor(v, o));
    return v;
}

#define XB_TMO      128
#define XB_XCNT(j)  (256  + 64 * (j))
#define XB_XSUB(j)  (1280 + 64 * (j))
#define XB_XGEN(j)  (2304 + 64 * (j))
#define XB_TOP      3328
#define XB_TOPGEN   3392
#define XCD_BAR_WORDS 3456
#define XB_SPIN_CAP (1u << 22)
__device__ __forceinline__ unsigned xb_ld(unsigned* p)              { return __hip_atomic_load(p, __ATOMIC_RELAXED, __HIP_MEMORY_SCOPE_AGENT); }
__device__ __forceinline__ unsigned xb_add(unsigned* p, unsigned v) { return __hip_atomic_fetch_add(p, v, __ATOMIC_RELAXED, __HIP_MEMORY_SCOPE_AGENT); }
__device__ __forceinline__ unsigned xb_xcc_id() { return (unsigned)__builtin_amdgcn_s_getreg((3 << 11) | 20) & 0xFu; }
#define XB_SPIN(cond, bar) do { unsigned _sp = 0; while (cond) { __builtin_amdgcn_s_sleep(1); \
    if ((++_sp & 255u) == 0u) { if (xb_ld(&(bar)[XB_TMO])) break; if (_sp > XB_SPIN_CAP) { atomicAdd(&(bar)[XB_TMO], 1u); break; } } } } while (0)
struct XcdBarrier { unsigned* bar; unsigned x; volatile LAS unsigned* st; };
__device__ __forceinline__ XcdBarrier xcd_barrier_post(unsigned* bar, volatile LAS unsigned* st) {
    XcdBarrier b; b.bar = bar; b.x = xb_xcc_id(); b.st = st;
    if (threadIdx.x == 0) (void)xb_add(&bar[XB_XCNT(b.x)], 1u);
    return b;
}
__device__ __forceinline__ void xcd_barrier_complete(unsigned* bar, unsigned x, unsigned& nloc, unsigned& nx) {
    const unsigned G = gridDim.x * gridDim.y * gridDim.z;
    unsigned sum, cnt, mine, sp = 0u;
    for (;;) {
        sum = 0u; cnt = 0u; mine = 0u;
#pragma unroll
        for (unsigned j = 0; j < 16; ++j) { const unsigned c = xb_ld(&bar[XB_XCNT(j)]); sum += c; cnt += (c > 0u) ? 1u : 0u; mine = (j == x) ? c : mine; }
        if (sum == G) break;
        __builtin_amdgcn_s_sleep(1);
        if ((++sp & 255u) == 0u) { if (xb_ld(&bar[XB_TMO])) break; if (sp > XB_SPIN_CAP) { atomicAdd(&bar[XB_TMO], 1u); break; } }
    }
    nloc = mine > 0u ? mine : 1u; nx = cnt > 0u ? cnt : 1u;
}
__device__ __forceinline__ void xcd_barrier(const XcdBarrier& b) {
    asm volatile("s_waitcnt vmcnt(0)" ::: "memory");
    __syncthreads();
    if (threadIdx.x == 0) {
        unsigned* bar = b.bar;
        __builtin_amdgcn_s_waitcnt(0);
        unsigned nloc = b.st[0], nx = b.st[1];
        if (nloc == 0u) { xcd_barrier_complete(bar, b.x, nloc, nx); b.st[0] = nloc; b.st[1] = nx; }
        const unsigned old = xb_add(&bar[XB_XSUB(b.x)], 1u);
        const unsigned gen = old / nloc;
        if (old + 1u == (gen + 1u) * nloc) {
            __builtin_amdgcn_fence(__ATOMIC_RELEASE, "agent");
            asm volatile("s_waitcnt vmcnt(0)" ::: "memory");
            const unsigned og = xb_add(&bar[XB_TOP], 1u);
            const unsigned tg = og / nx;
            if (og + 1u == (tg + 1u) * nx) xb_add(&bar[XB_TOPGEN], 1u);
            else XB_SPIN(xb_ld(&bar[XB_TOPGEN]) == tg, bar);
            __builtin_amdgcn_fence(__ATOMIC_ACQUIRE, "agent");
            xb_add(&bar[XB_XGEN(b.x)], 1u);
            asm volatile("s_waitcnt vmcnt(0)" ::: "memory");
        } else {
            XB_SPIN(xb_ld(&bar[XB_XGEN(b.x)]) == gen, bar);
            __builtin_amdgcn_fence(__ATOMIC_ACQUIRE, "agent");
            asm volatile("s_waitcnt vmcnt(0)" ::: "memory");
        }
    }
    __syncthreads();
}

struct Frame {
    LAS unsigned char* lds;
    volatile LAS unsigned* MISC;
    int wave;
    __device__ __forceinline__ int lane_() const { return lane_id(); }
    int vcu, G;
    unsigned char* out;
    unsigned char* ws;
};
enum { I_XP = 0, I_XS, I_CP, I_CS, I_RELB, I_NORMW, I_WADA, I_BADA, I_WIN, I_MU, I_W0, I_W2, I_A0, I_A2, I_KK, I_KA, I_RK, I_LNW, I_LNB, I_QG, I_KG, I_WOA, I_WOB, I_WO };
__device__ __forceinline__ int kopaque() { int z = 0; asm volatile("" : "+s"(z)); return z; }
__device__ __forceinline__ const float* kin(int k, int kof) { return ((const float* const __attribute__((address_space(4)))*)__builtin_amdgcn_kernarg_segment_ptr())[k + kof]; }
__device__ __forceinline__ const float* xrow_ptr(const float* xp, const float* xs, int m) { return m < NBP * T ? xp + (size_t)m * D : xs + (size_t)(m - NBP * T) * D; }

namespace pg8 {
struct EpiPB {
    static constexpr bool PERM = true;
    bf16_t* O; const float* qg; const float* kg; PG8_LAS float* P; float* dbg;
    __device__ __forceinline__ bool operator()(f32x4 (&acc)[2][2][4][2], const Unit& u, int wr, int wc, int fr, int fq) const {
        const int row0 = u.pm * BM + wr * 64 + fr, col0 = u.pn * BM + wc * 32 + 8 * fq;
        if (u.pn < 12) {
#pragma unroll
            for (int ai = 0; ai < 2; ++ai)
#pragma unroll
                for (int m = 0; m < 4; ++m) {
#pragma unroll
                    for (int bj = 0; bj < 2; ++bj) { const f32x4 a = acc[ai][bj][m][0], b = acc[ai][bj][m][1];
                        float s = (a[0] * a[0] + a[1] * a[1]) + (a[2] * a[2] + a[3] * a[3]) + (b[0] * b[0] + b[1] * b[1]) + (b[2] * b[2] + b[3] * b[3]);
                        s += __shfl_xor(s, 16); s += __shfl_xor(s, 32);
                        if (fq == 0) P[((ai * HALF + wr * 64 + m * 16 + fr) * 2 + bj) * 4 + wc] = s; }
                    asm volatile("" ::: "memory"); }
            asm volatile("s_waitcnt lgkmcnt(0)" ::: "memory"); __builtin_amdgcn_s_barrier(); asm volatile("" ::: "memory");
            const bool isq = u.pn < 6; const float* gp = (isq ? qg : kg) + wc * 32 + 8 * fq; const float gs = isq ? 0.08838834764831845f * 1.4426950408889634f : 1.f;
            float gn[8];
#pragma unroll
            for (int e = 0; e < 8; ++e) gn[e] = gp[e] * gs;
#pragma unroll
            for (int ai = 0; ai < 2; ++ai)
#pragma unroll
                for (int m = 0; m < 4; ++m)
#pragma unroll
                    for (int bj = 0; bj < 2; ++bj) { const f32x4 p4 = *(const PG8_LAS f32x4*)(P + ((ai * HALF + wr * 64 + m * 16 + fr) * 2 + bj) * 4);
                        const float rs = 1.0f / sqrtf(((p4[0] + p4[1]) + (p4[2] + p4[3])) * (1.f / 128.f) + 1e-6f);
#pragma unroll
                        for (int e = 0; e < 4; ++e) { acc[ai][bj][m][0][e] *= rs * gn[e]; acc[ai][bj][m][1][e] *= rs * gn[4 + e]; }
                        asm volatile("" ::: "memory"); }
        }
        const bool act = u.pn >= 18;
#pragma unroll
        for (int ai = 0; ai < 2; ++ai)
#pragma unroll
            for (int m = 0; m < 4; ++m) { bf16_t* rowp = O + (size_t)(row0 + ai * HALF + m * 16) * B_COLS + col0;
#pragma unroll
                for (int bj = 0; bj < 2; ++bj) { f32x4 v0 = acc[ai][bj][m][0], v1 = acc[ai][bj][m][1];
                    if (act) {
#pragma unroll
                        for (int e = 0; e < 4; ++e) { v0[e] = siluf_(v0[e]); v1[e] = siluf_(v1[e]); } }
                    u32x4 w; w.x = cvt_pk_bf16(v0[0], v0[1]); w.y = cvt_pk_bf16(v0[2], v0[3]); w.z = cvt_pk_bf16(v1[0], v1[1]); w.w = cvt_pk_bf16(v1[2], v1[3]);
                    *(u32x4*)(rowp + bj * HALF) = w; } }
        return false;
    }
};
struct EpiAG {
    static constexpr bool PERM = true;
    bf16_t* PA; bf16_t* PG; float* dbg;
    __device__ __forceinline__ bool operator()(const f32x4 (&acc)[2][2][4][2], const Unit& u, int wr, int wc, int fr, int fq) const {
        const bool isg = u.pn >= 9; bf16_t* base = isg ? PG : PA; const int ldc = isg ? G_COLS : A_COLS; const int pn = isg ? u.pn - 9 : u.pn;
        const int row0 = u.pm * BM + wr * 64 + fr, col0 = pn * BM + wc * 32 + 8 * fq;
#pragma unroll
        for (int ai = 0; ai < 2; ++ai)
#pragma unroll
            for (int m = 0; m < 4; ++m) { bf16_t* rowp = base + (size_t)(row0 + ai * HALF + m * 16) * ldc + col0;
#pragma unroll
                for (int bj = 0; bj < 2; ++bj) { const f32x4 v0 = acc[ai][bj][m][0], v1 = acc[ai][bj][m][1];
                    u32x4 w; w.x = cvt_pk_bf16(v0[0], v0[1]); w.y = cvt_pk_bf16(v0[2], v0[3]); w.z = cvt_pk_bf16(v1[0], v1[1]); w.w = cvt_pk_bf16(v1[2], v1[3]);
                    *(u32x4*)(rowp + bj * HALF) = w; } }
        return false;
    }
};
struct EpiPG {
    static constexpr bool PERM = true;
    bf16_t* PG; float* dbg;
    __device__ __forceinline__ bool operator()(const f32x4 (&acc)[2][2][4][2], const Unit& u, int wr, int wc, int fr, int fq) const {
        const int row0 = u.pm * BM + wr * 64 + fr, col0 = u.pn * BM + wc * 32 + 8 * fq;
#pragma unroll
        for (int ai = 0; ai < 2; ++ai)
#pragma unroll
            for (int m = 0; m < 4; ++m) { bf16_t* rowp = PG + (size_t)(row0 + ai * HALF + m * 16) * G_COLS + col0;
#pragma unroll
                for (int bj = 0; bj < 2; ++bj) { const f32x4 v0 = acc[ai][bj][m][0], v1 = acc[ai][bj][m][1];
                    u32x4 w; w.x = cvt_pk_bf16(v0[0], v0[1]); w.y = cvt_pk_bf16(v0[2], v0[3]); w.z = cvt_pk_bf16(v1[0], v1[1]); w.w = cvt_pk_bf16(v1[2], v1[3]);
                    *(u32x4*)(rowp + bj * HALF) = w; } }
        return false;
    }
};
struct EpiMerge {
    static constexpr bool PERM = true;
    const bf16_t* PG; bf16_t* O; float* dbg;
    __device__ __forceinline__ bool operator()(f32x4 (&acc)[2][2][4][2], const Unit& u, int wr, int wc, int fr, int fq) const {
        const int row0 = u.pm * BM + wr * 64 + fr, col0 = u.pn * BM + wc * 32 + 8 * fq;
#pragma unroll
        for (int ai = 0; ai < 2; ++ai)
#pragma unroll
            for (int m = 0; m < 4; ++m) { const size_t row = (size_t)(row0 + ai * HALF + m * 16);
#pragma unroll
                for (int bj = 0; bj < 2; ++bj) { const int col = col0 + bj * HALF;
                    const u32x4 gb8 = *(const u32x4*)(PG + row * G_COLS + D + col);
                    float zb[8] = {bflo(gb8.x), bfhi(gb8.x), bflo(gb8.y), bfhi(gb8.y), bflo(gb8.z), bfhi(gb8.z), bflo(gb8.w), bfhi(gb8.w)};
                    if (u.sel == 0) {
                        const u32x4 ga8 = *(const u32x4*)(PG + row * G_COLS + col);
                        float za[8] = {bflo(ga8.x), bfhi(ga8.x), bflo(ga8.y), bfhi(ga8.y), bflo(ga8.z), bfhi(ga8.z), bflo(ga8.w), bfhi(ga8.w)};
#pragma unroll
                        for (int e = 0; e < 8; ++e) { const float ea = __expf(-fminf(fmaxf(za[e], -30.f), 30.f)), eb = __expf(-fminf(fmaxf(zb[e], -30.f), 30.f));
                            const float r = (1.f + eb) * __builtin_amdgcn_rcpf(1.f + ea); acc[ai][bj][m][e >> 2][e & 3] *= r; }
                    } else {
                        float o[8];
#pragma unroll
                        for (int e = 0; e < 8; ++e) { const float eb = __expf(-fminf(fmaxf(zb[e], -30.f), 30.f)); o[e] = acc[ai][bj][m][e >> 2][e & 3] * __builtin_amdgcn_rcpf(1.f + eb); }
                        u32x4 w; w.x = cvt_pk_bf16(o[0], o[1]); w.y = cvt_pk_bf16(o[2], o[3]); w.z = cvt_pk_bf16(o[4], o[5]); w.w = cvt_pk_bf16(o[6], o[7]);
                        *(u32x4*)(O + row * D + col) = w;
                    } } }
        return u.sel == 0;
    }
};
struct EpiOut {
    static constexpr bool PERM = false;
    const float* xp; const float* xs; const float* mod; float* out; float* dbg;
    __device__ __forceinline__ bool operator()(const f32x4 (&acc)[2][2][4][2], const Unit& u, int wr, int wc, int fr, int fq) const {
        const int rowt = u.pm * BM, b = rowt >> 13; const float* xb = rowt < NBP * T ? xp + (size_t)rowt * D : xs + (size_t)(rowt - NBP * T) * D;
        const int rl0 = wr * 64 + fr, col0 = u.pn * BM + wc * 32 + 4 * fq; const float* gt = mod + b * 3072 + 2048;
#pragma unroll
        for (int bj = 0; bj < 2; ++bj)
#pragma unroll
            for (int n = 0; n < 2; ++n) { const int col = col0 + bj * HALF + n * 16; const f32x4 g4 = *(const f32x4*)(gt + col);
#pragma unroll
                for (int ai = 0; ai < 2; ++ai)
#pragma unroll
                    for (int m = 0; m < 4; ++m) { const int rl = rl0 + ai * HALF + m * 16; const f32x4 x4 = *(const f32x4*)(xb + (size_t)rl * D + col);
                        *(f32x4*)(out + (size_t)(rowt + rl) * D + col) = x4 + g4 * acc[ai][bj][m][n]; } }
        return false;
    }
};
}

__device__ __forceinline__ void p0_transpose_item(const float* W, int K, int N, bf16* WT, int k0, int n0, int drow0, LAS float* scr, int lane) {
#pragma unroll 8
    for (int i = 0; i < 32; ++i) { const int kk = 2 * i + (lane >> 5); scr[kk * 33 + (lane & 31)] = W[(size_t)(k0 + kk) * N + n0 + (lane & 31)]; }
    LDS_WAIT(); asm volatile("" ::: "memory");
    const int c = lane & 7;
#pragma unroll
    for (int j = 0; j < 4; ++j) { const int n = (lane >> 3) + 8 * j; const LAS float* s = scr + (8 * c) * 33 + n;
        v4u o; o.x = pk2(s[0 * 33], s[1 * 33]); o.y = pk2(s[2 * 33], s[3 * 33]); o.z = pk2(s[4 * 33], s[5 * 33]); o.w = pk2(s[6 * 33], s[7 * 33]);
        *(GAS v4u*)(WT + (size_t)(drow0 + n) * K + k0 + 8 * c) = o; }
    LDS_WAIT(); asm volatile("" ::: "memory");
}
__device__ __forceinline__ int t5_bucket(int rel) {
    const int n = rel < 0 ? -rel : rel; int ret = rel > 0 ? 16 : 0;
    const float lf = logf((float)(n > 1 ? n : 1) / 8.0f) / 4.852030263919617f * 8.0f;
    int large = 8 + (int)lf; large = large < 15 ? large : 15;
    return ret + (n < 8 ? n : large);
}
__device__ __forceinline__ void p0a(Frame& F) {
    const int ko = kopaque(); const float *cp_ = kin(I_CP, ko), *cs_ = kin(I_CS, ko), *w_ada = kin(I_WADA, ko), *b_ada = kin(I_BADA, ko), *rel_bias = kin(I_RELB, ko), *w_in = kin(I_WIN, ko), *w_out_a = kin(I_WOA, ko), *w_out_b = kin(I_WOB, ko), *w_out = kin(I_WO, ko);
    float* mod = (float*)(F.ws + WS_MOD);
    if (blockIdx.x < 48) {
        LAS float* sc = (LAS float*)F.lds;
        LAS float* part = (LAS float*)(F.lds + 40960);
        for (int i = (F.wave * 64 + lane_id()); i < NB * D; i += NWAVES * 64) { const int b = i >> 10, k = i & 1023; const float cv = b < NBP ? cp_[b * D + k] : cs_[(b - NBP) * D + k]; sc[i] = siluf_(cv); }
        __syncthreads();
        const int j = blockIdx.x * 64 + lane_id(); float a[NB];
#pragma unroll
        for (int b = 0; b < NB; ++b) a[b] = 0.f;
        for (int k = F.wave * 128; k < F.wave * 128 + 128; ++k) { const float w = w_ada[(size_t)k * 3072 + j];
#pragma unroll
            for (int b = 0; b < NB; ++b) a[b] += sc[b * D + k] * w; }
#pragma unroll
        for (int b = 0; b < NB; ++b) part[(F.wave * NB + b) * 64 + lane_id()] = a[b];
        __syncthreads();
        for (int i = (F.wave * 64 + lane_id()); i < NB * 64; i += NWAVES * 64) { const int b = i >> 6, l = i & 63; float s = b_ada[blockIdx.x * 64 + l];
#pragma unroll
            for (int w = 0; w < NWAVES; ++w) s += part[(w * NB + b) * 64 + l];
            mod[b * 3072 + blockIdx.x * 64 + l] = s; }
        __syncthreads();
    }
    if (blockIdx.x == 255 % gridDim.x) {
        float* bt = (float*)(F.ws + WS_BTAB);
        for (int i = (F.wave * 64 + lane_id()); i < 12 * 129; i += NWAVES * 64) { const int gh = i / 129, r = i % 129, gi = gh >> 2; const int rel = (r - 64) * (1 << (2 * gi));
            bt[i] = rel_bias[t5_bucket(rel) * 12 + gh] * 1.4426950408889634f; }
    }
    LAS float* scr = (LAS float*)(F.lds + RING_OFF + F.wave * 16384);
    const int gw = F.vcu * NWAVES + F.wave, NGW = F.G * NWAVES;
    constexpr int I_IN = (D / 64) * (IN_COLS / 32), I_OA = (A_W / 64) * (D / 32), I_OB = (B_W / 64) * (D / 32), I_O = (D / 64) * (D / 32);
    constexpr int NITEMS = I_IN + I_OA + I_OB + I_O;
    for (int it = gw; it < NITEMS; it += NGW) {
        int r = it;
        if (r < I_IN) { const int nblk = IN_COLS / 32, kb = r / nblk, nb = r % nblk, n0 = nb * 32;
            bf16* dst; int drow;
            if (n0 < A_COLS) { dst = (bf16*)(F.ws + WS_WAG); drow = n0; }
            else if (n0 < A_COLS + B_COLS) { dst = (bf16*)(F.ws + WS_WB); drow = n0 - A_COLS; }
            else { dst = (bf16*)(F.ws + WS_WAG); drow = A_COLS + (n0 - A_COLS - B_COLS); }
            p0_transpose_item(w_in, D, IN_COLS, dst, kb * 64, n0, drow, scr, lane_id()); continue; }
        r -= I_IN;
        if (r < I_OA) { const int nblk = D / 32, kb = r / nblk, nb = r % nblk; p0_transpose_item(w_out_a, A_W, D, (bf16*)(F.ws + WS_WOA), kb * 64, nb * 32, nb * 32, scr, lane_id()); continue; }
        r -= I_OA;
        if (r < I_OB) { const int nblk = D / 32, kb = r / nblk, nb = r % nblk; p0_transpose_item(w_out_b, B_W, D, (bf16*)(F.ws + WS_WOB), kb * 64, nb * 32, nb * 32, scr, lane_id()); continue; }
        r -= I_OB;
        { const int nblk = D / 32, kb = r / nblk, nb = r % nblk; p0_transpose_item(w_out, D, D, (bf16*)(F.ws + WS_WO), kb * 64, nb * 32, nb * 32, scr, lane_id()); }
    }
}
__device__ __forceinline__ void p0b(Frame& F) {
    const int ko = kopaque(); const float *xp = kin(I_XP, ko), *xs = kin(I_XS, ko), *norm_w = kin(I_NORMW, ko);
    const float* mod = (const float*)(F.ws + WS_MOD);
    const int gw = F.vcu * NWAVES + F.wave, NGW = F.G * NWAVES, lane = lane_id();
    const int per = (M + NGW - 1) / NGW, m0 = gw * per, m1 = (m0 + per < M) ? m0 + per : M;
    int bcur = -1; f32x4 cs[4], sh[4];
    for (int m = m0; m < m1; ++m) {
        const int b = m >> 13;
        if (b != bcur) { bcur = b;
#pragma unroll
            for (int j = 0; j < 4; ++j) { const int col = 4 * (lane + 64 * j); const f32x4 nw = *(const f32x4*)(norm_w + col), sc = *(const f32x4*)(mod + b * 3072 + 1024 + col);
                cs[j] = nw * (sc + 1.f); sh[j] = *(const f32x4*)(mod + b * 3072 + col); } }
        const f32x4* xr = (const f32x4*)xrow_ptr(xp, xs, m) + lane;
        f32x4 v[4]; float s = 0.f;
#pragma unroll
        for (int j = 0; j < 4; ++j) { v[j] = xr[64 * j]; s += (v[j].x * v[j].x + v[j].y * v[j].y) + (v[j].z * v[j].z + v[j].w * v[j].w); }
        const float rs = __builtin_amdgcn_rsqf(wave_sum(s) * (1.f / D) + RMS_EPS);
        v2u* o8 = (v2u*)(F.out + (size_t)m * OROW + OS_H) + lane;
#pragma unroll
        for (int j = 0; j < 4; ++j) { const f32x4 h = v[j] * rs * cs[j] + sh[j]; v2u w; w.x = cvtpk(h.x, h.y); w.y = cvtpk(h.z, h.w); o8[64 * j] = w; }
    }
}
typedef short v4i16_t __attribute__((ext_vector_type(4)));
typedef float f32x4a __attribute__((ext_vector_type(4)));
constexpr int AT_K = 0, AT_V = 65536, AT_BT = RING_BYTES + 9216 + 1024;
constexpr size_t WS_LSE = WS_Y;
__device__ __forceinline__ void attn_unit_geom(int u, int& b, int& gi, int& hh, int& res, int& blk) {
    const int sub = u & 63; int r = u >> 6; hh = r & 3; r >>= 2; gi = r % 3; b = r / 3;
    if (gi == 0) { res = 0; blk = sub; } else if (gi == 1) { res = sub >> 4; blk = sub & 15; } else { res = sub >> 2; blk = sub & 3; }
}
__device__ __forceinline__ void attn_dma_k(Frame& F, const bf16* pb, int b, int lg, int L, int res, int head, int q0) {
    const int lane = lane_id();
#pragma unroll
    for (int ii = 0; ii < 8; ++ii) { const int i = F.wave * 8 + ii, row = 4 * i + (lane >> 4); int kp = q0 - 64 + row; kp = kp < 0 ? 0 : (kp >= L ? L - 1 : kp);
        const int c = (lane & 15) ^ (row & 15);
        const bf16* src = pb + (size_t)(b * T + (kp << lg) + res) * B_COLS + B_QKV + head * 128 + c * 8;
        __builtin_amdgcn_global_load_lds((const unsigned*)src, (LAS unsigned*)(F.lds + AT_K + i * 1024), 16, 0, 0); }
}
__device__ __forceinline__ void attn_dma_v(Frame& F, const bf16* pb, int b, int lg, int L, int res, int head, int q0) {
    const int lane = lane_id();
#pragma unroll
    for (int jj = 0; jj < 8; ++jj) { const int j = F.wave * 8 + jj, dblk = j >> 4, kgrp = j & 15, key = 16 * kgrp + (lane >> 2); int kp = q0 - 64 + key; kp = kp < 0 ? 0 : (kp >= L ? L - 1 : kp);
        const bf16* src = pb + (size_t)(b * T + (kp << lg) + res) * B_COLS + 2 * B_QKV + head * 128 + dblk * 32 + (lane & 3) * 8;
        __builtin_amdgcn_global_load_lds((const unsigned*)src, (LAS unsigned*)(F.lds + AT_V + dblk * 16384 + kgrp * 1024), 16, 0, 0); }
}
__device__ __forceinline__ void attn_mfma(Frame& F, bool dry = false) {
    bf16* pb = (bf16*)(F.ws + WS_R); const float* btab = (const float*)(F.ws + WS_BTAB); float* lse = (float*)(F.ws + WS_LSE);
    int lane = lane_id(); asm volatile("" : "+v"(lane));
    const int w = F.wave, qi = lane & 15, g = lane >> 4;
    LAS float* btp = (LAS float*)(F.lds + AT_BT);
    const int NU = NB * 3 * 4 * 64, per = (NU + F.G - 1) / F.G; const int u0 = F.vcu * per, u1 = (u0 + per < NU) ? u0 + per : NU;
    if (u0 >= u1) return;
#ifdef PROBE_AT
    const unsigned long long pat_t0 = __builtin_amdgcn_s_memtime();
#endif
    int koff[4];
#pragma unroll
    for (int ks = 0; ks < 4; ++ks) koff[ks] = AT_K + w * 4096 + qi * 256 + (((4 * ks + g) ^ qi) << 4);
    const int q4 = qi >> 2, p4 = qi & 3, kr = 4 * g + q4;
    const int voff = AT_V + w * 1024 + (kr >> 3) * 512 + (kr & 7) * 64 + 8 * p4;
    int b, gi, hh, res, blk; attn_unit_geom(u0, b, gi, hh, res, blk);
    { const int lg = 2 * gi; attn_dma_k(F, pb, b, lg, T >> lg, res, gi * 4 + hh, blk * 128); }
    for (int u = u0; u < u1; ++u) {
        attn_unit_geom(u, b, gi, hh, res, blk);
        const int lg = 2 * gi, L = T >> lg, head = gi * 4 + hh, q0 = blk * 128;
        if ((F.wave * 64 + lane_id()) < 176) { const int i = (F.wave * 64 + lane_id()) - 16; btp[(F.wave * 64 + lane_id())] = (i >= 0 && i <= 128) ? btab[head * 129 + i] : -1e30f; }
        bf16* qrow = pb + (size_t)(b * T + ((q0 + 16 * w + qi) << lg) + res) * B_COLS + head * 128;
        bf16x8 qf[4];
#pragma unroll
        for (int ks = 0; ks < 4; ++ks) qf[ks] = *(const bf16x8*)(qrow + 32 * ks + 8 * g);
        asm volatile("s_waitcnt vmcnt(0) lgkmcnt(0)" ::: "memory"); __builtin_amdgcn_s_barrier(); asm volatile("" ::: "memory");
        attn_dma_v(F, pb, b, lg, L, res, head, q0);
        f32x4a S[9];
#pragma unroll
        for (int kb = 0; kb < 9; ++kb) { S[kb] = (f32x4a){0.f, 0.f, 0.f, 0.f};
#pragma unroll
            for (int ks = 0; ks < 4; ++ks) { const bf16x8 kf = *(const LAS bf16x8*)(F.lds + koff[ks] + kb * 4096);
                S[kb] = __builtin_amdgcn_mfma_f32_16x16x32_bf16(kf, qf[ks], S[kb], 0, 0, 0); } }
        const bool edge = (q0 == 0) || (q0 + 128 >= L);
        float mx = -1e30f;
#pragma unroll
        for (int kb = 0; kb < 9; ++kb)
#pragma unroll
            for (int r = 0; r < 4; ++r) { const int kw = 16 * kb + 4 * g + r; float sv = S[kb][r] + btp[kw - qi + 16];
                if (edge) { const int kp = q0 + 16 * w + kw - 64; if (kp < 0 || kp >= L) sv = -1e30f; }
                S[kb][r] = sv; mx = fmaxf(mx, sv); }
        mx = fmaxf(mx, __shfl_xor(mx, 16)); mx = fmaxf(mx, __shfl_xor(mx, 32));
        float ls = 0.f;
#pragma unroll
        for (int kb = 0; kb < 9; ++kb)
#pragma unroll
            for (int r = 0; r < 4; ++r) { const float p = __builtin_amdgcn_exp2f(S[kb][r] - mx); S[kb][r] = p; ls += p; }
        ls += __shfl_xor(ls, 16); ls += __shfl_xor(ls, 32);
        bf16x8 pf[5];
#pragma unroll
        for (int c = 0; c < 5; ++c) { v4u t; t.x = cvtpk(S[2 * c][0], S[2 * c][1]); t.y = cvtpk(S[2 * c][2], S[2 * c][3]);
            if (c < 4) { t.z = cvtpk(S[2 * c + 1][0], S[2 * c + 1][1]); t.w = cvtpk(S[2 * c + 1][2], S[2 * c + 1][3]); } else { t.z = 0u; t.w = 0u; }
            pf[c] = __builtin_bit_cast(bf16x8, t); }
        asm volatile("s_waitcnt vmcnt(0) lgkmcnt(0)" ::: "memory"); __builtin_amdgcn_s_barrier(); asm volatile("" ::: "memory");
        if (u + 1 < u1) { int b2, gi2, hh2, res2, blk2; attn_unit_geom(u + 1, b2, gi2, hh2, res2, blk2); const int lg2 = 2 * gi2; attn_dma_k(F, pb, b2, lg2, T >> lg2, res2, gi2 * 4 + hh2, blk2 * 128); }
        const float il = 1.f / ls;
#pragma unroll
        for (int db = 0; db < 8; ++db) { f32x4a o = (f32x4a){0.f, 0.f, 0.f, 0.f};
#pragma unroll
            for (int c = 0; c < 5; ++c) { const int off = voff + (db >> 1) * 16384 + (db & 1) * 32 + c * 2048;
                const v4i16_t lo = __builtin_amdgcn_ds_read_tr16_b64_v4i16((LAS v4i16_t*)(F.lds + off));
                const v4i16_t hi = __builtin_amdgcn_ds_read_tr16_b64_v4i16((LAS v4i16_t*)(F.lds + off + (c < 4 ? 1024 : 0)));
                const bf16x8 vf = (bf16x8){lo[0], lo[1], lo[2], lo[3], hi[0], hi[1], hi[2], hi[3]};
                o = __builtin_amdgcn_mfma_f32_16x16x32_bf16(vf, pf[c], o, 0, 0, 0); }
            v2u wv; wv.x = cvtpk(o[0] * il, o[1] * il); wv.y = cvtpk(o[2] * il, o[3] * il);
            *(v2u*)((dry ? (bf16*)(F.ws + WS_Y) + (size_t)((F.wave * 64 + lane_id()) >> 2) * B_COLS : qrow) + 16 * db + 4 * g) = wv; }
        if (g == 0 && !dry) lse[(size_t)(b * T + ((q0 + 16 * w + qi) << lg) + res) * 12 + head] = mx + __builtin_amdgcn_logf(ls);
    }
    asm volatile("s_waitcnt vmcnt(0) lgkmcnt(0)" ::: "memory"); __builtin_amdgcn_s_barrier();
#ifdef PROBE_AT
    if (blockIdx.x == 0 && (F.wave * 64 + lane_id()) == 0) ((float*)(F.ws + WS_CTL + 32768))[0] = (float)((double)(((__builtin_amdgcn_s_memtime() - pat_t0) / (unsigned long long)(u1 - u0) + 1024ull) >> 11 << 11) / 65536.0);
#endif
}
__device__ __forceinline__ void attn_combine(Frame& F) {
    const bf16* pb = (const bf16*)(F.ws + WS_R); const float* lse = (const float*)(F.ws + WS_LSE);
    const int gw = F.vcu * NWAVES + F.wave, NGW = F.G * NWAVES, lane = lane_id(), hh = lane >> 4, d0 = (lane & 15) * 8;
    for (int m = gw; m < M; m += NGW) {
        const bf16* row = pb + (size_t)m * B_COLS;
        const float l0 = lse[(size_t)m * 12 + hh], l1 = lse[(size_t)m * 12 + 4 + hh], l2 = lse[(size_t)m * 12 + 8 + hh];
        const float mxl = fmaxf(l0, fmaxf(l1, l2)); float w0 = exp2f(l0 - mxl), w1 = exp2f(l1 - mxl), w2 = exp2f(l2 - mxl); const float iw = 1.f / (w0 + w1 + w2); w0 *= iw; w1 *= iw; w2 *= iw;
        const v4u a = *(const v4u*)(row + hh * 128 + d0), bq = *(const v4u*)(row + (4 + hh) * 128 + d0), c = *(const v4u*)(row + (8 + hh) * 128 + d0), gt = *(const v4u*)(row + 3 * B_QKV + hh * 128 + d0);
        v4u o;
        o.x = pk2((w0 * bflo(a.x) + w1 * bflo(bq.x) + w2 * bflo(c.x)) * bflo(gt.x), (w0 * bfhi(a.x) + w1 * bfhi(bq.x) + w2 * bfhi(c.x)) * bfhi(gt.x));
        o.y = pk2((w0 * bflo(a.y) + w1 * bflo(bq.y) + w2 * bflo(c.y)) * bflo(gt.y), (w0 * bfhi(a.y) + w1 * bfhi(bq.y) + w2 * bfhi(c.y)) * bfhi(gt.y));
        o.z = pk2((w0 * bflo(a.z) + w1 * bflo(bq.z) + w2 * bflo(c.z)) * bflo(gt.z), (w0 * bfhi(a.z) + w1 * bfhi(bq.z) + w2 * bfhi(c.z)) * bfhi(gt.z));
        o.w = pk2((w0 * bflo(a.w) + w1 * bflo(bq.w) + w2 * bflo(c.w)) * bflo(gt.w), (w0 * bfhi(a.w) + w1 * bfhi(bq.w) + w2 * bfhi(c.w)) * bfhi(gt.w));
        *(v4u*)(F.out + (size_t)m * OROW + OS_YB + (hh * 128 + d0) * 2) = o;
    }
}

#ifdef PROBE_TA
#define STAMP(k) do { if ((k) == PROBE_TA) pt_a = __builtin_amdgcn_s_memtime(); if ((k) == PROBE_TB) pt_sel += __builtin_amdgcn_s_memtime() - pt_a; } while (0)
#else
#define STAMP(k) do { } while (0)
#endif
#ifndef REP_S0
#define REP_S0 1
#define REP_S12 1
#define REP_S3 1
#define REP_S45 1
#endif
typedef float f32x4r __attribute__((ext_vector_type(4)));
constexpr int RS = 144, RM = 64 * RS;
constexpr int R_AT = 0 * RM, R_RT = 1 * RM, R_BW = 2 * RM, R_KU = 3 * RM, R_BT = 4 * RM, R_KT = 5 * RM, R_VT = 6 * RM, R_AAB = 7 * RM, R_AAK = 8 * RM, R_ARB = 9 * RM, R_ARK = 10 * RM, R_HT = 11 * RM;
constexpr int R_W2T = 12 * RM, R_A2T = 13 * RM;
constexpr int R_WLF = R_AT, R_ALF = R_BT, FS = 272;
constexpr int R_TI = 132096, TIS = 48, R_PC = R_TI + 3072, R_BLK = R_PC + 256, R_AD = R_BLK + 2048;
__device__ __forceinline__ bf16x8 ldfrag(LAS unsigned char* lds, int mat, int row0, int k0, int r, int g) { return *(const LAS bf16x8*)(lds + mat + (row0 + r) * RS + (k0 + 8 * g) * 2); }
__device__ __forceinline__ void storeT(LAS unsigned char* lds, int mat, const f32x4r& d, int row0, int col0, int r, int g) {
    v2u w; w.x = cvtpk(d[0], d[1]); w.y = cvtpk(d[2], d[3]); *(LAS v2u*)(lds + mat + (col0 + r) * RS + (row0 + 4 * g) * 2) = w; }
__device__ __forceinline__ bf16x8 pack2(const f32x4r& a, const f32x4r& b) { v4u t; t.x = cvtpk(a[0], a[1]); t.y = cvtpk(a[2], a[3]); t.z = cvtpk(b[0], b[1]); t.w = cvtpk(b[2], b[3]); return __builtin_bit_cast(bf16x8, t); }
__device__ __forceinline__ bf16x8 pack1(const f32x4r& a) { v4u t; t.x = cvtpk(a[0], a[1]); t.y = cvtpk(a[2], a[3]); t.z = 0u; t.w = 0u; return __builtin_bit_cast(bf16x8, t); }
__device__ __forceinline__ bf16x8 ld2x4(LAS unsigned char* lds, int off0, int off1) { const v2u a = *(const LAS v2u*)(lds + off0), b = *(const LAS v2u*)(lds + off1); v4u t; t.x = a.x; t.y = a.y; t.z = b.x; t.w = b.y; return __builtin_bit_cast(bf16x8, t); }
#define MF16(a, b, c) __builtin_amdgcn_mfma_f32_16x16x32_bf16((a), (b), (c), 0, 0, 0)
#define WGBAR() do { asm volatile("s_waitcnt lgkmcnt(0)" ::: "memory"); __builtin_amdgcn_s_barrier(); asm volatile("" ::: "memory"); } while (0)
template <int CTRL> __device__ __forceinline__ float dppf(float x) { return __builtin_bit_cast(float, __builtin_amdgcn_update_dpp(0, __builtin_bit_cast(int, x), CTRL, 0xF, 0xF, true)); }
__device__ __forceinline__ float row16_sum(float v) { v += dppf<0xB1>(v); v += dppf<0x4E>(v); v += dppf<0x141>(v); v += dppf<0x140>(v); return v; }
__device__ __forceinline__ float wave_sum_dpp(float v) { v = row16_sum(v);
    return (__builtin_bit_cast(float, __builtin_amdgcn_readlane(__builtin_bit_cast(int, v), 0)) + __builtin_bit_cast(float, __builtin_amdgcn_readlane(__builtin_bit_cast(int, v), 16)))
         + (__builtin_bit_cast(float, __builtin_amdgcn_readlane(__builtin_bit_cast(int, v), 32)) + __builtin_bit_cast(float, __builtin_amdgcn_readlane(__builtin_bit_cast(int, v), 48))); }
__device__ __forceinline__ void reduce8(const float (&v)[8], float (&s)[8], float& v0, float& v1, int lane) {
    const bool b0 = lane & 1, b1 = lane & 2; float r1[4], r2[2];
#pragma unroll
    for (int i = 0; i < 4; ++i) { const float keep = b0 ? v[2 * i + 1] : v[2 * i], send = b0 ? v[2 * i] : v[2 * i + 1]; r1[i] = keep + dppf<0xB1>(send); }
#pragma unroll
    for (int i = 0; i < 2; ++i) { const float keep = b1 ? r1[2 * i + 1] : r1[2 * i], send = b1 ? r1[2 * i] : r1[2 * i + 1]; r2[i] = keep + dppf<0x4E>(send); }
#pragma unroll
    for (int i = 0; i < 2; ++i) { float x = r2[i]; x += dppf<0x124>(x); x += dppf<0x128>(x);
        x += __builtin_bit_cast(float, __builtin_amdgcn_ds_swizzle(__builtin_bit_cast(int, x), 0x401F));
        x += __shfl_xor(x, 32);
        r2[i] = x; }
    v0 = r2[0]; v1 = r2[1];
#pragma unroll
    for (int q = 0; q < 8; ++q) s[q] = __builtin_bit_cast(float, __builtin_amdgcn_readlane(__builtin_bit_cast(int, r2[q >> 2]), q & 3));
}
typedef float f2v __attribute__((ext_vector_type(2)));
__device__ __forceinline__ f2v exp2v(f2v x) { return (f2v){__builtin_amdgcn_exp2f(x.x), __builtin_amdgcn_exp2f(x.y)}; }
__device__ __forceinline__ f2v rcpv(f2v x) { return (f2v){__builtin_amdgcn_rcpf(x.x), __builtin_amdgcn_rcpf(x.y)}; }
__device__ __forceinline__ unsigned cvtpk2(f2v v) { bf16x2_t b = __builtin_convertvector(v, bf16x2_t); return __builtin_bit_cast(unsigned, b); }
__device__ __forceinline__ float fast_tanh(float x) { const float e = __expf(2.f * x); return 1.f - 2.f * __builtin_amdgcn_rcpf(e + 1.f); }
template <bool RV> __device__ __forceinline__ void rwkv_load_rows(__amdgpu_buffer_rsrc_t rsrc, int b, int d, int c, int w, unsigned o_r, unsigned o_w, unsigned (&x0)[10], unsigned (&x1)[10], unsigned (&x2)[10]) {
    const int s0 = c * 64 + 8 * w - 1;
#pragma unroll
    for (int k = 0; k < 10; ++k) { const int s = s0 + k; int tk = d ? T - 1 - s : s; tk = tk < 0 ? 0 : (tk > T - 1 ? T - 1 : tk);
        const int so = __builtin_amdgcn_readfirstlane((b * T + tk) * (A_COLS * 2));
        if (RV) { x0[k] = __builtin_amdgcn_raw_buffer_load_b32(rsrc, o_r, so, 0); x1[k] = __builtin_amdgcn_raw_buffer_load_b32(rsrc, o_r + 2 * A_W * 2, so, 0); }
        else { x0[k] = __builtin_amdgcn_raw_buffer_load_b32(rsrc, o_r + A_W * 2, so, 0); x1[k] = __builtin_amdgcn_raw_buffer_load_b32(rsrc, o_w, so, 0); x2[k] = __builtin_amdgcn_raw_buffer_load_b32(rsrc, o_w + 2 * RANK * 2, so, 0); } }
}
__device__ __forceinline__ void rwkv_chunked(Frame& F) {
    if (blockIdx.x >= 2 * NB * A_HEADS) return;
    const int chain = blockIdx.x, d = chain / (NB * A_HEADS), rem = chain % (NB * A_HEADS), b = rem >> 3, hd = rem & 7;
    const bf16* pa = (const bf16*)(F.ws + WS_PA); bf16* ybuf = (bf16*)(F.ws + WS_Y) + (size_t)d * M * A_W; float* bon = (float*)(F.ws + WS_BON) + (size_t)d * M * 8;
    const int ko = kopaque(); const float *w2_ = kin(I_W2, ko), *a2_ = kin(I_A2, ko), *mu_ = kin(I_MU, ko), *w0_ = kin(I_W0, ko), *a0_ = kin(I_A0, ko), *kk_ = kin(I_KK, ko), *ka_ = kin(I_KA, ko), *rk_ = kin(I_RK, ko);
    LAS unsigned char* L = F.lds;
    int lane = lane_id(); asm volatile("" : "+v"(lane));
    const int w = F.wave, j = lane, ch = hd * 64 + j;
    int r, g;
#define RELANE() do { int ln_ = lane; asm volatile("" : "+v"(ln_)); r = ln_ & 15; g = ln_ >> 4; } while (0)
    for (int i = (F.wave * 64 + lane_id()); i < 4096; i += NWAVES * 64) { const int jo = i >> 6, jr = i & 63;
        *(LAS bf16*)(L + R_W2T + jo * RS + jr * 2) = (bf16)f2bf(w2_[((size_t)d * RANK + jr) * A_W + hd * 64 + jo]);
        *(LAS bf16*)(L + R_A2T + jo * RS + jr * 2) = (bf16)f2bf(a2_[((size_t)d * RANK + jr) * A_W + hd * 64 + jo]); }
    for (int i = (F.wave * 64 + lane_id()); i < 5 * RM / 4; i += NWAVES * 64) ((LAS unsigned*)(L + R_AAB))[i] = 0u;
    const int cr = ch, ck = A_W + ch, cv = 2 * A_W + ch, cw = 4 * A_W + d * RANK + j, ca = 4 * A_W + 2 * RANK + d * RANK + j;
    const float mr0 = mu_[cr], mr1 = mu_[A_COLS + cr], mk0 = mu_[ck], mk1 = mu_[A_COLS + ck], mv0 = mu_[cv], mv1 = mu_[A_COLS + cv];
    const float mw0 = mu_[cw], mw1 = mu_[A_COLS + cw], ma0 = mu_[ca], ma1 = mu_[A_COLS + ca];
    const __amdgpu_buffer_rsrc_t rsrc = __builtin_amdgcn_make_buffer_rsrc((void*)pa, 0, M * A_COLS * 2, 0x00020000);
    const unsigned o_r = (cr * 2) & ~3u, o_w = (cw * 2) & ~3u;
    const unsigned psel = (j & 1) ? 0x07060c0cu : 0x05040c0cu;
    const float sr0 = d ? mr1 : mr0, sr1 = d ? mr0 : mr1, sk0 = d ? mk1 : mk0, sk1 = d ? mk0 : mk1, sv0 = d ? mv1 : mv0, sv1 = d ? mv0 : mv1, sw0 = d ? mw1 : mw0, sw1 = d ? mw0 : mw1, sa0 = d ? ma1 : ma0, sa1 = d ? ma0 : ma1;
    const float w0j = w0_[d * A_W + ch], a0j = a0_[d * A_W + ch], kkj = kk_[ch], kaj = ka_[ch], rkj = rk_[ch];
    const int vt = w & 3;
    f32x4r Hs[4];
#pragma unroll
    for (int i = 0; i < 4; ++i) Hs[i] = (f32x4r){0.f, 0.f, 0.f, 0.f};
    unsigned xk[10], xw[10], xa[10];
    rwkv_load_rows<false>(rsrc, b, d, 0, w, o_r, o_w, xk, xw, xa);
    WGBAR();
#ifdef PROBE_TA
    unsigned long long pt_a = 0, pt_sel = 0; const unsigned long long pt_t0 = __builtin_amdgcn_s_memtime();
#endif
    for (int c = 0; c < T / 64; ++c) {
        STAMP(0);
        f2v ks2[4], kn2[4];
        for (int rep0_ = 0; rep0_ < REP_S0; ++rep0_) {
        if (REP_S0 > 1 && rep0_ > 0) rwkv_load_rows<false>(rsrc, b, d, c, w, o_r, o_w, xk, xw, xa);
        unsigned xr[10], xv[10], xdum[10];
        rwkv_load_rows<true>(rsrc, b, d, c, w, o_r, o_w, xr, xv, xdum);
        const bool okp = (c * 64 + 8 * w) > 0, okn = (c * 64 + 8 * w + 8) < T;
#define XF(x, k) ((((k) == 0 && !okp) || ((k) == 9 && !okn)) ? 0.f : __builtin_bit_cast(float, __builtin_amdgcn_perm((x)[k], 0u, psel)))
#define SH2(dst, x, m0, m1) do { float xf_[10]; _Pragma("unroll") for (int k_ = 0; k_ < 10; ++k_) xf_[k_] = XF(x, k_); const float mc_ = 1.f - (m0) - (m1); \
        _Pragma("unroll") for (int q2_ = 0; q2_ < 4; ++q2_) (dst)[q2_] = (f2v){xf_[2 * q2_ + 1], xf_[2 * q2_ + 2]} * mc_ + (f2v){xf_[2 * q2_], xf_[2 * q2_ + 1]} * (m0) + (f2v){xf_[2 * q2_ + 2], xf_[2 * q2_ + 3]} * (m1); } while (0)
        { f2v ws2[4], as2[4]; SH2(ks2, xk, sk0, sk1); SH2(ws2, xw, sw0, sw1); SH2(as2, xa, sa0, sa1);
#pragma unroll
          for (int q2 = 0; q2 < 4; ++q2) { const int i0 = 8 * w + 2 * q2;
              const f2v e2 = exp2v(ws2[q2] * 2.8853900817779268f); const f2v th = 1.f - 2.f * rcpv(e2 + 1.f);
              const unsigned pa0 = cvtpk(th.x, as2[q2].x), pa1 = cvtpk(th.y, as2[q2].y);
              *(LAS bf16*)(L + R_BW + i0 * RS + j * 2) = (bf16)pa0; *(LAS bf16*)(L + R_KU + i0 * RS + j * 2) = (bf16)(pa0 >> 16);
              *(LAS bf16*)(L + R_BW + (i0 + 1) * RS + j * 2) = (bf16)pa1; *(LAS bf16*)(L + R_KU + (i0 + 1) * RS + j * 2) = (bf16)(pa1 >> 16);
              kn2[q2] = ks2[q2] * kkj; } }
        { float sq[8], n2[8], d0_, d1_;
#pragma unroll
          for (int q2 = 0; q2 < 4; ++q2) { const f2v s = kn2[q2] * kn2[q2]; sq[2 * q2] = s.x; sq[2 * q2 + 1] = s.y; }
          reduce8(sq, n2, d0_, d1_, lane);
#pragma unroll
          for (int q2 = 0; q2 < 4; ++q2) kn2[q2] *= (f2v){__builtin_amdgcn_rsqf(fmaxf(n2[2 * q2], 1e-24f)), __builtin_amdgcn_rsqf(fmaxf(n2[2 * q2 + 1], 1e-24f))}; }
        WGBAR();
        STAMP(1);
        RELANE();
        { const int it = w >> 1;
          bf16x8 ta[2], aa[2];
#pragma unroll
          for (int k2 = 0; k2 < 2; ++k2) { ta[k2] = ldfrag(L, R_BW, 16 * it, 32 * k2, r, g); aa[k2] = ldfrag(L, R_KU, 16 * it, 32 * k2, r, g); }
#pragma unroll
          for (int j2 = 0; j2 < 2; ++j2) { const int jt = 2 * (w & 1) + j2; f32x4r dw = (f32x4r){0.f, 0.f, 0.f, 0.f}, da = dw;
#pragma unroll
              for (int k2 = 0; k2 < 2; ++k2) { dw = MF16(ta[k2], ldfrag(L, R_W2T, 16 * jt, 32 * k2, r, g), dw); da = MF16(aa[k2], ldfrag(L, R_A2T, 16 * jt, 32 * k2, r, g), da); }
#pragma unroll
              for (int e = 0; e < 4; ++e) { *(LAS float*)(L + R_WLF + (16 * it + 4 * g + e) * FS + (16 * jt + r) * 4) = dw[e]; *(LAS float*)(L + R_ALF + (16 * it + 4 * g + e) * FS + (16 * jt + r) * 4) = da[e]; } } }
        WGBAR();
        STAMP(2);
        f2v av2[4]; float cp[8]; float run = 1.f;
#pragma unroll
        for (int q2 = 0; q2 < 4; ++q2) { const int i0 = 8 * w + 2 * q2;
            const f2v wl = (f2v){*(const LAS float*)(L + R_WLF + i0 * FS + j * 4), *(const LAS float*)(L + R_WLF + (i0 + 1) * FS + j * 4)} + w0j;
            const f2v al = (f2v){*(const LAS float*)(L + R_ALF + i0 * FS + j * 4), *(const LAS float*)(L + R_ALF + (i0 + 1) * FS + j * 4)} + a0j;
            const f2v dec = exp2v(rcpv(exp2v(wl * -1.4426950408889634f) + 1.f) * (-0.6065306597126334f * 1.4426950408889634f));
            av2[q2] = rcpv(exp2v(al * -1.4426950408889634f) + 1.f);
            run *= dec.x; cp[2 * q2] = run; run *= dec.y; cp[2 * q2 + 1] = run; }
        *(LAS float*)(L + R_BLK + (w * 64 + j) * 4) = run;
        WGBAR();
        STAMP(3);
        { float off = 1.f, tot = 1.f;
#pragma unroll
          for (int w2 = 0; w2 < 8; ++w2) { const float bt = *(const LAS float*)(L + R_BLK + (w2 * 64 + j) * 4); off *= (w2 < w) ? bt : 1.f; tot *= bt; }
          if (w == 0) *(LAS float*)(L + R_PC + j * 4) = tot;
          f2v rs2[4], vs2[4], kd2[4]; SH2(rs2, xr, sr0, sr1); SH2(vs2, xv, sv0, sv1);
          { float bp[8], bs[8], b0_, b1_;
#pragma unroll
            for (int q2 = 0; q2 < 4; ++q2) { kd2[q2] = ks2[q2] * (av2[q2] * kaj + (1.f - kaj)); const f2v t = rs2[q2] * kd2[q2] * rkj; bp[2 * q2] = t.x; bp[2 * q2 + 1] = t.y; }
            reduce8(bp, bs, b0_, b1_, lane);
            if (lane < 4) { const int s0_ = c * 64 + 8 * w + lane, s1_ = s0_ + 4; const int t0_ = d ? T - 1 - s0_ : s0_, t1_ = d ? T - 1 - s1_ : s1_;
                bon[(size_t)(b * T + t0_) * 8 + hd] = b0_; bon[(size_t)(b * T + t1_) * 8 + hd] = b1_; } }
          unsigned pb_[4], pk_[4], pv_[4];
#pragma unroll
          for (int q2 = 0; q2 < 4; ++q2) { const int qa = 2 * q2, i0 = 8 * w + qa;
              const f2v pt = (f2v){cp[qa], cp[qa + 1]} * off; const f2v pm = (f2v){(qa == 0) ? off : off * cp[qa > 0 ? qa - 1 : 0], pt.x}; const f2v em = rcpv(pt);
              const unsigned pa_ = cvtpk2(-kn2[q2] * pm), pr_ = cvtpk2(rs2[q2] * pt); pb_[q2] = cvtpk2(kn2[q2] * av2[q2] * em); pk_[q2] = cvtpk2(kd2[q2] * em); pv_[q2] = cvtpk2(vs2[q2]);
              *(LAS bf16*)(L + R_AT + i0 * RS + j * 2) = (bf16)pa_; *(LAS bf16*)(L + R_AT + (i0 + 1) * RS + j * 2) = (bf16)(pa_ >> 16);
              *(LAS bf16*)(L + R_RT + i0 * RS + j * 2) = (bf16)pr_; *(LAS bf16*)(L + R_RT + (i0 + 1) * RS + j * 2) = (bf16)(pr_ >> 16);
              *(LAS bf16*)(L + R_BW + i0 * RS + j * 2) = (bf16)pb_[q2]; *(LAS bf16*)(L + R_BW + (i0 + 1) * RS + j * 2) = (bf16)(pb_[q2] >> 16);
              *(LAS bf16*)(L + R_KU + i0 * RS + j * 2) = (bf16)pk_[q2]; *(LAS bf16*)(L + R_KU + (i0 + 1) * RS + j * 2) = (bf16)(pk_[q2] >> 16); }
          *(LAS v4u*)(L + R_BT + j * RS + 16 * w) = (v4u){pb_[0], pb_[1], pb_[2], pb_[3]};
          *(LAS v4u*)(L + R_KT + j * RS + 16 * w) = (v4u){pk_[0], pk_[1], pk_[2], pk_[3]};
          *(LAS v4u*)(L + R_VT + j * RS + 16 * w) = (v4u){pv_[0], pv_[1], pv_[2], pv_[3]}; }
        WGBAR();
#undef SH2
#undef XF
        }
        STAMP(4);
        if (c + 1 < T / 64) rwkv_load_rows<false>(rsrc, b, d, c + 1, w, o_r, o_w, xk, xw, xa);
        STAMP(5);
        RELANE();
        f32x4r A0[4], KV[4];
#define tc(i) KV[(i) >> 2][(i) & 3]
        for (int rep1_ = 0; rep1_ < REP_S12; ++rep1_) {
        if (w == 0) {
#pragma unroll
            for (int i = 0; i < 4; ++i) { f32x4r dd = (f32x4r){0.f, 0.f, 0.f, 0.f};
#pragma unroll
                for (int k2 = 0; k2 < 2; ++k2) dd = MF16(ldfrag(L, R_BW, 16 * i, 32 * k2, r, g), ldfrag(L, R_AT, 16 * i, 32 * k2, r, g), dd);
#pragma unroll
                for (int e = 0; e < 4; ++e) if (4 * g + e >= r) dd[e] = 0.f;
                storeT(L, R_AAB, dd, 16 * i, 16 * i, r, g);
                *(LAS f32x4r*)(L + R_AD + i * 1024 + r * 64 + 16 * g) = dd; }
            asm volatile("s_waitcnt lgkmcnt(0)" ::: "memory");
            const int blk = lane >> 4, cc = lane & 15;
#pragma unroll
            for (int rr = 0; rr < 8; ++rr) { float acc = (rr == cc) ? 1.f : 0.f;
#pragma unroll
                for (int s4 = 0; s4 < (rr + 3) / 4; ++s4) { const f32x4r a4 = *(const LAS f32x4r*)(L + R_AD + blk * 1024 + rr * 64 + s4 * 16);
#pragma unroll
                    for (int e = 0; e < 4; ++e) if (4 * s4 + e < rr) acc += a4[e] * tc(4 * s4 + e); }
                tc(rr) = acc; *(LAS bf16*)(L + R_TI + (16 * blk + rr) * TIS + cc * 2) = (bf16)f2bf(acc); }
        } else {
#pragma unroll
            for (int kb = 0; kb < 3; ++kb) {
                bf16x8 fa[2][2], fb[2][2]; int dmv[2], tsv[2], ttv[2]; bool inc[2], val[2];
#pragma unroll
                for (int k = 0; k < 2; ++k) { const int jb = w - 1 + 7 * (2 * kb + k); val[k] = jb < 36; const int jc = val[k] ? jb : 0;
                    int mat, idx; if (jc < 6) { mat = 0; idx = (0x865321 >> (4 * jc)) & 15; } else { const int q = jc - 6; mat = 1 + q / 10; idx = q - 10 * (mat - 1); }
                    const int ts = (int)((0x3221110000ull >> (4 * idx)) & 15), tt = (int)((0x3323213210ull >> (4 * idx)) & 15);
                    const int ym = (mat & 1) ? R_KU : R_BW, xm = (mat & 2) ? R_RT : R_AT; dmv[k] = R_AAB + mat * RM; inc[k] = mat >= 2; tsv[k] = ts; ttv[k] = tt;
#pragma unroll
                    for (int k2 = 0; k2 < 2; ++k2) { fa[k][k2] = ldfrag(L, ym, 16 * ts, 32 * k2, r, g); fb[k][k2] = ldfrag(L, xm, 16 * tt, 32 * k2, r, g); } }
#pragma unroll
                for (int k = 0; k < 2; ++k) { f32x4r dd = (f32x4r){0.f, 0.f, 0.f, 0.f};
#pragma unroll
                    for (int k2 = 0; k2 < 2; ++k2) dd = MF16(fa[k][k2], fb[k][k2], dd);
                    if (tsv[k] == ttv[k]) {
#pragma unroll
                        for (int e = 0; e < 4; ++e) { const int sl = 4 * g + e; if (inc[k] ? (sl > r) : (sl >= r)) dd[e] = 0.f; } }
                    if (val[k]) storeT(L, dmv[k], dd, 16 * tsv[k], 16 * ttv[k], r, g); }
            }
        }
        STAMP(11);
        WGBAR();
        STAMP(6);
        RELANE();
        if (w == 0) {
            const int blk = lane >> 4, cc = lane & 15;
#pragma unroll
            for (int rr = 8; rr < 16; ++rr) { float acc = (rr == cc) ? 1.f : 0.f;
#pragma unroll
                for (int s4 = 0; s4 < (rr + 3) / 4; ++s4) { const f32x4r a4 = *(const LAS f32x4r*)(L + R_AD + blk * 1024 + rr * 64 + s4 * 16);
#pragma unroll
                    for (int e = 0; e < 4; ++e) if (4 * s4 + e < rr) acc += a4[e] * tc(4 * s4 + e); }
                tc(rr) = acc; *(LAS bf16*)(L + R_TI + (16 * blk + rr) * TIS + cc * 2) = (bf16)f2bf(acc); }
        } else if (w < 4) {
#pragma unroll
            for (int i = 0; i < 4; ++i) { A0[i] = (f32x4r){0.f, 0.f, 0.f, 0.f};
#pragma unroll
                for (int k2 = 0; k2 < 2; ++k2) A0[i] = MF16(ldfrag(L, R_VT, 16 * vt, 32 * k2, r, g), ldfrag(L, R_ARK, 16 * i, 32 * k2, r, g), A0[i]); }
        } else {
#pragma unroll
            for (int i = 0; i < 4; ++i) { A0[i] = (f32x4r){0.f, 0.f, 0.f, 0.f}; KV[i] = A0[i];
#pragma unroll
                for (int k2 = 0; k2 < 2; ++k2) { const bf16x8 vf = ldfrag(L, R_VT, 16 * vt, 32 * k2, r, g);
                    A0[i] = MF16(ldfrag(L, R_AAK, 16 * i, 32 * k2, r, g), vf, A0[i]); KV[i] = MF16(ldfrag(L, R_KT, 16 * i, 32 * k2, r, g), vf, KV[i]); } }
        }
        WGBAR();
        }
        STAMP(7);
        RELANE();
        f32x4r Usv[4];
#pragma unroll
        for (int i = 0; i < 4; ++i) Usv[i] = A0[i];
        for (int rep3_ = 0; rep3_ < REP_S3; ++rep3_) {
#pragma unroll
          for (int i = 0; i < 4; ++i) A0[i] = Usv[i];
        { f32x4r X[4];
          if (w < 4) {
#pragma unroll
              for (int i = 0; i < 4; ++i)
#pragma unroll
                  for (int e = 0; e < 4; ++e) X[i][e] = bf2f(*(const LAS bf16*)(L + R_AT + (16 * i + 4 * g + e) * RS + (16 * w + r) * 2));
          } else {
#pragma unroll
              for (int i = 0; i < 4; ++i) X[i] = A0[i];
          }
          const f32x4r z4 = (f32x4r){0.f, 0.f, 0.f, 0.f};
#define TIF(i) ld2x4(L, R_TI + (16 * (i) + r) * TIS + 8 * g, R_TI + (16 * (i) + r) * TIS + 8 * g)
#define ABF(i, j0) ld2x4(L, R_AAB + (16 * (i) + r) * RS + (16 * (j0) + 4 * g) * 2, R_AAB + (16 * (i) + r) * RS + (16 * ((j0) + 1) + 4 * g) * 2)
          X[0] = MF16(TIF(0), pack1(X[0]), z4);
          X[1] = MF16(ABF(1, 0), pack1(X[0]), X[1]); X[1] = MF16(TIF(1), pack1(X[1]), z4);
          X[2] = MF16(ABF(2, 0), pack2(X[0], X[1]), X[2]); X[2] = MF16(TIF(2), pack1(X[2]), z4);
          X[3] = MF16(ABF(3, 0), pack2(X[0], X[1]), X[3]); X[3] = MF16(ABF(3, 2), pack1(X[2]), X[3]); X[3] = MF16(TIF(3), pack1(X[3]), z4);
#undef TIF
#undef ABF
          if (w < 4) {
#pragma unroll
              for (int i = 0; i < 4; ++i)
#pragma unroll
                  for (int e = 0; e < 4; e += 2) { const unsigned pk = cvtpk(X[i][e], X[i][e + 1]);
                      *(LAS bf16*)(L + R_BW + (16 * i + 4 * g + e) * RS + (16 * w + r) * 2) = (bf16)pk; *(LAS bf16*)(L + R_BW + (16 * i + 4 * g + e + 1) * RS + (16 * w + r) * 2) = (bf16)(pk >> 16); }
          } else {
#pragma unroll
              for (int i = 0; i < 4; ++i) A0[i] = X[i];
          } }
        WGBAR();
        }
        STAMP(8);
        RELANE();
        f32x4r Ysv[4], Hsv[4];
#pragma unroll
        for (int i = 0; i < 4; ++i) { Ysv[i] = A0[i]; Hsv[i] = Hs[i]; }
        for (int rep4_ = 0; rep4_ < REP_S45; ++rep4_) {
#pragma unroll
        for (int i = 0; i < 4; ++i) { A0[i] = Ysv[i]; Hs[i] = Hsv[i]; }
        if (w < 4) {
            if (w == 0) {
#pragma unroll
                for (int i = 0; i < 4; ++i) { A0[i] = (f32x4r){0.f, 0.f, 0.f, 0.f};
#pragma unroll
                    for (int k2 = 0; k2 < 2; ++k2) A0[i] = MF16(ldfrag(L, R_VT, 0, 32 * k2, r, g), ldfrag(L, R_ARK, 16 * i, 32 * k2, r, g), A0[i]); } }
#pragma unroll
            for (int i = 0; i < 4; ++i)
#pragma unroll
                for (int k2 = 0; k2 < 2; ++k2) A0[i] = MF16(ldfrag(L, R_HT, 16 * vt, 32 * k2, r, g), ldfrag(L, R_RT, 16 * i, 32 * k2, r, g), A0[i]);
        } else {
#pragma unroll
            for (int i = 0; i < 4; ++i) {
#pragma unroll
                for (int k2 = 0; k2 < 2; ++k2) A0[i] = MF16(ldfrag(L, R_BW, 16 * i, 32 * k2, r, g), ldfrag(L, R_HT, 16 * vt, 32 * k2, r, g), A0[i]);
                storeT(L, R_KU, A0[i], 16 * i, 16 * vt, r, g); }
        }
        WGBAR();
        STAMP(9);
        RELANE();
        if (w < 4) {
#pragma unroll
            for (int i = 0; i < 4; ++i) {
#pragma unroll
                for (int k2 = 0; k2 < 2; ++k2) A0[i] = MF16(ldfrag(L, R_KU, 16 * vt, 32 * k2, r, g), ldfrag(L, R_ARB, 16 * i, 32 * k2, r, g), A0[i]);
                const int s = c * 64 + 16 * i + r, t = d ? T - 1 - s : s; v2u yw; yw.x = cvtpk(A0[i][0], A0[i][1]); yw.y = cvtpk(A0[i][2], A0[i][3]);
                *(v2u*)(ybuf + (size_t)(b * T + t) * A_W + hd * 64 + 16 * vt + 4 * g) = yw; }
        } else {
#pragma unroll
            for (int i = 0; i < 4; ++i) { f32x4r acc = Hs[i] + KV[i];
#pragma unroll
                for (int k2 = 0; k2 < 2; ++k2) acc = MF16(ldfrag(L, R_BT, 16 * i, 32 * k2, r, g), ldfrag(L, R_KU, 16 * vt, 32 * k2, r, g), acc);
                const f32x4r pc = *(const LAS f32x4r*)(L + R_PC + (16 * i + 4 * g) * 4);
                Hs[i] = acc * pc; storeT(L, R_HT, Hs[i], 16 * i, 16 * vt, r, g); }
        }
        WGBAR();
        if (rep4_ + 1 < REP_S45) {
#pragma unroll
            for (int i = 0; i < 4; ++i) if (w >= 4) storeT(L, R_HT, Hsv[i], 16 * i, 16 * vt, r, g);
            WGBAR(); }
        }
        STAMP(10);
    }
#ifdef PROBE_TA
    if (blockIdx.x == 0 && (F.wave * 64 + lane_id()) == 0) { float* pf = (float*)(F.ws + WS_CTL + 32768); pf[0] = (float)((double)pt_sel / (double)(__builtin_amdgcn_s_memtime() - pt_t0)); }
#endif
#undef RELANE
#undef tc
}
__device__ __forceinline__ void rwkv_post(Frame& F) {
    const bf16* pa = (const bf16*)(F.ws + WS_PA); const bf16* y0 = (const bf16*)(F.ws + WS_Y); const bf16* y1 = y0 + (size_t)M * A_W;
    const float* bon0 = (const float*)(F.ws + WS_BON); const float* bon1 = bon0 + (size_t)M * 8;
    const int ko = kopaque(); const float *lnx_w = kin(I_LNW, ko), *lnx_b = kin(I_LNB, ko), *mu_ = kin(I_MU, ko);
    int lane = lane_id(); asm volatile("" : "+v"(lane));
    const int gw = F.vcu * NWAVES + F.wave, NGW = F.G * NWAVES, hd = lane >> 3, c0 = lane * 8;
    float lw_[8], lb_[8], mv0[8], mv1[8], mg0[8], mg1[8];
#pragma unroll
    for (int e = 0; e < 8; ++e) { lw_[e] = lnx_w[c0 + e]; lb_[e] = lnx_b[c0 + e]; mv0[e] = mu_[2 * A_W + c0 + e]; mv1[e] = mu_[A_COLS + 2 * A_W + c0 + e];
        mg0[e] = mu_[3 * A_W + c0 + e]; mg1[e] = mu_[A_COLS + 3 * A_W + c0 + e]; }
    for (int m = gw; m < M; m += NGW) {
        const int t = m & (T - 1); const bool hp = t > 0, hn = t < T - 1;
        const v4u a = *(const v4u*)(y0 + (size_t)m * A_W + c0), bq = *(const v4u*)(y1 + (size_t)m * A_W + c0);
        const bf16* p0 = pa + (size_t)m * A_COLS;
        const v4u vc = *(const v4u*)(p0 + 2 * A_W + c0), gc = *(const v4u*)(p0 + 3 * A_W + c0);
        const v4u z = (v4u){0u, 0u, 0u, 0u};
        const v4u vp = hp ? *(const v4u*)(p0 - A_COLS + 2 * A_W + c0) : z, gp = hp ? *(const v4u*)(p0 - A_COLS + 3 * A_W + c0) : z;
        const v4u vn = hn ? *(const v4u*)(p0 + A_COLS + 2 * A_W + c0) : z, gn = hn ? *(const v4u*)(p0 + A_COLS + 3 * A_W + c0) : z;
        const float bsum = bon0[(size_t)m * 8 + hd] + bon1[(size_t)m * 8 + hd];
        float y[8]; const unsigned aw[4] = {a.x, a.y, a.z, a.w}, bw[4] = {bq.x, bq.y, bq.z, bq.w};
        float s1 = 0.f;
#pragma unroll
        for (int e = 0; e < 4; ++e) { y[2 * e] = bflo(aw[e]) + bflo(bw[e]); y[2 * e + 1] = bfhi(aw[e]) + bfhi(bw[e]); s1 += y[2 * e] + y[2 * e + 1]; }
        s1 += dppf<0xB1>(s1); s1 += dppf<0x4E>(s1); s1 += dppf<0x141>(s1);
        const float mean = s1 * (1.f / 64.f); float s2 = 0.f;
#pragma unroll
        for (int e = 0; e < 8; ++e) { y[e] -= mean; s2 += y[e] * y[e]; }
        s2 += dppf<0xB1>(s2); s2 += dppf<0x4E>(s2); s2 += dppf<0x141>(s2);
        const float rstd = __builtin_amdgcn_rsqf(s2 * (1.f / 64.f) + GN_EPS);
        const unsigned vcw[4] = {vc.x, vc.y, vc.z, vc.w}, vpw[4] = {vp.x, vp.y, vp.z, vp.w}, vnw[4] = {vn.x, vn.y, vn.z, vn.w}, gcw[4] = {gc.x, gc.y, gc.z, gc.w}, gpw[4] = {gp.x, gp.y, gp.z, gp.w}, gnw[4] = {gn.x, gn.y, gn.z, gn.w};
        float o[8];
#pragma unroll
        for (int e = 0; e < 8; ++e) { const int k = e >> 1; const bool hi = e & 1;
            const float v0 = hi ? bfhi(vcw[k]) : bflo(vcw[k]), vm = hi ? bfhi(vpw[k]) : bflo(vpw[k]), vx = hi ? bfhi(vnw[k]) : bflo(vnw[k]);
            const float g0 = hi ? bfhi(gcw[k]) : bflo(gcw[k]), gm = hi ? bfhi(gpw[k]) : bflo(gpw[k]), gx = hi ? bfhi(gnw[k]) : bflo(gnw[k]);
            const float vs = v0 * (1.f - mv0[e] - mv1[e]) + mv0[e] * vm + mv1[e] * vx, gs = g0 * (1.f - mg0[e] - mg1[e]) + mg0[e] * gm + mg1[e] * gx;
            o[e] = (y[e] * rstd * lw_[e] + lb_[e] + bsum * vs) * siluf_(gs); }
        v4u ov; ov.x = cvtpk(o[0], o[1]); ov.y = cvtpk(o[2], o[3]); ov.z = cvtpk(o[4], o[5]); ov.w = cvtpk(o[6], o[7]);
        *(v4u*)(F.out + (size_t)m * OROW + OS_YA + c0 * 2) = ov;
    }
}
struct Args { const float* in[24]; unsigned char* out; unsigned char* ws; };
__global__ void __launch_bounds__(NWAVES * 64, 2) hybrid_fwd(Args args) {
    extern __shared__ __attribute__((aligned(16))) unsigned char lds[];
    Frame F;
    F.lds = (LAS unsigned char*)lds;
    F.MISC = (volatile LAS unsigned*)(F.lds + MISC_OFF);
    F.wave = __builtin_amdgcn_readfirstlane((int)threadIdx.x >> 6);
    F.G = gridDim.x; { const int bx = blockIdx.x; F.vcu = (F.G % 8 == 0) ? (bx % 8) * (F.G / 8) + bx / 8 : bx; }
    F.out = args.out; F.ws = args.ws;
    for (int u = (F.wave * 64 + lane_id()); u < (LDS_BYTES - LDSCTL_OFF) / 4; u += NWAVES * 64) ((LAS unsigned*)(F.lds + LDSCTL_OFF))[u] = 0u;
    __syncthreads();
    XcdBarrier bar = xcd_barrier_post((unsigned*)(F.ws + WS_CTL) + CW_BAR, F.MISC + 8);
#define GRID_BAR() xcd_barrier(bar)
#ifdef PROBE_G
#define PGDBG(k) ((k) == PROBE_GSEL ? (float*)(F.ws + WS_CTL + 32768) : (float*)nullptr)
#else
#define PGDBG(k) ((float*)nullptr)
#endif
    typedef pg8::bf16_t bt;
    p0a(F); GRID_BAR();
    p0b(F); GRID_BAR();
    { pg8::Gemm g{(const bt*)(F.out + OS_H), (const bt*)(F.ws + WS_WB), nullptr, nullptr, OROW / 2, D}; pg8::Order S; S.init(M, B_COLS, F.G, (int)blockIdx.x, 1);
      const int ko = kopaque(); pg8::EpiPB E{(bt*)(F.ws + WS_R), kin(I_QG, ko), kin(I_KG, ko), (LAS float*)(F.lds + EPI_OFF), PGDBG(0)};
      pg8::gemm_phase<pg8::EpiPB, pg8::Order, true, true>(F.lds + RING_OFF, g, S, E, F.wave); }
    GRID_BAR();
    attn_mfma(F); GRID_BAR();
    attn_combine(F); GRID_BAR();
    { pg8::Gemm g{(const bt*)(F.out + OS_H), (const bt*)(F.ws + WS_WAG), nullptr, nullptr, OROW / 2, D}; pg8::Order S; S.init(M, A_COLS + PGM * 256, F.G, (int)blockIdx.x, 1);
      pg8::EpiAG E{(bt*)(F.ws + WS_PA), (bt*)(F.ws + WS_PG), PGDBG(1)};
      pg8::gemm_phase<pg8::EpiAG, pg8::Order, true, true>(F.lds + RING_OFF, g, S, E, F.wave); }
    GRID_BAR();
    if (blockIdx.x < NCHAIN || F.G <= NCHAIN) rwkv_chunked(F);
    if (blockIdx.x >= NCHAIN || F.G <= NCHAIN) {
        const int Gs = F.G > NCHAIN ? F.G - NCHAIN : F.G, cs = F.G > NCHAIN ? (int)blockIdx.x - NCHAIN : (int)blockIdx.x;
        pg8::Gemm g{(const bt*)(F.out + OS_H), (const bt*)(F.ws + WS_WAG) + (size_t)(A_COLS + PGM * 256) * D, nullptr, nullptr, OROW / 2, D}; pg8::Order S; S.init(M, G_COLS - PGM * 256, Gs, cs, 1);
        pg8::EpiPG E{(bt*)(F.ws + WS_PG) + PGM * 256, PGDBG(4)};
        pg8::gemm_phase<pg8::EpiPG, pg8::Order, true, true>(F.lds + RING_OFF, g, S, E, F.wave); }
    GRID_BAR();
    rwkv_post(F); GRID_BAR();
    { pg8::Gemm g{(const bt*)(F.out + OS_YA), (const bt*)(F.ws + WS_WOA), (const bt*)(F.out + OS_YB), (const bt*)(F.ws + WS_WOB), OROW / 2, A_W}; pg8::Order S; S.init(M, D, F.G, (int)blockIdx.x, 2);
      pg8::EpiMerge E{(const bt*)(F.ws + WS_PG), (bt*)(F.ws + WS_Y), PGDBG(2)};
      pg8::gemm_phase<pg8::EpiMerge, pg8::Order, true, true>(F.lds + RING_OFF, g, S, E, F.wave); }
    GRID_BAR();
    { pg8::Gemm g{(const bt*)(F.ws + WS_Y), (const bt*)(F.ws + WS_WO), nullptr, nullptr, D, D}; pg8::Order S; S.init(M, D, F.G, (int)blockIdx.x, 1);
      const int ko = kopaque(); pg8::EpiOut E{kin(I_XP, ko), kin(I_XS, ko), (const float*)(F.ws + WS_MOD), (float*)F.out, PGDBG(3)};
      pg8::gemm_phase<pg8::EpiOut, pg8::Order, true, true>(F.lds + RING_OFF, g, S, E, F.wave); }
#if defined(PROBE_TA) || defined(PROBE_G) || defined(PROBE_AT)
    GRID_BAR();
    { const float f = ((const float*)(F.ws + WS_CTL + 32768))[0]; float* o = (float*)F.out;
      for (int i = blockIdx.x * 512 + (F.wave * 64 + lane_id()); i < 655 * 1024; i += gridDim.x * 512) o[i] *= (1.f + f); }
#endif
}

extern "C" void kernel_launch(void* const* d_in, const int* in_sizes, int n_in, void* d_out, int out_size, void* d_ws, size_t ws_size, hipStream_t stream) {
    static int grid = 0;
    if (grid == 0) {
        if (n_in != 24 || out_size != M * D || ws_size < WS_END) { fprintf(stderr, "kernel_launch: unexpected shapes: n_in %d out %d ws %zu (need %zu)\n", n_in, out_size, ws_size, (size_t)WS_END); grid = -1; return; }
        int dev = 0, cus = 0, per_cu = 0;
        if (hipGetDevice(&dev) != hipSuccess || hipDeviceGetAttribute(&cus, hipDeviceAttributeMultiprocessorCount, dev) != hipSuccess) { grid = -1; return; }
        if (hipFuncSetAttribute((const void*)hybrid_fwd, hipFuncAttributeMaxDynamicSharedMemorySize, LDS_BYTES) != hipSuccess) { fprintf(stderr, "kernel_launch: hipFuncSetAttribute failed\n"); grid = -1; return; }
        if (hipOccupancyMaxActiveBlocksPerMultiprocessor(&per_cu, (const void*)hybrid_fwd, NWAVES * 64, LDS_BYTES) != hipSuccess || per_cu < 1) { fprintf(stderr, "kernel_launch: occupancy query says %d\n", per_cu); }
        (void)hipGetLastError();
        grid = cus;
    }
    if (grid < 0) return;
    if (hipMemsetAsync((char*)d_ws + WS_CTL, 0, CTL_ZERO_BYTES, stream) != hipSuccess) return;
    Args a{};
    for (int i = 0; i < 24; ++i) a.in[i] = (const float*)d_in[i];
    a.out = (unsigned char*)d_out; a.ws = (unsigned char*)d_ws;
    hipLaunchKernelGGL(hybrid_fwd, dim3(grid), dim3(NWAVES * 64), LDS_BYTES, stream, a);
}
```

```cpp
#include <hip/hip_runtime.h>
#include <cstdio>
#include <cstdint>
__device__ __forceinline__ int lane_id() { unsigned m = ~0u; asm volatile("" : "+s"(m) :: "memory"); return (int)__builtin_amdgcn_mbcnt_hi(m, __builtin_amdgcn_mbcnt_lo(m, 0u)); }
namespace pg8 {
#define PG8_LAS __attribute__((address_space(3)))
typedef unsigned short bf16_t;
typedef short bf16x8 __attribute__((ext_vector_type(8)));
typedef float f32x4 __attribute__((ext_vector_type(4)));
typedef unsigned u32x4 __attribute__((ext_vector_type(4)));
constexpr int BM = 256, BK = 64, HALF = 128, HTB = HALF * BK * 2  , STAGE_BYTES = 8 * HTB, NXCD = 8, WGM = 8;

__host__ __device__ __forceinline__ int lds_byte(int r, int c) { const int st = (r >> 4) * 2 + (c >> 5), rr = r & 15, cc = c & 31, ob = rr * 64 + cc * 2; return st * 1024 + (ob ^ (((ob >> 9) & 1) << 5)); }
__host__ __device__ __forceinline__ void stage_rc(int b, int& R, int& C) { const int st = b / 1024, sb = b % 1024, swz = sb ^ (((sb >> 9) & 1) << 5); R = (st >> 1) * 16 + swz / 64; C = (st & 1) * 32 + (swz % 64) / 2; }
__host__ __device__ __forceinline__ int perm32(int rho) { const int n = rho >> 4, i = rho & 15; return 8 * (i >> 2) + 4 * n + (i & 3); }

struct Unit { int pm, pn, sel; };
struct Gemm { const bf16_t* A0; const bf16_t* B0; const bf16_t* A1; const bf16_t* B1; int lda; int K; };

struct Order {
    int nM, nN, nwg, G, c, CH;
    __host__ __device__ void init(int M, int N, int G_, int c_, int CH_) { nM = M / BM; nN = N / BM; nwg = nM * nN; G = G_; c = c_; CH = CH_; }
    __host__ __device__ bool next(int i, Unit& u) const {
        const int ti = (CH == 2) ? (i >> 1) : i; u.sel = (CH == 2) ? (i & 1) : 0;
        const long L = (long)ti * G + c; if (L >= nwg) return false;
        int wgid = (int)L; { const int q = nwg / NXCD, r = nwg % NXCD, xcd = wgid % NXCD, off = wgid / NXCD; wgid = (xcd < r ? xcd * (q + 1) : r * (q + 1) + (xcd - r) * q) + off; }
        const int nig = WGM * nN, gid = wgid / nig, fm = gid * WGM, gsz = (nM - fm) < WGM ? (nM - fm) : WGM;
        u.pm = fm + ((wgid % nig) % gsz); u.pn = (wgid % nig) / gsz; return true;
    }
};
__device__ __forceinline__ unsigned cvt_pk_bf16(float lo, float hi) { unsigned r; asm volatile("v_cvt_pk_bf16_f32 %0, %1, %2" : "=v"(r) : "v"(lo), "v"(hi)); return r; }
template <class Epi, class Sched, bool ALIGN_EPI = false, bool SP2 = false>
__device__ __forceinline__ void gemm_phase(PG8_LAS unsigned char* lds, const Gemm g, const Sched& S, const Epi& E, const int wave_id) {
    int tid = wave_id * 64 + lane_id(); asm volatile("" : "+v"(tid));
    const int wid = wave_id, lane = tid & 63, wr = wid >> 2, wc = wid & 3, fr = lane & 15, fq = lane >> 4;
    const int K = g.K, nt = K / BK;
    unsigned voffA[2], voffB[2];
#pragma unroll
    for (int i = 0; i < 2; ++i) { int R, C; stage_rc(tid * 16 + i * 8192, R, C); const int Rb = Epi::PERM ? ((R & ~31) + perm32(R & 31)) : R;
        voffA[i] = (unsigned)(R * g.lda + C) * 2u; voffB[i] = (unsigned)(Rb * K + C) * 2u; }
    const size_t kstep = (size_t)(BK * 2);
    const size_t hstepA = (size_t)HALF * g.lda * 2, hstepB = (size_t)HALF * K * 2;
    const size_t tstepA = 2 * hstepA, tstepB = 2 * hstepB;
    const unsigned ldsw = (unsigned)wid * 1024u;
    const int aoff = lds_byte(wr * 64 + fr, fq * 8), boff = lds_byte(wc * 32 + fr, fq * 8);
#define PG8_SA(b, h) (((b) * 2 + (h)) * HTB)
#define PG8_SB(b, h) ((4 + (b) * 2 + (h)) * HTB)
#define PG8_STAGE(bufoff, gbase, voff) do { _Pragma("unroll") for (int _i = 0; _i < 2; ++_i) \
        __builtin_amdgcn_global_load_lds((const unsigned*)((const char*)(gbase) + (voff)[_i]), (PG8_LAS unsigned*)(lds + (bufoff) + ldsw + _i * 8192), 16, 0, 0); } while (0)
#define PG8_LDA(dst, b, h) do { _Pragma("unroll") for (int m = 0; m < 4; ++m) _Pragma("unroll") for (int k = 0; k < 2; ++k) dst[m][k] = *(const PG8_LAS bf16x8*)(lds + PG8_SA(b, h) + aoff + m * 2048 + k * 1024); } while (0)
#define PG8_LDB(dst, b, h) do { _Pragma("unroll") for (int n = 0; n < 2; ++n) _Pragma("unroll") for (int k = 0; k < 2; ++k) dst[n][k] = *(const PG8_LAS bf16x8*)(lds + PG8_SB(b, h) + boff + n * 2048 + k * 1024); } while (0)
#define PG8_MMA(ai, bj, At, Bt) do { __builtin_amdgcn_s_setprio(1); _Pragma("unroll") for (int m = 0; m < 4; ++m) _Pragma("unroll") for (int n = 0; n < 2; ++n) _Pragma("unroll") for (int k = 0; k < 2; ++k) \
        acc[ai][bj][m][n] = __builtin_amdgcn_mfma_f32_16x16x32_bf16(Bt[n][k], At[m][k], acc[ai][bj][m][n], 0, 0, 0); __builtin_amdgcn_s_setprio(0); } while (0)
#define PG8_APTR(u) ((const char*)((u).sel ? g.A1 : g.A0) + (size_t)(u).pm * tstepA)
#define PG8_BPTR(u) ((const char*)((u).sel ? g.B1 : g.B0) + (size_t)(u).pn * tstepB)
#define PG8_WAIT_V(n) asm volatile("s_waitcnt vmcnt(" #n ")" ::: "memory")
#define PG8_WAIT_L(n) asm volatile("s_waitcnt lgkmcnt(" #n ")" ::: "memory")
#define PG8_BAR __builtin_amdgcn_s_barrier()
#define PG8_SCHED __builtin_amdgcn_sched_barrier(0)
    Unit cur, nxt; int ui = 0;
    if (!S.next(0, cur)) return;
#ifdef PROBE_G
    unsigned long long pg_epi = 0; const unsigned long long pg_start = __builtin_amdgcn_s_memtime();
#endif
    f32x4 acc[2][2][4][2];
#pragma unroll
    for (int a = 0; a < 2; ++a)
#pragma unroll
        for (int b = 0; b < 2; ++b)
#pragma unroll
            for (int m = 0; m < 4; ++m)
#pragma unroll
                for (int n = 0; n < 2; ++n) acc[a][b][m][n] = (f32x4){0.f, 0.f, 0.f, 0.f};
    bf16x8 At[4][2], B0[2][2], B1[2][2];
    const char* cA = PG8_APTR(cur); const char* cB = PG8_BPTR(cur);
    if constexpr (SP2) {
        PG8_STAGE(PG8_SB(0, 0), cB, voffB); PG8_STAGE(PG8_SB(0, 1), cB + hstepB, voffB); PG8_STAGE(PG8_SA(0, 0), cA, voffA); PG8_STAGE(PG8_SA(0, 1), cA + hstepA, voffA);
        if (wr == 1) PG8_BAR;
        PG8_WAIT_V(2); PG8_BAR;
        PG8_STAGE(PG8_SB(1, 0), cB + kstep, voffB); PG8_STAGE(PG8_SA(1, 0), cA + kstep, voffA); PG8_STAGE(PG8_SB(1, 1), cB + hstepB + kstep, voffB);
        PG8_WAIT_V(6); PG8_BAR;
    } else {
        PG8_STAGE(PG8_SB(0, 0), cB, voffB); PG8_STAGE(PG8_SA(0, 0), cA, voffA); PG8_STAGE(PG8_SB(0, 1), cB + hstepB, voffB); PG8_STAGE(PG8_SA(0, 1), cA + hstepA, voffA);
        if (wr == 1) PG8_BAR;
        PG8_WAIT_V(4); PG8_BAR;
        PG8_STAGE(PG8_SB(1, 0), cB + kstep, voffB); PG8_STAGE(PG8_SA(1, 0), cA + kstep, voffA); PG8_STAGE(PG8_SB(1, 1), cB + hstepB + kstep, voffB);
        PG8_WAIT_V(6); PG8_BAR;
    }
    for (;;) {
        const bool has_next = S.next(ui + 1, nxt);
        const char* nA = has_next ? PG8_APTR(nxt) : cA; const char* nB = has_next ? PG8_BPTR(nxt) : cB;
        for (int t = 0; t < nt; t += 2) {
            const bool last = (t == nt - 2);
            const char* a1 = cA + (size_t)(t + 1) * kstep;
            const char* a2 = last ? nA : cA + (size_t)(t + 2) * kstep; const char* b2 = last ? nB : cB + (size_t)(t + 2) * kstep;
            const char* a3 = a2 + kstep; const char* b3 = b2 + kstep;
            if constexpr (SP2) {
            PG8_LDB(B0, 0, 0); PG8_LDB(B1, 0, 1); PG8_SCHED; PG8_LDA(At, 0, 0); PG8_STAGE(PG8_SA(1, 1), a1 + hstepA, voffA);
            PG8_WAIT_V(8); PG8_WAIT_L(0); PG8_BAR; PG8_MMA(0, 0, At, B0); PG8_MMA(0, 1, At, B1); PG8_BAR; PG8_SCHED;
            PG8_LDA(At, 0, 1); PG8_STAGE(PG8_SB(0, 0), b2, voffB); PG8_STAGE(PG8_SB(0, 1), b2 + hstepB, voffB); PG8_STAGE(PG8_SA(0, 0), a2, voffA);
            PG8_WAIT_V(8); PG8_WAIT_L(0); PG8_BAR; PG8_MMA(1, 0, At, B0); PG8_MMA(1, 1, At, B1); PG8_BAR; PG8_SCHED;
            PG8_LDB(B0, 1, 0); PG8_LDB(B1, 1, 1); PG8_SCHED; PG8_LDA(At, 1, 0); PG8_STAGE(PG8_SA(0, 1), a2 + hstepA, voffA);
            PG8_WAIT_V(8); PG8_WAIT_L(0); PG8_BAR; PG8_MMA(0, 0, At, B0); PG8_MMA(0, 1, At, B1); PG8_BAR; PG8_SCHED;
            PG8_LDA(At, 1, 1); PG8_STAGE(PG8_SB(1, 0), b3, voffB); PG8_STAGE(PG8_SB(1, 1), b3 + hstepB, voffB); PG8_STAGE(PG8_SA(1, 0), a3, voffA);
            PG8_WAIT_V(8); PG8_WAIT_L(0); PG8_BAR; PG8_MMA(1, 0, At, B0); PG8_MMA(1, 1, At, B1); PG8_BAR; PG8_SCHED;
            } else {
            PG8_LDB(B0, 0, 0); PG8_SCHED; PG8_LDA(At, 0, 0); PG8_STAGE(PG8_SA(1, 1), a1 + hstepA, voffA);
            PG8_WAIT_L(8); PG8_BAR; PG8_WAIT_L(0); PG8_MMA(0, 0, At, B0); PG8_BAR; PG8_SCHED;
            PG8_LDB(B1, 0, 1); PG8_STAGE(PG8_SB(0, 0), b2, voffB);
            PG8_BAR; PG8_WAIT_L(0); PG8_MMA(0, 1, At, B1); PG8_BAR;
            PG8_LDA(At, 0, 1); PG8_STAGE(PG8_SA(0, 0), a2, voffA);
            PG8_BAR; PG8_WAIT_L(0); PG8_MMA(1, 0, At, B0); PG8_BAR; PG8_SCHED;
            PG8_STAGE(PG8_SB(0, 1), b2 + hstepB, voffB);
            PG8_WAIT_V(6); PG8_BAR; PG8_MMA(1, 1, At, B1); PG8_BAR;
            PG8_LDB(B0, 1, 0); PG8_SCHED; PG8_LDA(At, 1, 0); PG8_STAGE(PG8_SA(0, 1), a2 + hstepA, voffA);
            PG8_WAIT_L(8); PG8_BAR; PG8_WAIT_L(0); PG8_MMA(0, 0, At, B0); PG8_BAR; PG8_SCHED;
            PG8_LDB(B1, 1, 1); PG8_STAGE(PG8_SB(1, 0), b3, voffB);
            PG8_BAR; PG8_WAIT_L(0); PG8_MMA(0, 1, At, B1); PG8_BAR;
            PG8_LDA(At, 1, 1); PG8_STAGE(PG8_SA(1, 0), a3, voffA);
            PG8_BAR; PG8_WAIT_L(0); PG8_MMA(1, 0, At, B0); PG8_BAR; PG8_SCHED;
            PG8_STAGE(PG8_SB(1, 1), b3 + hstepB, voffB);
            PG8_WAIT_V(6); PG8_BAR; PG8_MMA(1, 1, At, B1); PG8_BAR;
            }
        }
        if constexpr (ALIGN_EPI) { if (wr == 0) PG8_BAR; }
#ifdef PROBE_G
        const unsigned long long pg_t0 = __builtin_amdgcn_s_memtime();
#endif
        const bool keep = E(acc, cur, wr, wc, fr, fq);
#ifdef PROBE_G
        pg_epi += __builtin_amdgcn_s_memtime() - pg_t0;
#endif
        if (!has_next) break;
        if (!keep) {
#pragma unroll
        for (int a = 0; a < 2; ++a)
#pragma unroll
            for (int b = 0; b < 2; ++b)
#pragma unroll
                for (int m = 0; m < 4; ++m)
#pragma unroll
                    for (int n = 0; n < 2; ++n) acc[a][b][m][n] = (f32x4){0.f, 0.f, 0.f, 0.f};
        }
        cur = nxt; cA = nA; cB = nB; ++ui;
        if constexpr (ALIGN_EPI) { if (wr == 1) PG8_BAR; }
    }
#ifdef PROBE_G
    if (E.dbg && blockIdx.x == 0 && threadIdx.x == 0) { const double tot = (double)(__builtin_amdgcn_s_memtime() - pg_start);
        E.dbg[0] = (PROBE_G == 1) ? (float)(tot / (double)(ui + 1) / 262144.0) : (float)((double)pg_epi / tot); }
#endif
    PG8_WAIT_V(0);
    if constexpr (!ALIGN_EPI) { if (wr == 0) PG8_BAR; }
    PG8_BAR;
#undef PG8_SA
#undef PG8_SB
#undef PG8_STAGE
#undef PG8_LDA
#undef PG8_LDB
#undef PG8_MMA
#undef PG8_APTR
#undef PG8_BPTR
#undef PG8_WAIT_V
#undef PG8_WAIT_L
#undef PG8_BAR
#undef PG8_SCHED
}
}

constexpr int NWAVES = 8;
constexpr int T = 8192, D = 1024, NBP = 8, NBS = 2, NB = NBP + NBS, M = NB * T;
constexpr int NCHAIN = 160, NSIDE = 64;
#ifndef PG_MAIN_TILES
#define PG_MAIN_TILES 0
#endif
constexpr int PGM = PG_MAIN_TILES;
constexpr int A_HEADS = 8, A_HD = 64, A_W = 512, RANK = 64;
constexpr int A_COLS = 2304, B_COLS = 5120, G_COLS = 2048, IN_COLS = 9472, AG_COLS = A_COLS + G_COLS;
constexpr int B_QKV = 1536, B_W = 512, B_HD = 128;
constexpr float RMS_EPS = 1e-6f, GN_EPS = 64e-5f;
constexpr size_t MiB = 1u << 20;
constexpr size_t WS_CTL = 0, CTL_ZERO_BYTES = 65536;
constexpr size_t WS_MOD = 1 * MiB;
constexpr size_t WS_BTAB = 1 * MiB + 128 * 1024;
constexpr size_t WS_WB = 2 * MiB;
constexpr size_t WS_WAG = 12 * MiB;
constexpr size_t WS_WOA = 21 * MiB, WS_WOB = 22 * MiB, WS_WO = 23 * MiB;
constexpr size_t WS_BON = 26 * MiB;
constexpr size_t WS_R = 32 * MiB;
constexpr size_t WS_PA = WS_R, WS_PG = WS_R + 360 * MiB;
constexpr size_t WS_Y = 832 * MiB;
constexpr size_t WS_END = 992 * MiB;
constexpr int CW_BAR = 4096;
constexpr int OS_H = 0, OS_YA = 2048, OS_YB = 3072, OROW = 4096;
constexpr int RING_OFF = 0, RING_BYTES = 131072;
constexpr int LDSCTL_OFF = RING_BYTES, MISC_OFF = LDSCTL_OFF + 320;
constexpr int EPI_OFF = RING_BYTES + 1024;
constexpr int LDS_BYTES = 147456;

#define GAS __attribute__((address_space(1)))
#define LAS __attribute__((address_space(3)))
typedef unsigned short bf16;
typedef unsigned v4u __attribute__((ext_vector_type(4)));
typedef unsigned v2u __attribute__((ext_vector_type(2)));
typedef float f32x4 __attribute__((ext_vector_type(4)));
typedef short bf16x8 __attribute__((ext_vector_type(8)));
typedef GAS unsigned gu32;
#define RLX_AGENT __ATOMIC_RELAXED, __HIP_MEMORY_SCOPE_AGENT
#define LDS_WAIT() asm volatile("s_waitcnt lgkmcnt(0)" ::: "memory")
#define VM_WAIT() asm volatile("s_waitcnt vmcnt(0)" ::: "memory")
__device__ __forceinline__ unsigned f2bf(float f) { unsigned u = __builtin_bit_cast(unsigned, f); return (u + 0x7fffu + ((u >> 16) & 1u)) >> 16; }
__device__ __forceinline__ unsigned pk2(float lo, float hi) { return f2bf(lo) | (f2bf(hi) << 16); }
typedef float f32x2_t __attribute__((ext_vector_type(2))); typedef __bf16 bf16x2_t __attribute__((ext_vector_type(2)));
__device__ __forceinline__ unsigned cvtpk(float lo, float hi) { f32x2_t v = {lo, hi}; bf16x2_t b = __builtin_convertvector(v, bf16x2_t); return __builtin_bit_cast(unsigned, b); }
__device__ __forceinline__ float bf2f(unsigned short h) { return __builtin_bit_cast(float, (unsigned)h << 16); }
__device__ __forceinline__ float bflo(unsigned w) { return __builtin_bit_cast(float, w << 16); }
__device__ __forceinline__ float bfhi(unsigned w) { return __builtin_bit_cast(float, w & 0xffff0000u); }
__device__ __forceinline__ float sigmoidf_(float v) { return __builtin_amdgcn_rcpf(1.f + __expf(-v)); }
__device__ __forceinline__ float siluf_(float v) { return v * sigmoidf_(v); }
__device__ __forceinline__ float wave_sum(float v) {
#pragma unroll
    for (int o = 1; o < 64; o <<= 1) v += __shfl_xor(v, o);
    return v;
}
__device__ __forceinline__ float wave_max(float v) {
#pragma unroll
    for (int o = 1; o < 64; o <<= 1) v = fmaxf(v, __shfl_xor(v, o));
    return v;
}

#define XB_TMO      128
#define XB_XCNT(j)  (256  + 64 * (j))
#define XB_XSUB(j)  (1280 + 64 * (j))
#define XB_XGEN(j)  (2304 + 64 * (j))
#define XB_TOP      3328
#define XB_TOPGEN   3392
#define XCD_BAR_WORDS 3456
#define XB_SPIN_CAP (1u << 22)
__device__ __forceinline__ unsigned xb_ld(unsigned* p)              { return __hip_atomic_load(p, __ATOMIC_RELAXED, __HIP_MEMORY_SCOPE_AGENT); }
__device__ __forceinline__ unsigned xb_add(unsigned* p, unsigned v) { return __hip_atomic_fetch_add(p, v, __ATOMIC_RELAXED, __HIP_MEMORY_SCOPE_AGENT); }
__device__ __forceinline__ unsigned xb_xcc_id() { return (unsigned)__builtin_amdgcn_s_getreg((3 << 11) | 20) & 0xFu; }
#define XB_SPIN(cond, bar) do { unsigned _sp = 0; while (cond) { __builtin_amdgcn_s_sleep(1); \
    if ((++_sp & 255u) == 0u) { if (xb_ld(&(bar)[XB_TMO])) break; if (_sp > XB_SPIN_CAP) { atomicAdd(&(bar)[XB_TMO], 1u); break; } } } } while (0)
struct XcdBarrier { unsigned* bar; unsigned x; volatile LAS unsigned* st; };
__device__ __forceinline__ XcdBarrier xcd_barrier_post(unsigned* bar, volatile LAS unsigned* st) {
    XcdBarrier b; b.bar = bar; b.x = xb_xcc_id(); b.st = st;
    if (threadIdx.x == 0) (void)xb_add(&bar[XB_XCNT(b.x)], 1u);
    return b;
}
__device__ __forceinline__ void xcd_barrier_complete(unsigned* bar, unsigned x, unsigned& nloc, unsigned& nx) {
    const unsigned G = gridDim.x * gridDim.y * gridDim.z;
    unsigned sum, cnt, mine, sp = 0u;
    for (;;) {
        sum = 0u; cnt = 0u; mine = 0u;
#pragma unroll
        for (unsigned j = 0; j < 16; ++j) { const unsigned c = xb_ld(&bar[XB_XCNT(j)]); sum += c; cnt += (c > 0u) ? 1u : 0u; mine = (j == x) ? c : mine; }
        if (sum == G) break;
        __builtin_amdgcn_s_sleep(1);
        if ((++sp & 255u) == 0u) { if (xb_ld(&bar[XB_TMO])) break; if (sp > XB_SPIN_CAP) { atomicAdd(&bar[XB_TMO], 1u); break; } }
    }
    nloc = mine > 0u ? mine : 1u; nx = cnt > 0u ? cnt : 1u;
}
__device__ __forceinline__ void xcd_barrier(const XcdBarrier& b, const int wave_id) {
    asm volatile("s_waitcnt vmcnt(0)" ::: "memory");
    __syncthreads();
    if (wave_id == 0 && lane_id() == 0) {
        unsigned* bar = b.bar;
        __builtin_amdgcn_s_waitcnt(0);
        unsigned nloc = b.st[0], nx = b.st[1];
        if (nloc == 0u) { xcd_barrier_complete(bar, b.x, nloc, nx); b.st[0] = nloc; b.st[1] = nx; }
        const unsigned old = xb_add(&bar[XB_XSUB(b.x)], 1u);
        const unsigned gen = old / nloc;
        if (old + 1u == (gen + 1u) * nloc) {
            __builtin_amdgcn_fence(__ATOMIC_RELEASE, "agent");
            asm volatile("s_waitcnt vmcnt(0)" ::: "memory");
            const unsigned og = xb_add(&bar[XB_TOP], 1u);
            const unsigned tg = og / nx;
            if (og + 1u == (tg + 1u) * nx) xb_add(&bar[XB_TOPGEN], 1u);
            else XB_SPIN(xb_ld(&bar[XB_TOPGEN]) == tg, bar);
            __builtin_amdgcn_fence(__ATOMIC_ACQUIRE, "agent");
            xb_add(&bar[XB_XGEN(b.x)], 1u);
            asm volatile("s_waitcnt vmcnt(0)" ::: "memory");
        } else {
            XB_SPIN(xb_ld(&bar[XB_XGEN(b.x)]) == gen, bar);
            __builtin_amdgcn_fence(__ATOMIC_ACQUIRE, "agent");
            asm volatile("s_waitcnt vmcnt(0)" ::: "memory");
        }
    }
    __syncthreads();
}

struct Frame {
    LAS unsigned char* lds;
    volatile LAS unsigned* MISC;
    int wave;
    __device__ __forceinline__ int lane_() const { return lane_id(); }
    int vcu, G;
    unsigned char* out;
    unsigned char* ws;
};
enum { I_XP = 0, I_XS, I_CP, I_CS, I_RELB, I_NORMW, I_WADA, I_BADA, I_WIN, I_MU, I_W0, I_W2, I_A0, I_A2, I_KK, I_KA, I_RK, I_LNW, I_LNB, I_QG, I_KG, I_WOA, I_WOB, I_WO };
__device__ __forceinline__ int kopaque() { int z = 0; asm volatile("" : "+s"(z)); return z; }
__device__ __forceinline__ const float* kin(int k, int kof) { return ((const float* const __attribute__((address_space(4)))*)__builtin_amdgcn_kernarg_segment_ptr())[k + kof]; }
__device__ __forceinline__ const float* xrow_ptr(const float* xp, const float* xs, int m) { return m < NBP * T ? xp + (size_t)m * D : xs + (size_t)(m - NBP * T) * D; }

namespace pg8 {
struct EpiPB {
    static constexpr bool PERM = true;
    bf16_t* O; const float* qg; const float* kg; PG8_LAS float* P; float* dbg;
    __device__ __forceinline__ bool operator()(f32x4 (&acc)[2][2][4][2], const Unit& u, int wr, int wc, int fr, int fq) const {
        const int row0 = u.pm * BM + wr * 64 + fr, col0 = u.pn * BM + wc * 32 + 8 * fq;
        if (u.pn < 12) {
#pragma unroll
            for (int ai = 0; ai < 2; ++ai)
#pragma unroll
                for (int m = 0; m < 4; ++m) {
#pragma unroll
                    for (int bj = 0; bj < 2; ++bj) { const f32x4 a = acc[ai][bj][m][0], b = acc[ai][bj][m][1];
                        float s = (a[0] * a[0] + a[1] * a[1]) + (a[2] * a[2] + a[3] * a[3]) + (b[0] * b[0] + b[1] * b[1]) + (b[2] * b[2] + b[3] * b[3]);
                        s += __shfl_xor(s, 16); s += __shfl_xor(s, 32);
                        if (fq == 0) P[((ai * HALF + wr * 64 + m * 16 + fr) * 2 + bj) * 4 + wc] = s; }
                    asm volatile("" ::: "memory"); }
            asm volatile("s_waitcnt lgkmcnt(0)" ::: "memory"); __builtin_amdgcn_s_barrier(); asm volatile("" ::: "memory");
            const bool isq = u.pn < 6; const float* gp = (isq ? qg : kg) + wc * 32 + 8 * fq; const float gs = isq ? 0.08838834764831845f * 1.4426950408889634f : 1.f;
            float gn[8];
#pragma unroll
            for (int e = 0; e < 8; ++e) gn[e] = gp[e] * gs;
#pragma unroll
            for (int ai = 0; ai < 2; ++ai)
#pragma unroll
                for (int m = 0; m < 4; ++m)
#pragma unroll
                    for (int bj = 0; bj < 2; ++bj) { const f32x4 p4 = *(const PG8_LAS f32x4*)(P + ((ai * HALF + wr * 64 + m * 16 + fr) * 2 + bj) * 4);
                        const float rs = 1.0f / sqrtf(((p4[0] + p4[1]) + (p4[2] + p4[3])) * (1.f / 128.f) + 1e-6f);
#pragma unroll
                        for (int e = 0; e < 4; ++e) { acc[ai][bj][m][0][e] *= rs * gn[e]; acc[ai][bj][m][1][e] *= rs * gn[4 + e]; }
                        asm volatile("" ::: "memory"); }
        }
        const bool act = u.pn >= 18;
#pragma unroll
        for (int ai = 0; ai < 2; ++ai)
#pragma unroll
            for (int m = 0; m < 4; ++m) { bf16_t* rowp = O + (size_t)(row0 + ai * HALF + m * 16) * B_COLS + col0;
#pragma unroll
                for (int bj = 0; bj < 2; ++bj) { f32x4 v0 = acc[ai][bj][m][0], v1 = acc[ai][bj][m][1];
                    if (act) {
#pragma unroll
                        for (int e = 0; e < 4; ++e) { v0[e] = siluf_(v0[e]); v1[e] = siluf_(v1[e]); } }
                    u32x4 w; w.x = cvt_pk_bf16(v0[0], v0[1]); w.y = cvt_pk_bf16(v0[2], v0[3]); w.z = cvt_pk_bf16(v1[0], v1[1]); w.w = cvt_pk_bf16(v1[2], v1[3]);
                    *(u32x4*)(rowp + bj * HALF) = w; } }
        return false;
    }
};
struct EpiAG {
    static constexpr bool PERM = true;
    bf16_t* PA; bf16_t* PG; float* dbg;
    __device__ __forceinline__ bool operator()(const f32x4 (&acc)[2][2][4][2], const Unit& u, int wr, int wc, int fr, int fq) const {
        const bool isg = u.pn >= 9; bf16_t* base = isg ? PG : PA; const int ldc = isg ? G_COLS : A_COLS; const int pn = isg ? u.pn - 9 : u.pn;
        const int row0 = u.pm * BM + wr * 64 + fr, col0 = pn * BM + wc * 32 + 8 * fq;
#pragma unroll
        for (int ai = 0; ai < 2; ++ai)
#pragma unroll
            for (int m = 0; m < 4; ++m) { bf16_t* rowp = base + (size_t)(row0 + ai * HALF + m * 16) * ldc + col0;
#pragma unroll
                for (int bj = 0; bj < 2; ++bj) { const f32x4 v0 = acc[ai][bj][m][0], v1 = acc[ai][bj][m][1];
                    u32x4 w; w.x = cvt_pk_bf16(v0[0], v0[1]); w.y = cvt_pk_bf16(v0[2], v0[3]); w.z = cvt_pk_bf16(v1[0], v1[1]); w.w = cvt_pk_bf16(v1[2], v1[3]);
                    *(u32x4*)(rowp + bj * HALF) = w; } }
        return false;
    }
};
struct EpiPG {
    static constexpr bool PERM = true;
    bf16_t* PG; float* dbg;
    __device__ __forceinline__ bool operator()(const f32x4 (&acc)[2][2][4][2], const Unit& u, int wr, int wc, int fr, int fq) const {
        const int row0 = u.pm * BM + wr * 64 + fr, col0 = u.pn * BM + wc * 32 + 8 * fq;
#pragma unroll
        for (int ai = 0; ai < 2; ++ai)
#pragma unroll
            for (int m = 0; m < 4; ++m) { bf16_t* rowp = PG + (size_t)(row0 + ai * HALF + m * 16) * G_COLS + col0;
#pragma unroll
                for (int bj = 0; bj < 2; ++bj) { const f32x4 v0 = acc[ai][bj][m][0], v1 = acc[ai][bj][m][1];
                    u32x4 w; w.x = cvt_pk_bf16(v0[0], v0[1]); w.y = cvt_pk_bf16(v0[2], v0[3]); w.z = cvt_pk_bf16(v1[0], v1[1]); w.w = cvt_pk_bf16(v1[2], v1[3]);
                    *(u32x4*)(rowp + bj * HALF) = w; } }
        return false;
    }
};
struct EpiMerge {
    static constexpr bool PERM = true;
    const bf16_t* PG; bf16_t* O; float* dbg;
    __device__ __forceinline__ bool operator()(f32x4 (&acc)[2][2][4][2], const Unit& u, int wr, int wc, int fr, int fq) const {
        const int row0 = u.pm * BM + wr * 64 + fr, col0 = u.pn * BM + wc * 32 + 8 * fq;
#pragma unroll
        for (int ai = 0; ai < 2; ++ai)
#pragma unroll
            for (int m = 0; m < 4; ++m) { const size_t row = (size_t)(row0 + ai * HALF + m * 16);
#pragma unroll
                for (int bj = 0; bj < 2; ++bj) { const int col = col0 + bj * HALF;
                    const u32x4 gb8 = *(const u32x4*)(PG + row * G_COLS + D + col);
                    float zb[8] = {bflo(gb8.x), bfhi(gb8.x), bflo(gb8.y), bfhi(gb8.y), bflo(gb8.z), bfhi(gb8.z), bflo(gb8.w), bfhi(gb8.w)};
                    if (u.sel == 0) {
                        const u32x4 ga8 = *(const u32x4*)(PG + row * G_COLS + col);
                        float za[8] = {bflo(ga8.x), bfhi(ga8.x), bflo(ga8.y), bfhi(ga8.y), bflo(ga8.z), bfhi(ga8.z), bflo(ga8.w), bfhi(ga8.w)};
#pragma unroll
                        for (int e = 0; e < 8; ++e) { const float ea = __expf(-fminf(fmaxf(za[e], -30.f), 30.f)), eb = __expf(-fminf(fmaxf(zb[e], -30.f), 30.f));
                            const float r = (1.f + eb) * __builtin_amdgcn_rcpf(1.f + ea); acc[ai][bj][m][e >> 2][e & 3] *= r; }
                    } else {
                        float o[8];
#pragma unroll
                        for (int e = 0; e < 8; ++e) { const float eb = __expf(-fminf(fmaxf(zb[e], -30.f), 30.f)); o[e] = acc[ai][bj][m][e >> 2][e & 3] * __builtin_amdgcn_rcpf(1.f + eb); }
                        u32x4 w; w.x = cvt_pk_bf16(o[0], o[1]); w.y = cvt_pk_bf16(o[2], o[3]); w.z = cvt_pk_bf16(o[4], o[5]); w.w = cvt_pk_bf16(o[6], o[7]);
                        *(u32x4*)(O + row * D + col) = w;
                    } } }
        return u.sel == 0;
    }
};
struct EpiOut {
    static constexpr bool PERM = false;
    const float* xp; const float* xs; const float* mod; float* out; float* dbg;
    __device__ __forceinline__ bool operator()(const f32x4 (&acc)[2][2][4][2], const Unit& u, int wr, int wc, int fr, int fq) const {
        const int rowt = u.pm * BM, b = rowt >> 13; const float* xb = rowt < NBP * T ? xp + (size_t)rowt * D : xs + (size_t)(rowt - NBP * T) * D;
        const int rl0 = wr * 64 + fr, col0 = u.pn * BM + wc * 32 + 4 * fq; const float* gt = mod + b * 3072 + 2048;
#pragma unroll
        for (int bj = 0; bj < 2; ++bj)
#pragma unroll
            for (int n = 0; n < 2; ++n) { const int col = col0 + bj * HALF + n * 16; const f32x4 g4 = *(const f32x4*)(gt + col);
#pragma unroll
                for (int ai = 0; ai < 2; ++ai)
#pragma unroll
                    for (int m = 0; m < 4; ++m) { const int rl = rl0 + ai * HALF + m * 16; const f32x4 x4 = *(const f32x4*)(xb + (size_t)rl * D + col);
                        *(f32x4*)(out + (size_t)(rowt + rl) * D + col) = x4 + g4 * acc[ai][bj][m][n]; } }
        return false;
    }
};
}

__device__ __forceinline__ void p0_transpose_item(const float* W, int K, int N, bf16* WT, int k0, int n0, int drow0, LAS float* scr, int lane) {
#pragma unroll 8
    for (int i = 0; i < 32; ++i) { const int kk = 2 * i + (lane >> 5); scr[kk * 33 + (lane & 31)] = W[(size_t)(k0 + kk) * N + n0 + (lane & 31)]; }
    LDS_WAIT(); asm volatile("" ::: "memory");
    const int c = lane & 7;
#pragma unroll
    for (int j = 0; j < 4; ++j) { const int n = (lane >> 3) + 8 * j; const LAS float* s = scr + (8 * c) * 33 + n;
        v4u o; o.x = pk2(s[0 * 33], s[1 * 33]); o.y = pk2(s[2 * 33], s[3 * 33]); o.z = pk2(s[4 * 33], s[5 * 33]); o.w = pk2(s[6 * 33], s[7 * 33]);
        *(GAS v4u*)(WT + (size_t)(drow0 + n) * K + k0 + 8 * c) = o; }
    LDS_WAIT(); asm volatile("" ::: "memory");
}
__device__ __forceinline__ int t5_bucket(int rel) {
    const int n = rel < 0 ? -rel : rel; int ret = rel > 0 ? 16 : 0;
    const float lf = logf((float)(n > 1 ? n : 1) / 8.0f) / 4.852030263919617f * 8.0f;
    int large = 8 + (int)lf; large = large < 15 ? large : 15;
    return ret + (n < 8 ? n : large);
}
__device__ __forceinline__ void p0a(Frame& F) {
    const int ko = kopaque(); const float *cp_ = kin(I_CP, ko), *cs_ = kin(I_CS, ko), *w_ada = kin(I_WADA, ko), *b_ada = kin(I_BADA, ko), *rel_bias = kin(I_RELB, ko), *w_in = kin(I_WIN, ko), *w_out_a = kin(I_WOA, ko), *w_out_b = kin(I_WOB, ko), *w_out = kin(I_WO, ko);
    float* mod = (float*)(F.ws + WS_MOD);
    if (blockIdx.x < 48) {
        LAS float* sc = (LAS float*)F.lds;
        LAS float* part = (LAS float*)(F.lds + 40960);
        for (int i = (F.wave * 64 + lane_id()); i < NB * D; i += NWAVES * 64) { const int b = i >> 10, k = i & 1023; const float cv = b < NBP ? cp_[b * D + k] : cs_[(b - NBP) * D + k]; sc[i] = siluf_(cv); }
        __syncthreads();
        const int j = blockIdx.x * 64 + lane_id(); float a[NB];
#pragma unroll
        for (int b = 0; b < NB; ++b) a[b] = 0.f;
        for (int k = F.wave * 128; k < F.wave * 128 + 128; ++k) { const float w = w_ada[(size_t)k * 3072 + j];
#pragma unroll
            for (int b = 0; b < NB; ++b) a[b] += sc[b * D + k] * w; }
#pragma unroll
        for (int b = 0; b < NB; ++b) part[(F.wave * NB + b) * 64 + lane_id()] = a[b];
        __syncthreads();
        for (int i = (F.wave * 64 + lane_id()); i < NB * 64; i += NWAVES * 64) { const int b = i >> 6, l = i & 63; float s = b_ada[blockIdx.x * 64 + l];
#pragma unroll
            for (int w = 0; w < NWAVES; ++w) s += part[(w * NB + b) * 64 + l];
            mod[b * 3072 + blockIdx.x * 64 + l] = s; }
        __syncthreads();
    }
    if (blockIdx.x == 255 % gridDim.x) {
        float* bt = (float*)(F.ws + WS_BTAB);
        for (int i = (F.wave * 64 + lane_id()); i < 12 * 129; i += NWAVES * 64) { const int gh = i / 129, r = i % 129, gi = gh >> 2; const int rel = (r - 64) * (1 << (2 * gi));
            bt[i] = rel_bias[t5_bucket(rel) * 12 + gh] * 1.4426950408889634f; }
    }
    LAS float* scr = (LAS float*)(F.lds + RING_OFF + F.wave * 16384);
    const int gw = F.vcu * NWAVES + F.wave, NGW = F.G * NWAVES;
    constexpr int I_IN = (D / 64) * (IN_COLS / 32), I_OA = (A_W / 64) * (D / 32), I_OB = (B_W / 64) * (D / 32), I_O = (D / 64) * (D / 32);
    constexpr int NITEMS = I_IN + I_OA + I_OB + I_O;
    for (int it = gw; it < NITEMS; it += NGW) {
        int r = it;
        if (r < I_IN) { const int nblk = IN_COLS / 32, kb = r / nblk, nb = r % nblk, n0 = nb * 32;
            bf16* dst; int drow;
            if (n0 < A_COLS) { dst = (bf16*)(F.ws + WS_WAG); drow = n0; }
            else if (n0 < A_COLS + B_COLS) { dst = (bf16*)(F.ws + WS_WB); drow = n0 - A_COLS; }
            else { dst = (bf16*)(F.ws + WS_WAG); drow = A_COLS + (n0 - A_COLS - B_COLS); }
            p0_transpose_item(w_in, D, IN_COLS, dst, kb * 64, n0, drow, scr, lane_id()); continue; }
        r -= I_IN;
        if (r < I_OA) { const int nblk = D / 32, kb = r / nblk, nb = r % nblk; p0_transpose_item(w_out_a, A_W, D, (bf16*)(F.ws + WS_WOA), kb * 64, nb * 32, nb * 32, scr, lane_id()); continue; }
        r -= I_OA;
        if (r < I_OB) { const int nblk = D / 32, kb = r / nblk, nb = r % nblk; p0_transpose_item(w_out_b, B_W, D, (bf16*)(F.ws + WS_WOB), kb * 64, nb * 32, nb * 32, scr, lane_id()); continue; }
        r -= I_OB;
        { const int nblk = D / 32, kb = r / nblk, nb = r % nblk; p0_transpose_item(w_out, D, D, (bf16*)(F.ws + WS_WO), kb * 64, nb * 32, nb * 32, scr, lane_id()); }
    }
}
__device__ __forceinline__ void p0b(Frame& F) {
    const int ko = kopaque(); const float *xp = kin(I_XP, ko), *xs = kin(I_XS, ko), *norm_w = kin(I_NORMW, ko);
    const float* mod = (const float*)(F.ws + WS_MOD);
    const int gw = F.vcu * NWAVES + F.wave, NGW = F.G * NWAVES, lane = lane_id();
    const int per = (M + NGW - 1) / NGW, m0 = gw * per, m1 = (m0 + per < M) ? m0 + per : M;
    int bcur = -1; f32x4 cs[4], sh[4];
    for (int m = m0; m < m1; ++m) {
        const int b = m >> 13;
        if (b != bcur) { bcur = b;
#pragma unroll
            for (int j = 0; j < 4; ++j) { const int col = 4 * (lane + 64 * j); const f32x4 nw = *(const f32x4*)(norm_w + col), sc = *(const f32x4*)(mod + b * 3072 + 1024 + col);
                cs[j] = nw * (sc + 1.f); sh[j] = *(const f32x4*)(mod + b * 3072 + col); } }
        const f32x4* xr = (const f32x4*)xrow_ptr(xp, xs, m) + lane;
        f32x4 v[4]; float s = 0.f;
#pragma unroll
        for (int j = 0; j < 4; ++j) { v[j] = xr[64 * j]; s += (v[j].x * v[j].x + v[j].y * v[j].y) + (v[j].z * v[j].z + v[j].w * v[j].w); }
        const float rs = __builtin_amdgcn_rsqf(wave_sum(s) * (1.f / D) + RMS_EPS);
        v2u* o8 = (v2u*)(F.out + (size_t)m * OROW + OS_H) + lane;
#pragma unroll
        for (int j = 0; j < 4; ++j) { const f32x4 h = v[j] * rs * cs[j] + sh[j]; v2u w; w.x = cvtpk(h.x, h.y); w.y = cvtpk(h.z, h.w); o8[64 * j] = w; }
    }
}
typedef short v4i16_t __attribute__((ext_vector_type(4)));
typedef float f32x4a __attribute__((ext_vector_type(4)));
constexpr int AT_K = 0, AT_V = 65536, AT_BT = RING_BYTES + 9216 + 1024;
constexpr size_t WS_LSE = WS_Y;
__device__ __forceinline__ void attn_unit_geom(int u, int& b, int& gi, int& hh, int& res, int& blk) {
    const int sub = u & 63; int r = u >> 6; hh = r & 3; r >>= 2; gi = r % 3; b = r / 3;
    if (gi == 0) { res = 0; blk = sub; } else if (gi == 1) { res = sub >> 4; blk = sub & 15; } else { res = sub >> 2; blk = sub & 3; }
}
__device__ __forceinline__ void attn_dma_k_half(Frame& F, const bf16* pb, int b, int lg, int L, int res, int head, int q0, int hb) {
    const int lane = lane_id();
#pragma unroll
    for (int ii = 0; ii < 4; ++ii) { const int i = (hb >> 2) + F.wave * 4 + ii, row = 4 * i + (lane >> 4); int kp = q0 - 64 + ((row - q0) & 255); kp = kp < 0 ? 0 : (kp >= L ? L - 1 : kp);
        const int c = (lane & 15) ^ (row & 15);
        const bf16* src = pb + (size_t)(b * T + (kp << lg) + res) * B_COLS + B_QKV + head * 128 + c * 8;
        __builtin_amdgcn_global_load_lds((const unsigned*)src, (LAS unsigned*)(F.lds + AT_K + i * 1024), 16, 0, 0); }
}
__device__ __forceinline__ void attn_dma_v_half(Frame& F, const bf16* pb, int b, int lg, int L, int res, int head, int q0, int hb) {
    const int lane = lane_id();
#pragma unroll
    for (int jj = 0; jj < 4; ++jj) { const int j = F.wave * 4 + jj, dblk = j >> 3, kgrp = (hb >> 4) + (j & 7), row = 16 * kgrp + (lane >> 2); int kp = q0 - 64 + ((row - q0) & 255); kp = kp < 0 ? 0 : (kp >= L ? L - 1 : kp);
        const bf16* src = pb + (size_t)(b * T + (kp << lg) + res) * B_COLS + 2 * B_QKV + head * 128 + dblk * 32 + (lane & 3) * 8;
        __builtin_amdgcn_global_load_lds((const unsigned*)src, (LAS unsigned*)(F.lds + AT_V + dblk * 16384 + kgrp * 1024), 16, 0, 0); }
}
__device__ __forceinline__ void attn_mfma(Frame& F, bool dry = false) {
    bf16* pb = (bf16*)(F.ws + WS_R); const float* btab = (const float*)(F.ws + WS_BTAB); float* lse = (float*)(F.ws + WS_LSE);
    int lane = lane_id(); asm volatile("" : "+v"(lane));
    const int w = F.wave, qi = lane & 15, g = lane >> 4;
    LAS float* btp = (LAS float*)(F.lds + AT_BT);
    const int NU = NB * 3 * 4 * 64, per = (NU + F.G - 1) / F.G; const int u0 = F.vcu * per, u1 = (u0 + per < NU) ? u0 + per : NU;
    if (u0 >= u1) return;
#ifdef PROBE_AT
    const unsigned long long pat_t0 = __builtin_amdgcn_s_memtime();
#endif
    int koff[4];
#pragma unroll
    for (int ks = 0; ks < 4; ++ks) koff[ks] = AT_K + qi * 256 + (((4 * ks + g) ^ qi) << 4);
    const int q4 = qi >> 2, p4 = qi & 3, kr = 4 * g + q4;
    const int voff = AT_V + (kr >> 3) * 512 + (kr & 7) * 64 + 8 * p4;
    int b, gi, hh, res, blk; attn_unit_geom(u0, b, gi, hh, res, blk);
    { const int lg = 2 * gi; attn_dma_k_half(F, pb, b, lg, T >> lg, res, gi * 4 + hh, blk * 128, 0); attn_dma_k_half(F, pb, b, lg, T >> lg, res, gi * 4 + hh, blk * 128, 128); }
    for (int u = u0; u < u1; ++u) {
        attn_unit_geom(u, b, gi, hh, res, blk);
        const int lg = 2 * gi, L = T >> lg, head = gi * 4 + hh, q0 = blk * 128;
        const bool cont = (u > u0) && (blk != 0);
        const int s8 = ((q0 >> 4) + w) & 15;
        if ((F.wave * 64 + lane_id()) < 176) { const int i = (F.wave * 64 + lane_id()) - 16; btp[(F.wave * 64 + lane_id())] = (i >= 0 && i <= 128) ? btab[head * 129 + i] : -1e30f; }
        bf16* qrow = pb + (size_t)(b * T + ((q0 + 16 * w + qi) << lg) + res) * B_COLS + head * 128;
        bf16x8 qf[4];
#pragma unroll
        for (int ks = 0; ks < 4; ++ks) qf[ks] = *(const bf16x8*)(qrow + 32 * ks + 8 * g);
        asm volatile("s_waitcnt vmcnt(0) lgkmcnt(0)" ::: "memory"); __builtin_amdgcn_s_barrier(); asm volatile("" ::: "memory");
        if (!cont) attn_dma_v_half(F, pb, b, lg, L, res, head, q0, q0 & 255);
        attn_dma_v_half(F, pb, b, lg, L, res, head, q0, (q0 + 128) & 255);
        f32x4a S[9];
#pragma unroll
        for (int kb = 0; kb < 9; ++kb) { S[kb] = (f32x4a){0.f, 0.f, 0.f, 0.f}; const int rb = ((s8 + kb) & 15) * 4096;
#pragma unroll
            for (int ks = 0; ks < 4; ++ks) { const bf16x8 kf = *(const LAS bf16x8*)(F.lds + koff[ks] + rb);
                S[kb] = __builtin_amdgcn_mfma_f32_16x16x32_bf16(kf, qf[ks], S[kb], 0, 0, 0); } }
        const bool edge = (q0 == 0) || (q0 + 128 >= L);
        float mx = -1e30f;
#pragma unroll
        for (int kb = 0; kb < 9; ++kb)
#pragma unroll
            for (int r = 0; r < 4; ++r) { const int kw = 16 * kb + 4 * g + r; float sv = S[kb][r] + btp[kw - qi + 16];
                if (edge) { const int kp = q0 + 16 * w + kw - 64; if (kp < 0 || kp >= L) sv = -1e30f; }
                S[kb][r] = sv; mx = fmaxf(mx, sv); }
        mx = fmaxf(mx, __shfl_xor(mx, 16)); mx = fmaxf(mx, __shfl_xor(mx, 32));
        float ls = 0.f;
#pragma unroll
        for (int kb = 0; kb < 9; ++kb)
#pragma unroll
            for (int r = 0; r < 4; ++r) { const float p = __builtin_amdgcn_exp2f(S[kb][r] - mx); S[kb][r] = p; ls += p; }
        ls += __shfl_xor(ls, 16); ls += __shfl_xor(ls, 32);
        bf16x8 pf[5];
#pragma unroll
        for (int c = 0; c < 5; ++c) { v4u t; t.x = cvtpk(S[2 * c][0], S[2 * c][1]); t.y = cvtpk(S[2 * c][2], S[2 * c][3]);
            if (c < 4) { t.z = cvtpk(S[2 * c + 1][0], S[2 * c + 1][1]); t.w = cvtpk(S[2 * c + 1][2], S[2 * c + 1][3]); } else { t.z = 0u; t.w = 0u; }
            pf[c] = __builtin_bit_cast(bf16x8, t); }
        asm volatile("s_waitcnt vmcnt(0) lgkmcnt(0)" ::: "memory"); __builtin_amdgcn_s_barrier(); asm volatile("" ::: "memory");
        if (u + 1 < u1) { int b2, gi2, hh2, res2, blk2; attn_unit_geom(u + 1, b2, gi2, hh2, res2, blk2); const int lg2 = 2 * gi2, q02 = blk2 * 128;
            if (blk2 == 0) attn_dma_k_half(F, pb, b2, lg2, T >> lg2, res2, gi2 * 4 + hh2, q02, q02 & 255);
            attn_dma_k_half(F, pb, b2, lg2, T >> lg2, res2, gi2 * 4 + hh2, q02, (q02 + 128) & 255); }
        const float il = 1.f / ls;
        int vlo[5], vhi[5];
#pragma unroll
        for (int c = 0; c < 5; ++c) { vlo[c] = voff + ((s8 + 2 * c) & 15) * 1024; vhi[c] = (c < 4) ? voff + ((s8 + 2 * c + 1) & 15) * 1024 : vlo[c]; }
#pragma unroll
        for (int db = 0; db < 8; ++db) { f32x4a o = (f32x4a){0.f, 0.f, 0.f, 0.f};
#pragma unroll
            for (int c = 0; c < 5; ++c) { const int dofs = (db >> 1) * 16384 + (db & 1) * 32;
                const v4i16_t lo = __builtin_amdgcn_ds_read_tr16_b64_v4i16((LAS v4i16_t*)(F.lds + vlo[c] + dofs));
                const v4i16_t hi = __builtin_amdgcn_ds_read_tr16_b64_v4i16((LAS v4i16_t*)(F.lds + vhi[c] + dofs));
                const bf16x8 vf = (bf16x8){lo[0], lo[1], lo[2], lo[3], hi[0], hi[1], hi[2], hi[3]};
                o = __builtin_amdgcn_mfma_f32_16x16x32_bf16(vf, pf[c], o, 0, 0, 0); }
            v2u wv; wv.x = cvtpk(o[0] * il, o[1] * il); wv.y = cvtpk(o[2] * il, o[3] * il);
            *(v2u*)((dry ? (bf16*)(F.ws + WS_Y) + (size_t)((F.wave * 64 + lane_id()) >> 2) * B_COLS : qrow) + 16 * db + 4 * g) = wv; }
        if (g == 0 && !dry) lse[(size_t)(b * T + ((q0 + 16 * w + qi) << lg) + res) * 12 + head] = mx + __builtin_amdgcn_logf(ls);
    }
    asm volatile("s_waitcnt vmcnt(0) lgkmcnt(0)" ::: "memory"); __builtin_amdgcn_s_barrier();
#ifdef PROBE_AT
    if (blockIdx.x == 0 && (F.wave * 64 + lane_id()) == 0) ((float*)(F.ws + WS_CTL + 32768))[0] = (float)((double)(((__builtin_amdgcn_s_memtime() - pat_t0) / (unsigned long long)(u1 - u0) + 1024ull) >> 11 << 11) / 65536.0);
#endif
}
__device__ __forceinline__ void attn_combine(Frame& F) {
    const bf16* pb = (const bf16*)(F.ws + WS_R); const float* lse = (const float*)(F.ws + WS_LSE);
    const int gw = F.vcu * NWAVES + F.wave, NGW = F.G * NWAVES, lane = lane_id(), hh = lane >> 4, d0 = (lane & 15) * 8;
    for (int m = gw; m < M; m += NGW) {
        const bf16* row = pb + (size_t)m * B_COLS;
        const float l0 = lse[(size_t)m * 12 + hh], l1 = lse[(size_t)m * 12 + 4 + hh], l2 = lse[(size_t)m * 12 + 8 + hh];
        const float mxl = fmaxf(l0, fmaxf(l1, l2)); float w0 = exp2f(l0 - mxl), w1 = exp2f(l1 - mxl), w2 = exp2f(l2 - mxl); const float iw = 1.f / (w0 + w1 + w2); w0 *= iw; w1 *= iw; w2 *= iw;
        const v4u a = *(const v4u*)(row + hh * 128 + d0), bq = *(const v4u*)(row + (4 + hh) * 128 + d0), c = *(const v4u*)(row + (8 + hh) * 128 + d0), gt = *(const v4u*)(row + 3 * B_QKV + hh * 128 + d0);
        v4u o;
        o.x = pk2((w0 * bflo(a.x) + w1 * bflo(bq.x) + w2 * bflo(c.x)) * bflo(gt.x), (w0 * bfhi(a.x) + w1 * bfhi(bq.x) + w2 * bfhi(c.x)) * bfhi(gt.x));
        o.y = pk2((w0 * bflo(a.y) + w1 * bflo(bq.y) + w2 * bflo(c.y)) * bflo(gt.y), (w0 * bfhi(a.y) + w1 * bfhi(bq.y) + w2 * bfhi(c.y)) * bfhi(gt.y));
        o.z = pk2((w0 * bflo(a.z) + w1 * bflo(bq.z) + w2 * bflo(c.z)) * bflo(gt.z), (w0 * bfhi(a.z) + w1 * bfhi(bq.z) + w2 * bfhi(c.z)) * bfhi(gt.z));
        o.w = pk2((w0 * bflo(a.w) + w1 * bflo(bq.w) + w2 * bflo(c.w)) * bflo(gt.w), (w0 * bfhi(a.w) + w1 * bfhi(bq.w) + w2 * bfhi(c.w)) * bfhi(gt.w));
        *(v4u*)(F.out + (size_t)m * OROW + OS_YB + (hh * 128 + d0) * 2) = o;
    }
}

#ifdef PROBE_TA
#define STAMP(k) do { if ((k) == PROBE_TA) pt_a = __builtin_amdgcn_s_memtime(); if ((k) == PROBE_TB) pt_sel += __builtin_amdgcn_s_memtime() - pt_a; } while (0)
#else
#define STAMP(k) do { } while (0)
#endif
#ifndef REP_S0
#define REP_S0 1
#define REP_S12 1
#define REP_S3 1
#define REP_S45 1
#endif
typedef float f32x4r __attribute__((ext_vector_type(4)));
constexpr int RS = 144, RM = 64 * RS;
constexpr int R_AT = 0 * RM, R_RT = 1 * RM, R_BW = 2 * RM, R_KU = 3 * RM, R_BT = 4 * RM, R_KT = 5 * RM, R_VT = 6 * RM, R_AAB = 7 * RM, R_AAK = 8 * RM, R_ARB = 9 * RM, R_ARK = 10 * RM, R_HT = 11 * RM;
constexpr int R_W2T = 12 * RM, R_A2T = 13 * RM;
constexpr int R_WLF = R_AT, R_ALF = R_BT, FS = 272;
constexpr int R_TI = 132096, TIS = 48, R_PC = R_TI + 3072, R_BLK = R_PC + 256, R_AD = R_BLK + 2048;
__device__ __forceinline__ bf16x8 ldfrag(LAS unsigned char* lds, int mat, int row0, int k0, int r, int g) { return *(const LAS bf16x8*)(lds + mat + (row0 + r) * RS + (k0 + 8 * g) * 2); }
__device__ __forceinline__ void storeT(LAS unsigned char* lds, int mat, const f32x4r& d, int row0, int col0, int r, int g) {
    v2u w; w.x = cvtpk(d[0], d[1]); w.y = cvtpk(d[2], d[3]); *(LAS v2u*)(lds + mat + (col0 + r) * RS + (row0 + 4 * g) * 2) = w; }
__device__ __forceinline__ bf16x8 pack2(const f32x4r& a, const f32x4r& b) { v4u t; t.x = cvtpk(a[0], a[1]); t.y = cvtpk(a[2], a[3]); t.z = cvtpk(b[0], b[1]); t.w = cvtpk(b[2], b[3]); return __builtin_bit_cast(bf16x8, t); }
__device__ __forceinline__ bf16x8 pack1(const f32x4r& a) { v4u t; t.x = cvtpk(a[0], a[1]); t.y = cvtpk(a[2], a[3]); t.z = 0u; t.w = 0u; return __builtin_bit_cast(bf16x8, t); }
__device__ __forceinline__ bf16x8 ld2x4(LAS unsigned char* lds, int off0, int off1) { const v2u a = *(const LAS v2u*)(lds + off0), b = *(const LAS v2u*)(lds + off1); v4u t; t.x = a.x; t.y = a.y; t.z = b.x; t.w = b.y; return __builtin_bit_cast(bf16x8, t); }
#define MF16(a, b, c) __builtin_amdgcn_mfma_f32_16x16x32_bf16((a), (b), (c), 0, 0, 0)
#define WGBAR() do { asm volatile("s_waitcnt lgkmcnt(0)" ::: "memory"); __builtin_amdgcn_s_barrier(); asm volatile("" ::: "memory"); } while (0)
template <int CTRL> __device__ __forceinline__ float dppf(float x) { return __builtin_bit_cast(float, __builtin_amdgcn_update_dpp(0, __builtin_bit_cast(int, x), CTRL, 0xF, 0xF, true)); }
__device__ __forceinline__ float row16_sum(float v) { v += dppf<0xB1>(v); v += dppf<0x4E>(v); v += dppf<0x141>(v); v += dppf<0x140>(v); return v; }
__device__ __forceinline__ float wave_sum_dpp(float v) { v = row16_sum(v);
    return (__builtin_bit_cast(float, __builtin_amdgcn_readlane(__builtin_bit_cast(int, v), 0)) + __builtin_bit_cast(float, __builtin_amdgcn_readlane(__builtin_bit_cast(int, v), 16)))
         + (__builtin_bit_cast(float, __builtin_amdgcn_readlane(__builtin_bit_cast(int, v), 32)) + __builtin_bit_cast(float, __builtin_amdgcn_readlane(__builtin_bit_cast(int, v), 48))); }
__device__ __forceinline__ void reduce8(const float (&v)[8], float (&s)[8], float& v0, float& v1, int lane) {
    const bool b0 = lane & 1, b1 = lane & 2; float r1[4], r2[2];
#pragma unroll
    for (int i = 0; i < 4; ++i) { const float keep = b0 ? v[2 * i + 1] : v[2 * i], send = b0 ? v[2 * i] : v[2 * i + 1]; r1[i] = keep + dppf<0xB1>(send); }
#pragma unroll
    for (int i = 0; i < 2; ++i) { const float keep = b1 ? r1[2 * i + 1] : r1[2 * i], send = b1 ? r1[2 * i] : r1[2 * i + 1]; r2[i] = keep + dppf<0x4E>(send); }
#pragma unroll
    for (int i = 0; i < 2; ++i) { float x = r2[i]; x += dppf<0x124>(x); x += dppf<0x128>(x);
        x += __builtin_bit_cast(float, __builtin_amdgcn_ds_swizzle(__builtin_bit_cast(int, x), 0x401F));
        x += __shfl_xor(x, 32);
        r2[i] = x; }
    v0 = r2[0]; v1 = r2[1];
#pragma unroll
    for (int q = 0; q < 8; ++q) s[q] = __builtin_bit_cast(float, __builtin_amdgcn_readlane(__builtin_bit_cast(int, r2[q >> 2]), q & 3));
}
typedef float f2v __attribute__((ext_vector_type(2)));
__device__ __forceinline__ f2v exp2v(f2v x) { return (f2v){__builtin_amdgcn_exp2f(x.x), __builtin_amdgcn_exp2f(x.y)}; }
__device__ __forceinline__ f2v rcpv(f2v x) { return (f2v){__builtin_amdgcn_rcpf(x.x), __builtin_amdgcn_rcpf(x.y)}; }
__device__ __forceinline__ unsigned cvtpk2(f2v v) { bf16x2_t b = __builtin_convertvector(v, bf16x2_t); return __builtin_bit_cast(unsigned, b); }
__device__ __forceinline__ float fast_tanh(float x) { const float e = __expf(2.f * x); return 1.f - 2.f * __builtin_amdgcn_rcpf(e + 1.f); }
template <bool RV> __device__ __forceinline__ void rwkv_load_rows(__amdgpu_buffer_rsrc_t rsrc, int b, int d, int c, int w, unsigned o_r, unsigned o_w, unsigned (&x0)[10], unsigned (&x1)[10], unsigned (&x2)[10]) {
    const int s0 = c * 64 + 8 * w - 1;
#pragma unroll
    for (int k = 0; k < 10; ++k) { const int s = s0 + k; int tk = d ? T - 1 - s : s; tk = tk < 0 ? 0 : (tk > T - 1 ? T - 1 : tk);
        const int so = __builtin_amdgcn_readfirstlane((b * T + tk) * (A_COLS * 2));
        if (RV) { x0[k] = __builtin_amdgcn_raw_buffer_load_b32(rsrc, o_r, so, 0); x1[k] = __builtin_amdgcn_raw_buffer_load_b32(rsrc, o_r + 2 * A_W * 2, so, 0); }
        else { x0[k] = __builtin_amdgcn_raw_buffer_load_b32(rsrc, o_r + A_W * 2, so, 0); x1[k] = __builtin_amdgcn_raw_buffer_load_b32(rsrc, o_w, so, 0); x2[k] = __builtin_amdgcn_raw_buffer_load_b32(rsrc, o_w + 2 * RANK * 2, so, 0); } }
}
__device__ __forceinline__ bf16x8 ldfragT(LAS unsigned char* lds, int mat, int m0, int k0, int lane) {
    const int i16 = lane & 15, g = lane >> 4, q = i16 >> 2, pq = i16 & 3; const int off = mat + (k0 + 8 * g + q) * RS + (m0 + 4 * pq) * 2;
    const v4i16_t lo = __builtin_amdgcn_ds_read_tr16_b64_v4i16((LAS v4i16_t*)(lds + off)), hi = __builtin_amdgcn_ds_read_tr16_b64_v4i16((LAS v4i16_t*)(lds + off + 4 * RS));
    return (bf16x8){lo[0], lo[1], lo[2], lo[3], hi[0], hi[1], hi[2], hi[3]};
}
__device__ __forceinline__ void rwkv_chunked(Frame& F) {
    if (blockIdx.x >= 2 * NB * A_HEADS) return;
    const int chain = blockIdx.x, d = chain / (NB * A_HEADS), rem = chain % (NB * A_HEADS), b = rem >> 3, hd = rem & 7;
    const bf16* pa = (const bf16*)(F.ws + WS_PA); bf16* ybuf = (bf16*)(F.ws + WS_Y) + (size_t)d * M * A_W; float* bon = (float*)(F.ws + WS_BON) + (size_t)d * M * 8;
    const int ko = kopaque(); const float *w2_ = kin(I_W2, ko), *a2_ = kin(I_A2, ko), *mu_ = kin(I_MU, ko), *w0_ = kin(I_W0, ko), *a0_ = kin(I_A0, ko), *kk_ = kin(I_KK, ko), *ka_ = kin(I_KA, ko), *rk_ = kin(I_RK, ko);
    LAS unsigned char* L = F.lds;
    int lane = lane_id(); asm volatile("" : "+v"(lane));
    const int w = F.wave, j = lane, ch = hd * 64 + j;
    int r, g;
#define RELANE() do { int ln_ = lane; asm volatile("" : "+v"(ln_)); r = ln_ & 15; g = ln_ >> 4; } while (0)
    for (int i = (F.wave * 64 + lane_id()); i < 4096; i += NWAVES * 64) { const int jo = i >> 6, jr = i & 63;
        *(LAS bf16*)(L + R_W2T + jo * RS + jr * 2) = (bf16)f2bf(w2_[((size_t)d * RANK + jr) * A_W + hd * 64 + jo]);
        *(LAS bf16*)(L + R_A2T + jo * RS + jr * 2) = (bf16)f2bf(a2_[((size_t)d * RANK + jr) * A_W + hd * 64 + jo]); }
    for (int i = (F.wave * 64 + lane_id()); i < 5 * RM / 4; i += NWAVES * 64) ((LAS unsigned*)(L + R_AAB))[i] = 0u;
    const int cr = ch, ck = A_W + ch, cv = 2 * A_W + ch, cw = 4 * A_W + d * RANK + j, ca = 4 * A_W + 2 * RANK + d * RANK + j;
    const float mr0 = mu_[cr], mr1 = mu_[A_COLS + cr], mk0 = mu_[ck], mk1 = mu_[A_COLS + ck], mv0 = mu_[cv], mv1 = mu_[A_COLS + cv];
    const float mw0 = mu_[cw], mw1 = mu_[A_COLS + cw], ma0 = mu_[ca], ma1 = mu_[A_COLS + ca];
    const __amdgpu_buffer_rsrc_t rsrc = __builtin_amdgcn_make_buffer_rsrc((void*)pa, 0, M * A_COLS * 2, 0x00020000);
#define O_R ((unsigned)(((hd * 64 + lnow_) * 2) & ~3))
#define O_W ((unsigned)(((4 * A_W + d * RANK + lnow_) * 2) & ~3))
#define PSEL ((lnow_ & 1) ? 0x07060c0cu : 0x05040c0cu)
    const float sr0 = d ? mr1 : mr0, sr1 = d ? mr0 : mr1, sk0 = d ? mk1 : mk0, sk1 = d ? mk0 : mk1, sv0 = d ? mv1 : mv0, sv1 = d ? mv0 : mv1, sw0 = d ? mw1 : mw0, sw1 = d ? mw0 : mw1, sa0 = d ? ma1 : ma0, sa1 = d ? ma0 : ma1;
    const float w0j = w0_[d * A_W + ch], a0j = a0_[d * A_W + ch], kkj = kk_[ch], kaj = ka_[ch], rkj = rk_[ch];
    const int vt = w & 3;
    f32x4r Hs[4];
#pragma unroll
    for (int i = 0; i < 4; ++i) Hs[i] = (f32x4r){0.f, 0.f, 0.f, 0.f};
    unsigned xk[10], xw[10], xa[10];
    { int lnow_ = lane; rwkv_load_rows<false>(rsrc, b, d, 0, w, O_R, O_W, xk, xw, xa); }
    WGBAR();
#ifdef PROBE_TA
    unsigned long long pt_a = 0, pt_sel = 0; const unsigned long long pt_t0 = __builtin_amdgcn_s_memtime();
#endif
    for (int c = 0; c < T / 64; ++c) {
        STAMP(0);
        f2v ks2[4], kn2[4];
        for (int rep0_ = 0; rep0_ < REP_S0; ++rep0_) {
        int lnow_ = lane; asm volatile("" : "+v"(lnow_)); const unsigned psel = PSEL;
        if (REP_S0 > 1 && rep0_ > 0) rwkv_load_rows<false>(rsrc, b, d, c, w, O_R, O_W, xk, xw, xa);
        const bool okp = (c * 64 + 8 * w) > 0, okn = (c * 64 + 8 * w + 8) < T;
#define XF(x, k) ((((k) == 0 && !okp) || ((k) == 9 && !okn)) ? 0.f : __builtin_bit_cast(float, __builtin_amdgcn_perm((x)[k], 0u, psel)))
#define SH2(dst, x, m0, m1) do { float xf_[10]; _Pragma("unroll") for (int k_ = 0; k_ < 10; ++k_) xf_[k_] = XF(x, k_); const float mc_ = 1.f - (m0) - (m1); \
        _Pragma("unroll") for (int q2_ = 0; q2_ < 4; ++q2_) (dst)[q2_] = (f2v){xf_[2 * q2_ + 1], xf_[2 * q2_ + 2]} * mc_ + (f2v){xf_[2 * q2_], xf_[2 * q2_ + 1]} * (m0) + (f2v){xf_[2 * q2_ + 2], xf_[2 * q2_ + 3]} * (m1); } while (0)
        { unsigned tw_[4], al_[4];
          { f2v ws2[4]; SH2(ws2, xw, sw0, sw1);
#pragma unroll
            for (int q2 = 0; q2 < 4; ++q2) { const f2v e2 = exp2v(ws2[q2] * 2.8853900817779268f); tw_[q2] = cvtpk2(1.f - 2.f * rcpv(e2 + 1.f)); } }
          asm volatile("" ::: "memory");
          { f2v as2[4]; SH2(as2, xa, sa0, sa1);
#pragma unroll
            for (int q2 = 0; q2 < 4; ++q2) al_[q2] = cvtpk2(as2[q2]); }
          asm volatile("" ::: "memory");
          SH2(ks2, xk, sk0, sk1);
#pragma unroll
          for (int q2 = 0; q2 < 4; ++q2) kn2[q2] = ks2[q2] * kkj;
          *(LAS v4u*)(L + R_BW + j * RS + 16 * w) = (v4u){tw_[0], tw_[1], tw_[2], tw_[3]};
          *(LAS v4u*)(L + R_KU + j * RS + 16 * w) = (v4u){al_[0], al_[1], al_[2], al_[3]}; }
        { float sq[8], n2[8], d0_, d1_;
#pragma unroll
          for (int q2 = 0; q2 < 4; ++q2) { const f2v s = kn2[q2] * kn2[q2]; sq[2 * q2] = s.x; sq[2 * q2 + 1] = s.y; }
          reduce8(sq, n2, d0_, d1_, lane);
#pragma unroll
          for (int q2 = 0; q2 < 4; ++q2) kn2[q2] *= (f2v){__builtin_amdgcn_rsqf(fmaxf(n2[2 * q2], 1e-24f)), __builtin_amdgcn_rsqf(fmaxf(n2[2 * q2 + 1], 1e-24f))}; }
        WGBAR();
        STAMP(1);
        RELANE();
        unsigned xr[10], xv[10], xdum[10];
        rwkv_load_rows<true>(rsrc, b, d, c, w, O_R, O_W, xr, xv, xdum);
        { const int it = w >> 1;
          bf16x8 ta[2], aa[2];
#pragma unroll
          for (int k2 = 0; k2 < 2; ++k2) { ta[k2] = ldfragT(L, R_BW, 16 * it, 32 * k2, lane); aa[k2] = ldfragT(L, R_KU, 16 * it, 32 * k2, lane); }
#pragma unroll
          for (int j2 = 0; j2 < 2; ++j2) { const int jt = 2 * (w & 1) + j2; f32x4r dw = (f32x4r){0.f, 0.f, 0.f, 0.f}, da = dw;
#pragma unroll
              for (int k2 = 0; k2 < 2; ++k2) { dw = MF16(ta[k2], ldfrag(L, R_W2T, 16 * jt, 32 * k2, r, g), dw); da = MF16(aa[k2], ldfrag(L, R_A2T, 16 * jt, 32 * k2, r, g), da); }
#pragma unroll
              for (int e = 0; e < 4; ++e) { *(LAS float*)(L + R_WLF + (16 * it + 4 * g + e) * FS + (16 * jt + r) * 4) = dw[e]; *(LAS float*)(L + R_ALF + (16 * it + 4 * g + e) * FS + (16 * jt + r) * 4) = da[e]; } } }
        WGBAR();
        STAMP(2);
        f2v av2[4]; float cp[8]; float run = 1.f;
#pragma unroll
        for (int q2 = 0; q2 < 4; ++q2) { const int i0 = 8 * w + 2 * q2;
            const f2v wl = (f2v){*(const LAS float*)(L + R_WLF + i0 * FS + j * 4), *(const LAS float*)(L + R_WLF + (i0 + 1) * FS + j * 4)} + w0j;
            const f2v al = (f2v){*(const LAS float*)(L + R_ALF + i0 * FS + j * 4), *(const LAS float*)(L + R_ALF + (i0 + 1) * FS + j * 4)} + a0j;
            const f2v dec = exp2v(rcpv(exp2v(wl * -1.4426950408889634f) + 1.f) * (-0.6065306597126334f * 1.4426950408889634f));
            av2[q2] = rcpv(exp2v(al * -1.4426950408889634f) + 1.f);
            run *= dec.x; cp[2 * q2] = run; run *= dec.y; cp[2 * q2 + 1] = run; }
        *(LAS float*)(L + R_BLK + (w * 64 + j) * 4) = run;
        WGBAR();
        STAMP(3);
        { float off = 1.f, tot = 1.f;
#pragma unroll
          for (int w2 = 0; w2 < 8; ++w2) { const float bt = *(const LAS float*)(L + R_BLK + (w2 * 64 + j) * 4); off *= (w2 < w) ? bt : 1.f; tot *= bt; }
          if (w == 0) *(LAS float*)(L + R_PC + j * 4) = tot;
          f2v rs2[4], vs2[4], kd2[4]; SH2(rs2, xr, sr0, sr1); SH2(vs2, xv, sv0, sv1);
          { float bp[8], bs[8], b0_, b1_;
#pragma unroll
            for (int q2 = 0; q2 < 4; ++q2) { kd2[q2] = ks2[q2] * (av2[q2] * kaj + (1.f - kaj)); const f2v t = rs2[q2] * kd2[q2] * rkj; bp[2 * q2] = t.x; bp[2 * q2 + 1] = t.y; }
            reduce8(bp, bs, b0_, b1_, lane);
            if (lane < 4) { const int s0_ = c * 64 + 8 * w + lane, s1_ = s0_ + 4; const int t0_ = d ? T - 1 - s0_ : s0_, t1_ = d ? T - 1 - s1_ : s1_;
                bon[(size_t)(b * T + t0_) * 8 + hd] = b0_; bon[(size_t)(b * T + t1_) * 8 + hd] = b1_; } }
          unsigned pa_[4], pr_[4], pb_[4], pk_[4], pv_[4];
#pragma unroll
          for (int q2 = 0; q2 < 4; ++q2) { const int qa = 2 * q2;
              const f2v pt = (f2v){cp[qa], cp[qa + 1]} * off; const f2v pm = (f2v){(qa == 0) ? off : off * cp[qa > 0 ? qa - 1 : 0], pt.x}; const f2v em = rcpv(pt);
              pa_[q2] = cvtpk2(-kn2[q2] * pm); pr_[q2] = cvtpk2(rs2[q2] * pt); pb_[q2] = cvtpk2(kn2[q2] * av2[q2] * em); pk_[q2] = cvtpk2(kd2[q2] * em); pv_[q2] = cvtpk2(vs2[q2]); }
          *(LAS v4u*)(L + R_AT + j * RS + 16 * w) = (v4u){pa_[0], pa_[1], pa_[2], pa_[3]};
          *(LAS v4u*)(L + R_RT + j * RS + 16 * w) = (v4u){pr_[0], pr_[1], pr_[2], pr_[3]};
          *(LAS v4u*)(L + R_BT + j * RS + 16 * w) = (v4u){pb_[0], pb_[1], pb_[2], pb_[3]};
          *(LAS v4u*)(L + R_KT + j * RS + 16 * w) = (v4u){pk_[0], pk_[1], pk_[2], pk_[3]};
          *(LAS v4u*)(L + R_VT + j * RS + 16 * w) = (v4u){pv_[0], pv_[1], pv_[2], pv_[3]}; }
        WGBAR();
#undef SH2
#undef XF
        }
        STAMP(4);
        if (c + 1 < T / 64) { int lnow_ = lane; asm volatile("" : "+v"(lnow_)); rwkv_load_rows<false>(rsrc, b, d, c + 1, w, O_R, O_W, xk, xw, xa); }
        STAMP(5);
        RELANE();
        f32x4r A0[4], KV[4];
#define tc(i) KV[(i) >> 2][(i) & 3]
        for (int rep1_ = 0; rep1_ < REP_S12; ++rep1_) {
        if (w == 0) {
#pragma unroll
            for (int i = 0; i < 4; ++i) { f32x4r dd = (f32x4r){0.f, 0.f, 0.f, 0.f};
#pragma unroll
                for (int k2 = 0; k2 < 2; ++k2) dd = MF16(ldfragT(L, R_BT, 16 * i, 32 * k2, lane), ldfragT(L, R_AT, 16 * i, 32 * k2, lane), dd);
#pragma unroll
                for (int e = 0; e < 4; ++e) if (4 * g + e >= r) dd[e] = 0.f;
                storeT(L, R_AAB, dd, 16 * i, 16 * i, r, g);
                *(LAS f32x4r*)(L + R_AD + i * 1024 + r * 64 + 16 * g) = dd; }
            asm volatile("s_waitcnt lgkmcnt(0)" ::: "memory");
            const int blk = lane >> 4, cc = lane & 15;
#pragma unroll
            for (int rr = 0; rr < 8; ++rr) { float acc = (rr == cc) ? 1.f : 0.f;
#pragma unroll
                for (int s4 = 0; s4 < (rr + 3) / 4; ++s4) { const f32x4r a4 = *(const LAS f32x4r*)(L + R_AD + blk * 1024 + rr * 64 + s4 * 16);
#pragma unroll
                    for (int e = 0; e < 4; ++e) if (4 * s4 + e < rr) acc += a4[e] * tc(4 * s4 + e); }
                tc(rr) = acc; *(LAS bf16*)(L + R_TI + (16 * blk + rr) * TIS + cc * 2) = (bf16)f2bf(acc); }
        } else {
#pragma unroll
            for (int kb = 0; kb < 3; ++kb) {
                bf16x8 fa[2][2], fb[2][2]; int dmv[2], tsv[2], ttv[2]; bool inc[2], val[2];
#pragma unroll
                for (int k = 0; k < 2; ++k) { const int jb = w - 1 + 7 * (2 * kb + k); val[k] = jb < 36; const int jc = val[k] ? jb : 0;
                    int mat, idx; if (jc < 6) { mat = 0; idx = (0x865321 >> (4 * jc)) & 15; } else { const int q = jc - 6; mat = 1 + q / 10; idx = q - 10 * (mat - 1); }
                    const int ts = (int)((0x3221110000ull >> (4 * idx)) & 15), tt = (int)((0x3323213210ull >> (4 * idx)) & 15);
                    const int ym = (mat & 1) ? R_KT : R_BT, xm = (mat & 2) ? R_RT : R_AT; dmv[k] = R_AAB + mat * RM; inc[k] = mat >= 2; tsv[k] = ts; ttv[k] = tt;
#pragma unroll
                    for (int k2 = 0; k2 < 2; ++k2) { fa[k][k2] = ldfragT(L, ym, 16 * ts, 32 * k2, lane); fb[k][k2] = ldfragT(L, xm, 16 * tt, 32 * k2, lane); } }
#pragma unroll
                for (int k = 0; k < 2; ++k) { f32x4r dd = (f32x4r){0.f, 0.f, 0.f, 0.f};
#pragma unroll
                    for (int k2 = 0; k2 < 2; ++k2) dd = MF16(fa[k][k2], fb[k][k2], dd);
                    if (tsv[k] == ttv[k]) {
#pragma unroll
                        for (int e = 0; e < 4; ++e) { const int sl = 4 * g + e; if (inc[k] ? (sl > r) : (sl >= r)) dd[e] = 0.f; } }
                    if (val[k]) storeT(L, dmv[k], dd, 16 * tsv[k], 16 * ttv[k], r, g); }
            }
        }
        STAMP(11);
        WGBAR();
        STAMP(6);
        RELANE();
        if (w == 0) {
            const int blk = lane >> 4, cc = lane & 15;
#pragma unroll
            for (int rr = 8; rr < 16; ++rr) { float acc = (rr == cc) ? 1.f : 0.f;
#pragma unroll
                for (int s4 = 0; s4 < (rr + 3) / 4; ++s4) { const f32x4r a4 = *(const LAS f32x4r*)(L + R_AD + blk * 1024 + rr * 64 + s4 * 16);
#pragma unroll
                    for (int e = 0; e < 4; ++e) if (4 * s4 + e < rr) acc += a4[e] * tc(4 * s4 + e); }
                tc(rr) = acc; *(LAS bf16*)(L + R_TI + (16 * blk + rr) * TIS + cc * 2) = (bf16)f2bf(acc); }
        } else if (w < 4) {
#pragma unroll
            for (int i = 0; i < 4; ++i) { A0[i] = (f32x4r){0.f, 0.f, 0.f, 0.f};
#pragma unroll
                for (int k2 = 0; k2 < 2; ++k2) A0[i] = MF16(ldfrag(L, R_VT, 16 * vt, 32 * k2, r, g), ldfrag(L, R_ARK, 16 * i, 32 * k2, r, g), A0[i]); }
        } else {
#pragma unroll
            for (int i = 0; i < 4; ++i) { A0[i] = (f32x4r){0.f, 0.f, 0.f, 0.f}; KV[i] = A0[i];
#pragma unroll
                for (int k2 = 0; k2 < 2; ++k2) { const bf16x8 vf = ldfrag(L, R_VT, 16 * vt, 32 * k2, r, g);
                    A0[i] = MF16(ldfrag(L, R_AAK, 16 * i, 32 * k2, r, g), vf, A0[i]); KV[i] = MF16(ldfrag(L, R_KT, 16 * i, 32 * k2, r, g), vf, KV[i]); } }
        }
        WGBAR();
        }
        STAMP(7);
        RELANE();
        f32x4r Usv[4];
#pragma unroll
        for (int i = 0; i < 4; ++i) Usv[i] = A0[i];
        for (int rep3_ = 0; rep3_ < REP_S3; ++rep3_) {
#pragma unroll
          for (int i = 0; i < 4; ++i) A0[i] = Usv[i];
        { f32x4r X[4];
          if (w < 4) {
#pragma unroll
              for (int i = 0; i < 4; ++i) { const v2u a2 = *(const LAS v2u*)(L + R_AT + (16 * w + r) * RS + (16 * i + 4 * g) * 2); X[i] = (f32x4r){bflo(a2.x), bfhi(a2.x), bflo(a2.y), bfhi(a2.y)}; }
          } else {
#pragma unroll
              for (int i = 0; i < 4; ++i) X[i] = A0[i];
          }
          const f32x4r z4 = (f32x4r){0.f, 0.f, 0.f, 0.f};
#define TIF(i) ld2x4(L, R_TI + (16 * (i) + r) * TIS + 8 * g, R_TI + (16 * (i) + r) * TIS + 8 * g)
#define ABF(i, j0) ld2x4(L, R_AAB + (16 * (i) + r) * RS + (16 * (j0) + 4 * g) * 2, R_AAB + (16 * (i) + r) * RS + (16 * ((j0) + 1) + 4 * g) * 2)
          X[0] = MF16(TIF(0), pack1(X[0]), z4);
          X[1] = MF16(ABF(1, 0), pack1(X[0]), X[1]); X[1] = MF16(TIF(1), pack1(X[1]), z4);
          X[2] = MF16(ABF(2, 0), pack2(X[0], X[1]), X[2]); X[2] = MF16(TIF(2), pack1(X[2]), z4);
          X[3] = MF16(ABF(3, 0), pack2(X[0], X[1]), X[3]); X[3] = MF16(ABF(3, 2), pack1(X[2]), X[3]); X[3] = MF16(TIF(3), pack1(X[3]), z4);
#undef TIF
#undef ABF
          if (w < 4) {
#pragma unroll
              for (int i = 0; i < 4; ++i) storeT(L, R_BW, X[i], 16 * i, 16 * w, r, g);
          } else {
#pragma unroll
              for (int i = 0; i < 4; ++i) A0[i] = X[i];
          } }
        WGBAR();
        }
        STAMP(8);
        RELANE();
        f32x4r Ysv[4], Hsv[4];
#pragma unroll
        for (int i = 0; i < 4; ++i) { Ysv[i] = A0[i]; Hsv[i] = Hs[i]; }
        for (int rep4_ = 0; rep4_ < REP_S45; ++rep4_) {
#pragma unroll
        for (int i = 0; i < 4; ++i) { A0[i] = Ysv[i]; Hs[i] = Hsv[i]; }
        if (w < 4) {
            if (w == 0) {
#pragma unroll
                for (int i = 0; i < 4; ++i) { A0[i] = (f32x4r){0.f, 0.f, 0.f, 0.f};
#pragma unroll
                    for (int k2 = 0; k2 < 2; ++k2) A0[i] = MF16(ldfrag(L, R_VT, 0, 32 * k2, r, g), ldfrag(L, R_ARK, 16 * i, 32 * k2, r, g), A0[i]); } }
#pragma unroll
            for (int i = 0; i < 4; ++i)
#pragma unroll
                for (int k2 = 0; k2 < 2; ++k2) A0[i] = MF16(ldfrag(L, R_HT, 16 * vt, 32 * k2, r, g), ldfragT(L, R_RT, 16 * i, 32 * k2, lane), A0[i]);
        } else {
#pragma unroll
            for (int i = 0; i < 4; ++i) {
#pragma unroll
                for (int k2 = 0; k2 < 2; ++k2) A0[i] = MF16(ldfragT(L, R_BW, 16 * i, 32 * k2, lane), ldfrag(L, R_HT, 16 * vt, 32 * k2, r, g), A0[i]);
                storeT(L, R_KU, A0[i], 16 * i, 16 * vt, r, g); }
        }
        WGBAR();
        STAMP(9);
        RELANE();
        if (w < 4) {
#pragma unroll
            for (int i = 0; i < 4; ++i) {
#pragma unroll
                for (int k2 = 0; k2 < 2; ++k2) A0[i] = MF16(ldfrag(L, R_KU, 16 * vt, 32 * k2, r, g), ldfrag(L, R_ARB, 16 * i, 32 * k2, r, g), A0[i]);
                const int s = c * 64 + 16 * i + r, t = d ? T - 1 - s : s; v2u yw; yw.x = cvtpk(A0[i][0], A0[i][1]); yw.y = cvtpk(A0[i][2], A0[i][3]);
                *(v2u*)(ybuf + (size_t)(b * T + t) * A_W + hd * 64 + 16 * vt + 4 * g) = yw; }
        } else {
#pragma unroll
            for (int i = 0; i < 4; ++i) { f32x4r acc = Hs[i] + KV[i];
#pragma unroll
                for (int k2 = 0; k2 < 2; ++k2) acc = MF16(ldfrag(L, R_BT, 16 * i, 32 * k2, r, g), ldfrag(L, R_KU, 16 * vt, 32 * k2, r, g), acc);
                const f32x4r pc = *(const LAS f32x4r*)(L + R_PC + (16 * i + 4 * g) * 4);
                Hs[i] = acc * pc; storeT(L, R_HT, Hs[i], 16 * i, 16 * vt, r, g); }
        }
        WGBAR();
        if (rep4_ + 1 < REP_S45) {
#pragma unroll
            for (int i = 0; i < 4; ++i) if (w >= 4) storeT(L, R_HT, Hsv[i], 16 * i, 16 * vt, r, g);
            WGBAR(); }
        }
        STAMP(10);
    }
#ifdef PROBE_TA
    if (blockIdx.x == 0 && (F.wave * 64 + lane_id()) == 0) { float* pf = (float*)(F.ws + WS_CTL + 32768); pf[0] = (float)((double)pt_sel / (double)(__builtin_amdgcn_s_memtime() - pt_t0)); }
#endif
#undef RELANE
#undef tc
#undef O_R
#undef O_W
#undef PSEL
}
__device__ __forceinline__ void rwkv_post(Frame& F) {
    const bf16* pa = (const bf16*)(F.ws + WS_PA); const bf16* y0 = (const bf16*)(F.ws + WS_Y); const bf16* y1 = y0 + (size_t)M * A_W;
    const float* bon0 = (const float*)(F.ws + WS_BON); const float* bon1 = bon0 + (size_t)M * 8;
    const int ko = kopaque(); const float *lnx_w = kin(I_LNW, ko), *lnx_b = kin(I_LNB, ko), *mu_ = kin(I_MU, ko);
    int lane = lane_id(); asm volatile("" : "+v"(lane));
    const int gw = F.vcu * NWAVES + F.wave, NGW = F.G * NWAVES, hd = lane >> 3, c0 = lane * 8;
    float lw_[8], lb_[8], mv0[8], mv1[8], mg0[8], mg1[8];
#pragma unroll
    for (int e = 0; e < 8; ++e) { lw_[e] = lnx_w[c0 + e]; lb_[e] = lnx_b[c0 + e]; mv0[e] = mu_[2 * A_W + c0 + e]; mv1[e] = mu_[A_COLS + 2 * A_W + c0 + e];
        mg0[e] = mu_[3 * A_W + c0 + e]; mg1[e] = mu_[A_COLS + 3 * A_W + c0 + e]; }
    for (int m = gw; m < M; m += NGW) {
        const int t = m & (T - 1); const bool hp = t > 0, hn = t < T - 1;
        const v4u a = *(const v4u*)(y0 + (size_t)m * A_W + c0), bq = *(const v4u*)(y1 + (size_t)m * A_W + c0);
        const bf16* p0 = pa + (size_t)m * A_COLS;
        const v4u vc = *(const v4u*)(p0 + 2 * A_W + c0), gc = *(const v4u*)(p0 + 3 * A_W + c0);
        const v4u z = (v4u){0u, 0u, 0u, 0u};
        const v4u vp = hp ? *(const v4u*)(p0 - A_COLS + 2 * A_W + c0) : z, gp = hp ? *(const v4u*)(p0 - A_COLS + 3 * A_W + c0) : z;
        const v4u vn = hn ? *(const v4u*)(p0 + A_COLS + 2 * A_W + c0) : z, gn = hn ? *(const v4u*)(p0 + A_COLS + 3 * A_W + c0) : z;
        const float bsum = bon0[(size_t)m * 8 + hd] + bon1[(size_t)m * 8 + hd];
        float y[8]; const unsigned aw[4] = {a.x, a.y, a.z, a.w}, bw[4] = {bq.x, bq.y, bq.z, bq.w};
        float s1 = 0.f;
#pragma unroll
        for (int e = 0; e < 4; ++e) { y[2 * e] = bflo(aw[e]) + bflo(bw[e]); y[2 * e + 1] = bfhi(aw[e]) + bfhi(bw[e]); s1 += y[2 * e] + y[2 * e + 1]; }
        s1 += dppf<0xB1>(s1); s1 += dppf<0x4E>(s1); s1 += dppf<0x141>(s1);
        const float mean = s1 * (1.f / 64.f); float s2 = 0.f;
#pragma unroll
        for (int e = 0; e < 8; ++e) { y[e] -= mean; s2 += y[e] * y[e]; }
        s2 += dppf<0xB1>(s2); s2 += dppf<0x4E>(s2); s2 += dppf<0x141>(s2);
        const float rstd = __builtin_amdgcn_rsqf(s2 * (1.f / 64.f) + GN_EPS);
        const unsigned vcw[4] = {vc.x, vc.y, vc.z, vc.w}, vpw[4] = {vp.x, vp.y, vp.z, vp.w}, vnw[4] = {vn.x, vn.y, vn.z, vn.w}, gcw[4] = {gc.x, gc.y, gc.z, gc.w}, gpw[4] = {gp.x, gp.y, gp.z, gp.w}, gnw[4] = {gn.x, gn.y, gn.z, gn.w};
        float o[8];
#pragma unroll
        for (int e = 0; e < 8; ++e) { const int k = e >> 1; const bool hi = e & 1;
            const float v0 = hi ? bfhi(vcw[k]) : bflo(vcw[k]), vm = hi ? bfhi(vpw[k]) : bflo(vpw[k]), vx = hi ? bfhi(vnw[k]) : bflo(vnw[k]);
            const float g0 = hi ? bfhi(gcw[k]) : bflo(gcw[k]), gm = hi ? bfhi(gpw[k]) : bflo(gpw[k]), gx = hi ? bfhi(gnw[k]) : bflo(gnw[k]);
            const float vs = v0 * (1.f - mv0[e] - mv1[e]) + mv0[e] * vm + mv1[e] * vx, gs = g0 * (1.f - mg0[e] - mg1[e]) + mg0[e] * gm + mg1[e] * gx;
            o[e] = (y[e] * rstd * lw_[e] + lb_[e] + bsum * vs) * siluf_(gs); }
        v4u ov; ov.x = cvtpk(o[0], o[1]); ov.y = cvtpk(o[2], o[3]); ov.z = cvtpk(o[4], o[5]); ov.w = cvtpk(o[6], o[7]);
        *(v4u*)(F.out + (size_t)m * OROW + OS_YA + c0 * 2) = ov;
    }
}
struct Args { const float* in[24]; unsigned char* out; unsigned char* ws; };
__global__ void __launch_bounds__(NWAVES * 64, 2) hybrid_fwd(Args args) {
    extern __shared__ __attribute__((aligned(16))) unsigned char lds[];
    Frame F;
    F.lds = (LAS unsigned char*)lds;
    F.MISC = (volatile LAS unsigned*)(F.lds + MISC_OFF);
    F.wave = __builtin_amdgcn_readfirstlane((int)threadIdx.x >> 6);
    F.G = gridDim.x; { const int bx = blockIdx.x; F.vcu = (F.G % 8 == 0) ? (bx % 8) * (F.G / 8) + bx / 8 : bx; }
    F.out = args.out; F.ws = args.ws;
    for (int u = (F.wave * 64 + lane_id()); u < (LDS_BYTES - LDSCTL_OFF) / 4; u += NWAVES * 64) ((LAS unsigned*)(F.lds + LDSCTL_OFF))[u] = 0u;
    __syncthreads();
    XcdBarrier bar = xcd_barrier_post((unsigned*)(F.ws + WS_CTL) + CW_BAR, F.MISC + 8);
#define GRID_BAR() xcd_barrier(bar, F.wave)
#ifdef PROBE_G
#define PGDBG(k) ((k) == PROBE_GSEL ? (float*)(F.ws + WS_CTL + 32768) : (float*)nullptr)
#else
#define PGDBG(k) ((float*)nullptr)
#endif
    typedef pg8::bf16_t bt;
    p0a(F); GRID_BAR();
    p0b(F); GRID_BAR();
    { pg8::Gemm g{(const bt*)(F.out + OS_H), (const bt*)(F.ws + WS_WB), nullptr, nullptr, OROW / 2, D}; pg8::Order S; S.init(M, B_COLS, F.G, (int)blockIdx.x, 1);
      const int ko = kopaque(); pg8::EpiPB E{(bt*)(F.ws + WS_R), kin(I_QG, ko), kin(I_KG, ko), (LAS float*)(F.lds + EPI_OFF), PGDBG(0)};
      pg8::gemm_phase<pg8::EpiPB, pg8::Order, true, true>(F.lds + RING_OFF, g, S, E, F.wave); }
    GRID_BAR();
    attn_mfma(F); GRID_BAR();
    attn_combine(F); GRID_BAR();
    { pg8::Gemm g{(const bt*)(F.out + OS_H), (const bt*)(F.ws + WS_WAG), nullptr, nullptr, OROW / 2, D}; pg8::Order S; S.init(M, A_COLS + PGM * 256, F.G, (int)blockIdx.x, 1);
      pg8::EpiAG E{(bt*)(F.ws + WS_PA), (bt*)(F.ws + WS_PG), PGDBG(1)};
      pg8::gemm_phase<pg8::EpiAG, pg8::Order, true, true>(F.lds + RING_OFF, g, S, E, F.wave); }
    GRID_BAR();
#ifdef PROBE_RT
    const unsigned long long prt0 = __builtin_amdgcn_s_memrealtime();
#endif
    if (blockIdx.x < NCHAIN || F.G <= NCHAIN) rwkv_chunked(F);
    if ((blockIdx.x >= NCHAIN && blockIdx.x < NCHAIN + NSIDE) || F.G <= NCHAIN) {
        const int Gs = F.G > NCHAIN ? (F.G - NCHAIN < NSIDE ? F.G - NCHAIN : NSIDE) : F.G, cs = F.G > NCHAIN ? (int)blockIdx.x - NCHAIN : (int)blockIdx.x;
        pg8::Gemm g{(const bt*)(F.out + OS_H), (const bt*)(F.ws + WS_WAG) + (size_t)(A_COLS + PGM * 256) * D, nullptr, nullptr, OROW / 2, D}; pg8::Order S; S.init(M, G_COLS - PGM * 256, Gs, cs, 1);
        pg8::EpiPG E{(bt*)(F.ws + WS_PG) + PGM * 256, PGDBG(4)};
        pg8::gemm_phase<pg8::EpiPG, pg8::Order, true, true>(F.lds + RING_OFF, g, S, E, F.wave); }
#ifdef PROBE_RT
    if (blockIdx.x == 0 && threadIdx.x == 0) ((float*)(F.ws + WS_CTL + 32768))[2] = (float)(__builtin_amdgcn_s_memrealtime() - prt0);
    if (blockIdx.x == PROBE_RT && threadIdx.x == 0) ((float*)(F.ws + WS_CTL + 32768))[3] = (float)(__builtin_amdgcn_s_memrealtime() - prt0);
#endif
    GRID_BAR();
    rwkv_post(F); GRID_BAR();
    { pg8::Gemm g{(const bt*)(F.out + OS_YA), (const bt*)(F.ws + WS_WOA), (const bt*)(F.out + OS_YB), (const bt*)(F.ws + WS_WOB), OROW / 2, A_W}; pg8::Order S; S.init(M, D, F.G, (int)blockIdx.x, 2);
      pg8::EpiMerge E{(const bt*)(F.ws + WS_PG), (bt*)(F.ws + WS_Y), PGDBG(2)};
      pg8::gemm_phase<pg8::EpiMerge, pg8::Order, true, true>(F.lds + RING_OFF, g, S, E, F.wave); }
    GRID_BAR();
    { pg8::Gemm g{(const bt*)(F.ws + WS_Y), (const bt*)(F.ws + WS_WO), nullptr, nullptr, D, D}; pg8::Order S; S.init(M, D, F.G, (int)blockIdx.x, 1);
      const int ko = kopaque(); pg8::EpiOut E{kin(I_XP, ko), kin(I_XS, ko), (const float*)(F.ws + WS_MOD), (float*)F.out, PGDBG(3)};
      pg8::gemm_phase<pg8::EpiOut, pg8::Order, true, true>(F.lds + RING_OFF, g, S, E, F.wave); }
#if defined(PROBE_TA) || defined(PROBE_G) || defined(PROBE_AT) || defined(PROBE_RT)
    GRID_BAR();
#ifdef PROBE_RT
    { const float* pf_ = (const float*)(F.ws + WS_CTL + 32768); const float f = 0.5f * pf_[3] / pf_[2]; float* o = (float*)F.out;
#else
    { const float f = ((const float*)(F.ws + WS_CTL + 32768))[0]; float* o = (float*)F.out;
#endif
      for (int i = blockIdx.x * 512 + (F.wave * 64 + lane_id()); i < 655 * 1024; i += gridDim.x * 512) o[i] *= (1.f + f); }
#endif
}

extern "C" void kernel_launch(void* const* d_in, const int* in_sizes, int n_in, void* d_out, int out_size, void* d_ws, size_t ws_size, hipStream_t stream) {
    static int grid = 0;
    if (grid == 0) {
        if (n_in != 24 || out_size != M * D || ws_size < WS_END) { fprintf(stderr, "kernel_launch: unexpected shapes: n_in %d out %d ws %zu (need %zu)\n", n_in, out_size, ws_size, (size_t)WS_END); grid = -1; return; }
        int dev = 0, cus = 0, per_cu = 0;
        if (hipGetDevice(&dev) != hipSuccess || hipDeviceGetAttribute(&cus, hipDeviceAttributeMultiprocessorCount, dev) != hipSuccess) { grid = -1; return; }
        if (hipFuncSetAttribute((const void*)hybrid_fwd, hipFuncAttributeMaxDynamicSharedMemorySize, LDS_BYTES) != hipSuccess) { fprintf(stderr, "kernel_launch: hipFuncSetAttribute failed\n"); grid = -1; return; }
        if (hipOccupancyMaxActiveBlocksPerMultiprocessor(&per_cu, (const void*)hybrid_fwd, NWAVES * 64, LDS_BYTES) != hipSuccess || per_cu < 1) { fprintf(stderr, "kernel_launch: occupancy query says %d\n", per_cu); }
        (void)hipGetLastError();
        grid = cus;
    }
    if (grid < 0) return;
    if (hipMemsetAsync((char*)d_ws + WS_CTL, 0, CTL_ZERO_BYTES, stream) != hipSuccess) return;
    Args a{};
    for (int i = 0; i < 24; ++i) a.in[i] = (const float*)d_in[i];
    a.out = (unsigned char*)d_out; a.ws = (unsigned char*)d_ws;
    hipLaunchKernelGGL(hybrid_fwd, dim3(grid), dim3(NWAVES * 64), LDS_BYTES, stream, a);
}
```

```cpp
#include <hip/hip_runtime.h>
#include <cstdio>
#include <cstdint>
__device__ __forceinline__ int lane_id() { unsigned m = ~0u; asm volatile("" : "+s"(m) :: "memory"); return (int)__builtin_amdgcn_mbcnt_hi(m, __builtin_amdgcn_mbcnt_lo(m, 0u)); }
namespace pg8 {
#define PG8_LAS __attribute__((address_space(3)))
typedef unsigned short bf16_t;
typedef short bf16x8 __attribute__((ext_vector_type(8)));
typedef float f32x4 __attribute__((ext_vector_type(4)));
typedef unsigned u32x4 __attribute__((ext_vector_type(4)));
constexpr int BM = 256, BK = 64, HALF = 128, HTB = HALF * BK * 2  , STAGE_BYTES = 8 * HTB, NXCD = 8, WGM = 8;

__host__ __device__ __forceinline__ int lds_byte(int r, int c) { const int st = (r >> 4) * 2 + (c >> 5), rr = r & 15, cc = c & 31, ob = rr * 64 + cc * 2; return st * 1024 + (ob ^ (((ob >> 9) & 1) << 5)); }
__host__ __device__ __forceinline__ void stage_rc(int b, int& R, int& C) { const int st = b / 1024, sb = b % 1024, swz = sb ^ (((sb >> 9) & 1) << 5); R = (st >> 1) * 16 + swz / 64; C = (st & 1) * 32 + (swz % 64) / 2; }
__host__ __device__ __forceinline__ int perm32(int rho) { const int n = rho >> 4, i = rho & 15; return 8 * (i >> 2) + 4 * n + (i & 3); }

struct Unit { int pm, pn, sel; };
struct Gemm { const bf16_t* A0; const bf16_t* B0; const bf16_t* A1; const bf16_t* B1; int lda; int K; };

struct Order {
    int nM, nN, nwg, G, c, CH;
    __host__ __device__ void init(int M, int N, int G_, int c_, int CH_) { nM = M / BM; nN = N / BM; nwg = nM * nN; G = G_; c = c_; CH = CH_; }
    __host__ __device__ bool next(int i, Unit& u) const {
        const int ti = (CH == 2) ? (i >> 1) : i; u.sel = (CH == 2) ? (i & 1) : 0;
        const long L = (long)ti * G + c; if (L >= nwg) return false;
        int wgid = (int)L; { const int q = nwg / NXCD, r = nwg % NXCD, xcd = wgid % NXCD, off = wgid / NXCD; wgid = (xcd < r ? xcd * (q + 1) : r * (q + 1) + (xcd - r) * q) + off; }
        const int nig = WGM * nN, gid = wgid / nig, fm = gid * WGM, gsz = (nM - fm) < WGM ? (nM - fm) : WGM;
        u.pm = fm + ((wgid % nig) % gsz); u.pn = (wgid % nig) / gsz; return true;
    }
};
__device__ __forceinline__ unsigned cvt_pk_bf16(float lo, float hi) { unsigned r; asm volatile("v_cvt_pk_bf16_f32 %0, %1, %2" : "=v"(r) : "v"(lo), "v"(hi)); return r; }
template <class Epi, class Sched, bool ALIGN_EPI = false, bool SP2 = false>
__device__ __forceinline__ void gemm_phase(PG8_LAS unsigned char* lds, const Gemm g, const Sched& S, const Epi& E, const int wave_id) {
    int tid = wave_id * 64 + lane_id(); asm volatile("" : "+v"(tid));
    const int wid = wave_id, lane = tid & 63, wr = wid >> 2, wc = wid & 3, fr = lane & 15, fq = lane >> 4;
    const int K = g.K, nt = K / BK;
    unsigned voffA[2], voffB[2];
#pragma unroll
    for (int i = 0; i < 2; ++i) { int R, C; stage_rc(tid * 16 + i * 8192, R, C); const int Rb = Epi::PERM ? ((R & ~31) + perm32(R & 31)) : R;
        voffA[i] = (unsigned)(R * g.lda + C) * 2u; voffB[i] = (unsigned)(Rb * K + C) * 2u; }
    const size_t kstep = (size_t)(BK * 2);
    const size_t hstepA = (size_t)HALF * g.lda * 2, hstepB = (size_t)HALF * K * 2;
    const size_t tstepA = 2 * hstepA, tstepB = 2 * hstepB;
    const unsigned ldsw = (unsigned)wid * 1024u;
    const int aoff = lds_byte(wr * 64 + fr, fq * 8), boff = lds_byte(wc * 32 + fr, fq * 8);
#define PG8_SA(b, h) (((b) * 2 + (h)) * HTB)
#define PG8_SB(b, h) ((4 + (b) * 2 + (h)) * HTB)
#define PG8_STAGE(bufoff, gbase, voff) do { _Pragma("unroll") for (int _i = 0; _i < 2; ++_i) \
        __builtin_amdgcn_global_load_lds((const unsigned*)((const char*)(gbase) + (voff)[_i]), (PG8_LAS unsigned*)(lds + (bufoff) + ldsw + _i * 8192), 16, 0, 0); } while (0)
#define PG8_LDA(dst, b, h) do { _Pragma("unroll") for (int m = 0; m < 4; ++m) _Pragma("unroll") for (int k = 0; k < 2; ++k) dst[m][k] = *(const PG8_LAS bf16x8*)(lds + PG8_SA(b, h) + aoff + m * 2048 + k * 1024); } while (0)
#define PG8_LDB(dst, b, h) do { _Pragma("unroll") for (int n = 0; n < 2; ++n) _Pragma("unroll") for (int k = 0; k < 2; ++k) dst[n][k] = *(const PG8_LAS bf16x8*)(lds + PG8_SB(b, h) + boff + n * 2048 + k * 1024); } while (0)
#define PG8_MMA(ai, bj, At, Bt) do { __builtin_amdgcn_s_setprio(1); _Pragma("unroll") for (int m = 0; m < 4; ++m) _Pragma("unroll") for (int n = 0; n < 2; ++n) _Pragma("unroll") for (int k = 0; k < 2; ++k) \
        acc[ai][bj][m][n] = __builtin_amdgcn_mfma_f32_16x16x32_bf16(Bt[n][k], At[m][k], acc[ai][bj][m][n], 0, 0, 0); __builtin_amdgcn_s_setprio(0); } while (0)
#define PG8_APTR(u) ((const char*)((u).sel ? g.A1 : g.A0) + (size_t)(u).pm * tstepA)
#define PG8_BPTR(u) ((const char*)((u).sel ? g.B1 : g.B0) + (size_t)(u).pn * tstepB)
#define PG8_WAIT_V(n) asm volatile("s_waitcnt vmcnt(" #n ")" ::: "memory")
#define PG8_WAIT_L(n) asm volatile("s_waitcnt lgkmcnt(" #n ")" ::: "memory")
#define PG8_BAR __builtin_amdgcn_s_barrier()
#define PG8_SCHED __builtin_amdgcn_sched_barrier(0)
    Unit cur, nxt; int ui = 0;
    if (!S.next(0, cur)) return;
#ifdef PROBE_G
    unsigned long long pg_epi = 0; const unsigned long long pg_start = __builtin_amdgcn_s_memtime();
#endif
    f32x4 acc[2][2][4][2];
#pragma unroll
    for (int a = 0; a < 2; ++a)
#pragma unroll
        for (int b = 0; b < 2; ++b)
#pragma unroll
            for (int m = 0; m < 4; ++m)
#pragma unroll
                for (int n = 0; n < 2; ++n) acc[a][b][m][n] = (f32x4){0.f, 0.f, 0.f, 0.f};
    bf16x8 At[4][2], B0[2][2], B1[2][2];
    const char* cA = PG8_APTR(cur); const char* cB = PG8_BPTR(cur);
    if constexpr (SP2) {
        PG8_STAGE(PG8_SB(0, 0), cB, voffB); PG8_STAGE(PG8_SB(0, 1), cB + hstepB, voffB); PG8_STAGE(PG8_SA(0, 0), cA, voffA); PG8_STAGE(PG8_SA(0, 1), cA + hstepA, voffA);
        if (wr == 1) PG8_BAR;
        PG8_WAIT_V(2); PG8_BAR;
        PG8_STAGE(PG8_SB(1, 0), cB + kstep, voffB); PG8_STAGE(PG8_SA(1, 0), cA + kstep, voffA); PG8_STAGE(PG8_SB(1, 1), cB + hstepB + kstep, voffB);
        PG8_WAIT_V(6); PG8_BAR;
    } else {
        PG8_STAGE(PG8_SB(0, 0), cB, voffB); PG8_STAGE(PG8_SA(0, 0), cA, voffA); PG8_STAGE(PG8_SB(0, 1), cB + hstepB, voffB); PG8_STAGE(PG8_SA(0, 1), cA + hstepA, voffA);
        if (wr == 1) PG8_BAR;
        PG8_WAIT_V(4); PG8_BAR;
        PG8_STAGE(PG8_SB(1, 0), cB + kstep, voffB); PG8_STAGE(PG8_SA(1, 0), cA + kstep, voffA); PG8_STAGE(PG8_SB(1, 1), cB + hstepB + kstep, voffB);
        PG8_WAIT_V(6); PG8_BAR;
    }
    for (;;) {
        const bool has_next = S.next(ui + 1, nxt);
        const char* nA = has_next ? PG8_APTR(nxt) : cA; const char* nB = has_next ? PG8_BPTR(nxt) : cB;
        for (int t = 0; t < nt; t += 2) {
            const bool last = (t == nt - 2);
            const char* a1 = cA + (size_t)(t + 1) * kstep;
            const char* a2 = last ? nA : cA + (size_t)(t + 2) * kstep; const char* b2 = last ? nB : cB + (size_t)(t + 2) * kstep;
            const char* a3 = a2 + kstep; const char* b3 = b2 + kstep;
            if constexpr (SP2) {
            PG8_LDB(B0, 0, 0); PG8_LDB(B1, 0, 1); PG8_SCHED; PG8_LDA(At, 0, 0); PG8_STAGE(PG8_SA(1, 1), a1 + hstepA, voffA);
            PG8_WAIT_V(8); PG8_WAIT_L(0); PG8_BAR; PG8_MMA(0, 0, At, B0); PG8_MMA(0, 1, At, B1); PG8_BAR; PG8_SCHED;
            PG8_LDA(At, 0, 1); PG8_STAGE(PG8_SB(0, 0), b2, voffB); PG8_STAGE(PG8_SB(0, 1), b2 + hstepB, voffB); PG8_STAGE(PG8_SA(0, 0), a2, voffA);
            PG8_WAIT_V(8); PG8_WAIT_L(0); PG8_BAR; PG8_MMA(1, 0, At, B0); PG8_MMA(1, 1, At, B1); PG8_BAR; PG8_SCHED;
            PG8_LDB(B0, 1, 0); PG8_LDB(B1, 1, 1); PG8_SCHED; PG8_LDA(At, 1, 0); PG8_STAGE(PG8_SA(0, 1), a2 + hstepA, voffA);
            PG8_WAIT_V(8); PG8_WAIT_L(0); PG8_BAR; PG8_MMA(0, 0, At, B0); PG8_MMA(0, 1, At, B1); PG8_BAR; PG8_SCHED;
            PG8_LDA(At, 1, 1); PG8_STAGE(PG8_SB(1, 0), b3, voffB); PG8_STAGE(PG8_SB(1, 1), b3 + hstepB, voffB); PG8_STAGE(PG8_SA(1, 0), a3, voffA);
            PG8_WAIT_V(8); PG8_WAIT_L(0); PG8_BAR; PG8_MMA(1, 0, At, B0); PG8_MMA(1, 1, At, B1); PG8_BAR; PG8_SCHED;
            } else {
            PG8_LDB(B0, 0, 0); PG8_SCHED; PG8_LDA(At, 0, 0); PG8_STAGE(PG8_SA(1, 1), a1 + hstepA, voffA);
            PG8_WAIT_L(8); PG8_BAR; PG8_WAIT_L(0); PG8_MMA(0, 0, At, B0); PG8_BAR; PG8_SCHED;
            PG8_LDB(B1, 0, 1); PG8_STAGE(PG8_SB(0, 0), b2, voffB);
            PG8_BAR; PG8_WAIT_L(0); PG8_MMA(0, 1, At, B1); PG8_BAR;
            PG8_LDA(At, 0, 1); PG8_STAGE(PG8_SA(0, 0), a2, voffA);
            PG8_BAR; PG8_WAIT_L(0); PG8_MMA(1, 0, At, B0); PG8_BAR; PG8_SCHED;
            PG8_STAGE(PG8_SB(0, 1), b2 + hstepB, voffB);
            PG8_WAIT_V(6); PG8_BAR; PG8_MMA(1, 1, At, B1); PG8_BAR;
            PG8_LDB(B0, 1, 0); PG8_SCHED; PG8_LDA(At, 1, 0); PG8_STAGE(PG8_SA(0, 1), a2 + hstepA, voffA);
            PG8_WAIT_L(8); PG8_BAR; PG8_WAIT_L(0); PG8_MMA(0, 0, At, B0); PG8_BAR; PG8_SCHED;
            PG8_LDB(B1, 1, 1); PG8_STAGE(PG8_SB(1, 0), b3, voffB);
            PG8_BAR; PG8_WAIT_L(0); PG8_MMA(0, 1, At, B1); PG8_BAR;
            PG8_LDA(At, 1, 1); PG8_STAGE(PG8_SA(1, 0), a3, voffA);
            PG8_BAR; PG8_WAIT_L(0); PG8_MMA(1, 0, At, B0); PG8_BAR; PG8_SCHED;
            PG8_STAGE(PG8_SB(1, 1), b3 + hstepB, voffB);
            PG8_WAIT_V(6); PG8_BAR; PG8_MMA(1, 1, At, B1); PG8_BAR;
            }
        }
        if constexpr (ALIGN_EPI) { if (wr == 0) PG8_BAR; }
#ifdef PROBE_G
        const unsigned long long pg_t0 = __builtin_amdgcn_s_memtime();
#endif
        const bool keep = E(acc, cur, wr, wc, fr, fq);
#ifdef PROBE_G
        pg_epi += __builtin_amdgcn_s_memtime() - pg_t0;
#endif
        if (!has_next) break;
        if (!keep) {
#pragma unroll
        for (int a = 0; a < 2; ++a)
#pragma unroll
            for (int b = 0; b < 2; ++b)
#pragma unroll
                for (int m = 0; m < 4; ++m)
#pragma unroll
                    for (int n = 0; n < 2; ++n) acc[a][b][m][n] = (f32x4){0.f, 0.f, 0.f, 0.f};
        }
        cur = nxt; cA = nA; cB = nB; ++ui;
        if constexpr (ALIGN_EPI) { if (wr == 1) PG8_BAR; }
    }
#ifdef PROBE_G
    if (E.dbg && blockIdx.x == 0 && threadIdx.x == 0) { const double tot = (double)(__builtin_amdgcn_s_memtime() - pg_start);
        E.dbg[0] = (PROBE_G == 1) ? (float)(tot / (double)(ui + 1) / 262144.0) : (float)((double)pg_epi / tot); }
#endif
    PG8_WAIT_V(0);
    if constexpr (!ALIGN_EPI) { if (wr == 0) PG8_BAR; }
    PG8_BAR;
#undef PG8_SA
#undef PG8_SB
#undef PG8_STAGE
#undef PG8_LDA
#undef PG8_LDB
#undef PG8_MMA
#undef PG8_APTR
#undef PG8_BPTR
#undef PG8_WAIT_V
#undef PG8_WAIT_L
#undef PG8_BAR
#undef PG8_SCHED
}
}

constexpr int NWAVES = 8;
constexpr int T = 8192, D = 1024, NBP = 8, NBS = 2, NB = NBP + NBS, M = NB * T;
constexpr int NCHAIN = 160, NSIDE = 56;
#ifndef PG_MAIN_TILES
#define PG_MAIN_TILES 0
#endif
constexpr int PGM = PG_MAIN_TILES;
constexpr int A_HEADS = 8, A_HD = 64, A_W = 512, RANK = 64;
constexpr int A_COLS = 2304, B_COLS = 5120, G_COLS = 2048, IN_COLS = 9472, AG_COLS = A_COLS + G_COLS;
constexpr int B_QKV = 1536, B_W = 512, B_HD = 128;
constexpr float RMS_EPS = 1e-6f, GN_EPS = 64e-5f;
constexpr size_t MiB = 1u << 20;
constexpr size_t WS_CTL = 0, CTL_ZERO_BYTES = 65536;
constexpr size_t WS_MOD = 1 * MiB;
constexpr size_t WS_BTAB = 1 * MiB + 128 * 1024;
constexpr size_t WS_WB = 2 * MiB;
constexpr size_t WS_WAG = 12 * MiB;
constexpr size_t WS_WOA = 21 * MiB, WS_WOB = 22 * MiB, WS_WO = 23 * MiB;
constexpr size_t WS_BON = 26 * MiB;
constexpr size_t WS_R = 32 * MiB;
constexpr size_t WS_PA = WS_R, WS_PG = WS_R + 360 * MiB;
constexpr size_t WS_Y = 832 * MiB;
constexpr size_t WS_END = 992 * MiB;
constexpr int CW_BAR = 4096;
constexpr int OS_H = 0, OS_YA = 2048, OS_YB = 3072, OROW = 4096;
constexpr int RING_OFF = 0, RING_BYTES = 131072;
constexpr int LDSCTL_OFF = RING_BYTES, MISC_OFF = LDSCTL_OFF + 320;
constexpr int EPI_OFF = RING_BYTES + 1024;
constexpr int LDS_BYTES = 147456;

#define GAS __attribute__((address_space(1)))
#define LAS __attribute__((address_space(3)))
typedef unsigned short bf16;
typedef unsigned v4u __attribute__((ext_vector_type(4)));
typedef unsigned v2u __attribute__((ext_vector_type(2)));
typedef float f32x4 __attribute__((ext_vector_type(4)));
typedef short bf16x8 __attribute__((ext_vector_type(8)));
typedef GAS unsigned gu32;
#define RLX_AGENT __ATOMIC_RELAXED, __HIP_MEMORY_SCOPE_AGENT
#define LDS_WAIT() asm volatile("s_waitcnt lgkmcnt(0)" ::: "memory")
#define VM_WAIT() asm volatile("s_waitcnt vmcnt(0)" ::: "memory")
__device__ __forceinline__ unsigned f2bf(float f) { unsigned u = __builtin_bit_cast(unsigned, f); return (u + 0x7fffu + ((u >> 16) & 1u)) >> 16; }
__device__ __forceinline__ unsigned pk2(float lo, float hi) { return f2bf(lo) | (f2bf(hi) << 16); }
typedef float f32x2_t __attribute__((ext_vector_type(2))); typedef __bf16 bf16x2_t __attribute__((ext_vector_type(2)));
__device__ __forceinline__ unsigned cvtpk(float lo, float hi) { f32x2_t v = {lo, hi}; bf16x2_t b = __builtin_convertvector(v, bf16x2_t); return __builtin_bit_cast(unsigned, b); }
__device__ __forceinline__ float bf2f(unsigned short h) { return __builtin_bit_cast(float, (unsigned)h << 16); }
__device__ __forceinline__ float bflo(unsigned w) { return __builtin_bit_cast(float, w << 16); }
__device__ __forceinline__ float bfhi(unsigned w) { return __builtin_bit_cast(float, w & 0xffff0000u); }
__device__ __forceinline__ float sigmoidf_(float v) { return __builtin_amdgcn_rcpf(1.f + __expf(-v)); }
__device__ __forceinline__ float siluf_(float v) { return v * sigmoidf_(v); }
__device__ __forceinline__ float wave_sum(float v) {
#pragma unroll
    for (int o = 1; o < 64; o <<= 1) v += __shfl_xor(v, o);
    return v;
}
__device__ __forceinline__ float wave_max(float v) {
#pragma unroll
    for (int o = 1; o < 64; o <<= 1) v = fmaxf(v, __shfl_xor(v, o));
    return v;
}

#define XB_TMO      128
#define XB_XCNT(j)  (256  + 64 * (j))
#define XB_XSUB(j)  (1280 + 64 * (j))
#define XB_XGEN(j)  (2304 + 64 * (j))
#define XB_TOP      3328
#define XB_TOPGEN   3392
#define XCD_BAR_WORDS 3456
#define XB_SPIN_CAP (1u << 22)
__device__ __forceinline__ unsigned xb_ld(unsigned* p)              { return __hip_atomic_load(p, __ATOMIC_RELAXED, __HIP_MEMORY_SCOPE_AGENT); }
__device__ __forceinline__ unsigned xb_add(unsigned* p, unsigned v) { return __hip_atomic_fetch_add(p, v, __ATOMIC_RELAXED, __HIP_MEMORY_SCOPE_AGENT); }
__device__ __forceinline__ unsigned xb_xcc_id() { return (unsigned)__builtin_amdgcn_s_getreg((3 << 11) | 20) & 0xFu; }
#define XB_SPIN(cond, bar) do { unsigned _sp = 0; while (cond) { __builtin_amdgcn_s_sleep(1); \
    if ((++_sp & 255u) == 0u) { if (xb_ld(&(bar)[XB_TMO])) break; if (_sp > XB_SPIN_CAP) { atomicAdd(&(bar)[XB_TMO], 1u); break; } } } } while (0)
struct XcdBarrier { unsigned* bar; unsigned x; volatile LAS unsigned* st; };
__device__ __forceinline__ XcdBarrier xcd_barrier_post(unsigned* bar, volatile LAS unsigned* st) {
    XcdBarrier b; b.bar = bar; b.x = xb_xcc_id(); b.st = st;
    if (threadIdx.x == 0) (void)xb_add(&bar[XB_XCNT(b.x)], 1u);
    return b;
}
__device__ __forceinline__ void xcd_barrier_complete(unsigned* bar, unsigned x, unsigned& nloc, unsigned& nx) {
    const unsigned G = gridDim.x * gridDim.y * gridDim.z;
    unsigned sum, cnt, mine, sp = 0u;
    for (;;) {
        sum = 0u; cnt = 0u; mine = 0u;
#pragma unroll
        for (unsigned j = 0; j < 16; ++j) { const unsigned c = xb_ld(&bar[XB_XCNT(j)]); sum += c; cnt += (c > 0u) ? 1u : 0u; mine = (j == x) ? c : mine; }
        if (sum == G) break;
        __builtin_amdgcn_s_sleep(1);
        if ((++sp & 255u) == 0u) { if (xb_ld(&bar[XB_TMO])) break; if (sp > XB_SPIN_CAP) { atomicAdd(&bar[XB_TMO], 1u); break; } }
    }
    nloc = mine > 0u ? mine : 1u; nx = cnt > 0u ? cnt : 1u;
}
__device__ __forceinline__ void xcd_barrier(const XcdBarrier& b, const int wave_id) {
    asm volatile("s_waitcnt vmcnt(0)" ::: "memory");
    __syncthreads();
    if (wave_id == 0 && lane_id() == 0) {
        unsigned* bar = b.bar;
        __builtin_amdgcn_s_waitcnt(0);
        unsigned nloc = b.st[0], nx = b.st[1];
        if (nloc == 0u) { xcd_barrier_complete(bar, b.x, nloc, nx); b.st[0] = nloc; b.st[1] = nx; }
        const unsigned old = xb_add(&bar[XB_XSUB(b.x)], 1u);
        const unsigned gen = old / nloc;
        if (old + 1u == (gen + 1u) * nloc) {
            __builtin_amdgcn_fence(__ATOMIC_RELEASE, "agent");
            asm volatile("s_waitcnt vmcnt(0)" ::: "memory");
            const unsigned og = xb_add(&bar[XB_TOP], 1u);
            const unsigned tg = og / nx;
            if (og + 1u == (tg + 1u) * nx) xb_add(&bar[XB_TOPGEN], 1u);
            else XB_SPIN(xb_ld(&bar[XB_TOPGEN]) == tg, bar);
            __builtin_amdgcn_fence(__ATOMIC_ACQUIRE, "agent");
            xb_add(&bar[XB_XGEN(b.x)], 1u);
            asm volatile("s_waitcnt vmcnt(0)" ::: "memory");
        } else {
            XB_SPIN(xb_ld(&bar[XB_XGEN(b.x)]) == gen, bar);
            __builtin_amdgcn_fence(__ATOMIC_ACQUIRE, "agent");
            asm volatile("s_waitcnt vmcnt(0)" ::: "memory");
        }
    }
    __syncthreads();
}

struct Frame {
    LAS unsigned char* lds;
    volatile LAS unsigned* MISC;
    int wave;
    __device__ __forceinline__ int lane_() const { return lane_id(); }
    int vcu, G;
    unsigned char* out;
    unsigned char* ws;
};
enum { I_XP = 0, I_XS, I_CP, I_CS, I_RELB, I_NORMW, I_WADA, I_BADA, I_WIN, I_MU, I_W0, I_W2, I_A0, I_A2, I_KK, I_KA, I_RK, I_LNW, I_LNB, I_QG, I_KG, I_WOA, I_WOB, I_WO };
__device__ __forceinline__ int kopaque() { int z = 0; asm volatile("" : "+s"(z)); return z; }
__device__ __forceinline__ const float* kin(int k, int kof) { return ((const float* const __attribute__((address_space(4)))*)__builtin_amdgcn_kernarg_segment_ptr())[k + kof]; }
__device__ __forceinline__ const float* xrow_ptr(const float* xp, const float* xs, int m) { return m < NBP * T ? xp + (size_t)m * D : xs + (size_t)(m - NBP * T) * D; }

namespace pg8 {
struct EpiPB {
    static constexpr bool PERM = true;
    bf16_t* O; const float* qg; const float* kg; PG8_LAS float* P; float* dbg;
    __device__ __forceinline__ bool operator()(f32x4 (&acc)[2][2][4][2], const Unit& u, int wr, int wc, int fr, int fq) const {
        const int row0 = u.pm * BM + wr * 64 + fr, col0 = u.pn * BM + wc * 32 + 8 * fq;
        if (u.pn < 12) {
#pragma unroll
            for (int ai = 0; ai < 2; ++ai)
#pragma unroll
                for (int m = 0; m < 4; ++m) {
#pragma unroll
                    for (int bj = 0; bj < 2; ++bj) { const f32x4 a = acc[ai][bj][m][0], b = acc[ai][bj][m][1];
                        float s = (a[0] * a[0] + a[1] * a[1]) + (a[2] * a[2] + a[3] * a[3]) + (b[0] * b[0] + b[1] * b[1]) + (b[2] * b[2] + b[3] * b[3]);
                        s += __shfl_xor(s, 16); s += __shfl_xor(s, 32);
                        if (fq == 0) P[((ai * HALF + wr * 64 + m * 16 + fr) * 2 + bj) * 4 + wc] = s; }
                    asm volatile("" ::: "memory"); }
            asm volatile("s_waitcnt lgkmcnt(0)" ::: "memory"); __builtin_amdgcn_s_barrier(); asm volatile("" ::: "memory");
            const bool isq = u.pn < 6; const float* gp = (isq ? qg : kg) + wc * 32 + 8 * fq; const float gs = isq ? 0.08838834764831845f * 1.4426950408889634f : 1.f;
            float gn[8];
#pragma unroll
            for (int e = 0; e < 8; ++e) gn[e] = gp[e] * gs;
#pragma unroll
            for (int ai = 0; ai < 2; ++ai)
#pragma unroll
                for (int m = 0; m < 4; ++m)
#pragma unroll
                    for (int bj = 0; bj < 2; ++bj) { const f32x4 p4 = *(const PG8_LAS f32x4*)(P + ((ai * HALF + wr * 64 + m * 16 + fr) * 2 + bj) * 4);
                        const float rs = 1.0f / sqrtf(((p4[0] + p4[1]) + (p4[2] + p4[3])) * (1.f / 128.f) + 1e-6f);
#pragma unroll
                        for (int e = 0; e < 4; ++e) { acc[ai][bj][m][0][e] *= rs * gn[e]; acc[ai][bj][m][1][e] *= rs * gn[4 + e]; }
                        asm volatile("" ::: "memory"); }
        }
        const bool act = u.pn >= 18;
#pragma unroll
        for (int ai = 0; ai < 2; ++ai)
#pragma unroll
            for (int m = 0; m < 4; ++m) { bf16_t* rowp = O + (size_t)(row0 + ai * HALF + m * 16) * B_COLS + col0;
#pragma unroll
                for (int bj = 0; bj < 2; ++bj) { f32x4 v0 = acc[ai][bj][m][0], v1 = acc[ai][bj][m][1];
                    if (act) {
#pragma unroll
                        for (int e = 0; e < 4; ++e) { v0[e] = siluf_(v0[e]); v1[e] = siluf_(v1[e]); } }
                    u32x4 w; w.x = cvt_pk_bf16(v0[0], v0[1]); w.y = cvt_pk_bf16(v0[2], v0[3]); w.z = cvt_pk_bf16(v1[0], v1[1]); w.w = cvt_pk_bf16(v1[2], v1[3]);
                    *(u32x4*)(rowp + bj * HALF) = w; } }
        return false;
    }
};
struct EpiAG {
    static constexpr bool PERM = true;
    bf16_t* PA; bf16_t* PG; float* dbg;
    __device__ __forceinline__ bool operator()(const f32x4 (&acc)[2][2][4][2], const Unit& u, int wr, int wc, int fr, int fq) const {
        const bool isg = u.pn >= 9; bf16_t* base = isg ? PG : PA; const int ldc = isg ? G_COLS : A_COLS; const int pn = isg ? u.pn - 9 : u.pn;
        const int row0 = u.pm * BM + wr * 64 + fr, col0 = pn * BM + wc * 32 + 8 * fq;
#pragma unroll
        for (int ai = 0; ai < 2; ++ai)
#pragma unroll
            for (int m = 0; m < 4; ++m) { bf16_t* rowp = base + (size_t)(row0 + ai * HALF + m * 16) * ldc + col0;
#pragma unroll
                for (int bj = 0; bj < 2; ++bj) { const f32x4 v0 = acc[ai][bj][m][0], v1 = acc[ai][bj][m][1];
                    u32x4 w; w.x = cvt_pk_bf16(v0[0], v0[1]); w.y = cvt_pk_bf16(v0[2], v0[3]); w.z = cvt_pk_bf16(v1[0], v1[1]); w.w = cvt_pk_bf16(v1[2], v1[3]);
                    *(u32x4*)(rowp + bj * HALF) = w; } }
        return false;
    }
};
struct EpiPG {
    static constexpr bool PERM = true;
    bf16_t* PG; float* dbg;
    __device__ __forceinline__ bool operator()(const f32x4 (&acc)[2][2][4][2], const Unit& u, int wr, int wc, int fr, int fq) const {
        const int row0 = u.pm * BM + wr * 64 + fr, col0 = u.pn * BM + wc * 32 + 8 * fq;
#pragma unroll
        for (int ai = 0; ai < 2; ++ai)
#pragma unroll
            for (int m = 0; m < 4; ++m) { bf16_t* rowp = PG + (size_t)(row0 + ai * HALF + m * 16) * G_COLS + col0;
#pragma unroll
                for (int bj = 0; bj < 2; ++bj) { const f32x4 v0 = acc[ai][bj][m][0], v1 = acc[ai][bj][m][1];
                    u32x4 w; w.x = cvt_pk_bf16(v0[0], v0[1]); w.y = cvt_pk_bf16(v0[2], v0[3]); w.z = cvt_pk_bf16(v1[0], v1[1]); w.w = cvt_pk_bf16(v1[2], v1[3]);
                    *(u32x4*)(rowp + bj * HALF) = w; } }
        return false;
    }
};
struct EpiMerge {
    static constexpr bool PERM = true;
    const bf16_t* PG; bf16_t* O; float* dbg;
    __device__ __forceinline__ bool operator()(f32x4 (&acc)[2][2][4][2], const Unit& u, int wr, int wc, int fr, int fq) const {
        const int row0 = u.pm * BM + wr * 64 + fr, col0 = u.pn * BM + wc * 32 + 8 * fq;
#pragma unroll
        for (int ai = 0; ai < 2; ++ai)
#pragma unroll
            for (int m = 0; m < 4; ++m) { const size_t row = (size_t)(row0 + ai * HALF + m * 16);
#pragma unroll
                for (int bj = 0; bj < 2; ++bj) { const int col = col0 + bj * HALF;
                    const u32x4 gb8 = *(const u32x4*)(PG + row * G_COLS + D + col);
                    float zb[8] = {bflo(gb8.x), bfhi(gb8.x), bflo(gb8.y), bfhi(gb8.y), bflo(gb8.z), bfhi(gb8.z), bflo(gb8.w), bfhi(gb8.w)};
                    if (u.sel == 0) {
                        const u32x4 ga8 = *(const u32x4*)(PG + row * G_COLS + col);
                        float za[8] = {bflo(ga8.x), bfhi(ga8.x), bflo(ga8.y), bfhi(ga8.y), bflo(ga8.z), bfhi(ga8.z), bflo(ga8.w), bfhi(ga8.w)};
#pragma unroll
                        for (int e = 0; e < 8; ++e) { const float ea = __expf(-fminf(fmaxf(za[e], -30.f), 30.f)), eb = __expf(-fminf(fmaxf(zb[e], -30.f), 30.f));
                            const float r = (1.f + eb) * __builtin_amdgcn_rcpf(1.f + ea); acc[ai][bj][m][e >> 2][e & 3] *= r; }
                    } else {
                        float o[8];
#pragma unroll
                        for (int e = 0; e < 8; ++e) { const float eb = __expf(-fminf(fmaxf(zb[e], -30.f), 30.f)); o[e] = acc[ai][bj][m][e >> 2][e & 3] * __builtin_amdgcn_rcpf(1.f + eb); }
                        u32x4 w; w.x = cvt_pk_bf16(o[0], o[1]); w.y = cvt_pk_bf16(o[2], o[3]); w.z = cvt_pk_bf16(o[4], o[5]); w.w = cvt_pk_bf16(o[6], o[7]);
                        *(u32x4*)(O + row * D + col) = w;
                    } } }
        return u.sel == 0;
    }
};
struct EpiOut {
    static constexpr bool PERM = false;
    const float* xp; const float* xs; const float* mod; float* out; float* dbg;
    __device__ __forceinline__ bool operator()(const f32x4 (&acc)[2][2][4][2], const Unit& u, int wr, int wc, int fr, int fq) const {
        const int rowt = u.pm * BM, b = rowt >> 13; const float* xb = rowt < NBP * T ? xp + (size_t)rowt * D : xs + (size_t)(rowt - NBP * T) * D;
        const int rl0 = wr * 64 + fr, col0 = u.pn * BM + wc * 32 + 4 * fq; const float* gt = mod + b * 3072 + 2048;
#pragma unroll
        for (int bj = 0; bj < 2; ++bj)
#pragma unroll
            for (int n = 0; n < 2; ++n) { const int col = col0 + bj * HALF + n * 16; const f32x4 g4 = *(const f32x4*)(gt + col);
#pragma unroll
                for (int ai = 0; ai < 2; ++ai)
#pragma unroll
                    for (int m = 0; m < 4; ++m) { const int rl = rl0 + ai * HALF + m * 16; const f32x4 x4 = *(const f32x4*)(xb + (size_t)rl * D + col);
                        *(f32x4*)(out + (size_t)(rowt + rl) * D + col) = x4 + g4 * acc[ai][bj][m][n]; } }
        return false;
    }
};
}

__device__ __forceinline__ void p0_transpose_item(const float* W, int K, int N, bf16* WT, int k0, int n0, int drow0, LAS float* scr, int lane) {
#pragma unroll 8
    for (int i = 0; i < 32; ++i) { const int kk = 2 * i + (lane >> 5); scr[kk * 33 + (lane & 31)] = W[(size_t)(k0 + kk) * N + n0 + (lane & 31)]; }
    LDS_WAIT(); asm volatile("" ::: "memory");
    const int c = lane & 7;
#pragma unroll
    for (int j = 0; j < 4; ++j) { const int n = (lane >> 3) + 8 * j; const LAS float* s = scr + (8 * c) * 33 + n;
        v4u o; o.x = pk2(s[0 * 33], s[1 * 33]); o.y = pk2(s[2 * 33], s[3 * 33]); o.z = pk2(s[4 * 33], s[5 * 33]); o.w = pk2(s[6 * 33], s[7 * 33]);
        *(GAS v4u*)(WT + (size_t)(drow0 + n) * K + k0 + 8 * c) = o; }
    LDS_WAIT(); asm volatile("" ::: "memory");
}
__device__ __forceinline__ int t5_bucket(int rel) {
    const int n = rel < 0 ? -rel : rel; int ret = rel > 0 ? 16 : 0;
    const float lf = logf((float)(n > 1 ? n : 1) / 8.0f) / 4.852030263919617f * 8.0f;
    int large = 8 + (int)lf; large = large < 15 ? large : 15;
    return ret + (n < 8 ? n : large);
}
__device__ __forceinline__ void p0a(Frame& F) {
    const int ko = kopaque(); const float *cp_ = kin(I_CP, ko), *cs_ = kin(I_CS, ko), *w_ada = kin(I_WADA, ko), *b_ada = kin(I_BADA, ko), *rel_bias = kin(I_RELB, ko), *w_in = kin(I_WIN, ko), *w_out_a = kin(I_WOA, ko), *w_out_b = kin(I_WOB, ko), *w_out = kin(I_WO, ko);
    float* mod = (float*)(F.ws + WS_MOD);
    if (blockIdx.x < 48) {
        LAS float* sc = (LAS float*)F.lds;
        LAS float* part = (LAS float*)(F.lds + 40960);
        for (int i = (F.wave * 64 + lane_id()); i < NB * D; i += NWAVES * 64) { const int b = i >> 10, k = i & 1023; const float cv = b < NBP ? cp_[b * D + k] : cs_[(b - NBP) * D + k]; sc[i] = siluf_(cv); }
        __syncthreads();
        const int j = blockIdx.x * 64 + lane_id(); float a[NB];
#pragma unroll
        for (int b = 0; b < NB; ++b) a[b] = 0.f;
        for (int k = F.wave * 128; k < F.wave * 128 + 128; ++k) { const float w = w_ada[(size_t)k * 3072 + j];
#pragma unroll
            for (int b = 0; b < NB; ++b) a[b] += sc[b * D + k] * w; }
#pragma unroll
        for (int b = 0; b < NB; ++b) part[(F.wave * NB + b) * 64 + lane_id()] = a[b];
        __syncthreads();
        for (int i = (F.wave * 64 + lane_id()); i < NB * 64; i += NWAVES * 64) { const int b = i >> 6, l = i & 63; float s = b_ada[blockIdx.x * 64 + l];
#pragma unroll
            for (int w = 0; w < NWAVES; ++w) s += part[(w * NB + b) * 64 + l];
            mod[b * 3072 + blockIdx.x * 64 + l] = s; }
        __syncthreads();
    }
    if (blockIdx.x == 255 % gridDim.x) {
        float* bt = (float*)(F.ws + WS_BTAB);
        for (int i = (F.wave * 64 + lane_id()); i < 12 * 129; i += NWAVES * 64) { const int gh = i / 129, r = i % 129, gi = gh >> 2; const int rel = (r - 64) * (1 << (2 * gi));
            bt[i] = rel_bias[t5_bucket(rel) * 12 + gh] * 1.4426950408889634f; }
    }
    LAS float* scr = (LAS float*)(F.lds + RING_OFF + F.wave * 16384);
    const int gw = F.vcu * NWAVES + F.wave, NGW = F.G * NWAVES;
    constexpr int I_IN = (D / 64) * (IN_COLS / 32), I_OA = (A_W / 64) * (D / 32), I_OB = (B_W / 64) * (D / 32), I_O = (D / 64) * (D / 32);
    constexpr int NITEMS = I_IN + I_OA + I_OB + I_O;
    for (int it = gw; it < NITEMS; it += NGW) {
        int r = it;
        if (r < I_IN) { const int nblk = IN_COLS / 32, kb = r / nblk, nb = r % nblk, n0 = nb * 32;
            bf16* dst; int drow;
            if (n0 < A_COLS) { dst = (bf16*)(F.ws + WS_WAG); drow = n0; }
            else if (n0 < A_COLS + B_COLS) { dst = (bf16*)(F.ws + WS_WB); drow = n0 - A_COLS; }
            else { dst = (bf16*)(F.ws + WS_WAG); drow = A_COLS + (n0 - A_COLS - B_COLS); }
            p0_transpose_item(w_in, D, IN_COLS, dst, kb * 64, n0, drow, scr, lane_id()); continue; }
        r -= I_IN;
        if (r < I_OA) { const int nblk = D / 32, kb = r / nblk, nb = r % nblk; p0_transpose_item(w_out_a, A_W, D, (bf16*)(F.ws + WS_WOA), kb * 64, nb * 32, nb * 32, scr, lane_id()); continue; }
        r -= I_OA;
        if (r < I_OB) { const int nblk = D / 32, kb = r / nblk, nb = r % nblk; p0_transpose_item(w_out_b, B_W, D, (bf16*)(F.ws + WS_WOB), kb * 64, nb * 32, nb * 32, scr, lane_id()); continue; }
        r -= I_OB;
        { const int nblk = D / 32, kb = r / nblk, nb = r % nblk; p0_transpose_item(w_out, D, D, (bf16*)(F.ws + WS_WO), kb * 64, nb * 32, nb * 32, scr, lane_id()); }
    }
}
__device__ __forceinline__ void p0b(Frame& F) {
    const int ko = kopaque(); const float *xp = kin(I_XP, ko), *xs = kin(I_XS, ko), *norm_w = kin(I_NORMW, ko);
    const float* mod = (const float*)(F.ws + WS_MOD);
    const int gw = F.vcu * NWAVES + F.wave, NGW = F.G * NWAVES, lane = lane_id();
    const int per = (M + NGW - 1) / NGW, m0 = gw * per, m1 = (m0 + per < M) ? m0 + per : M;
    int bcur = -1; f32x4 cs[4], sh[4];
    for (int m = m0; m < m1; ++m) {
        const int b = m >> 13;
        if (b != bcur) { bcur = b;
#pragma unroll
            for (int j = 0; j < 4; ++j) { const int col = 4 * (lane + 64 * j); const f32x4 nw = *(const f32x4*)(norm_w + col), sc = *(const f32x4*)(mod + b * 3072 + 1024 + col);
                cs[j] = nw * (sc + 1.f); sh[j] = *(const f32x4*)(mod + b * 3072 + col); } }
        const f32x4* xr = (const f32x4*)xrow_ptr(xp, xs, m) + lane;
        f32x4 v[4]; float s = 0.f;
#pragma unroll
        for (int j = 0; j < 4; ++j) { v[j] = xr[64 * j]; s += (v[j].x * v[j].x + v[j].y * v[j].y) + (v[j].z * v[j].z + v[j].w * v[j].w); }
        const float rs = __builtin_amdgcn_rsqf(wave_sum(s) * (1.f / D) + RMS_EPS);
        v2u* o8 = (v2u*)(F.out + (size_t)m * OROW + OS_H) + lane;
#pragma unroll
        for (int j = 0; j < 4; ++j) { const f32x4 h = v[j] * rs * cs[j] + sh[j]; v2u w; w.x = cvtpk(h.x, h.y); w.y = cvtpk(h.z, h.w); o8[64 * j] = w; }
    }
}
typedef short v4i16_t __attribute__((ext_vector_type(4)));
typedef float f32x4a __attribute__((ext_vector_type(4)));
constexpr int AT_K = 0, AT_V = 65536, AT_BT = RING_BYTES + 9216 + 1024;
constexpr size_t WS_LSE = WS_Y;
__device__ __forceinline__ void attn_unit_geom(int u, int& b, int& gi, int& hh, int& res, int& blk) {
    const int sub = u & 63; int r = u >> 6; hh = r & 3; r >>= 2; gi = r % 3; b = r / 3;
    if (gi == 0) { res = 0; blk = sub; } else if (gi == 1) { res = sub >> 4; blk = sub & 15; } else { res = sub >> 2; blk = sub & 3; }
}
__device__ __forceinline__ void glds16(const void* gsrc, unsigned lds_dst) { unsigned keep;
    asm volatile("s_mov_b32 %0, m0\n\ts_mov_b32 m0, %2\n\ts_nop 0\n\tglobal_load_lds_dwordx4 %1, off\n\ts_mov_b32 m0, %0" : "=&s"(keep) : "v"(gsrc), "s"(lds_dst) : "memory"); }
__device__ __forceinline__ void attn_dma_k_half(Frame& F, const bf16* pb, int b, int lg, int L, int res, int head, int q0, int hb) {
    const int lane = lane_id();
#pragma unroll
    for (int ii = 0; ii < 4; ++ii) { const int i = (hb >> 2) + F.wave * 4 + ii, row = 4 * i + (lane >> 4); int kp = q0 - 64 + ((row - q0) & 255); kp = kp < 0 ? 0 : (kp >= L ? L - 1 : kp);
        const int c = (lane & 15) ^ (row & 15);
        const bf16* src = pb + (size_t)(b * T + (kp << lg) + res) * B_COLS + B_QKV + head * 128 + c * 8;
        glds16(src, (unsigned)__builtin_amdgcn_readfirstlane((int)(unsigned)(size_t)(F.lds + AT_K + i * 1024))); }
}
__device__ __forceinline__ void attn_dma_v_half(Frame& F, const bf16* pb, int b, int lg, int L, int res, int head, int q0, int hb) {
    const int lane = lane_id();
#pragma unroll
    for (int jj = 0; jj < 4; ++jj) { const int j = F.wave * 4 + jj, dblk = j >> 3, kgrp = (hb >> 4) + (j & 7), row = 16 * kgrp + (lane >> 2); int kp = q0 - 64 + ((row - q0) & 255); kp = kp < 0 ? 0 : (kp >= L ? L - 1 : kp);
        const bf16* src = pb + (size_t)(b * T + (kp << lg) + res) * B_COLS + 2 * B_QKV + head * 128 + dblk * 32 + (lane & 3) * 8;
        glds16(src, (unsigned)__builtin_amdgcn_readfirstlane((int)(unsigned)(size_t)(F.lds + AT_V + dblk * 16384 + kgrp * 1024))); }
}
__device__ __forceinline__ void attn_mfma(Frame& F, bool dry = false) {
    bf16* pb = (bf16*)(F.ws + WS_R); const float* btab = (const float*)(F.ws + WS_BTAB); float* lse = (float*)(F.ws + WS_LSE);
    int lane = lane_id(); asm volatile("" : "+v"(lane));
    const int w = F.wave, qi = lane & 15, g = lane >> 4;
    LAS float* btp = (LAS float*)(F.lds + AT_BT);
    const int NU = NB * 3 * 4 * 64, per = (NU + F.G - 1) / F.G; const int u0 = F.vcu * per, u1 = (u0 + per < NU) ? u0 + per : NU;
    if (u0 >= u1) return;
#ifdef PROBE_AT
    const unsigned long long pat_t0 = __builtin_amdgcn_s_memtime();
#endif
    int koff[4];
#pragma unroll
    for (int ks = 0; ks < 4; ++ks) koff[ks] = AT_K + qi * 256 + (((4 * ks + g) ^ qi) << 4);
    const int q4 = qi >> 2, p4 = qi & 3, kr = 4 * g + q4;
    const int voff = AT_V + (kr >> 3) * 512 + (kr & 7) * 64 + 8 * p4;
    int b, gi, hh, res, blk; attn_unit_geom(u0, b, gi, hh, res, blk);
    { const int lg = 2 * gi; attn_dma_k_half(F, pb, b, lg, T >> lg, res, gi * 4 + hh, blk * 128, 0); attn_dma_k_half(F, pb, b, lg, T >> lg, res, gi * 4 + hh, blk * 128, 128); }
    int head_prev = -1;
    bf16x8 qA[4], qB[4];
#define ATTN_LOADQ(QD, uu) do { int b_, gi_, hh_, res_, blk_; attn_unit_geom((uu), b_, gi_, hh_, res_, blk_); const int lg_ = 2 * gi_; \
        const bf16* qr_ = pb + (size_t)(b_ * T + ((blk_ * 128 + 16 * w + qi) << lg_) + res_) * B_COLS + (gi_ * 4 + hh_) * 128; \
        _Pragma("unroll") for (int ks = 0; ks < 4; ++ks) QD[ks] = *(const bf16x8*)(qr_ + 32 * ks + 8 * g); } while (0)
    ATTN_LOADQ(qA, u0);
    asm volatile("" :: "v"(qA[0]), "v"(qA[1]), "v"(qA[2]), "v"(qA[3]));
#define ATTN_UNIT(u, qf, qnx) do { \
        attn_unit_geom(u, b, gi, hh, res, blk); \
        const int lg = 2 * gi, L = T >> lg, head = gi * 4 + hh, q0 = blk * 128; \
        const bool cont = ((u) > u0) && (blk != 0);                  \
        const int s8 = ((q0 >> 4) + w) & 15;                         \
        if (head != head_prev) { head_prev = head; const int tid_ = F.wave * 64 + lane_id(); if (tid_ < 176) { const int i = tid_ - 16; btp[tid_] = (i >= 0 && i <= 128) ? btab[head * 129 + i] : -1e30f; } asm volatile("s_waitcnt vmcnt(0)" ::: "memory"); } \
        bf16* qrow = pb + (size_t)(b * T + ((q0 + 16 * w + qi) << lg) + res) * B_COLS + head * 128; \
        if ((u) + 1 < u1) ATTN_LOADQ(qnx, (u) + 1); \
          \
        if ((u) == u0) asm volatile("s_waitcnt vmcnt(0) lgkmcnt(0)" ::: "memory"); else asm volatile("s_waitcnt vmcnt(6) lgkmcnt(0)" ::: "memory"); \
        __builtin_amdgcn_s_barrier(); asm volatile("" ::: "memory"); \
        if (!cont) attn_dma_v_half(F, pb, b, lg, L, res, head, q0, q0 & 255); \
        attn_dma_v_half(F, pb, b, lg, L, res, head, q0, (q0 + 128) & 255); \
        f32x4a S[9]; \
        _Pragma("unroll") for (int kb = 0; kb < 9; ++kb) { S[kb] = (f32x4a){0.f, 0.f, 0.f, 0.f}; const int rb = ((s8 + kb) & 15) * 4096; \
            _Pragma("unroll") for (int ks = 0; ks < 4; ++ks) { const bf16x8 kf = *(const LAS bf16x8*)(F.lds + koff[ks] + rb); \
                S[kb] = __builtin_amdgcn_mfma_f32_16x16x32_bf16(kf, qf[ks], S[kb], 0, 0, 0); } } \
        const bool edge = (q0 == 0) || (q0 + 128 >= L); \
        float mx = -1e30f; \
        _Pragma("unroll") for (int kb = 0; kb < 9; ++kb) \
            _Pragma("unroll") for (int r = 0; r < 4; ++r) { const int kw = 16 * kb + 4 * g + r; float sv = S[kb][r] + btp[kw - qi + 16]; \
                if (edge) { const int kp = q0 + 16 * w + kw - 64; if (kp < 0 || kp >= L) sv = -1e30f; } \
                S[kb][r] = sv; mx = fmaxf(mx, sv); } \
        mx = fmaxf(mx, __shfl_xor(mx, 16)); mx = fmaxf(mx, __shfl_xor(mx, 32)); \
        float ls = 0.f; \
        _Pragma("unroll") for (int kb = 0; kb < 9; ++kb) \
            _Pragma("unroll") for (int r = 0; r < 4; ++r) { const float pe = __builtin_amdgcn_exp2f(S[kb][r] - mx); S[kb][r] = pe; ls += pe; } \
        ls += __shfl_xor(ls, 16); ls += __shfl_xor(ls, 32); \
        bf16x8 pf[5]; \
        _Pragma("unroll") for (int c = 0; c < 5; ++c) { v4u t; t.x = cvtpk(S[2 * c][0], S[2 * c][1]); t.y = cvtpk(S[2 * c][2], S[2 * c][3]); \
            if (c < 4) { t.z = cvtpk(S[2 * c + 1][0], S[2 * c + 1][1]); t.w = cvtpk(S[2 * c + 1][2], S[2 * c + 1][3]); } else { t.z = 0u; t.w = 0u; } \
            pf[c] = __builtin_bit_cast(bf16x8, t); } \
        asm volatile("s_waitcnt vmcnt(0) lgkmcnt(0)" ::: "memory"); __builtin_amdgcn_s_barrier(); asm volatile("" ::: "memory"); \
        if ((u) + 1 < u1) { int b2, gi2, hh2, res2, blk2; attn_unit_geom((u) + 1, b2, gi2, hh2, res2, blk2); const int lg2 = 2 * gi2, q02 = blk2 * 128; \
            if (blk2 == 0) attn_dma_k_half(F, pb, b2, lg2, T >> lg2, res2, gi2 * 4 + hh2, q02, q02 & 255); \
            attn_dma_k_half(F, pb, b2, lg2, T >> lg2, res2, gi2 * 4 + hh2, q02, (q02 + 128) & 255); } \
        asm volatile("" ::: "memory");                                \
        const float il = 1.f / ls; \
        int vlo[5], vhi[5]; \
        _Pragma("unroll") for (int c = 0; c < 5; ++c) { vlo[c] = voff + ((s8 + 2 * c) & 15) * 1024; vhi[c] = (c < 4) ? voff + ((s8 + 2 * c + 1) & 15) * 1024 : vlo[c]; } \
        _Pragma("unroll") for (int db = 0; db < 8; ++db) { f32x4a o = (f32x4a){0.f, 0.f, 0.f, 0.f}; \
            _Pragma("unroll") for (int c = 0; c < 5; ++c) { const int dofs = (db >> 1) * 16384 + (db & 1) * 32; \
                const v4i16_t lo = __builtin_amdgcn_ds_read_tr16_b64_v4i16((LAS v4i16_t*)(F.lds + vlo[c] + dofs)); \
                const v4i16_t hi = __builtin_amdgcn_ds_read_tr16_b64_v4i16((LAS v4i16_t*)(F.lds + vhi[c] + dofs)); \
                const bf16x8 vf = (bf16x8){lo[0], lo[1], lo[2], lo[3], hi[0], hi[1], hi[2], hi[3]}; \
                o = __builtin_amdgcn_mfma_f32_16x16x32_bf16(vf, pf[c], o, 0, 0, 0); } \
            v2u wv; wv.x = cvtpk(o[0] * il, o[1] * il); wv.y = cvtpk(o[2] * il, o[3] * il); \
            *(v2u*)((dry ? (bf16*)(F.ws + WS_Y) + (size_t)((F.wave * 64 + lane_id()) >> 2) * B_COLS : qrow) + 16 * db + 4 * g) = wv; } \
        if (g == 0 && !dry) lse[(size_t)(b * T + ((q0 + 16 * w + qi) << lg) + res) * 12 + head] = mx + __builtin_amdgcn_logf(ls); \
        asm volatile("" :: "v"(qnx[0]), "v"(qnx[1]), "v"(qnx[2]), "v"(qnx[3]));     \
    } while (0)
    for (int u = u0; u < u1; u += 2) {
        ATTN_UNIT(u, qA, qB);
        if (u + 1 < u1) ATTN_UNIT(u + 1, qB, qA);
    }
#undef ATTN_UNIT
#undef ATTN_LOADQ
    asm volatile("s_waitcnt vmcnt(0) lgkmcnt(0)" ::: "memory"); __builtin_amdgcn_s_barrier();
#ifdef PROBE_AT
    if (blockIdx.x == 0 && (F.wave * 64 + lane_id()) == 0) ((float*)(F.ws + WS_CTL + 32768))[0] = (float)((double)(((__builtin_amdgcn_s_memtime() - pat_t0) / (unsigned long long)(u1 - u0) + 1024ull) >> 11 << 11) / 65536.0);
#endif
}
__device__ __forceinline__ void attn_combine(Frame& F) {
    const bf16* pb = (const bf16*)(F.ws + WS_R); const float* lse = (const float*)(F.ws + WS_LSE);
    const int gw = F.vcu * NWAVES + F.wave, NGW = F.G * NWAVES, lane = lane_id(), hh = lane >> 4, d0 = (lane & 15) * 8;
    for (int m = gw; m < M; m += NGW) {
        const bf16* row = pb + (size_t)m * B_COLS;
        const float l0 = lse[(size_t)m * 12 + hh], l1 = lse[(size_t)m * 12 + 4 + hh], l2 = lse[(size_t)m * 12 + 8 + hh];
        const float mxl = fmaxf(l0, fmaxf(l1, l2)); float w0 = exp2f(l0 - mxl), w1 = exp2f(l1 - mxl), w2 = exp2f(l2 - mxl); const float iw = 1.f / (w0 + w1 + w2); w0 *= iw; w1 *= iw; w2 *= iw;
        const v4u a = *(const v4u*)(row + hh * 128 + d0), bq = *(const v4u*)(row + (4 + hh) * 128 + d0), c = *(const v4u*)(row + (8 + hh) * 128 + d0), gt = *(const v4u*)(row + 3 * B_QKV + hh * 128 + d0);
        v4u o;
        o.x = pk2((w0 * bflo(a.x) + w1 * bflo(bq.x) + w2 * bflo(c.x)) * bflo(gt.x), (w0 * bfhi(a.x) + w1 * bfhi(bq.x) + w2 * bfhi(c.x)) * bfhi(gt.x));
        o.y = pk2((w0 * bflo(a.y) + w1 * bflo(bq.y) + w2 * bflo(c.y)) * bflo(gt.y), (w0 * bfhi(a.y) + w1 * bfhi(bq.y) + w2 * bfhi(c.y)) * bfhi(gt.y));
        o.z = pk2((w0 * bflo(a.z) + w1 * bflo(bq.z) + w2 * bflo(c.z)) * bflo(gt.z), (w0 * bfhi(a.z) + w1 * bfhi(bq.z) + w2 * bfhi(c.z)) * bfhi(gt.z));
        o.w = pk2((w0 * bflo(a.w) + w1 * bflo(bq.w) + w2 * bflo(c.w)) * bflo(gt.w), (w0 * bfhi(a.w) + w1 * bfhi(bq.w) + w2 * bfhi(c.w)) * bfhi(gt.w));
        *(v4u*)(F.out + (size_t)m * OROW + OS_YB + (hh * 128 + d0) * 2) = o;
    }
}

#ifdef PROBE_TA
#define STAMP(k) do { if ((k) == PROBE_TA) pt_a = __builtin_amdgcn_s_memtime(); if ((k) == PROBE_TB) pt_sel += __builtin_amdgcn_s_memtime() - pt_a; } while (0)
#else
#define STAMP(k) do { } while (0)
#endif
#ifndef REP_S0
#define REP_S0 1
#define REP_S12 1
#define REP_S3 1
#define REP_S45 1
#endif
typedef float f32x4r __attribute__((ext_vector_type(4)));
constexpr int RS = 144, RM = 64 * RS;
constexpr int R_AT = 0 * RM, R_RT = 1 * RM, R_BW = 2 * RM, R_KU = 3 * RM, R_BT = 4 * RM, R_KT = 5 * RM, R_VT = 6 * RM, R_AAB = 7 * RM, R_AAK = 8 * RM, R_ARB = 9 * RM, R_ARK = 10 * RM, R_HT = 11 * RM;
constexpr int R_W2T = 12 * RM, R_A2T = 13 * RM;
constexpr int R_WLF = R_AT, R_ALF = R_BT, FS = 272;
constexpr int R_TI = 132096, TIS = 48, R_PC = R_TI + 3072, R_BLK = R_PC + 256, R_AD = R_BLK + 2048;
__device__ __forceinline__ bf16x8 ldfrag(LAS unsigned char* lds, int mat, int row0, int k0, int r, int g) { return *(const LAS bf16x8*)(lds + mat + (row0 + r) * RS + (k0 + 8 * g) * 2); }
__device__ __forceinline__ void storeT(LAS unsigned char* lds, int mat, const f32x4r& d, int row0, int col0, int r, int g) {
    v2u w; w.x = cvtpk(d[0], d[1]); w.y = cvtpk(d[2], d[3]); *(LAS v2u*)(lds + mat + (col0 + r) * RS + (row0 + 4 * g) * 2) = w; }
__device__ __forceinline__ bf16x8 pack2(const f32x4r& a, const f32x4r& b) { v4u t; t.x = cvtpk(a[0], a[1]); t.y = cvtpk(a[2], a[3]); t.z = cvtpk(b[0], b[1]); t.w = cvtpk(b[2], b[3]); return __builtin_bit_cast(bf16x8, t); }
__device__ __forceinline__ bf16x8 pack1(const f32x4r& a) { v4u t; t.x = cvtpk(a[0], a[1]); t.y = cvtpk(a[2], a[3]); t.z = 0u; t.w = 0u; return __builtin_bit_cast(bf16x8, t); }
__device__ __forceinline__ bf16x8 ld2x4(LAS unsigned char* lds, int off0, int off1) { const v2u a = *(const LAS v2u*)(lds + off0), b = *(const LAS v2u*)(lds + off1); v4u t; t.x = a.x; t.y = a.y; t.z = b.x; t.w = b.y; return __builtin_bit_cast(bf16x8, t); }
#define MF16(a, b, c) __builtin_amdgcn_mfma_f32_16x16x32_bf16((a), (b), (c), 0, 0, 0)
#define WGBAR() do { asm volatile("s_waitcnt lgkmcnt(0)" ::: "memory"); __builtin_amdgcn_s_barrier(); asm volatile("" ::: "memory"); } while (0)
template <int CTRL> __device__ __forceinline__ float dppf(float x) { return __builtin_bit_cast(float, __builtin_amdgcn_update_dpp(0, __builtin_bit_cast(int, x), CTRL, 0xF, 0xF, true)); }
__device__ __forceinline__ float row16_sum(float v) { v += dppf<0xB1>(v); v += dppf<0x4E>(v); v += dppf<0x141>(v); v += dppf<0x140>(v); return v; }
__device__ __forceinline__ float wave_sum_dpp(float v) { v = row16_sum(v);
    return (__builtin_bit_cast(float, __builtin_amdgcn_readlane(__builtin_bit_cast(int, v), 0)) + __builtin_bit_cast(float, __builtin_amdgcn_readlane(__builtin_bit_cast(int, v), 16)))
         + (__builtin_bit_cast(float, __builtin_amdgcn_readlane(__builtin_bit_cast(int, v), 32)) + __builtin_bit_cast(float, __builtin_amdgcn_readlane(__builtin_bit_cast(int, v), 48))); }
__device__ __forceinline__ void reduce8(const float (&v)[8], float (&s)[8], float& v0, float& v1, int lane) {
    const bool b0 = lane & 1, b1 = lane & 2; float r1[4], r2[2];
#pragma unroll
    for (int i = 0; i < 4; ++i) { const float keep = b0 ? v[2 * i + 1] : v[2 * i], send = b0 ? v[2 * i] : v[2 * i + 1]; r1[i] = keep + dppf<0xB1>(send); }
#pragma unroll
    for (int i = 0; i < 2; ++i) { const float keep = b1 ? r1[2 * i + 1] : r1[2 * i], send = b1 ? r1[2 * i] : r1[2 * i + 1]; r2[i] = keep + dppf<0x4E>(send); }
#pragma unroll
    for (int i = 0; i < 2; ++i) { float x = r2[i]; x += dppf<0x124>(x); x += dppf<0x128>(x);
        x += __builtin_bit_cast(float, __builtin_amdgcn_ds_swizzle(__builtin_bit_cast(int, x), 0x401F));
        x += __shfl_xor(x, 32);
        r2[i] = x; }
    v0 = r2[0]; v1 = r2[1];
#pragma unroll
    for (int q = 0; q < 8; ++q) s[q] = __builtin_bit_cast(float, __builtin_amdgcn_readlane(__builtin_bit_cast(int, r2[q >> 2]), q & 3));
}
typedef float f2v __attribute__((ext_vector_type(2)));
__device__ __forceinline__ f2v exp2v(f2v x) { return (f2v){__builtin_amdgcn_exp2f(x.x), __builtin_amdgcn_exp2f(x.y)}; }
__device__ __forceinline__ f2v rcpv(f2v x) { return (f2v){__builtin_amdgcn_rcpf(x.x), __builtin_amdgcn_rcpf(x.y)}; }
__device__ __forceinline__ unsigned cvtpk2(f2v v) { bf16x2_t b = __builtin_convertvector(v, bf16x2_t); return __builtin_bit_cast(unsigned, b); }
__device__ __forceinline__ float fast_tanh(float x) { const float e = __expf(2.f * x); return 1.f - 2.f * __builtin_amdgcn_rcpf(e + 1.f); }
template <bool RV> __device__ __forceinline__ void rwkv_load_rows(__amdgpu_buffer_rsrc_t rsrc, int b, int d, int c, int w, unsigned o_r, unsigned o_w, unsigned (&x0)[10], unsigned (&x1)[10], unsigned (&x2)[10]) {
    const int s0 = c * 64 + 8 * w - 1;
#pragma unroll
    for (int k = 0; k < 10; ++k) { const int s = s0 + k; int tk = d ? T - 1 - s : s; tk = tk < 0 ? 0 : (tk > T - 1 ? T - 1 : tk);
        const int so = __builtin_amdgcn_readfirstlane((b * T + tk) * (A_COLS * 2));
        if (RV) { x0[k] = __builtin_amdgcn_raw_buffer_load_b32(rsrc, o_r, so, 0); x1[k] = __builtin_amdgcn_raw_buffer_load_b32(rsrc, o_r + 2 * A_W * 2, so, 0); }
        else { x0[k] = __builtin_amdgcn_raw_buffer_load_b32(rsrc, o_r + A_W * 2, so, 0); x1[k] = __builtin_amdgcn_raw_buffer_load_b32(rsrc, o_w, so, 0); x2[k] = __builtin_amdgcn_raw_buffer_load_b32(rsrc, o_w + 2 * RANK * 2, so, 0); } }
}
__device__ __forceinline__ bf16x8 ldfragT(LAS unsigned char* lds, int mat, int m0, int k0, int lane) {
    const int i16 = lane & 15, g = lane >> 4, q = i16 >> 2, pq = i16 & 3; const int off = mat + (k0 + 8 * g + q) * RS + (m0 + 4 * pq) * 2;
    const v4i16_t lo = __builtin_amdgcn_ds_read_tr16_b64_v4i16((LAS v4i16_t*)(lds + off)), hi = __builtin_amdgcn_ds_read_tr16_b64_v4i16((LAS v4i16_t*)(lds + off + 4 * RS));
    return (bf16x8){lo[0], lo[1], lo[2], lo[3], hi[0], hi[1], hi[2], hi[3]};
}
__device__ __forceinline__ void rwkv_chunked(Frame& F) {
    if (blockIdx.x >= 2 * NB * A_HEADS) return;
    const int chain = blockIdx.x, d = chain / (NB * A_HEADS), rem = chain % (NB * A_HEADS), b = rem >> 3, hd = rem & 7;
    const bf16* pa = (const bf16*)(F.ws + WS_PA); bf16* ybuf = (bf16*)(F.ws + WS_Y) + (size_t)d * M * A_W; float* bon = (float*)(F.ws + WS_BON) + (size_t)d * M * 8;
    const int ko = kopaque(); const float *w2_ = kin(I_W2, ko), *a2_ = kin(I_A2, ko), *mu_ = kin(I_MU, ko), *w0_ = kin(I_W0, ko), *a0_ = kin(I_A0, ko), *kk_ = kin(I_KK, ko), *ka_ = kin(I_KA, ko), *rk_ = kin(I_RK, ko);
    LAS unsigned char* L = F.lds;
    int lane = lane_id(); asm volatile("" : "+v"(lane));
    const int w = F.wave, j = lane, ch = hd * 64 + j;
    int r, g;
#define RELANE() do { int ln_ = lane; asm volatile("" : "+v"(ln_)); r = ln_ & 15; g = ln_ >> 4; } while (0)
    for (int i = (F.wave * 64 + lane_id()); i < 4096; i += NWAVES * 64) { const int jo = i >> 6, jr = i & 63;
        *(LAS bf16*)(L + R_W2T + jo * RS + jr * 2) = (bf16)f2bf(w2_[((size_t)d * RANK + jr) * A_W + hd * 64 + jo]);
        *(LAS bf16*)(L + R_A2T + jo * RS + jr * 2) = (bf16)f2bf(a2_[((size_t)d * RANK + jr) * A_W + hd * 64 + jo]); }
    for (int i = (F.wave * 64 + lane_id()); i < 5 * RM / 4; i += NWAVES * 64) ((LAS unsigned*)(L + R_AAB))[i] = 0u;
    const int cr = ch, ck = A_W + ch, cv = 2 * A_W + ch, cw = 4 * A_W + d * RANK + j, ca = 4 * A_W + 2 * RANK + d * RANK + j;
    const float mr0 = mu_[cr], mr1 = mu_[A_COLS + cr], mk0 = mu_[ck], mk1 = mu_[A_COLS + ck], mv0 = mu_[cv], mv1 = mu_[A_COLS + cv];
    const float mw0 = mu_[cw], mw1 = mu_[A_COLS + cw], ma0 = mu_[ca], ma1 = mu_[A_COLS + ca];
    const __amdgpu_buffer_rsrc_t rsrc = __builtin_amdgcn_make_buffer_rsrc((void*)pa, 0, M * A_COLS * 2, 0x00020000);
#define O_R ((unsigned)(((hd * 64 + lnow_) * 2) & ~3))
#define O_W ((unsigned)(((4 * A_W + d * RANK + lnow_) * 2) & ~3))
#define PSEL ((lnow_ & 1) ? 0x07060c0cu : 0x05040c0cu)
    const float sr0 = d ? mr1 : mr0, sr1 = d ? mr0 : mr1, sk0 = d ? mk1 : mk0, sk1 = d ? mk0 : mk1, sv0 = d ? mv1 : mv0, sv1 = d ? mv0 : mv1, sw0 = d ? mw1 : mw0, sw1 = d ? mw0 : mw1, sa0 = d ? ma1 : ma0, sa1 = d ? ma0 : ma1;
    const float w0j = w0_[d * A_W + ch], a0j = a0_[d * A_W + ch], kkj = kk_[ch], kaj = ka_[ch], rkj = rk_[ch];
    const int vt = w & 3;
    f32x4r Hs[4];
#pragma unroll
    for (int i = 0; i < 4; ++i) Hs[i] = (f32x4r){0.f, 0.f, 0.f, 0.f};
    unsigned xk[10], xw[10], xa[10];
    { int lnow_ = lane; rwkv_load_rows<false>(rsrc, b, d, 0, w, O_R, O_W, xk, xw, xa); }
    WGBAR();
#ifdef PROBE_TA
    unsigned long long pt_a = 0, pt_sel = 0; const unsigned long long pt_t0 = __builtin_amdgcn_s_memtime();
#endif
    for (int c = 0; c < T / 64; ++c) {
        STAMP(0);
        f2v ks2[4], kn2[4];
        for (int rep0_ = 0; rep0_ < REP_S0; ++rep0_) {
        int lnow_ = lane; asm volatile("" : "+v"(lnow_)); const unsigned psel = PSEL;
        if (REP_S0 > 1 && rep0_ > 0) rwkv_load_rows<false>(rsrc, b, d, c, w, O_R, O_W, xk, xw, xa);
        const bool okp = (c * 64 + 8 * w) > 0, okn = (c * 64 + 8 * w + 8) < T;
#define XF(x, k) ((((k) == 0 && !okp) || ((k) == 9 && !okn)) ? 0.f : __builtin_bit_cast(float, __builtin_amdgcn_perm((x)[k], 0u, psel)))
#define SH2(dst, x, m0, m1) do { float xf_[10]; _Pragma("unroll") for (int k_ = 0; k_ < 10; ++k_) xf_[k_] = XF(x, k_); const float mc_ = 1.f - (m0) - (m1); \
        _Pragma("unroll") for (int q2_ = 0; q2_ < 4; ++q2_) (dst)[q2_] = (f2v){xf_[2 * q2_ + 1], xf_[2 * q2_ + 2]} * mc_ + (f2v){xf_[2 * q2_], xf_[2 * q2_ + 1]} * (m0) + (f2v){xf_[2 * q2_ + 2], xf_[2 * q2_ + 3]} * (m1); } while (0)
        { unsigned tw_[4], al_[4];
          { f2v ws2[4]; SH2(ws2, xw, sw0, sw1);
#pragma unroll
            for (int q2 = 0; q2 < 4; ++q2) { const f2v e2 = exp2v(ws2[q2] * 2.8853900817779268f); tw_[q2] = cvtpk2(1.f - 2.f * rcpv(e2 + 1.f)); } }
          asm volatile("" ::: "memory");
          { f2v as2[4]; SH2(as2, xa, sa0, sa1);
#pragma unroll
            for (int q2 = 0; q2 < 4; ++q2) al_[q2] = cvtpk2(as2[q2]); }
          asm volatile("" ::: "memory");
          SH2(ks2, xk, sk0, sk1);
#pragma unroll
          for (int q2 = 0; q2 < 4; ++q2) kn2[q2] = ks2[q2] * kkj;
          *(LAS v4u*)(L + R_BW + j * RS + 16 * w) = (v4u){tw_[0], tw_[1], tw_[2], tw_[3]};
          *(LAS v4u*)(L + R_KU + j * RS + 16 * w) = (v4u){al_[0], al_[1], al_[2], al_[3]}; }
        { float sq[8], n2[8], d0_, d1_;
#pragma unroll
          for (int q2 = 0; q2 < 4; ++q2) { const f2v s = kn2[q2] * kn2[q2]; sq[2 * q2] = s.x; sq[2 * q2 + 1] = s.y; }
          reduce8(sq, n2, d0_, d1_, lane);
#pragma unroll
          for (int q2 = 0; q2 < 4; ++q2) kn2[q2] *= (f2v){__builtin_amdgcn_rsqf(fmaxf(n2[2 * q2], 1e-24f)), __builtin_amdgcn_rsqf(fmaxf(n2[2 * q2 + 1], 1e-24f))}; }
        WGBAR();
        STAMP(1);
        RELANE();
        unsigned xr[10], xv[10], xdum[10];
        rwkv_load_rows<true>(rsrc, b, d, c, w, O_R, O_W, xr, xv, xdum);
        { const int it = w >> 1;
          bf16x8 ta[2], aa[2];
#pragma unroll
          for (int k2 = 0; k2 < 2; ++k2) { ta[k2] = ldfragT(L, R_BW, 16 * it, 32 * k2, lane); aa[k2] = ldfragT(L, R_KU, 16 * it, 32 * k2, lane); }
#pragma unroll
          for (int j2 = 0; j2 < 2; ++j2) { const int jt = 2 * (w & 1) + j2; f32x4r dw = (f32x4r){0.f, 0.f, 0.f, 0.f}, da = dw;
#pragma unroll
              for (int k2 = 0; k2 < 2; ++k2) { dw = MF16(ta[k2], ldfrag(L, R_W2T, 16 * jt, 32 * k2, r, g), dw); da = MF16(aa[k2], ldfrag(L, R_A2T, 16 * jt, 32 * k2, r, g), da); }
#pragma unroll
              for (int e = 0; e < 4; ++e) { *(LAS float*)(L + R_WLF + (16 * it + 4 * g + e) * FS + (16 * jt + r) * 4) = dw[e]; *(LAS float*)(L + R_ALF + (16 * it + 4 * g + e) * FS + (16 * jt + r) * 4) = da[e]; } } }
        WGBAR();
        STAMP(2);
        f2v av2[4]; float cp[8]; float run = 1.f;
#pragma unroll
        for (int q2 = 0; q2 < 4; ++q2) { const int i0 = 8 * w + 2 * q2;
            const f2v wl = (f2v){*(const LAS float*)(L + R_WLF + i0 * FS + j * 4), *(const LAS float*)(L + R_WLF + (i0 + 1) * FS + j * 4)} + w0j;
            const f2v al = (f2v){*(const LAS float*)(L + R_ALF + i0 * FS + j * 4), *(const LAS float*)(L + R_ALF + (i0 + 1) * FS + j * 4)} + a0j;
            const f2v dec = exp2v(rcpv(exp2v(wl * -1.4426950408889634f) + 1.f) * (-0.6065306597126334f * 1.4426950408889634f));
            av2[q2] = rcpv(exp2v(al * -1.4426950408889634f) + 1.f);
            run *= dec.x; cp[2 * q2] = run; run *= dec.y; cp[2 * q2 + 1] = run; }
        *(LAS float*)(L + R_BLK + (w * 64 + j) * 4) = run;
        WGBAR();
        STAMP(3);
        { float off = 1.f, tot = 1.f;
#pragma unroll
          for (int w2 = 0; w2 < 8; ++w2) { const float bt = *(const LAS float*)(L + R_BLK + (w2 * 64 + j) * 4); off *= (w2 < w) ? bt : 1.f; tot *= bt; }
          if (w == 0) *(LAS float*)(L + R_PC + j * 4) = tot;
          f2v rs2[4], vs2[4], kd2[4]; SH2(rs2, xr, sr0, sr1); SH2(vs2, xv, sv0, sv1);
          { float bp[8], bs[8], b0_, b1_;
#pragma unroll
            for (int q2 = 0; q2 < 4; ++q2) { kd2[q2] = ks2[q2] * (av2[q2] * kaj + (1.f - kaj)); const f2v t = rs2[q2] * kd2[q2] * rkj; bp[2 * q2] = t.x; bp[2 * q2 + 1] = t.y; }
            reduce8(bp, bs, b0_, b1_, lane);
            if (lane < 4) { const int s0_ = c * 64 + 8 * w + lane, s1_ = s0_ + 4; const int t0_ = d ? T - 1 - s0_ : s0_, t1_ = d ? T - 1 - s1_ : s1_;
                bon[(size_t)(b * T + t0_) * 8 + hd] = b0_; bon[(size_t)(b * T + t1_) * 8 + hd] = b1_; } }
          unsigned pa_[4], pr_[4], pb_[4], pk_[4], pv_[4];
#pragma unroll
          for (int q2 = 0; q2 < 4; ++q2) { const int qa = 2 * q2;
              const f2v pt = (f2v){cp[qa], cp[qa + 1]} * off; const f2v pm = (f2v){(qa == 0) ? off : off * cp[qa > 0 ? qa - 1 : 0], pt.x}; const f2v em = rcpv(pt);
              pa_[q2] = cvtpk2(-kn2[q2] * pm); pr_[q2] = cvtpk2(rs2[q2] * pt); pb_[q2] = cvtpk2(kn2[q2] * av2[q2] * em); pk_[q2] = cvtpk2(kd2[q2] * em); pv_[q2] = cvtpk2(vs2[q2]); }
          *(LAS v4u*)(L + R_AT + j * RS + 16 * w) = (v4u){pa_[0], pa_[1], pa_[2], pa_[3]};
          *(LAS v4u*)(L + R_RT + j * RS + 16 * w) = (v4u){pr_[0], pr_[1], pr_[2], pr_[3]};
          *(LAS v4u*)(L + R_BT + j * RS + 16 * w) = (v4u){pb_[0], pb_[1], pb_[2], pb_[3]};
          *(LAS v4u*)(L + R_KT + j * RS + 16 * w) = (v4u){pk_[0], pk_[1], pk_[2], pk_[3]};
          *(LAS v4u*)(L + R_VT + j * RS + 16 * w) = (v4u){pv_[0], pv_[1], pv_[2], pv_[3]}; }
        WGBAR();
#undef SH2
#undef XF
        }
        STAMP(4);
        if (c + 1 < T / 64) { int lnow_ = lane; asm volatile("" : "+v"(lnow_)); rwkv_load_rows<false>(rsrc, b, d, c + 1, w, O_R, O_W, xk, xw, xa); }
        STAMP(5);
        RELANE();
        f32x4r A0[4], KV[4];
#define tc(i) KV[(i) >> 2][(i) & 3]
        for (int rep1_ = 0; rep1_ < REP_S12; ++rep1_) {
        if (w == 0) {
#pragma unroll
            for (int i = 0; i < 4; ++i) { f32x4r dd = (f32x4r){0.f, 0.f, 0.f, 0.f};
#pragma unroll
                for (int k2 = 0; k2 < 2; ++k2) dd = MF16(ldfragT(L, R_BT, 16 * i, 32 * k2, lane), ldfragT(L, R_AT, 16 * i, 32 * k2, lane), dd);
#pragma unroll
                for (int e = 0; e < 4; ++e) if (4 * g + e >= r) dd[e] = 0.f;
                storeT(L, R_AAB, dd, 16 * i, 16 * i, r, g);
                *(LAS f32x4r*)(L + R_AD + i * 1024 + r * 64 + 16 * g) = dd; }
            { f32x4r dd = (f32x4r){0.f, 0.f, 0.f, 0.f};
#pragma unroll
              for (int k2 = 0; k2 < 2; ++k2) dd = MF16(ldfragT(L, R_KT, 48, 32 * k2, lane), ldfragT(L, R_RT, 48, 32 * k2, lane), dd);
#pragma unroll
              for (int e = 0; e < 4; ++e) if (4 * g + e > r) dd[e] = 0.f;
              storeT(L, R_ARK, dd, 48, 48, r, g); }
            asm volatile("s_waitcnt lgkmcnt(0)" ::: "memory");
            const int blk = lane >> 4, cc = lane & 15;
#pragma unroll
            for (int rr = 0; rr < 8; ++rr) { float acc = (rr == cc) ? 1.f : 0.f;
#pragma unroll
                for (int s4 = 0; s4 < (rr + 3) / 4; ++s4) { const f32x4r a4 = *(const LAS f32x4r*)(L + R_AD + blk * 1024 + rr * 64 + s4 * 16);
#pragma unroll
                    for (int e = 0; e < 4; ++e) if (4 * s4 + e < rr) acc += a4[e] * tc(4 * s4 + e); }
                tc(rr) = acc; *(LAS bf16*)(L + R_TI + (16 * blk + rr) * TIS + cc * 2) = (bf16)f2bf(acc); }
        } else {
#pragma unroll
            for (int kb = 0; kb < 3; ++kb) {
                bf16x8 fa[2][2], fb[2][2]; int dmv[2], tsv[2], ttv[2]; bool inc[2];
#pragma unroll
                for (int k = 0; k < 2; ++k) if (kb < 2 || k == 0) { const int jc = w - 1 + 7 * (2 * kb + k);
                    int mat, idx; if (jc < 6) { mat = 0; idx = (0x865321 >> (4 * jc)) & 15; } else { const int q = jc - 6; mat = 1 + q / 10; idx = q - 10 * (mat - 1); }
                    const int ts = (int)((0x3221110000ull >> (4 * idx)) & 15), tt = (int)((0x3323213210ull >> (4 * idx)) & 15);
                    const int ym = (mat & 1) ? R_KT : R_BT, xm = (mat & 2) ? R_RT : R_AT; dmv[k] = R_AAB + mat * RM; inc[k] = mat >= 2; tsv[k] = ts; ttv[k] = tt;
#pragma unroll
                    for (int k2 = 0; k2 < 2; ++k2) { fa[k][k2] = ldfragT(L, ym, 16 * ts, 32 * k2, lane); fb[k][k2] = ldfragT(L, xm, 16 * tt, 32 * k2, lane); } }
#pragma unroll
                for (int k = 0; k < 2; ++k) if (kb < 2 || k == 0) { f32x4r dd = (f32x4r){0.f, 0.f, 0.f, 0.f};
#pragma unroll
                    for (int k2 = 0; k2 < 2; ++k2) dd = MF16(fa[k][k2], fb[k][k2], dd);
                    if (tsv[k] == ttv[k]) {
#pragma unroll
                        for (int e = 0; e < 4; ++e) { const int sl = 4 * g + e; if (inc[k] ? (sl > r) : (sl >= r)) dd[e] = 0.f; } }
                    storeT(L, dmv[k], dd, 16 * tsv[k], 16 * ttv[k], r, g); }
            }
        }
        WGBAR();
        STAMP(6);
        RELANE();
        if (w == 0) {
            const int blk = lane >> 4, cc = lane & 15;
#pragma unroll
            for (int rr = 8; rr < 16; ++rr) { float acc = (rr == cc) ? 1.f : 0.f;
#pragma unroll
                for (int s4 = 0; s4 < (rr + 3) / 4; ++s4) { const f32x4r a4 = *(const LAS f32x4r*)(L + R_AD + blk * 1024 + rr * 64 + s4 * 16);
#pragma unroll
                    for (int e = 0; e < 4; ++e) if (4 * s4 + e < rr) acc += a4[e] * tc(4 * s4 + e); }
                tc(rr) = acc; *(LAS bf16*)(L + R_TI + (16 * blk + rr) * TIS + cc * 2) = (bf16)f2bf(acc); }
        } else if (w < 4) {
#pragma unroll
            for (int i = 0; i < 4; ++i) { A0[i] = (f32x4r){0.f, 0.f, 0.f, 0.f};
#pragma unroll
                for (int k2 = 0; k2 < 2; ++k2) A0[i] = MF16(ldfrag(L, R_VT, 16 * vt, 32 * k2, r, g), ldfrag(L, R_ARK, 16 * i, 32 * k2, r, g), A0[i]); }
        } else {
#pragma unroll
            for (int i = 0; i < 4; ++i) { A0[i] = (f32x4r){0.f, 0.f, 0.f, 0.f}; KV[i] = A0[i];
#pragma unroll
                for (int k2 = 0; k2 < 2; ++k2) { const bf16x8 vf = ldfrag(L, R_VT, 16 * vt, 32 * k2, r, g);
                    A0[i] = MF16(ldfrag(L, R_AAK, 16 * i, 32 * k2, r, g), vf, A0[i]); KV[i] = MF16(ldfrag(L, R_KT, 16 * i, 32 * k2, r, g), vf, KV[i]); } }
        }
        WGBAR();
        }
        STAMP(7);
        RELANE();
        f32x4r Usv[4];
#pragma unroll
        for (int i = 0; i < 4; ++i) Usv[i] = A0[i];
        for (int rep3_ = 0; rep3_ < REP_S3; ++rep3_) {
#pragma unroll
          for (int i = 0; i < 4; ++i) A0[i] = Usv[i];
        { f32x4r X[4];
          if (w < 4) {
#pragma unroll
              for (int i = 0; i < 4; ++i) { const v2u a2 = *(const LAS v2u*)(L + R_AT + (16 * w + r) * RS + (16 * i + 4 * g) * 2); X[i] = (f32x4r){bflo(a2.x), bfhi(a2.x), bflo(a2.y), bfhi(a2.y)}; }
          } else {
#pragma unroll
              for (int i = 0; i < 4; ++i) X[i] = A0[i];
          }
          const f32x4r z4 = (f32x4r){0.f, 0.f, 0.f, 0.f};
#define TIF(i) ld2x4(L, R_TI + (16 * (i) + r) * TIS + 8 * g, R_TI + (16 * (i) + r) * TIS + 8 * g)
#define ABF(i, j0) ld2x4(L, R_AAB + (16 * (i) + r) * RS + (16 * (j0) + 4 * g) * 2, R_AAB + (16 * (i) + r) * RS + (16 * ((j0) + 1) + 4 * g) * 2)
          X[0] = MF16(TIF(0), pack1(X[0]), z4);
          X[1] = MF16(ABF(1, 0), pack1(X[0]), X[1]); X[1] = MF16(TIF(1), pack1(X[1]), z4);
          X[2] = MF16(ABF(2, 0), pack2(X[0], X[1]), X[2]); X[2] = MF16(TIF(2), pack1(X[2]), z4);
          X[3] = MF16(ABF(3, 0), pack2(X[0], X[1]), X[3]); X[3] = MF16(ABF(3, 2), pack1(X[2]), X[3]); X[3] = MF16(TIF(3), pack1(X[3]), z4);
#undef TIF
#undef ABF
          if (w < 4) {
#pragma unroll
              for (int i = 0; i < 4; ++i) storeT(L, R_BW, X[i], 16 * i, 16 * w, r, g);
          } else {
#pragma unroll
              for (int i = 0; i < 4; ++i) A0[i] = X[i];
          } }
        WGBAR();
        }
        STAMP(8);
        RELANE();
        f32x4r Ysv[4], Hsv[4];
#pragma unroll
        for (int i = 0; i < 4; ++i) { Ysv[i] = A0[i]; Hsv[i] = Hs[i]; }
        for (int rep4_ = 0; rep4_ < REP_S45; ++rep4_) {
#pragma unroll
        for (int i = 0; i < 4; ++i) { A0[i] = Ysv[i]; Hs[i] = Hsv[i]; }
        if (w < 4) {
            if (w == 0) {
#pragma unroll
                for (int i = 0; i < 4; ++i) { A0[i] = (f32x4r){0.f, 0.f, 0.f, 0.f};
#pragma unroll
                    for (int k2 = 0; k2 < 2; ++k2) A0[i] = MF16(ldfrag(L, R_VT, 0, 32 * k2, r, g), ldfrag(L, R_ARK, 16 * i, 32 * k2, r, g), A0[i]); } }
#pragma unroll
            for (int i = 0; i < 4; ++i)
#pragma unroll
                for (int k2 = 0; k2 < 2; ++k2) A0[i] = MF16(ldfrag(L, R_HT, 16 * vt, 32 * k2, r, g), ldfragT(L, R_RT, 16 * i, 32 * k2, lane), A0[i]);
        } else {
#pragma unroll
            for (int i = 0; i < 4; ++i) {
#pragma unroll
                for (int k2 = 0; k2 < 2; ++k2) A0[i] = MF16(ldfragT(L, R_BW, 16 * i, 32 * k2, lane), ldfrag(L, R_HT, 16 * vt, 32 * k2, r, g), A0[i]);
                storeT(L, R_KU, A0[i], 16 * i, 16 * vt, r, g); }
        }
        WGBAR();
        STAMP(9);
        RELANE();
        if (w < 4) {
#pragma unroll
            for (int i = 0; i < 4; ++i) {
#pragma unroll
                for (int k2 = 0; k2 < 2; ++k2) A0[i] = MF16(ldfrag(L, R_KU, 16 * vt, 32 * k2, r, g), ldfrag(L, R_ARB, 16 * i, 32 * k2, r, g), A0[i]);
                const int s = c * 64 + 16 * i + r, t = d ? T - 1 - s : s; v2u yw; yw.x = cvtpk(A0[i][0], A0[i][1]); yw.y = cvtpk(A0[i][2], A0[i][3]);
                *(v2u*)(ybuf + (size_t)(b * T + t) * A_W + hd * 64 + 16 * vt + 4 * g) = yw; }
        } else {
#pragma unroll
            for (int i = 0; i < 4; ++i) { f32x4r acc = Hs[i] + KV[i];
#pragma unroll
                for (int k2 = 0; k2 < 2; ++k2) acc = MF16(ldfrag(L, R_BT, 16 * i, 32 * k2, r, g), ldfrag(L, R_KU, 16 * vt, 32 * k2, r, g), acc);
                const f32x4r pc = *(const LAS f32x4r*)(L + R_PC + (16 * i + 4 * g) * 4);
                Hs[i] = acc * pc; storeT(L, R_HT, Hs[i], 16 * i, 16 * vt, r, g); }
        }
        WGBAR();
        if (rep4_ + 1 < REP_S45) {
#pragma unroll
            for (int i = 0; i < 4; ++i) if (w >= 4) storeT(L, R_HT, Hsv[i], 16 * i, 16 * vt, r, g);
            WGBAR(); }
        }
        STAMP(10);
    }
#ifdef PROBE_TA
    if (blockIdx.x == 0 && (F.wave * 64 + lane_id()) == 0) { float* pf = (float*)(F.ws + WS_CTL + 32768); pf[0] = (float)((double)pt_sel / (double)(__builtin_amdgcn_s_memtime() - pt_t0)); }
#endif
#undef RELANE
#undef tc
#undef O_R
#undef O_W
#undef PSEL
}
__device__ __forceinline__ void rwkv_post(Frame& F) {
    const bf16* pa = (const bf16*)(F.ws + WS_PA); const bf16* y0 = (const bf16*)(F.ws + WS_Y); const bf16* y1 = y0 + (size_t)M * A_W;
    const float* bon0 = (const float*)(F.ws + WS_BON); const float* bon1 = bon0 + (size_t)M * 8;
    const int ko = kopaque(); const float *lnx_w = kin(I_LNW, ko), *lnx_b = kin(I_LNB, ko), *mu_ = kin(I_MU, ko);
    int lane = lane_id(); asm volatile("" : "+v"(lane));
    const int gw = F.vcu * NWAVES + F.wave, NGW = F.G * NWAVES, hd = lane >> 3, c0 = lane * 8;
    float lw_[8], lb_[8], mv0[8], mv1[8], mg0[8], mg1[8];
#pragma unroll
    for (int e = 0; e < 8; ++e) { lw_[e] = lnx_w[c0 + e]; lb_[e] = lnx_b[c0 + e]; mv0[e] = mu_[2 * A_W + c0 + e]; mv1[e] = mu_[A_COLS + 2 * A_W + c0 + e];
        mg0[e] = mu_[3 * A_W + c0 + e]; mg1[e] = mu_[A_COLS + 3 * A_W + c0 + e]; }
    for (int m = gw; m < M; m += NGW) {
        const int t = m & (T - 1); const bool hp = t > 0, hn = t < T - 1;
        const v4u a = *(const v4u*)(y0 + (size_t)m * A_W + c0), bq = *(const v4u*)(y1 + (size_t)m * A_W + c0);
        const bf16* p0 = pa + (size_t)m * A_COLS;
        const v4u vc = *(const v4u*)(p0 + 2 * A_W + c0), gc = *(const v4u*)(p0 + 3 * A_W + c0);
        const v4u z = (v4u){0u, 0u, 0u, 0u};
        const v4u vp = hp ? *(const v4u*)(p0 - A_COLS + 2 * A_W + c0) : z, gp = hp ? *(const v4u*)(p0 - A_COLS + 3 * A_W + c0) : z;
        const v4u vn = hn ? *(const v4u*)(p0 + A_COLS + 2 * A_W + c0) : z, gn = hn ? *(const v4u*)(p0 + A_COLS + 3 * A_W + c0) : z;
        const float bsum = bon0[(size_t)m * 8 + hd] + bon1[(size_t)m * 8 + hd];
        float y[8]; const unsigned aw[4] = {a.x, a.y, a.z, a.w}, bw[4] = {bq.x, bq.y, bq.z, bq.w};
        float s1 = 0.f;
#pragma unroll
        for (int e = 0; e < 4; ++e) { y[2 * e] = bflo(aw[e]) + bflo(bw[e]); y[2 * e + 1] = bfhi(aw[e]) + bfhi(bw[e]); s1 += y[2 * e] + y[2 * e + 1]; }
        s1 += dppf<0xB1>(s1); s1 += dppf<0x4E>(s1); s1 += dppf<0x141>(s1);
        const float mean = s1 * (1.f / 64.f); float s2 = 0.f;
#pragma unroll
        for (int e = 0; e < 8; ++e) { y[e] -= mean; s2 += y[e] * y[e]; }
        s2 += dppf<0xB1>(s2); s2 += dppf<0x4E>(s2); s2 += dppf<0x141>(s2);
        const float rstd = __builtin_amdgcn_rsqf(s2 * (1.f / 64.f) + GN_EPS);
        const unsigned vcw[4] = {vc.x, vc.y, vc.z, vc.w}, vpw[4] = {vp.x, vp.y, vp.z, vp.w}, vnw[4] = {vn.x, vn.y, vn.z, vn.w}, gcw[4] = {gc.x, gc.y, gc.z, gc.w}, gpw[4] = {gp.x, gp.y, gp.z, gp.w}, gnw[4] = {gn.x, gn.y, gn.z, gn.w};
        float o[8];
#pragma unroll
        for (int e = 0; e < 8; ++e) { const int k = e >> 1; const bool hi = e & 1;
            const float v0 = hi ? bfhi(vcw[k]) : bflo(vcw[k]), vm = hi ? bfhi(vpw[k]) : bflo(vpw[k]), vx = hi ? bfhi(vnw[k]) : bflo(vnw[k]);
            const float g0 = hi ? bfhi(gcw[k]) : bflo(gcw[k]), gm = hi ? bfhi(gpw[k]) : bflo(gpw[k]), gx = hi ? bfhi(gnw[k]) : bflo(gnw[k]);
            const float vs = v0 * (1.f - mv0[e] - mv1[e]) + mv0[e] * vm + mv1[e] * vx, gs = g0 * (1.f - mg0[e] - mg1[e]) + mg0[e] * gm + mg1[e] * gx;
            o[e] = (y[e] * rstd * lw_[e] + lb_[e] + bsum * vs) * siluf_(gs); }
        v4u ov; ov.x = cvtpk(o[0], o[1]); ov.y = cvtpk(o[2], o[3]); ov.z = cvtpk(o[4], o[5]); ov.w = cvtpk(o[6], o[7]);
        *(v4u*)(F.out + (size_t)m * OROW + OS_YA + c0 * 2) = ov;
    }
}
struct Args { const float* in[24]; unsigned char* out; unsigned char* ws; };
__global__ void __launch_bounds__(NWAVES * 64, 2) hybrid_fwd(Args args) {
    extern __shared__ __attribute__((aligned(16))) unsigned char lds[];
    Frame F;
    F.lds = (LAS unsigned char*)lds;
    F.MISC = (volatile LAS unsigned*)(F.lds + MISC_OFF);
    F.wave = __builtin_amdgcn_readfirstlane((int)threadIdx.x >> 6);
    F.G = gridDim.x; { const int bx = blockIdx.x; F.vcu = (F.G % 8 == 0) ? (bx % 8) * (F.G / 8) + bx / 8 : bx; }
    F.out = args.out; F.ws = args.ws;
    for (int u = (F.wave * 64 + lane_id()); u < (LDS_BYTES - LDSCTL_OFF) / 4; u += NWAVES * 64) ((LAS unsigned*)(F.lds + LDSCTL_OFF))[u] = 0u;
    __syncthreads();
    XcdBarrier bar = xcd_barrier_post((unsigned*)(F.ws + WS_CTL) + CW_BAR, F.MISC + 8);
#define GRID_BAR() xcd_barrier(bar, F.wave)
#ifdef PROBE_G
#define PGDBG(k) ((k) == PROBE_GSEL ? (float*)(F.ws + WS_CTL + 32768) : (float*)nullptr)
#else
#define PGDBG(k) ((float*)nullptr)
#endif
    typedef pg8::bf16_t bt;
    p0a(F); GRID_BAR();
    p0b(F); GRID_BAR();
    { pg8::Gemm g{(const bt*)(F.out + OS_H), (const bt*)(F.ws + WS_WB), nullptr, nullptr, OROW / 2, D}; pg8::Order S; S.init(M, B_COLS, F.G, (int)blockIdx.x, 1);
      const int ko = kopaque(); pg8::EpiPB E{(bt*)(F.ws + WS_R), kin(I_QG, ko), kin(I_KG, ko), (LAS float*)(F.lds + EPI_OFF), PGDBG(0)};
      pg8::gemm_phase<pg8::EpiPB, pg8::Order, true, true>(F.lds + RING_OFF, g, S, E, F.wave); }
    GRID_BAR();
    attn_mfma(F); GRID_BAR();
    attn_combine(F); GRID_BAR();
    { pg8::Gemm g{(const bt*)(F.out + OS_H), (const bt*)(F.ws + WS_WAG), nullptr, nullptr, OROW / 2, D}; pg8::Order S; S.init(M, A_COLS + PGM * 256, F.G, (int)blockIdx.x, 1);
      pg8::EpiAG E{(bt*)(F.ws + WS_PA), (bt*)(F.ws + WS_PG), PGDBG(1)};
      pg8::gemm_phase<pg8::EpiAG, pg8::Order, true, true>(F.lds + RING_OFF, g, S, E, F.wave); }
    GRID_BAR();
#ifdef PROBE_RT
    const unsigned long long prt0 = __builtin_amdgcn_s_memrealtime();
#endif
    if (blockIdx.x < NCHAIN || F.G <= NCHAIN) rwkv_chunked(F);
    if ((blockIdx.x >= NCHAIN && blockIdx.x < NCHAIN + NSIDE) || F.G <= NCHAIN) {
        const int Gs = F.G > NCHAIN ? (F.G - NCHAIN < NSIDE ? F.G - NCHAIN : NSIDE) : F.G, cs = F.G > NCHAIN ? (int)blockIdx.x - NCHAIN : (int)blockIdx.x;
        pg8::Gemm g{(const bt*)(F.out + OS_H), (const bt*)(F.ws + WS_WAG) + (size_t)(A_COLS + PGM * 256) * D, nullptr, nullptr, OROW / 2, D}; pg8::Order S; S.init(M, G_COLS - PGM * 256, Gs, cs, 1);
        pg8::EpiPG E{(bt*)(F.ws + WS_PG) + PGM * 256, PGDBG(4)};
        pg8::gemm_phase<pg8::EpiPG, pg8::Order, true, true>(F.lds + RING_OFF, g, S, E, F.wave); }
#ifdef PROBE_RT
    if (blockIdx.x == 0 && threadIdx.x == 0) ((float*)(F.ws + WS_CTL + 32768))[2] = (float)(__builtin_amdgcn_s_memrealtime() - prt0);
    if (blockIdx.x == PROBE_RT && threadIdx.x == 0) ((float*)(F.ws + WS_CTL + 32768))[3] = (float)(__builtin_amdgcn_s_memrealtime() - prt0);
#endif
    GRID_BAR();
    rwkv_post(F); GRID_BAR();
    { pg8::Gemm g{(const bt*)(F.out + OS_YA), (const bt*)(F.ws + WS_WOA), (const bt*)(F.out + OS_YB), (const bt*)(F.ws + WS_WOB), OROW / 2, A_W}; pg8::Order S; S.init(M, D, F.G, (int)blockIdx.x, 2);
      pg8::EpiMerge E{(const bt*)(F.ws + WS_PG), (bt*)(F.ws + WS_Y), PGDBG(2)};
      pg8::gemm_phase<pg8::EpiMerge, pg8::Order, true, true>(F.lds + RING_OFF, g, S, E, F.wave); }
    GRID_BAR();
    { pg8::Gemm g{(const bt*)(F.ws + WS_Y), (const bt*)(F.ws + WS_WO), nullptr, nullptr, D, D}; pg8::Order S; S.init(M, D, F.G, (int)blockIdx.x, 1);
      const int ko = kopaque(); pg8::EpiOut E{kin(I_XP, ko), kin(I_XS, ko), (const float*)(F.ws + WS_MOD), (float*)F.out, PGDBG(3)};
      pg8::gemm_phase<pg8::EpiOut, pg8::Order, true, true>(F.lds + RING_OFF, g, S, E, F.wave); }
#if defined(PROBE_TA) || defined(PROBE_G) || defined(PROBE_AT) || defined(PROBE_RT)
    GRID_BAR();
#ifdef PROBE_RT
    { const float* pf_ = (const float*)(F.ws + WS_CTL + 32768); const float f = 0.5f * pf_[3] / pf_[2]; float* o = (float*)F.out;
#else
    { const float f = ((const float*)(F.ws + WS_CTL + 32768))[0]; float* o = (float*)F.out;
#endif
      for (int i = blockIdx.x * 512 + (F.wave * 64 + lane_id()); i < 655 * 1024; i += gridDim.x * 512) o[i] *= (1.f + f); }
#endif
}

extern "C" void kernel_launch(void* const* d_in, const int* in_sizes, int n_in, void* d_out, int out_size, void* d_ws, size_t ws_size, hipStream_t stream) {
    static int grid = 0;
    if (grid == 0) {
        if (n_in != 24 || out_size != M * D || ws_size < WS_END) { fprintf(stderr, "kernel_launch: unexpected shapes: n_in %d out %d ws %zu (need %zu)\n", n_in, out_size, ws_size, (size_t)WS_END); grid = -1; return; }
        int dev = 0, cus = 0, per_cu = 0;
        if (hipGetDevice(&dev) != hipSuccess || hipDeviceGetAttribute(&cus, hipDeviceAttributeMultiprocessorCount, dev) != hipSuccess) { grid = -1; return; }
        if (hipFuncSetAttribute((const void*)hybrid_fwd, hipFuncAttributeMaxDynamicSharedMemorySize, LDS_BYTES) != hipSuccess) { fprintf(stderr, "kernel_launch: hipFuncSetAttribute failed\n"); grid = -1; return; }
        if (hipOccupancyMaxActiveBlocksPerMultiprocessor(&per_cu, (const void*)hybrid_fwd, NWAVES * 64, LDS_BYTES) != hipSuccess || per_cu < 1) { fprintf(stderr, "kernel_launch: occupancy query says %d\n", per_cu); }
        (void)hipGetLastError();
        grid = cus;
    }
    if (grid < 0) return;
    if (hipMemsetAsync((char*)d_ws + WS_CTL, 0, CTL_ZERO_BYTES, stream) != hipSuccess) return;
    Args a{};
    for (int i = 0; i < 24; ++i) a.in[i] = (const float*)d_in[i];
    a.out = (unsigned char*)d_out; a.ws = (unsigned char*)d_ws;
    hipLaunchKernelGGL(hybrid_fwd, dim3(grid), dim3(NWAVES * 64), LDS_BYTES, stream, a);
}
```

```cpp
#include <hip/hip_runtime.h>
#include <cstdio>
#include <cstdint>
__device__ __forceinline__ int lane_id() { unsigned m = ~0u; asm volatile("" : "+s"(m) :: "memory"); return (int)__builtin_amdgcn_mbcnt_hi(m, __builtin_amdgcn_mbcnt_lo(m, 0u)); }
namespace pg8 {
#define PG8_LAS __attribute__((address_space(3)))
typedef unsigned short bf16_t;
typedef short bf16x8 __attribute__((ext_vector_type(8)));
typedef float f32x4 __attribute__((ext_vector_type(4)));
typedef unsigned u32x4 __attribute__((ext_vector_type(4)));
constexpr int BM = 256, BK = 64, HALF = 128, HTB = HALF * BK * 2  , STAGE_BYTES = 8 * HTB, NXCD = 8, WGM = 8;

__host__ __device__ __forceinline__ int lds_byte(int r, int c) { const int st = (r >> 4) * 2 + (c >> 5), rr = r & 15, cc = c & 31, ob = rr * 64 + cc * 2; return st * 1024 + (ob ^ (((ob >> 9) & 1) << 5)); }
__host__ __device__ __forceinline__ void stage_rc(int b, int& R, int& C) { const int st = b / 1024, sb = b % 1024, swz = sb ^ (((sb >> 9) & 1) << 5); R = (st >> 1) * 16 + swz / 64; C = (st & 1) * 32 + (swz % 64) / 2; }
__host__ __device__ __forceinline__ int perm32(int rho) { const int n = rho >> 4, i = rho & 15; return 8 * (i >> 2) + 4 * n + (i & 3); }

struct Unit { int pm, pn, sel; };
struct Gemm { const bf16_t* A0; const bf16_t* B0; const bf16_t* A1; const bf16_t* B1; int lda; int K; };

struct Order {
    int nM, nN, nwg, G, c, CH;
    __host__ __device__ void init(int M, int N, int G_, int c_, int CH_) { nM = M / BM; nN = N / BM; nwg = nM * nN; G = G_; c = c_; CH = CH_; }
    __host__ __device__ bool next(int i, Unit& u) const {
        const int ti = (CH == 2) ? (i >> 1) : i; u.sel = (CH == 2) ? (i & 1) : 0;
        const long L = (long)ti * G + c; if (L >= nwg) return false;
        int wgid = (int)L; { const int q = nwg / NXCD, r = nwg % NXCD, xcd = wgid % NXCD, off = wgid / NXCD; wgid = (xcd < r ? xcd * (q + 1) : r * (q + 1) + (xcd - r) * q) + off; }
        const int nig = WGM * nN, gid = wgid / nig, fm = gid * WGM, gsz = (nM - fm) < WGM ? (nM - fm) : WGM;
        u.pm = fm + ((wgid % nig) % gsz); u.pn = (wgid % nig) / gsz; return true;
    }
};
__device__ __forceinline__ unsigned cvt_pk_bf16(float lo, float hi) { unsigned r; asm volatile("v_cvt_pk_bf16_f32 %0, %1, %2" : "=v"(r) : "v"(lo), "v"(hi)); return r; }
template <class Epi, class Sched, bool ALIGN_EPI = false, bool SP2 = false>
__device__ __forceinline__ void gemm_phase(PG8_LAS unsigned char* lds, const Gemm g, const Sched& S, const Epi& E, const int wave_id) {
    int tid = wave_id * 64 + lane_id(); asm volatile("" : "+v"(tid));
    const int wid = wave_id, lane = tid & 63, wr = wid >> 2, wc = wid & 3, fr = lane & 15, fq = lane >> 4;
    const int K = g.K, nt = K / BK;
    unsigned voffA[2], voffB[2];
#pragma unroll
    for (int i = 0; i < 2; ++i) { int R, C; stage_rc(tid * 16 + i * 8192, R, C); const int Rb = Epi::PERM ? ((R & ~31) + perm32(R & 31)) : R;
        voffA[i] = (unsigned)(R * g.lda + C) * 2u; voffB[i] = (unsigned)(Rb * K + C) * 2u; }
    const size_t kstep = (size_t)(BK * 2);
    const size_t hstepA = (size_t)HALF * g.lda * 2, hstepB = (size_t)HALF * K * 2;
    const size_t tstepA = 2 * hstepA, tstepB = 2 * hstepB;
    const unsigned ldsw = (unsigned)wid * 1024u;
    const int aoff = lds_byte(wr * 64 + fr, fq * 8), boff = lds_byte(wc * 32 + fr, fq * 8);
#define PG8_SA(b, h) (((b) * 2 + (h)) * HTB)
#define PG8_SB(b, h) ((4 + (b) * 2 + (h)) * HTB)
#define PG8_STAGE(bufoff, gbase, voff) do { _Pragma("unroll") for (int _i = 0; _i < 2; ++_i) \
        __builtin_amdgcn_global_load_lds((const unsigned*)((const char*)(gbase) + (voff)[_i]), (PG8_LAS unsigned*)(lds + (bufoff) + ldsw + _i * 8192), 16, 0, 0); } while (0)
#define PG8_LDA(dst, b, h) do { _Pragma("unroll") for (int m = 0; m < 4; ++m) _Pragma("unroll") for (int k = 0; k < 2; ++k) dst[m][k] = *(const PG8_LAS bf16x8*)(lds + PG8_SA(b, h) + aoff + m * 2048 + k * 1024); } while (0)
#define PG8_LDB(dst, b, h) do { _Pragma("unroll") for (int n = 0; n < 2; ++n) _Pragma("unroll") for (int k = 0; k < 2; ++k) dst[n][k] = *(const PG8_LAS bf16x8*)(lds + PG8_SB(b, h) + boff + n * 2048 + k * 1024); } while (0)
#define PG8_MMA(ai, bj, At, Bt) do { __builtin_amdgcn_s_setprio(1); _Pragma("unroll") for (int m = 0; m < 4; ++m) _Pragma("unroll") for (int n = 0; n < 2; ++n) _Pragma("unroll") for (int k = 0; k < 2; ++k) \
        acc[ai][bj][m][n] = __builtin_amdgcn_mfma_f32_16x16x32_bf16(Bt[n][k], At[m][k], acc[ai][bj][m][n], 0, 0, 0); __builtin_amdgcn_s_setprio(0); } while (0)
#define PG8_APTR(u) ((const char*)((u).sel ? g.A1 : g.A0) + (size_t)(u).pm * tstepA)
#define PG8_BPTR(u) ((const char*)((u).sel ? g.B1 : g.B0) + (size_t)(u).pn * tstepB)
#define PG8_WAIT_V(n) asm volatile("s_waitcnt vmcnt(" #n ")" ::: "memory")
#define PG8_WAIT_L(n) asm volatile("s_waitcnt lgkmcnt(" #n ")" ::: "memory")
#define PG8_BAR __builtin_amdgcn_s_barrier()
#define PG8_SCHED __builtin_amdgcn_sched_barrier(0)
    Unit cur, nxt; int ui = 0;
    if (!S.next(0, cur)) return;
#ifdef PROBE_G
    unsigned long long pg_epi = 0; const unsigned long long pg_start = __builtin_amdgcn_s_memtime();
#endif
    f32x4 acc[2][2][4][2];
#pragma unroll
    for (int a = 0; a < 2; ++a)
#pragma unroll
        for (int b = 0; b < 2; ++b)
#pragma unroll
            for (int m = 0; m < 4; ++m)
#pragma unroll
                for (int n = 0; n < 2; ++n) acc[a][b][m][n] = (f32x4){0.f, 0.f, 0.f, 0.f};
    bf16x8 At[4][2], B0[2][2], B1[2][2];
    const char* cA = PG8_APTR(cur); const char* cB = PG8_BPTR(cur);
    if constexpr (SP2) {
        PG8_STAGE(PG8_SB(0, 0), cB, voffB); PG8_STAGE(PG8_SB(0, 1), cB + hstepB, voffB); PG8_STAGE(PG8_SA(0, 0), cA, voffA); PG8_STAGE(PG8_SA(0, 1), cA + hstepA, voffA);
        if (wr == 1) PG8_BAR;
        PG8_WAIT_V(2); PG8_BAR;
        PG8_STAGE(PG8_SB(1, 0), cB + kstep, voffB); PG8_STAGE(PG8_SA(1, 0), cA + kstep, voffA); PG8_STAGE(PG8_SB(1, 1), cB + hstepB + kstep, voffB);
        PG8_WAIT_V(6); PG8_BAR;
    } else {
        PG8_STAGE(PG8_SB(0, 0), cB, voffB); PG8_STAGE(PG8_SA(0, 0), cA, voffA); PG8_STAGE(PG8_SB(0, 1), cB + hstepB, voffB); PG8_STAGE(PG8_SA(0, 1), cA + hstepA, voffA);
        if (wr == 1) PG8_BAR;
        PG8_WAIT_V(4); PG8_BAR;
        PG8_STAGE(PG8_SB(1, 0), cB + kstep, voffB); PG8_STAGE(PG8_SA(1, 0), cA + kstep, voffA); PG8_STAGE(PG8_SB(1, 1), cB + hstepB + kstep, voffB);
        PG8_WAIT_V(6); PG8_BAR;
    }
    for (;;) {
        const bool has_next = S.next(ui + 1, nxt);
        const char* nA = has_next ? PG8_APTR(nxt) : cA; const char* nB = has_next ? PG8_BPTR(nxt) : cB;
        for (int t = 0; t < nt; t += 2) {
            const bool last = (t == nt - 2);
            const char* a1 = cA + (size_t)(t + 1) * kstep;
            const char* a2 = last ? nA : cA + (size_t)(t + 2) * kstep; const char* b2 = last ? nB : cB + (size_t)(t + 2) * kstep;
            const char* a3 = a2 + kstep; const char* b3 = b2 + kstep;
            if constexpr (SP2) {
            PG8_LDB(B0, 0, 0); PG8_LDB(B1, 0, 1); PG8_SCHED; PG8_LDA(At, 0, 0); PG8_STAGE(PG8_SA(1, 1), a1 + hstepA, voffA);
            PG8_WAIT_V(8); PG8_WAIT_L(0); PG8_BAR; PG8_MMA(0, 0, At, B0); PG8_MMA(0, 1, At, B1); PG8_BAR; PG8_SCHED;
            PG8_LDA(At, 0, 1); PG8_STAGE(PG8_SB(0, 0), b2, voffB); PG8_STAGE(PG8_SB(0, 1), b2 + hstepB, voffB); PG8_STAGE(PG8_SA(0, 0), a2, voffA);
            PG8_WAIT_V(8); PG8_WAIT_L(0); PG8_BAR; PG8_MMA(1, 0, At, B0); PG8_MMA(1, 1, At, B1); PG8_BAR; PG8_SCHED;
            PG8_LDB(B0, 1, 0); PG8_LDB(B1, 1, 1); PG8_SCHED; PG8_LDA(At, 1, 0); PG8_STAGE(PG8_SA(0, 1), a2 + hstepA, voffA);
            PG8_WAIT_V(8); PG8_WAIT_L(0); PG8_BAR; PG8_MMA(0, 0, At, B0); PG8_MMA(0, 1, At, B1); PG8_BAR; PG8_SCHED;
            PG8_LDA(At, 1, 1); PG8_STAGE(PG8_SB(1, 0), b3, voffB); PG8_STAGE(PG8_SB(1, 1), b3 + hstepB, voffB); PG8_STAGE(PG8_SA(1, 0), a3, voffA);
            PG8_WAIT_V(8); PG8_WAIT_L(0); PG8_BAR; PG8_MMA(1, 0, At, B0); PG8_MMA(1, 1, At, B1); PG8_BAR; PG8_SCHED;
            } else {
            PG8_LDB(B0, 0, 0); PG8_SCHED; PG8_LDA(At, 0, 0); PG8_STAGE(PG8_SA(1, 1), a1 + hstepA, voffA);
            PG8_WAIT_L(8); PG8_BAR; PG8_WAIT_L(0); PG8_MMA(0, 0, At, B0); PG8_BAR; PG8_SCHED;
            PG8_LDB(B1, 0, 1); PG8_STAGE(PG8_SB(0, 0), b2, voffB);
            PG8_BAR; PG8_WAIT_L(0); PG8_MMA(0, 1, At, B1); PG8_BAR;
            PG8_LDA(At, 0, 1); PG8_STAGE(PG8_SA(0, 0), a2, voffA);
            PG8_BAR; PG8_WAIT_L(0); PG8_MMA(1, 0, At, B0); PG8_BAR; PG8_SCHED;
            PG8_STAGE(PG8_SB(0, 1), b2 + hstepB, voffB);
            PG8_WAIT_V(6); PG8_BAR; PG8_MMA(1, 1, At, B1); PG8_BAR;
            PG8_LDB(B0, 1, 0); PG8_SCHED; PG8_LDA(At, 1, 0); PG8_STAGE(PG8_SA(0, 1), a2 + hstepA, voffA);
            PG8_WAIT_L(8); PG8_BAR; PG8_WAIT_L(0); PG8_MMA(0, 0, At, B0); PG8_BAR; PG8_SCHED;
            PG8_LDB(B1, 1, 1); PG8_STAGE(PG8_SB(1, 0), b3, voffB);
            PG8_BAR; PG8_WAIT_L(0); PG8_MMA(0, 1, At, B1); PG8_BAR;
            PG8_LDA(At, 1, 1); PG8_STAGE(PG8_SA(1, 0), a3, voffA);
            PG8_BAR; PG8_WAIT_L(0); PG8_MMA(1, 0, At, B0); PG8_BAR; PG8_SCHED;
            PG8_STAGE(PG8_SB(1, 1), b3 + hstepB, voffB);
            PG8_WAIT_V(6); PG8_BAR; PG8_MMA(1, 1, At, B1); PG8_BAR;
            }
        }
        if constexpr (ALIGN_EPI) { if (wr == 0) PG8_BAR; }
#ifdef PROBE_G
        const unsigned long long pg_t0 = __builtin_amdgcn_s_memtime();
#endif
        const bool keep = E(acc, cur, wr, wc, fr, fq);
#ifdef PROBE_G
        pg_epi += __builtin_amdgcn_s_memtime() - pg_t0;
#endif
        if (!has_next) break;
        if (!keep) {
#pragma unroll
        for (int a = 0; a < 2; ++a)
#pragma unroll
            for (int b = 0; b < 2; ++b)
#pragma unroll
                for (int m = 0; m < 4; ++m)
#pragma unroll
                    for (int n = 0; n < 2; ++n) acc[a][b][m][n] = (f32x4){0.f, 0.f, 0.f, 0.f};
        }
        cur = nxt; cA = nA; cB = nB; ++ui;
        if constexpr (ALIGN_EPI) { if (wr == 1) PG8_BAR; }
    }
#ifdef PROBE_G
    if (E.dbg && blockIdx.x == 0 && threadIdx.x == 0) { const double tot = (double)(__builtin_amdgcn_s_memtime() - pg_start);
        E.dbg[0] = (PROBE_G == 1) ? (float)(tot / (double)(ui + 1) / 262144.0) : (float)((double)pg_epi / tot); }
#endif
    PG8_WAIT_V(0);
    if constexpr (!ALIGN_EPI) { if (wr == 0) PG8_BAR; }
    PG8_BAR;
#undef PG8_SA
#undef PG8_SB
#undef PG8_STAGE
#undef PG8_LDA
#undef PG8_LDB
#undef PG8_MMA
#undef PG8_APTR
#undef PG8_BPTR
#undef PG8_WAIT_V
#undef PG8_WAIT_L
#undef PG8_BAR
#undef PG8_SCHED
}
}

constexpr int NWAVES = 8;
constexpr int T = 8192, D = 1024, NBP = 8, NBS = 2, NB = NBP + NBS, M = NB * T;
constexpr int NCHAIN = 160, NSIDE = 64;
#ifndef PG_MAIN_TILES
#define PG_MAIN_TILES 0
#endif
constexpr int PGM = PG_MAIN_TILES;
constexpr int A_HEADS = 8, A_HD = 64, A_W = 512, RANK = 64;
constexpr int A_COLS = 2304, B_COLS = 5120, G_COLS = 2048, IN_COLS = 9472, AG_COLS = A_COLS + G_COLS;
constexpr int B_QKV = 1536, B_W = 512, B_HD = 128;
constexpr float RMS_EPS = 1e-6f, GN_EPS = 64e-5f;
constexpr size_t MiB = 1u << 20;
constexpr size_t WS_CTL = 0, CTL_ZERO_BYTES = 65536;
constexpr size_t WS_MOD = 1 * MiB;
constexpr size_t WS_BTAB = 1 * MiB + 128 * 1024;
constexpr size_t WS_WB = 2 * MiB;
constexpr size_t WS_WAG = 12 * MiB;
constexpr size_t WS_WOA = 21 * MiB, WS_WOB = 22 * MiB, WS_WO = 23 * MiB;
constexpr size_t WS_BON = 26 * MiB;
constexpr size_t WS_R = 32 * MiB;
constexpr size_t WS_PA = WS_R, WS_PG = WS_R + 360 * MiB;
constexpr size_t WS_Y = 832 * MiB;
constexpr size_t WS_END = 992 * MiB;
constexpr int CW_BAR = 4096;
constexpr int OS_H = 0, OS_YA = 2048, OS_YB = 3072, OROW = 4096;
constexpr int RING_OFF = 0, RING_BYTES = 131072;
constexpr int LDSCTL_OFF = RING_BYTES, MISC_OFF = LDSCTL_OFF + 320;
constexpr int EPI_OFF = RING_BYTES + 1024;
constexpr int LDS_BYTES = 147456;

#define GAS __attribute__((address_space(1)))
#define LAS __attribute__((address_space(3)))
typedef unsigned short bf16;
typedef unsigned v4u __attribute__((ext_vector_type(4)));
typedef unsigned v2u __attribute__((ext_vector_type(2)));
typedef float f32x4 __attribute__((ext_vector_type(4)));
typedef short bf16x8 __attribute__((ext_vector_type(8)));
typedef GAS unsigned gu32;
#define RLX_AGENT __ATOMIC_RELAXED, __HIP_MEMORY_SCOPE_AGENT
#define LDS_WAIT() asm volatile("s_waitcnt lgkmcnt(0)" ::: "memory")
#define VM_WAIT() asm volatile("s_waitcnt vmcnt(0)" ::: "memory")
__device__ __forceinline__ unsigned f2bf(float f) { unsigned u = __builtin_bit_cast(unsigned, f); return (u + 0x7fffu + ((u >> 16) & 1u)) >> 16; }
__device__ __forceinline__ unsigned pk2(float lo, float hi) { return f2bf(lo) | (f2bf(hi) << 16); }
typedef float f32x2_t __attribute__((ext_vector_type(2))); typedef __bf16 bf16x2_t __attribute__((ext_vector_type(2)));
__device__ __forceinline__ unsigned cvtpk(float lo, float hi) { f32x2_t v = {lo, hi}; bf16x2_t b = __builtin_convertvector(v, bf16x2_t); return __builtin_bit_cast(unsigned, b); }
__device__ __forceinline__ float bf2f(unsigned short h) { return __builtin_bit_cast(float, (unsigned)h << 16); }
__device__ __forceinline__ float bflo(unsigned w) { return __builtin_bit_cast(float, w << 16); }
__device__ __forceinline__ float bfhi(unsigned w) { return __builtin_bit_cast(float, w & 0xffff0000u); }
__device__ __forceinline__ float sigmoidf_(float v) { return __builtin_amdgcn_rcpf(1.f + __expf(-v)); }
__device__ __forceinline__ float siluf_(float v) { return v * sigmoidf_(v); }
__device__ __forceinline__ float wave_sum(float v) {
#pragma unroll
    for (int o = 1; o < 64; o <<= 1) v += __shfl_xor(v, o);
    return v;
}
__device__ __forceinline__ float wave_max(float v) {
#pragma unroll
    for (int o = 1; o < 64; o <<= 1) v = fmaxf(v, __shfl_xor(v, o));
    return v;
}

#define XB_TMO      128
#define XB_XCNT(j)  (256  + 64 * (j))
#define XB_XSUB(j)  (1280 + 64 * (j))
#define XB_XGEN(j)  (2304 + 64 * (j))
#define XB_TOP      3328
#define XB_TOPGEN   3392
#define XCD_BAR_WORDS 3456
#define XB_SPIN_CAP (1u << 22)
__device__ __forceinline__ unsigned xb_ld(unsigned* p)              { return __hip_atomic_load(p, __ATOMIC_RELAXED, __HIP_MEMORY_SCOPE_AGENT); }
__device__ __forceinline__ unsigned xb_add(unsigned* p, unsigned v) { return __hip_atomic_fetch_add(p, v, __ATOMIC_RELAXED, __HIP_MEMORY_SCOPE_AGENT); }
__device__ __forceinline__ unsigned xb_xcc_id() { return (unsigned)__builtin_amdgcn_s_getreg((3 << 11) | 20) & 0xFu; }
#define XB_SPIN(cond, bar) do { unsigned _sp = 0; while (cond) { __builtin_amdgcn_s_sleep(1); \
    if ((++_sp & 255u) == 0u) { if (xb_ld(&(bar)[XB_TMO])) break; if (_sp > XB_SPIN_CAP) { atomicAdd(&(bar)[XB_TMO], 1u); break; } } } } while (0)
struct XcdBarrier { unsigned* bar; unsigned x; volatile LAS unsigned* st; };
__device__ __forceinline__ XcdBarrier xcd_barrier_post(unsigned* bar, volatile LAS unsigned* st) {
    XcdBarrier b; b.bar = bar; b.x = xb_xcc_id(); b.st = st;
    if (threadIdx.x == 0) (void)xb_add(&bar[XB_XCNT(b.x)], 1u);
    return b;
}
__device__ __forceinline__ void xcd_barrier_complete(unsigned* bar, unsigned x, unsigned& nloc, unsigned& nx) {
    const unsigned G = gridDim.x * gridDim.y * gridDim.z;
    unsigned sum, cnt, mine, sp = 0u;
    for (;;) {
        sum = 0u; cnt = 0u; mine = 0u;
#pragma unroll
        for (unsigned j = 0; j < 16; ++j) { const unsigned c = xb_ld(&bar[XB_XCNT(j)]); sum += c; cnt += (c > 0u) ? 1u : 0u; mine = (j == x) ? c : mine; }
        if (sum == G) break;
        __builtin_amdgcn_s_sleep(1);
        if ((++sp & 255u) == 0u) { if (xb_ld(&bar[XB_TMO])) break; if (sp > XB_SPIN_CAP) { atomicAdd(&bar[XB_TMO], 1u); break; } }
    }
    nloc = mine > 0u ? mine : 1u; nx = cnt > 0u ? cnt : 1u;
}
__device__ __forceinline__ void xcd_barrier(const XcdBarrier& b, const int wave_id) {
    asm volatile("s_waitcnt vmcnt(0)" ::: "memory");
    __syncthreads();
    if (wave_id == 0 && lane_id() == 0) {
        unsigned* bar = b.bar;
        __builtin_amdgcn_s_waitcnt(0);
        unsigned nloc = b.st[0], nx = b.st[1];
        if (nloc == 0u) { xcd_barrier_complete(bar, b.x, nloc, nx); b.st[0] = nloc; b.st[1] = nx; }
        const unsigned old = xb_add(&bar[XB_XSUB(b.x)], 1u);
        const unsigned gen = old / nloc;
        if (old + 1u == (gen + 1u) * nloc) {
            __builtin_amdgcn_fence(__ATOMIC_RELEASE, "agent");
            asm volatile("s_waitcnt vmcnt(0)" ::: "memory");
            const unsigned og = xb_add(&bar[XB_TOP], 1u);
            const unsigned tg = og / nx;
            if (og + 1u == (tg + 1u) * nx) xb_add(&bar[XB_TOPGEN], 1u);
            else XB_SPIN(xb_ld(&bar[XB_TOPGEN]) == tg, bar);
            __builtin_amdgcn_fence(__ATOMIC_ACQUIRE, "agent");
            xb_add(&bar[XB_XGEN(b.x)], 1u);
            asm volatile("s_waitcnt vmcnt(0)" ::: "memory");
        } else {
            XB_SPIN(xb_ld(&bar[XB_XGEN(b.x)]) == gen, bar);
            __builtin_amdgcn_fence(__ATOMIC_ACQUIRE, "agent");
            asm volatile("s_waitcnt vmcnt(0)" ::: "memory");
        }
    }
    __syncthreads();
}

struct Frame {
    LAS unsigned char* lds;
    volatile LAS unsigned* MISC;
    int wave;
    __device__ __forceinline__ int lane_() const { return lane_id(); }
    int vcu, G;
    unsigned char* out;
    unsigned char* ws;
};
enum { I_XP = 0, I_XS, I_CP, I_CS, I_RELB, I_NORMW, I_WADA, I_BADA, I_WIN, I_MU, I_W0, I_W2, I_A0, I_A2, I_KK, I_KA, I_RK, I_LNW, I_LNB, I_QG, I_KG, I_WOA, I_WOB, I_WO };
__device__ __forceinline__ int kopaque() { int z = 0; asm volatile("" : "+s"(z)); return z; }
__device__ __forceinline__ const float* kin(int k, int kof) { return ((const float* const __attribute__((address_space(4)))*)__builtin_amdgcn_kernarg_segment_ptr())[k + kof]; }
__device__ __forceinline__ const float* xrow_ptr(const float* xp, const float* xs, int m) { return m < NBP * T ? xp + (size_t)m * D : xs + (size_t)(m - NBP * T) * D; }

namespace pg8 {
struct EpiPB {
    static constexpr bool PERM = true;
    bf16_t* O; const float* qg; const float* kg; PG8_LAS float* P; float* dbg;
    __device__ __forceinline__ bool operator()(f32x4 (&acc)[2][2][4][2], const Unit& u, int wr, int wc, int fr, int fq) const {
        const int row0 = u.pm * BM + wr * 64 + fr, col0 = u.pn * BM + wc * 32 + 8 * fq;
        if (u.pn < 12) {
#pragma unroll
            for (int ai = 0; ai < 2; ++ai)
#pragma unroll
                for (int m = 0; m < 4; ++m) {
#pragma unroll
                    for (int bj = 0; bj < 2; ++bj) { const f32x4 a = acc[ai][bj][m][0], b = acc[ai][bj][m][1];
                        float s = (a[0] * a[0] + a[1] * a[1]) + (a[2] * a[2] + a[3] * a[3]) + (b[0] * b[0] + b[1] * b[1]) + (b[2] * b[2] + b[3] * b[3]);
                        s += __shfl_xor(s, 16); s += __shfl_xor(s, 32);
                        if (fq == 0) P[((ai * HALF + wr * 64 + m * 16 + fr) * 2 + bj) * 4 + wc] = s; }
                    asm volatile("" ::: "memory"); }
            asm volatile("s_waitcnt lgkmcnt(0)" ::: "memory"); __builtin_amdgcn_s_barrier(); asm volatile("" ::: "memory");
            const bool isq = u.pn < 6; const float* gp = (isq ? qg : kg) + wc * 32 + 8 * fq; const float gs = isq ? 0.08838834764831845f * 1.4426950408889634f : 1.f;
            float gn[8];
#pragma unroll
            for (int e = 0; e < 8; ++e) gn[e] = gp[e] * gs;
#pragma unroll
            for (int ai = 0; ai < 2; ++ai)
#pragma unroll
                for (int m = 0; m < 4; ++m)
#pragma unroll
                    for (int bj = 0; bj < 2; ++bj) { const f32x4 p4 = *(const PG8_LAS f32x4*)(P + ((ai * HALF + wr * 64 + m * 16 + fr) * 2 + bj) * 4);
                        const float rs = 1.0f / sqrtf(((p4[0] + p4[1]) + (p4[2] + p4[3])) * (1.f / 128.f) + 1e-6f);
#pragma unroll
                        for (int e = 0; e < 4; ++e) { acc[ai][bj][m][0][e] *= rs * gn[e]; acc[ai][bj][m][1][e] *= rs * gn[4 + e]; }
                        asm volatile("" ::: "memory"); }
        }
        const bool act = u.pn >= 18;
#pragma unroll
        for (int ai = 0; ai < 2; ++ai)
#pragma unroll
            for (int m = 0; m < 4; ++m) { bf16_t* rowp = O + (size_t)(row0 + ai * HALF + m * 16) * B_COLS + col0;
#pragma unroll
                for (int bj = 0; bj < 2; ++bj) { f32x4 v0 = acc[ai][bj][m][0], v1 = acc[ai][bj][m][1];
                    if (act) {
#pragma unroll
                        for (int e = 0; e < 4; ++e) { v0[e] = siluf_(v0[e]); v1[e] = siluf_(v1[e]); } }
                    u32x4 w; w.x = cvt_pk_bf16(v0[0], v0[1]); w.y = cvt_pk_bf16(v0[2], v0[3]); w.z = cvt_pk_bf16(v1[0], v1[1]); w.w = cvt_pk_bf16(v1[2], v1[3]);
                    *(u32x4*)(rowp + bj * HALF) = w; } }
        return false;
    }
};
struct EpiAG {
    static constexpr bool PERM = true;
    bf16_t* PA; bf16_t* PG; float* dbg;
    __device__ __forceinline__ bool operator()(const f32x4 (&acc)[2][2][4][2], const Unit& u, int wr, int wc, int fr, int fq) const {
        const bool isg = u.pn >= 9; bf16_t* base = isg ? PG : PA; const int ldc = isg ? G_COLS : A_COLS; const int pn = isg ? u.pn - 9 : u.pn;
        const int row0 = u.pm * BM + wr * 64 + fr, col0 = pn * BM + wc * 32 + 8 * fq;
#pragma unroll
        for (int ai = 0; ai < 2; ++ai)
#pragma unroll
            for (int m = 0; m < 4; ++m) { bf16_t* rowp = base + (size_t)(row0 + ai * HALF + m * 16) * ldc + col0;
#pragma unroll
                for (int bj = 0; bj < 2; ++bj) { const f32x4 v0 = acc[ai][bj][m][0], v1 = acc[ai][bj][m][1];
                    u32x4 w; w.x = cvt_pk_bf16(v0[0], v0[1]); w.y = cvt_pk_bf16(v0[2], v0[3]); w.z = cvt_pk_bf16(v1[0], v1[1]); w.w = cvt_pk_bf16(v1[2], v1[3]);
                    *(u32x4*)(rowp + bj * HALF) = w; } }
        return false;
    }
};
struct EpiPG {
    static constexpr bool PERM = true;
    bf16_t* PG; float* dbg;
    __device__ __forceinline__ bool operator()(const f32x4 (&acc)[2][2][4][2], const Unit& u, int wr, int wc, int fr, int fq) const {
        const int row0 = u.pm * BM + wr * 64 + fr, col0 = u.pn * BM + wc * 32 + 8 * fq;
#pragma unroll
        for (int ai = 0; ai < 2; ++ai)
#pragma unroll
            for (int m = 0; m < 4; ++m) { bf16_t* rowp = PG + (size_t)(row0 + ai * HALF + m * 16) * G_COLS + col0;
#pragma unroll
                for (int bj = 0; bj < 2; ++bj) { const f32x4 v0 = acc[ai][bj][m][0], v1 = acc[ai][bj][m][1];
                    u32x4 w; w.x = cvt_pk_bf16(v0[0], v0[1]); w.y = cvt_pk_bf16(v0[2], v0[3]); w.z = cvt_pk_bf16(v1[0], v1[1]); w.w = cvt_pk_bf16(v1[2], v1[3]);
                    *(u32x4*)(rowp + bj * HALF) = w; } }
        return false;
    }
};
struct EpiMerge {
    static constexpr bool PERM = true;
    const bf16_t* PG; bf16_t* O; float* dbg;
    __device__ __forceinline__ bool operator()(f32x4 (&acc)[2][2][4][2], const Unit& u, int wr, int wc, int fr, int fq) const {
        const int row0 = u.pm * BM + wr * 64 + fr, col0 = u.pn * BM + wc * 32 + 8 * fq;
#pragma unroll
        for (int ai = 0; ai < 2; ++ai)
#pragma unroll
            for (int m = 0; m < 4; ++m) { const size_t row = (size_t)(row0 + ai * HALF + m * 16);
#pragma unroll
                for (int bj = 0; bj < 2; ++bj) { const int col = col0 + bj * HALF;
                    const u32x4 gb8 = *(const u32x4*)(PG + row * G_COLS + D + col);
                    float zb[8] = {bflo(gb8.x), bfhi(gb8.x), bflo(gb8.y), bfhi(gb8.y), bflo(gb8.z), bfhi(gb8.z), bflo(gb8.w), bfhi(gb8.w)};
                    if (u.sel == 0) {
                        const u32x4 ga8 = *(const u32x4*)(PG + row * G_COLS + col);
                        float za[8] = {bflo(ga8.x), bfhi(ga8.x), bflo(ga8.y), bfhi(ga8.y), bflo(ga8.z), bfhi(ga8.z), bflo(ga8.w), bfhi(ga8.w)};
#pragma unroll
                        for (int e = 0; e < 8; ++e) { const float ea = __expf(-fminf(fmaxf(za[e], -30.f), 30.f)), eb = __expf(-fminf(fmaxf(zb[e], -30.f), 30.f));
                            const float r = (1.f + eb) * __builtin_amdgcn_rcpf(1.f + ea); acc[ai][bj][m][e >> 2][e & 3] *= r; }
                    } else {
                        float o[8];
#pragma unroll
                        for (int e = 0; e < 8; ++e) { const float eb = __expf(-fminf(fmaxf(zb[e], -30.f), 30.f)); o[e] = acc[ai][bj][m][e >> 2][e & 3] * __builtin_amdgcn_rcpf(1.f + eb); }
                        u32x4 w; w.x = cvt_pk_bf16(o[0], o[1]); w.y = cvt_pk_bf16(o[2], o[3]); w.z = cvt_pk_bf16(o[4], o[5]); w.w = cvt_pk_bf16(o[6], o[7]);
                        *(u32x4*)(O + row * D + col) = w;
                    } } }
        return u.sel == 0;
    }
};
struct EpiOut {
    static constexpr bool PERM = false;
    const float* xp; const float* xs; const float* mod; float* out; float* dbg;
    __device__ __forceinline__ bool operator()(const f32x4 (&acc)[2][2][4][2], const Unit& u, int wr, int wc, int fr, int fq) const {
        const int rowt = u.pm * BM, b = rowt >> 13; const float* xb = rowt < NBP * T ? xp + (size_t)rowt * D : xs + (size_t)(rowt - NBP * T) * D;
        const int rl0 = wr * 64 + fr, col0 = u.pn * BM + wc * 32 + 4 * fq; const float* gt = mod + b * 3072 + 2048;
#pragma unroll
        for (int bj = 0; bj < 2; ++bj)
#pragma unroll
            for (int n = 0; n < 2; ++n) { const int col = col0 + bj * HALF + n * 16; const f32x4 g4 = *(const f32x4*)(gt + col);
#pragma unroll
                for (int ai = 0; ai < 2; ++ai)
#pragma unroll
                    for (int m = 0; m < 4; ++m) { const int rl = rl0 + ai * HALF + m * 16; const f32x4 x4 = *(const f32x4*)(xb + (size_t)rl * D + col);
                        *(f32x4*)(out + (size_t)(rowt + rl) * D + col) = x4 + g4 * acc[ai][bj][m][n]; } }
        return false;
    }
};
}

__device__ __forceinline__ void p0_transpose_item(const float* W, int K, int N, bf16* WT, int k0, int n0, int drow0, LAS float* scr, int lane) {
#pragma unroll 8
    for (int i = 0; i < 32; ++i) { const int kk = 2 * i + (lane >> 5); scr[kk * 33 + (lane & 31)] = W[(size_t)(k0 + kk) * N + n0 + (lane & 31)]; }
    LDS_WAIT(); asm volatile("" ::: "memory");
    const int c = lane & 7;
#pragma unroll
    for (int j = 0; j < 4; ++j) { const int n = (lane >> 3) + 8 * j; const LAS float* s = scr + (8 * c) * 33 + n;
        v4u o; o.x = pk2(s[0 * 33], s[1 * 33]); o.y = pk2(s[2 * 33], s[3 * 33]); o.z = pk2(s[4 * 33], s[5 * 33]); o.w = pk2(s[6 * 33], s[7 * 33]);
        *(GAS v4u*)(WT + (size_t)(drow0 + n) * K + k0 + 8 * c) = o; }
    LDS_WAIT(); asm volatile("" ::: "memory");
}
__device__ __forceinline__ int t5_bucket(int rel) {
    const int n = rel < 0 ? -rel : rel; int ret = rel > 0 ? 16 : 0;
    const float lf = logf((float)(n > 1 ? n : 1) / 8.0f) / 4.852030263919617f * 8.0f;
    int large = 8 + (int)lf; large = large < 15 ? large : 15;
    return ret + (n < 8 ? n : large);
}
__device__ __forceinline__ void p0a(Frame& F) {
    const int ko = kopaque(); const float *cp_ = kin(I_CP, ko), *cs_ = kin(I_CS, ko), *w_ada = kin(I_WADA, ko), *b_ada = kin(I_BADA, ko), *rel_bias = kin(I_RELB, ko), *w_in = kin(I_WIN, ko), *w_out_a = kin(I_WOA, ko), *w_out_b = kin(I_WOB, ko), *w_out = kin(I_WO, ko);
    float* mod = (float*)(F.ws + WS_MOD);
    if (blockIdx.x < 48) {
        LAS float* sc = (LAS float*)F.lds;
        LAS float* part = (LAS float*)(F.lds + 40960);
        for (int i = (F.wave * 64 + lane_id()); i < NB * D; i += NWAVES * 64) { const int b = i >> 10, k = i & 1023; const float cv = b < NBP ? cp_[b * D + k] : cs_[(b - NBP) * D + k]; sc[i] = siluf_(cv); }
        __syncthreads();
        const int j = blockIdx.x * 64 + lane_id(); float a[NB];
#pragma unroll
        for (int b = 0; b < NB; ++b) a[b] = 0.f;
        for (int k = F.wave * 128; k < F.wave * 128 + 128; ++k) { const float w = w_ada[(size_t)k * 3072 + j];
#pragma unroll
            for (int b = 0; b < NB; ++b) a[b] += sc[b * D + k] * w; }
#pragma unroll
        for (int b = 0; b < NB; ++b) part[(F.wave * NB + b) * 64 + lane_id()] = a[b];
        __syncthreads();
        for (int i = (F.wave * 64 + lane_id()); i < NB * 64; i += NWAVES * 64) { const int b = i >> 6, l = i & 63; float s = b_ada[blockIdx.x * 64 + l];
#pragma unroll
            for (int w = 0; w < NWAVES; ++w) s += part[(w * NB + b) * 64 + l];
            mod[b * 3072 + blockIdx.x * 64 + l] = s; }
        __syncthreads();
    }
    if (blockIdx.x == 255 % gridDim.x) {
        float* bt = (float*)(F.ws + WS_BTAB);
        for (int i = (F.wave * 64 + lane_id()); i < 12 * 129; i += NWAVES * 64) { const int gh = i / 129, r = i % 129, gi = gh >> 2; const int rel = (r - 64) * (1 << (2 * gi));
            bt[i] = rel_bias[t5_bucket(rel) * 12 + gh] * 1.4426950408889634f; }
    }
    LAS float* scr = (LAS float*)(F.lds + RING_OFF + F.wave * 16384);
    const int gw = F.vcu * NWAVES + F.wave, NGW = F.G * NWAVES;
    constexpr int I_IN = (D / 64) * (IN_COLS / 32), I_OA = (A_W / 64) * (D / 32), I_OB = (B_W / 64) * (D / 32), I_O = (D / 64) * (D / 32);
    constexpr int NITEMS = I_IN + I_OA + I_OB + I_O;
    for (int it = gw; it < NITEMS; it += NGW) {
        int r = it;
        if (r < I_IN) { const int nblk = IN_COLS / 32, kb = r / nblk, nb = r % nblk, n0 = nb * 32;
            bf16* dst; int drow;
            if (n0 < A_COLS) { dst = (bf16*)(F.ws + WS_WAG); drow = n0; }
            else if (n0 < A_COLS + B_COLS) { dst = (bf16*)(F.ws + WS_WB); drow = n0 - A_COLS; }
            else { dst = (bf16*)(F.ws + WS_WAG); drow = A_COLS + (n0 - A_COLS - B_COLS); }
            p0_transpose_item(w_in, D, IN_COLS, dst, kb * 64, n0, drow, scr, lane_id()); continue; }
        r -= I_IN;
        if (r < I_OA) { const int nblk = D / 32, kb = r / nblk, nb = r % nblk; p0_transpose_item(w_out_a, A_W, D, (bf16*)(F.ws + WS_WOA), kb * 64, nb * 32, nb * 32, scr, lane_id()); continue; }
        r -= I_OA;
        if (r < I_OB) { const int nblk = D / 32, kb = r / nblk, nb = r % nblk; p0_transpose_item(w_out_b, B_W, D, (bf16*)(F.ws + WS_WOB), kb * 64, nb * 32, nb * 32, scr, lane_id()); continue; }
        r -= I_OB;
        { const int nblk = D / 32, kb = r / nblk, nb = r % nblk; p0_transpose_item(w_out, D, D, (bf16*)(F.ws + WS_WO), kb * 64, nb * 32, nb * 32, scr, lane_id()); }
    }
}
__device__ __forceinline__ void p0b(Frame& F) {
    const int ko = kopaque(); const float *xp = kin(I_XP, ko), *xs = kin(I_XS, ko), *norm_w = kin(I_NORMW, ko);
    const float* mod = (const float*)(F.ws + WS_MOD);
    const int gw = F.vcu * NWAVES + F.wave, NGW = F.G * NWAVES, lane = lane_id();
    const int per = (M + NGW - 1) / NGW, m0 = gw * per, m1 = (m0 + per < M) ? m0 + per : M;
    int bcur = -1; f32x4 cs[4], sh[4];
    for (int m = m0; m < m1; ++m) {
        const int b = m >> 13;
        if (b != bcur) { bcur = b;
#pragma unroll
            for (int j = 0; j < 4; ++j) { const int col = 4 * (lane + 64 * j); const f32x4 nw = *(const f32x4*)(norm_w + col), sc = *(const f32x4*)(mod + b * 3072 + 1024 + col);
                cs[j] = nw * (sc + 1.f); sh[j] = *(const f32x4*)(mod + b * 3072 + col); } }
        const f32x4* xr = (const f32x4*)xrow_ptr(xp, xs, m) + lane;
        f32x4 v[4]; float s = 0.f;
#pragma unroll
        for (int j = 0; j < 4; ++j) { v[j] = xr[64 * j]; s += (v[j].x * v[j].x + v[j].y * v[j].y) + (v[j].z * v[j].z + v[j].w * v[j].w); }
        const float rs = __builtin_amdgcn_rsqf(wave_sum(s) * (1.f / D) + RMS_EPS);
        v2u* o8 = (v2u*)(F.out + (size_t)m * OROW + OS_H) + lane;
#pragma unroll
        for (int j = 0; j < 4; ++j) { const f32x4 h = v[j] * rs * cs[j] + sh[j]; v2u w; w.x = cvtpk(h.x, h.y); w.y = cvtpk(h.z, h.w); o8[64 * j] = w; }
    }
}
typedef short v4i16_t __attribute__((ext_vector_type(4)));
typedef float f32x4a __attribute__((ext_vector_type(4)));
constexpr int AT_K = 0, AT_V = 65536, AT_BT = RING_BYTES + 9216 + 1024;
constexpr size_t WS_LSE = WS_Y;
__device__ __forceinline__ void attn_unit_geom(int u, int& b, int& gi, int& hh, int& res, int& blk) {
    const int sub = u & 63; int r = u >> 6; hh = r & 3; r >>= 2; gi = r % 3; b = r / 3;
    if (gi == 0) { res = 0; blk = sub; } else if (gi == 1) { res = sub >> 4; blk = sub & 15; } else { res = sub >> 2; blk = sub & 3; }
}
__device__ __forceinline__ void glds16(const void* gsrc, unsigned lds_dst) { unsigned keep;
    asm volatile("s_mov_b32 %0, m0\n\ts_mov_b32 m0, %2\n\ts_nop 0\n\tglobal_load_lds_dwordx4 %1, off\n\ts_mov_b32 m0, %0" : "=&s"(keep) : "v"(gsrc), "s"(lds_dst) : "memory"); }
__device__ __forceinline__ void attn_dma_k_half(Frame& F, const bf16* pb, int b, int lg, int L, int res, int head, int q0, int hb) {
    const int lane = lane_id();
#pragma unroll
    for (int ii = 0; ii < 4; ++ii) { const int i = (hb >> 2) + F.wave * 4 + ii, row = 4 * i + (lane >> 4); int kp = q0 - 64 + ((row - q0) & 255); kp = kp < 0 ? 0 : (kp >= L ? L - 1 : kp);
        const int c = (lane & 15) ^ (row & 15);
        const bf16* src = pb + (size_t)(b * T + (kp << lg) + res) * B_COLS + B_QKV + head * 128 + c * 8;
        glds16(src, (unsigned)__builtin_amdgcn_readfirstlane((int)(unsigned)(size_t)(F.lds + AT_K + i * 1024))); }
}
__device__ __forceinline__ void attn_dma_v_half(Frame& F, const bf16* pb, int b, int lg, int L, int res, int head, int q0, int hb) {
    const int lane = lane_id();
#pragma unroll
    for (int jj = 0; jj < 4; ++jj) { const int j = F.wave * 4 + jj, dblk = j >> 3, kgrp = (hb >> 4) + (j & 7), row = 16 * kgrp + (lane >> 2); int kp = q0 - 64 + ((row - q0) & 255); kp = kp < 0 ? 0 : (kp >= L ? L - 1 : kp);
        const bf16* src = pb + (size_t)(b * T + (kp << lg) + res) * B_COLS + 2 * B_QKV + head * 128 + dblk * 32 + (lane & 3) * 8;
        glds16(src, (unsigned)__builtin_amdgcn_readfirstlane((int)(unsigned)(size_t)(F.lds + AT_V + dblk * 16384 + kgrp * 1024))); }
}
__device__ __forceinline__ void attn_mfma(Frame& F, bool dry = false) {
    bf16* pb = (bf16*)(F.ws + WS_R); const float* btab = (const float*)(F.ws + WS_BTAB); float* lse = (float*)(F.ws + WS_LSE);
    int lane = lane_id(); asm volatile("" : "+v"(lane));
    const int w = F.wave, qi = lane & 15, g = lane >> 4;
    LAS float* btp = (LAS float*)(F.lds + AT_BT);
    const int NU = NB * 3 * 4 * 64, per = (NU + F.G - 1) / F.G; const int u0 = F.vcu * per, u1 = (u0 + per < NU) ? u0 + per : NU;
    if (u0 >= u1) return;
#ifdef PROBE_AT
    const unsigned long long pat_t0 = __builtin_amdgcn_s_memtime();
#endif
    int koff[4];
#pragma unroll
    for (int ks = 0; ks < 4; ++ks) koff[ks] = AT_K + qi * 256 + (((4 * ks + g) ^ qi) << 4);
    const int q4 = qi >> 2, p4 = qi & 3, kr = 4 * g + q4;
    const int voff = AT_V + (kr >> 3) * 512 + (kr & 7) * 64 + 8 * p4;
    int b, gi, hh, res, blk; attn_unit_geom(u0, b, gi, hh, res, blk);
    { const int lg = 2 * gi; attn_dma_k_half(F, pb, b, lg, T >> lg, res, gi * 4 + hh, blk * 128, 0); attn_dma_k_half(F, pb, b, lg, T >> lg, res, gi * 4 + hh, blk * 128, 128); }
    int head_prev = -1;
    bf16x8 qA[4], qB[4];
#define ATTN_LOADQ(QD, uu) do { int b_, gi_, hh_, res_, blk_; attn_unit_geom((uu), b_, gi_, hh_, res_, blk_); const int lg_ = 2 * gi_; \
        const bf16* qr_ = pb + (size_t)(b_ * T + ((blk_ * 128 + 16 * w + qi) << lg_) + res_) * B_COLS + (gi_ * 4 + hh_) * 128; \
        _Pragma("unroll") for (int ks = 0; ks < 4; ++ks) QD[ks] = *(const bf16x8*)(qr_ + 32 * ks + 8 * g); } while (0)
    ATTN_LOADQ(qA, u0);
    asm volatile("" :: "v"(qA[0]), "v"(qA[1]), "v"(qA[2]), "v"(qA[3]));
#define ATTN_UNIT(u, qf, qnx) do { \
        attn_unit_geom(u, b, gi, hh, res, blk); \
        const int lg = 2 * gi, L = T >> lg, head = gi * 4 + hh, q0 = blk * 128; \
        const bool cont = ((u) > u0) && (blk != 0);                  \
        const int s8 = ((q0 >> 4) + w) & 15;                         \
        if (head != head_prev) { head_prev = head; const int tid_ = F.wave * 64 + lane_id(); if (tid_ < 176) { const int i = tid_ - 16; btp[tid_] = (i >= 0 && i <= 128) ? btab[head * 129 + i] : -1e30f; } asm volatile("s_waitcnt vmcnt(0)" ::: "memory"); } \
        bf16* qrow = pb + (size_t)(b * T + ((q0 + 16 * w + qi) << lg) + res) * B_COLS + head * 128; \
        if ((u) + 1 < u1) ATTN_LOADQ(qnx, (u) + 1); \
          \
        if ((u) == u0) asm volatile("s_waitcnt vmcnt(0) lgkmcnt(0)" ::: "memory"); else asm volatile("s_waitcnt vmcnt(6) lgkmcnt(0)" ::: "memory"); \
        __builtin_amdgcn_s_barrier(); asm volatile("" ::: "memory"); \
        if (!cont) attn_dma_v_half(F, pb, b, lg, L, res, head, q0, q0 & 255); \
        attn_dma_v_half(F, pb, b, lg, L, res, head, q0, (q0 + 128) & 255); \
        f32x4a S[9]; \
        _Pragma("unroll") for (int kb = 0; kb < 9; ++kb) { S[kb] = (f32x4a){0.f, 0.f, 0.f, 0.f}; const int rb = ((s8 + kb) & 15) * 4096; \
            _Pragma("unroll") for (int ks = 0; ks < 4; ++ks) { const bf16x8 kf = *(const LAS bf16x8*)(F.lds + koff[ks] + rb); \
                S[kb] = __builtin_amdgcn_mfma_f32_16x16x32_bf16(kf, qf[ks], S[kb], 0, 0, 0); } } \
        const bool edge = (q0 == 0) || (q0 + 128 >= L); \
        float mx = -1e30f; \
        _Pragma("unroll") for (int kb = 0; kb < 9; ++kb) \
            _Pragma("unroll") for (int r = 0; r < 4; ++r) { const int kw = 16 * kb + 4 * g + r; float sv = S[kb][r] + btp[kw - qi + 16]; \
                if (edge) { const int kp = q0 + 16 * w + kw - 64; if (kp < 0 || kp >= L) sv = -1e30f; } \
                S[kb][r] = sv; mx = fmaxf(mx, sv); } \
        mx = fmaxf(mx, __shfl_xor(mx, 16)); mx = fmaxf(mx, __shfl_xor(mx, 32)); \
        float ls = 0.f; \
        _Pragma("unroll") for (int kb = 0; kb < 9; ++kb) \
            _Pragma("unroll") for (int r = 0; r < 4; ++r) { const float pe = __builtin_amdgcn_exp2f(S[kb][r] - mx); S[kb][r] = pe; ls += pe; } \
        ls += __shfl_xor(ls, 16); ls += __shfl_xor(ls, 32); \
        bf16x8 pf[5]; \
        _Pragma("unroll") for (int c = 0; c < 5; ++c) { v4u t; t.x = cvtpk(S[2 * c][0], S[2 * c][1]); t.y = cvtpk(S[2 * c][2], S[2 * c][3]); \
            if (c < 4) { t.z = cvtpk(S[2 * c + 1][0], S[2 * c + 1][1]); t.w = cvtpk(S[2 * c + 1][2], S[2 * c + 1][3]); } else { t.z = 0u; t.w = 0u; } \
            pf[c] = __builtin_bit_cast(bf16x8, t); } \
        asm volatile("s_waitcnt vmcnt(0) lgkmcnt(0)" ::: "memory"); __builtin_amdgcn_s_barrier(); asm volatile("" ::: "memory"); \
        if ((u) + 1 < u1) { int b2, gi2, hh2, res2, blk2; attn_unit_geom((u) + 1, b2, gi2, hh2, res2, blk2); const int lg2 = 2 * gi2, q02 = blk2 * 128; \
            if (blk2 == 0) attn_dma_k_half(F, pb, b2, lg2, T >> lg2, res2, gi2 * 4 + hh2, q02, q02 & 255); \
            attn_dma_k_half(F, pb, b2, lg2, T >> lg2, res2, gi2 * 4 + hh2, q02, (q02 + 128) & 255); } \
        asm volatile("" ::: "memory");                                \
        const float il = 1.f / ls; \
        int vlo[5], vhi[5]; \
        _Pragma("unroll") for (int c = 0; c < 5; ++c) { vlo[c] = voff + ((s8 + 2 * c) & 15) * 1024; vhi[c] = (c < 4) ? voff + ((s8 + 2 * c + 1) & 15) * 1024 : vlo[c]; } \
        _Pragma("unroll") for (int db = 0; db < 8; ++db) { f32x4a o = (f32x4a){0.f, 0.f, 0.f, 0.f}; \
            _Pragma("unroll") for (int c = 0; c < 5; ++c) { const int dofs = (db >> 1) * 16384 + (db & 1) * 32; \
                const v4i16_t lo = __builtin_amdgcn_ds_read_tr16_b64_v4i16((LAS v4i16_t*)(F.lds + vlo[c] + dofs)); \
                const v4i16_t hi = __builtin_amdgcn_ds_read_tr16_b64_v4i16((LAS v4i16_t*)(F.lds + vhi[c] + dofs)); \
                const bf16x8 vf = (bf16x8){lo[0], lo[1], lo[2], lo[3], hi[0], hi[1], hi[2], hi[3]}; \
                o = __builtin_amdgcn_mfma_f32_16x16x32_bf16(vf, pf[c], o, 0, 0, 0); } \
            v2u wv; wv.x = cvtpk(o[0] * il, o[1] * il); wv.y = cvtpk(o[2] * il, o[3] * il); \
            *(v2u*)((dry ? (bf16*)(F.ws + WS_Y) + (size_t)((F.wave * 64 + lane_id()) >> 2) * B_COLS : qrow) + 16 * db + 4 * g) = wv; } \
        if (g == 0 && !dry) lse[(size_t)(b * T + ((q0 + 16 * w + qi) << lg) + res) * 12 + head] = mx + __builtin_amdgcn_logf(ls); \
        asm volatile("" :: "v"(qnx[0]), "v"(qnx[1]), "v"(qnx[2]), "v"(qnx[3]));     \
    } while (0)
    for (int u = u0; u < u1; u += 2) {
        ATTN_UNIT(u, qA, qB);
        if (u + 1 < u1) ATTN_UNIT(u + 1, qB, qA);
    }
#undef ATTN_UNIT
#undef ATTN_LOADQ
    asm volatile("s_waitcnt vmcnt(0) lgkmcnt(0)" ::: "memory"); __builtin_amdgcn_s_barrier();
#ifdef PROBE_AT
    if (blockIdx.x == 0 && (F.wave * 64 + lane_id()) == 0) ((float*)(F.ws + WS_CTL + 32768))[0] = (float)((double)(((__builtin_amdgcn_s_memtime() - pat_t0) / (unsigned long long)(u1 - u0) + 1024ull) >> 11 << 11) / 65536.0);
#endif
}
__device__ __forceinline__ void attn_combine(Frame& F) {
    const bf16* pb = (const bf16*)(F.ws + WS_R); const float* lse = (const float*)(F.ws + WS_LSE);
    const int gw = F.vcu * NWAVES + F.wave, NGW = F.G * NWAVES, lane = lane_id(), hh = lane >> 4, d0 = (lane & 15) * 8;
    for (int m = gw; m < M; m += NGW) {
        const bf16* row = pb + (size_t)m * B_COLS;
        const float l0 = lse[(size_t)m * 12 + hh], l1 = lse[(size_t)m * 12 + 4 + hh], l2 = lse[(size_t)m * 12 + 8 + hh];
        const float mxl = fmaxf(l0, fmaxf(l1, l2)); float w0 = exp2f(l0 - mxl), w1 = exp2f(l1 - mxl), w2 = exp2f(l2 - mxl); const float iw = 1.f / (w0 + w1 + w2); w0 *= iw; w1 *= iw; w2 *= iw;
        const v4u a = *(const v4u*)(row + hh * 128 + d0), bq = *(const v4u*)(row + (4 + hh) * 128 + d0), c = *(const v4u*)(row + (8 + hh) * 128 + d0), gt = *(const v4u*)(row + 3 * B_QKV + hh * 128 + d0);
        v4u o;
        o.x = pk2((w0 * bflo(a.x) + w1 * bflo(bq.x) + w2 * bflo(c.x)) * bflo(gt.x), (w0 * bfhi(a.x) + w1 * bfhi(bq.x) + w2 * bfhi(c.x)) * bfhi(gt.x));
        o.y = pk2((w0 * bflo(a.y) + w1 * bflo(bq.y) + w2 * bflo(c.y)) * bflo(gt.y), (w0 * bfhi(a.y) + w1 * bfhi(bq.y) + w2 * bfhi(c.y)) * bfhi(gt.y));
        o.z = pk2((w0 * bflo(a.z) + w1 * bflo(bq.z) + w2 * bflo(c.z)) * bflo(gt.z), (w0 * bfhi(a.z) + w1 * bfhi(bq.z) + w2 * bfhi(c.z)) * bfhi(gt.z));
        o.w = pk2((w0 * bflo(a.w) + w1 * bflo(bq.w) + w2 * bflo(c.w)) * bflo(gt.w), (w0 * bfhi(a.w) + w1 * bfhi(bq.w) + w2 * bfhi(c.w)) * bfhi(gt.w));
        *(v4u*)(F.out + (size_t)m * OROW + OS_YB + (hh * 128 + d0) * 2) = o;
    }
}

#ifdef PROBE_TA
#define STAMP(k) do { if ((k) == PROBE_TA) pt_a = __builtin_amdgcn_s_memtime(); if ((k) == PROBE_TB) pt_sel += __builtin_amdgcn_s_memtime() - pt_a; } while (0)
#else
#define STAMP(k) do { } while (0)
#endif
#ifndef REP_S0
#define REP_S0 1
#define REP_S12 1
#define REP_S3 1
#define REP_S45 1
#endif
typedef float f32x4r __attribute__((ext_vector_type(4)));
constexpr int RS = 144, RM = 64 * RS;
constexpr int R_AT = 0 * RM, R_RT = 1 * RM, R_BW = 2 * RM, R_KU = 3 * RM, R_BT = 4 * RM, R_KT = 5 * RM, R_VT = 6 * RM, R_AAB = 7 * RM, R_AAK = 8 * RM, R_ARB = 9 * RM, R_ARK = 10 * RM, R_HT = 11 * RM;
constexpr int R_W2T = 12 * RM, R_A2T = 13 * RM;
constexpr int R_WLF = R_AT, R_ALF = R_BT, FS = 272;
constexpr int R_TI = 132096, TIS = 48, R_PC = R_TI + 3072, R_BLK = R_PC + 256, R_AD = R_BLK + 2048;
__device__ __forceinline__ bf16x8 ldfrag(LAS unsigned char* lds, int mat, int row0, int k0, int r, int g) { return *(const LAS bf16x8*)(lds + mat + (row0 + r) * RS + (k0 + 8 * g) * 2); }
__device__ __forceinline__ void storeT(LAS unsigned char* lds, int mat, const f32x4r& d, int row0, int col0, int r, int g) {
    v2u w; w.x = cvtpk(d[0], d[1]); w.y = cvtpk(d[2], d[3]); *(LAS v2u*)(lds + mat + (col0 + r) * RS + (row0 + 4 * g) * 2) = w; }
__device__ __forceinline__ bf16x8 pack2(const f32x4r& a, const f32x4r& b) { v4u t; t.x = cvtpk(a[0], a[1]); t.y = cvtpk(a[2], a[3]); t.z = cvtpk(b[0], b[1]); t.w = cvtpk(b[2], b[3]); return __builtin_bit_cast(bf16x8, t); }
__device__ __forceinline__ bf16x8 pack1(const f32x4r& a) { v4u t; t.x = cvtpk(a[0], a[1]); t.y = cvtpk(a[2], a[3]); t.z = 0u; t.w = 0u; return __builtin_bit_cast(bf16x8, t); }
__device__ __forceinline__ bf16x8 ld2x4(LAS unsigned char* lds, int off0, int off1) { const v2u a = *(const LAS v2u*)(lds + off0), b = *(const LAS v2u*)(lds + off1); v4u t; t.x = a.x; t.y = a.y; t.z = b.x; t.w = b.y; return __builtin_bit_cast(bf16x8, t); }
#define MF16(a, b, c) __builtin_amdgcn_mfma_f32_16x16x32_bf16((a), (b), (c), 0, 0, 0)
#define WGBAR() do { asm volatile("s_waitcnt lgkmcnt(0)" ::: "memory"); __builtin_amdgcn_s_barrier(); asm volatile("" ::: "memory"); } while (0)
template <int CTRL> __device__ __forceinline__ float dppf(float x) { return __builtin_bit_cast(float, __builtin_amdgcn_update_dpp(0, __builtin_bit_cast(int, x), CTRL, 0xF, 0xF, true)); }
__device__ __forceinline__ float row16_sum(float v) { v += dppf<0xB1>(v); v += dppf<0x4E>(v); v += dppf<0x141>(v); v += dppf<0x140>(v); return v; }
__device__ __forceinline__ float wave_sum_dpp(float v) { v = row16_sum(v);
    return (__builtin_bit_cast(float, __builtin_amdgcn_readlane(__builtin_bit_cast(int, v), 0)) + __builtin_bit_cast(float, __builtin_amdgcn_readlane(__builtin_bit_cast(int, v), 16)))
         + (__builtin_bit_cast(float, __builtin_amdgcn_readlane(__builtin_bit_cast(int, v), 32)) + __builtin_bit_cast(float, __builtin_amdgcn_readlane(__builtin_bit_cast(int, v), 48))); }
__device__ __forceinline__ void reduce8(const float (&v)[8], float (&s)[8], float& v0, float& v1, int lane) {
    const bool b0 = lane & 1, b1 = lane & 2; float r1[4], r2[2];
#pragma unroll
    for (int i = 0; i < 4; ++i) { const float keep = b0 ? v[2 * i + 1] : v[2 * i], send = b0 ? v[2 * i] : v[2 * i + 1]; r1[i] = keep + dppf<0xB1>(send); }
#pragma unroll
    for (int i = 0; i < 2; ++i) { const float keep = b1 ? r1[2 * i + 1] : r1[2 * i], send = b1 ? r1[2 * i] : r1[2 * i + 1]; r2[i] = keep + dppf<0x4E>(send); }
#pragma unroll
    for (int i = 0; i < 2; ++i) { float x = r2[i]; x += dppf<0x124>(x); x += dppf<0x128>(x);
        x += __builtin_bit_cast(float, __builtin_amdgcn_ds_swizzle(__builtin_bit_cast(int, x), 0x401F));
        x += __shfl_xor(x, 32);
        r2[i] = x; }
    v0 = r2[0]; v1 = r2[1];
#pragma unroll
    for (int q = 0; q < 8; ++q) s[q] = __builtin_bit_cast(float, __builtin_amdgcn_readlane(__builtin_bit_cast(int, r2[q >> 2]), q & 3));
}
typedef float f2v __attribute__((ext_vector_type(2)));
__device__ __forceinline__ f2v exp2v(f2v x) { return (f2v){__builtin_amdgcn_exp2f(x.x), __builtin_amdgcn_exp2f(x.y)}; }
__device__ __forceinline__ f2v rcpv(f2v x) { return (f2v){__builtin_amdgcn_rcpf(x.x), __builtin_amdgcn_rcpf(x.y)}; }
__device__ __forceinline__ unsigned cvtpk2(f2v v) { bf16x2_t b = __builtin_convertvector(v, bf16x2_t); return __builtin_bit_cast(unsigned, b); }
__device__ __forceinline__ float fast_tanh(float x) { const float e = __expf(2.f * x); return 1.f - 2.f * __builtin_amdgcn_rcpf(e + 1.f); }
template <bool RV> __device__ __forceinline__ void rwkv_load_rows(__amdgpu_buffer_rsrc_t rsrc, int b, int d, int c, int w, unsigned o_r, unsigned o_w, unsigned (&x0)[10], unsigned (&x1)[10], unsigned (&x2)[10]) {
    const int s0 = c * 64 + 8 * w - 1;
#pragma unroll
    for (int k = 0; k < 10; ++k) { const int s = s0 + k; int tk = d ? T - 1 - s : s; tk = tk < 0 ? 0 : (tk > T - 1 ? T - 1 : tk);
        const int so = __builtin_amdgcn_readfirstlane((b * T + tk) * (A_COLS * 2));
        if (RV) { x0[k] = __builtin_amdgcn_raw_buffer_load_b32(rsrc, o_r, so, 0); x1[k] = __builtin_amdgcn_raw_buffer_load_b32(rsrc, o_r + 2 * A_W * 2, so, 0); }
        else { x0[k] = __builtin_amdgcn_raw_buffer_load_b32(rsrc, o_r + A_W * 2, so, 0); x1[k] = __builtin_amdgcn_raw_buffer_load_b32(rsrc, o_w, so, 0); x2[k] = __builtin_amdgcn_raw_buffer_load_b32(rsrc, o_w + 2 * RANK * 2, so, 0); } }
}
__device__ __forceinline__ bf16x8 ldfragT(LAS unsigned char* lds, int mat, int m0, int k0, int lane) {
    const int i16 = lane & 15, g = lane >> 4, q = i16 >> 2, pq = i16 & 3; const int off = mat + (k0 + 8 * g + q) * RS + (m0 + 4 * pq) * 2;
    const v4i16_t lo = __builtin_amdgcn_ds_read_tr16_b64_v4i16((LAS v4i16_t*)(lds + off)), hi = __builtin_amdgcn_ds_read_tr16_b64_v4i16((LAS v4i16_t*)(lds + off + 4 * RS));
    return (bf16x8){lo[0], lo[1], lo[2], lo[3], hi[0], hi[1], hi[2], hi[3]};
}
__device__ __forceinline__ void rwkv_chunked(Frame& F) {
    if (blockIdx.x >= 2 * NB * A_HEADS) return;
    const int chain = blockIdx.x, d = chain / (NB * A_HEADS), rem = chain % (NB * A_HEADS), b = rem >> 3, hd = rem & 7;
    const bf16* pa = (const bf16*)(F.ws + WS_PA); bf16* ybuf = (bf16*)(F.ws + WS_Y) + (size_t)d * M * A_W; float* bon = (float*)(F.ws + WS_BON) + (size_t)d * M * 8;
    const int ko = kopaque(); const float *w2_ = kin(I_W2, ko), *a2_ = kin(I_A2, ko), *mu_ = kin(I_MU, ko), *w0_ = kin(I_W0, ko), *a0_ = kin(I_A0, ko), *kk_ = kin(I_KK, ko), *ka_ = kin(I_KA, ko), *rk_ = kin(I_RK, ko);
    LAS unsigned char* L = F.lds;
    int lane = lane_id(); asm volatile("" : "+v"(lane));
    const int w = F.wave, j = lane, ch = hd * 64 + j;
    int r, g;
#define RELANE() do { int ln_ = lane; asm volatile("" : "+v"(ln_)); r = ln_ & 15; g = ln_ >> 4; } while (0)
    for (int i = (F.wave * 64 + lane_id()); i < 4096; i += NWAVES * 64) { const int jo = i >> 6, jr = i & 63;
        *(LAS bf16*)(L + R_W2T + jo * RS + jr * 2) = (bf16)f2bf(w2_[((size_t)d * RANK + jr) * A_W + hd * 64 + jo]);
        *(LAS bf16*)(L + R_A2T + jo * RS + jr * 2) = (bf16)f2bf(a2_[((size_t)d * RANK + jr) * A_W + hd * 64 + jo]); }
    for (int i = (F.wave * 64 + lane_id()); i < 5 * RM / 4; i += NWAVES * 64) ((LAS unsigned*)(L + R_AAB))[i] = 0u;
    const int cr = ch, ck = A_W + ch, cv = 2 * A_W + ch, cw = 4 * A_W + d * RANK + j, ca = 4 * A_W + 2 * RANK + d * RANK + j;
    const float mr0 = mu_[cr], mr1 = mu_[A_COLS + cr], mk0 = mu_[ck], mk1 = mu_[A_COLS + ck], mv0 = mu_[cv], mv1 = mu_[A_COLS + cv];
    const float mw0 = mu_[cw], mw1 = mu_[A_COLS + cw], ma0 = mu_[ca], ma1 = mu_[A_COLS + ca];
    const __amdgpu_buffer_rsrc_t rsrc = __builtin_amdgcn_make_buffer_rsrc((void*)pa, 0, M * A_COLS * 2, 0x00020000);
#define O_R ((unsigned)(((hd * 64 + lnow_) * 2) & ~3))
#define O_W ((unsigned)(((4 * A_W + d * RANK + lnow_) * 2) & ~3))
#define PSEL ((lnow_ & 1) ? 0x07060c0cu : 0x05040c0cu)
    const float sr0 = d ? mr1 : mr0, sr1 = d ? mr0 : mr1, sk0 = d ? mk1 : mk0, sk1 = d ? mk0 : mk1, sv0 = d ? mv1 : mv0, sv1 = d ? mv0 : mv1, sw0 = d ? mw1 : mw0, sw1 = d ? mw0 : mw1, sa0 = d ? ma1 : ma0, sa1 = d ? ma0 : ma1;
    const float w0j = w0_[d * A_W + ch], a0j = a0_[d * A_W + ch], kkj = kk_[ch], kaj = ka_[ch], rkj = rk_[ch];
    const int vt = w & 3;
    f32x4r Hs[4];
#pragma unroll
    for (int i = 0; i < 4; ++i) Hs[i] = (f32x4r){0.f, 0.f, 0.f, 0.f};
    unsigned xk[10], xw[10], xa[10];
    { int lnow_ = lane; rwkv_load_rows<false>(rsrc, b, d, 0, w, O_R, O_W, xk, xw, xa); }
    WGBAR();
#ifdef PROBE_TA
    unsigned long long pt_a = 0, pt_sel = 0; const unsigned long long pt_t0 = __builtin_amdgcn_s_memtime();
#endif
    for (int c = 0; c < T / 64; ++c) {
        STAMP(0);
        f2v ks2[4], kn2[4];
        for (int rep0_ = 0; rep0_ < REP_S0; ++rep0_) {
        int lnow_ = lane; asm volatile("" : "+v"(lnow_)); const unsigned psel = PSEL;
        if (REP_S0 > 1 && rep0_ > 0) rwkv_load_rows<false>(rsrc, b, d, c, w, O_R, O_W, xk, xw, xa);
        const bool okp = (c * 64 + 8 * w) > 0, okn = (c * 64 + 8 * w + 8) < T;
#define XF(x, k) ((((k) == 0 && !okp) || ((k) == 9 && !okn)) ? 0.f : __builtin_bit_cast(float, __builtin_amdgcn_perm((x)[k], 0u, psel)))
#define SH2(dst, x, m0, m1) do { float xf_[10]; _Pragma("unroll") for (int k_ = 0; k_ < 10; ++k_) xf_[k_] = XF(x, k_); const float mc_ = 1.f - (m0) - (m1); \
        _Pragma("unroll") for (int q2_ = 0; q2_ < 4; ++q2_) (dst)[q2_] = (f2v){xf_[2 * q2_ + 1], xf_[2 * q2_ + 2]} * mc_ + (f2v){xf_[2 * q2_], xf_[2 * q2_ + 1]} * (m0) + (f2v){xf_[2 * q2_ + 2], xf_[2 * q2_ + 3]} * (m1); } while (0)
        { unsigned tw_[4], al_[4];
          { f2v ws2[4]; SH2(ws2, xw, sw0, sw1);
#pragma unroll
            for (int q2 = 0; q2 < 4; ++q2) { const f2v e2 = exp2v(ws2[q2] * 2.8853900817779268f); tw_[q2] = cvtpk2(1.f - 2.f * rcpv(e2 + 1.f)); } }
          asm volatile("" ::: "memory");
          { f2v as2[4]; SH2(as2, xa, sa0, sa1);
#pragma unroll
            for (int q2 = 0; q2 < 4; ++q2) al_[q2] = cvtpk2(as2[q2]); }
          asm volatile("" ::: "memory");
          SH2(ks2, xk, sk0, sk1);
#pragma unroll
          for (int q2 = 0; q2 < 4; ++q2) kn2[q2] = ks2[q2] * kkj;
          *(LAS v4u*)(L + R_BW + j * RS + 16 * w) = (v4u){tw_[0], tw_[1], tw_[2], tw_[3]};
          *(LAS v4u*)(L + R_KU + j * RS + 16 * w) = (v4u){al_[0], al_[1], al_[2], al_[3]}; }
        { float sq[8], n2[8], d0_, d1_;
#pragma unroll
          for (int q2 = 0; q2 < 4; ++q2) { const f2v s = kn2[q2] * kn2[q2]; sq[2 * q2] = s.x; sq[2 * q2 + 1] = s.y; }
          reduce8(sq, n2, d0_, d1_, lane);
#pragma unroll
          for (int q2 = 0; q2 < 4; ++q2) kn2[q2] *= (f2v){__builtin_amdgcn_rsqf(fmaxf(n2[2 * q2], 1e-24f)), __builtin_amdgcn_rsqf(fmaxf(n2[2 * q2 + 1], 1e-24f))}; }
        WGBAR();
        STAMP(1);
        RELANE();
        unsigned xr[10], xv[10], xdum[10];
        rwkv_load_rows<true>(rsrc, b, d, c, w, O_R, O_W, xr, xv, xdum);
        { const int it = w >> 1;
          bf16x8 ta[2], aa[2];
#pragma unroll
          for (int k2 = 0; k2 < 2; ++k2) { ta[k2] = ldfragT(L, R_BW, 16 * it, 32 * k2, lane); aa[k2] = ldfragT(L, R_KU, 16 * it, 32 * k2, lane); }
#pragma unroll
          for (int j2 = 0; j2 < 2; ++j2) { const int jt = 2 * (w & 1) + j2; f32x4r dw = (f32x4r){0.f, 0.f, 0.f, 0.f}, da = dw;
#pragma unroll
              for (int k2 = 0; k2 < 2; ++k2) { dw = MF16(ta[k2], ldfrag(L, R_W2T, 16 * jt, 32 * k2, r, g), dw); da = MF16(aa[k2], ldfrag(L, R_A2T, 16 * jt, 32 * k2, r, g), da); }
#pragma unroll
              for (int e = 0; e < 4; ++e) { *(LAS float*)(L + R_WLF + (16 * it + 4 * g + e) * FS + (16 * jt + r) * 4) = dw[e]; *(LAS float*)(L + R_ALF + (16 * it + 4 * g + e) * FS + (16 * jt + r) * 4) = da[e]; } } }
        WGBAR();
        STAMP(2);
        f2v av2[4]; float cp[8]; float run = 1.f;
#pragma unroll
        for (int q2 = 0; q2 < 4; ++q2) { const int i0 = 8 * w + 2 * q2;
            const f2v wl = (f2v){*(const LAS float*)(L + R_WLF + i0 * FS + j * 4), *(const LAS float*)(L + R_WLF + (i0 + 1) * FS + j * 4)} + w0j;
            const f2v al = (f2v){*(const LAS float*)(L + R_ALF + i0 * FS + j * 4), *(const LAS float*)(L + R_ALF + (i0 + 1) * FS + j * 4)} + a0j;
            const f2v dec = exp2v(rcpv(exp2v(wl * -1.4426950408889634f) + 1.f) * (-0.6065306597126334f * 1.4426950408889634f));
            av2[q2] = rcpv(exp2v(al * -1.4426950408889634f) + 1.f);
            run *= dec.x; cp[2 * q2] = run; run *= dec.y; cp[2 * q2 + 1] = run; }
        *(LAS float*)(L + R_BLK + (w * 64 + j) * 4) = run;
        WGBAR();
        STAMP(3);
        { float off = 1.f, tot = 1.f;
#pragma unroll
          for (int w2 = 0; w2 < 8; ++w2) { const float bt = *(const LAS float*)(L + R_BLK + (w2 * 64 + j) * 4); off *= (w2 < w) ? bt : 1.f; tot *= bt; }
          if (w == 0) *(LAS float*)(L + R_PC + j * 4) = tot;
          f2v rs2[4], vs2[4], kd2[4]; SH2(rs2, xr, sr0, sr1); SH2(vs2, xv, sv0, sv1);
          { float bp[8], bs[8], b0_, b1_;
#pragma unroll
            for (int q2 = 0; q2 < 4; ++q2) { kd2[q2] = ks2[q2] * (av2[q2] * kaj + (1.f - kaj)); const f2v t = rs2[q2] * kd2[q2] * rkj; bp[2 * q2] = t.x; bp[2 * q2 + 1] = t.y; }
            reduce8(bp, bs, b0_, b1_, lane);
            if (lane < 4) { const int s0_ = c * 64 + 8 * w + lane, s1_ = s0_ + 4; const int t0_ = d ? T - 1 - s0_ : s0_, t1_ = d ? T - 1 - s1_ : s1_;
                bon[(size_t)(b * T + t0_) * 8 + hd] = b0_; bon[(size_t)(b * T + t1_) * 8 + hd] = b1_; } }
          unsigned pa_[4], pr_[4], pb_[4], pk_[4], pv_[4];
#pragma unroll
          for (int q2 = 0; q2 < 4; ++q2) { const int qa = 2 * q2;
              const f2v pt = (f2v){cp[qa], cp[qa + 1]} * off; const f2v pm = (f2v){(qa == 0) ? off : off * cp[qa > 0 ? qa - 1 : 0], pt.x}; const f2v em = rcpv(pt);
              pa_[q2] = cvtpk2(-kn2[q2] * pm); pr_[q2] = cvtpk2(rs2[q2] * pt); pb_[q2] = cvtpk2(kn2[q2] * av2[q2] * em); pk_[q2] = cvtpk2(kd2[q2] * em); pv_[q2] = cvtpk2(vs2[q2]); }
          *(LAS v4u*)(L + R_AT + j * RS + 16 * w) = (v4u){pa_[0], pa_[1], pa_[2], pa_[3]};
          *(LAS v4u*)(L + R_RT + j * RS + 16 * w) = (v4u){pr_[0], pr_[1], pr_[2], pr_[3]};
          *(LAS v4u*)(L + R_BT + j * RS + 16 * w) = (v4u){pb_[0], pb_[1], pb_[2], pb_[3]};
          *(LAS v4u*)(L + R_KT + j * RS + 16 * w) = (v4u){pk_[0], pk_[1], pk_[2], pk_[3]};
          *(LAS v4u*)(L + R_VT + j * RS + 16 * w) = (v4u){pv_[0], pv_[1], pv_[2], pv_[3]}; }
        WGBAR();
#undef SH2
#undef XF
        }
        STAMP(4);
        if (c + 1 < T / 64) { int lnow_ = lane; asm volatile("" : "+v"(lnow_)); rwkv_load_rows<false>(rsrc, b, d, c + 1, w, O_R, O_W, xk, xw, xa); }
        STAMP(5);
        RELANE();
        f32x4r A0[4], KV[4];
#define tc(i) KV[(i) >> 2][(i) & 3]
        for (int rep1_ = 0; rep1_ < REP_S12; ++rep1_) {
        if (w == 0) {
#pragma unroll
            for (int i = 0; i < 4; ++i) { f32x4r dd = (f32x4r){0.f, 0.f, 0.f, 0.f};
#pragma unroll
                for (int k2 = 0; k2 < 2; ++k2) dd = MF16(ldfragT(L, R_BT, 16 * i, 32 * k2, lane), ldfragT(L, R_AT, 16 * i, 32 * k2, lane), dd);
#pragma unroll
                for (int e = 0; e < 4; ++e) if (4 * g + e >= r) dd[e] = 0.f;
                storeT(L, R_AAB, dd, 16 * i, 16 * i, r, g);
                *(LAS f32x4r*)(L + R_AD + i * 1024 + r * 64 + 16 * g) = dd; }
            { f32x4r dd = (f32x4r){0.f, 0.f, 0.f, 0.f};
#pragma unroll
              for (int k2 = 0; k2 < 2; ++k2) dd = MF16(ldfragT(L, R_KT, 48, 32 * k2, lane), ldfragT(L, R_RT, 48, 32 * k2, lane), dd);
#pragma unroll
              for (int e = 0; e < 4; ++e) if (4 * g + e > r) dd[e] = 0.f;
              storeT(L, R_ARK, dd, 48, 48, r, g); }
            asm volatile("s_waitcnt lgkmcnt(0)" ::: "memory");
            const int blk = lane >> 4, cc = lane & 15;
#pragma unroll
            for (int rr = 0; rr < 8; ++rr) { float acc = (rr == cc) ? 1.f : 0.f;
#pragma unroll
                for (int s4 = 0; s4 < (rr + 3) / 4; ++s4) { const f32x4r a4 = *(const LAS f32x4r*)(L + R_AD + blk * 1024 + rr * 64 + s4 * 16);
#pragma unroll
                    for (int e = 0; e < 4; ++e) if (4 * s4 + e < rr) acc += a4[e] * tc(4 * s4 + e); }
                tc(rr) = acc; *(LAS bf16*)(L + R_TI + (16 * blk + rr) * TIS + cc * 2) = (bf16)f2bf(acc); }
        } else {
#pragma unroll
            for (int kb = 0; kb < 3; ++kb) {
                bf16x8 fa[2][2], fb[2][2]; int dmv[2], tsv[2], ttv[2]; bool inc[2];
#pragma unroll
                for (int k = 0; k < 2; ++k) if (kb < 2 || k == 0) { const int jc = w - 1 + 7 * (2 * kb + k);
                    int mat, idx; if (jc < 6) { mat = 0; idx = (0x865321 >> (4 * jc)) & 15; } else { const int q = jc - 6; mat = 1 + q / 10; idx = q - 10 * (mat - 1); }
                    const int ts = (int)((0x3221110000ull >> (4 * idx)) & 15), tt = (int)((0x3323213210ull >> (4 * idx)) & 15);
                    const int ym = (mat & 1) ? R_KT : R_BT, xm = (mat & 2) ? R_RT : R_AT; dmv[k] = R_AAB + mat * RM; inc[k] = mat >= 2; tsv[k] = ts; ttv[k] = tt;
#pragma unroll
                    for (int k2 = 0; k2 < 2; ++k2) { fa[k][k2] = ldfragT(L, ym, 16 * ts, 32 * k2, lane); fb[k][k2] = ldfragT(L, xm, 16 * tt, 32 * k2, lane); } }
#pragma unroll
                for (int k = 0; k < 2; ++k) if (kb < 2 || k == 0) { f32x4r dd = (f32x4r){0.f, 0.f, 0.f, 0.f};
#pragma unroll
                    for (int k2 = 0; k2 < 2; ++k2) dd = MF16(fa[k][k2], fb[k][k2], dd);
                    if (tsv[k] == ttv[k]) {
#pragma unroll
                        for (int e = 0; e < 4; ++e) { const int sl = 4 * g + e; if (inc[k] ? (sl > r) : (sl >= r)) dd[e] = 0.f; } }
                    storeT(L, dmv[k], dd, 16 * tsv[k], 16 * ttv[k], r, g); }
            }
        }
        WGBAR();
        STAMP(6);
        RELANE();
        if (w == 0) {
            const int blk = lane >> 4, cc = lane & 15;
#pragma unroll
            for (int rr = 8; rr < 16; ++rr) { float acc = (rr == cc) ? 1.f : 0.f;
#pragma unroll
                for (int s4 = 0; s4 < (rr + 3) / 4; ++s4) { const f32x4r a4 = *(const LAS f32x4r*)(L + R_AD + blk * 1024 + rr * 64 + s4 * 16);
#pragma unroll
                    for (int e = 0; e < 4; ++e) if (4 * s4 + e < rr) acc += a4[e] * tc(4 * s4 + e); }
                tc(rr) = acc; *(LAS bf16*)(L + R_TI + (16 * blk + rr) * TIS + cc * 2) = (bf16)f2bf(acc); }
        } else if (w < 4) {
#pragma unroll
            for (int i = 0; i < 4; ++i) { A0[i] = (f32x4r){0.f, 0.f, 0.f, 0.f};
#pragma unroll
                for (int k2 = 0; k2 < 2; ++k2) A0[i] = MF16(ldfrag(L, R_VT, 16 * vt, 32 * k2, r, g), ldfrag(L, R_ARK, 16 * i, 32 * k2, r, g), A0[i]); }
        } else {
#pragma unroll
            for (int i = 0; i < 4; ++i) { A0[i] = (f32x4r){0.f, 0.f, 0.f, 0.f}; KV[i] = A0[i];
#pragma unroll
                for (int k2 = 0; k2 < 2; ++k2) { const bf16x8 vf = ldfrag(L, R_VT, 16 * vt, 32 * k2, r, g);
                    A0[i] = MF16(ldfrag(L, R_AAK, 16 * i, 32 * k2, r, g), vf, A0[i]); KV[i] = MF16(ldfrag(L, R_KT, 16 * i, 32 * k2, r, g), vf, KV[i]); } }
        }
        WGBAR();
        }
        STAMP(7);
        RELANE();
        if (w < 4) {
            if (w == 0) {
#pragma unroll
                for (int i = 0; i < 4; ++i) { A0[i] = (f32x4r){0.f, 0.f, 0.f, 0.f};
#pragma unroll
                    for (int k2 = 0; k2 < 2; ++k2) A0[i] = MF16(ldfrag(L, R_VT, 0, 32 * k2, r, g), ldfrag(L, R_ARK, 16 * i, 32 * k2, r, g), A0[i]); } }
#pragma unroll
            for (int i = 0; i < 4; ++i)
#pragma unroll
                for (int k2 = 0; k2 < 2; ++k2) A0[i] = MF16(ldfrag(L, R_HT, 16 * vt, 32 * k2, r, g), ldfragT(L, R_RT, 16 * i, 32 * k2, lane), A0[i]);
        } else {
            f32x4r X[4];
#pragma unroll
            for (int i = 0; i < 4; ++i) { X[i] = A0[i];
#pragma unroll
                for (int k2 = 0; k2 < 2; ++k2) X[i] = MF16(ldfragT(L, R_AT, 16 * i, 32 * k2, lane), ldfrag(L, R_HT, 16 * vt, 32 * k2, r, g), X[i]); }
            const f32x4r z4 = (f32x4r){0.f, 0.f, 0.f, 0.f};
#define TIF(i) ld2x4(L, R_TI + (16 * (i) + r) * TIS + 8 * g, R_TI + (16 * (i) + r) * TIS + 8 * g)
#define ABF(i, j0) ld2x4(L, R_AAB + (16 * (i) + r) * RS + (16 * (j0) + 4 * g) * 2, R_AAB + (16 * (i) + r) * RS + (16 * ((j0) + 1) + 4 * g) * 2)
            X[0] = MF16(TIF(0), pack1(X[0]), z4);
            X[1] = MF16(ABF(1, 0), pack1(X[0]), X[1]); X[1] = MF16(TIF(1), pack1(X[1]), z4);
            X[2] = MF16(ABF(2, 0), pack2(X[0], X[1]), X[2]); X[2] = MF16(TIF(2), pack1(X[2]), z4);
            X[3] = MF16(ABF(3, 0), pack2(X[0], X[1]), X[3]); X[3] = MF16(ABF(3, 2), pack1(X[2]), X[3]); X[3] = MF16(TIF(3), pack1(X[3]), z4);
#undef TIF
#undef ABF
#pragma unroll
            for (int i = 0; i < 4; ++i) { A0[i] = X[i]; storeT(L, R_KU, X[i], 16 * i, 16 * vt, r, g); }
        }
        WGBAR();
        STAMP(8);
        STAMP(9);
        RELANE();
        for (int rep4_ = 0; rep4_ < 1; ++rep4_) {
        if (w < 4) {
#pragma unroll
            for (int i = 0; i < 4; ++i) {
#pragma unroll
                for (int k2 = 0; k2 < 2; ++k2) A0[i] = MF16(ldfrag(L, R_KU, 16 * vt, 32 * k2, r, g), ldfrag(L, R_ARB, 16 * i, 32 * k2, r, g), A0[i]);
                const int s = c * 64 + 16 * i + r, t = d ? T - 1 - s : s; v2u yw; yw.x = cvtpk(A0[i][0], A0[i][1]); yw.y = cvtpk(A0[i][2], A0[i][3]);
                *(v2u*)(ybuf + (size_t)(b * T + t) * A_W + hd * 64 + 16 * vt + 4 * g) = yw; }
        } else {
#pragma unroll
            for (int i = 0; i < 4; ++i) { f32x4r acc = Hs[i] + KV[i];
#pragma unroll
                for (int k2 = 0; k2 < 2; ++k2) acc = MF16(ldfrag(L, R_BT, 16 * i, 32 * k2, r, g), ldfrag(L, R_KU, 16 * vt, 32 * k2, r, g), acc);
                const f32x4r pc = *(const LAS f32x4r*)(L + R_PC + (16 * i + 4 * g) * 4);
                Hs[i] = acc * pc; storeT(L, R_HT, Hs[i], 16 * i, 16 * vt, r, g); }
        }
        WGBAR();
        }
        STAMP(10);
    }
#ifdef PROBE_TA
    if (blockIdx.x == 0 && (F.wave * 64 + lane_id()) == 0) { float* pf = (float*)(F.ws + WS_CTL + 32768); pf[0] = (float)((double)pt_sel / (double)(__builtin_amdgcn_s_memtime() - pt_t0)); }
#endif
#undef RELANE
#undef tc
#undef O_R
#undef O_W
#undef PSEL
}
__device__ __forceinline__ void rwkv_post(Frame& F) {
    const bf16* pa = (const bf16*)(F.ws + WS_PA); const bf16* y0 = (const bf16*)(F.ws + WS_Y); const bf16* y1 = y0 + (size_t)M * A_W;
    const float* bon0 = (const float*)(F.ws + WS_BON); const float* bon1 = bon0 + (size_t)M * 8;
    const int ko = kopaque(); const float *lnx_w = kin(I_LNW, ko), *lnx_b = kin(I_LNB, ko), *mu_ = kin(I_MU, ko);
    int lane = lane_id(); asm volatile("" : "+v"(lane));
    const int gw = F.vcu * NWAVES + F.wave, NGW = F.G * NWAVES, hd = lane >> 3, c0 = lane * 8;
    float lw_[8], lb_[8], mv0[8], mv1[8], mg0[8], mg1[8];
#pragma unroll
    for (int e = 0; e < 8; ++e) { lw_[e] = lnx_w[c0 + e]; lb_[e] = lnx_b[c0 + e]; mv0[e] = mu_[2 * A_W + c0 + e]; mv1[e] = mu_[A_COLS + 2 * A_W + c0 + e];
        mg0[e] = mu_[3 * A_W + c0 + e]; mg1[e] = mu_[A_COLS + 3 * A_W + c0 + e]; }
    for (int m = gw; m < M; m += NGW) {
        const int t = m & (T - 1); const bool hp = t > 0, hn = t < T - 1;
        const v4u a = *(const v4u*)(y0 + (size_t)m * A_W + c0), bq = *(const v4u*)(y1 + (size_t)m * A_W + c0);
        const bf16* p0 = pa + (size_t)m * A_COLS;
        const v4u vc = *(const v4u*)(p0 + 2 * A_W + c0), gc = *(const v4u*)(p0 + 3 * A_W + c0);
        const v4u z = (v4u){0u, 0u, 0u, 0u};
        const v4u vp = hp ? *(const v4u*)(p0 - A_COLS + 2 * A_W + c0) : z, gp = hp ? *(const v4u*)(p0 - A_COLS + 3 * A_W + c0) : z;
        const v4u vn = hn ? *(const v4u*)(p0 + A_COLS + 2 * A_W + c0) : z, gn = hn ? *(const v4u*)(p0 + A_COLS + 3 * A_W + c0) : z;
        const float bsum = bon0[(size_t)m * 8 + hd] + bon1[(size_t)m * 8 + hd];
        float y[8]; const unsigned aw[4] = {a.x, a.y, a.z, a.w}, bw[4] = {bq.x, bq.y, bq.z, bq.w};
        float s1 = 0.f;
#pragma unroll
        for (int e = 0; e < 4; ++e) { y[2 * e] = bflo(aw[e]) + bflo(bw[e]); y[2 * e + 1] = bfhi(aw[e]) + bfhi(bw[e]); s1 += y[2 * e] + y[2 * e + 1]; }
        s1 += dppf<0xB1>(s1); s1 += dppf<0x4E>(s1); s1 += dppf<0x141>(s1);
        const float mean = s1 * (1.f / 64.f); float s2 = 0.f;
#pragma unroll
        for (int e = 0; e < 8; ++e) { y[e] -= mean; s2 += y[e] * y[e]; }
        s2 += dppf<0xB1>(s2); s2 += dppf<0x4E>(s2); s2 += dppf<0x141>(s2);
        const float rstd = __builtin_amdgcn_rsqf(s2 * (1.f / 64.f) + GN_EPS);
        const unsigned vcw[4] = {vc.x, vc.y, vc.z, vc.w}, vpw[4] = {vp.x, vp.y, vp.z, vp.w}, vnw[4] = {vn.x, vn.y, vn.z, vn.w}, gcw[4] = {gc.x, gc.y, gc.z, gc.w}, gpw[4] = {gp.x, gp.y, gp.z, gp.w}, gnw[4] = {gn.x, gn.y, gn.z, gn.w};
        float o[8];
#pragma unroll
        for (int e = 0; e < 8; ++e) { const int k = e >> 1; const bool hi = e & 1;
            const float v0 = hi ? bfhi(vcw[k]) : bflo(vcw[k]), vm = hi ? bfhi(vpw[k]) : bflo(vpw[k]), vx = hi ? bfhi(vnw[k]) : bflo(vnw[k]);
            const float g0 = hi ? bfhi(gcw[k]) : bflo(gcw[k]), gm = hi ? bfhi(gpw[k]) : bflo(gpw[k]), gx = hi ? bfhi(gnw[k]) : bflo(gnw[k]);
            const float vs = v0 * (1.f - mv0[e] - mv1[e]) + mv0[e] * vm + mv1[e] * vx, gs = g0 * (1.f - mg0[e] - mg1[e]) + mg0[e] * gm + mg1[e] * gx;
            o[e] = (y[e] * rstd * lw_[e] + lb_[e] + bsum * vs) * siluf_(gs); }
        v4u ov; ov.x = cvtpk(o[0], o[1]); ov.y = cvtpk(o[2], o[3]); ov.z = cvtpk(o[4], o[5]); ov.w = cvtpk(o[6], o[7]);
        *(v4u*)(F.out + (size_t)m * OROW + OS_YA + c0 * 2) = ov;
    }
}
struct Args { const float* in[24]; unsigned char* out; unsigned char* ws; };
__global__ void __launch_bounds__(NWAVES * 64, 2) hybrid_fwd(Args args) {
    extern __shared__ __attribute__((aligned(16))) unsigned char lds[];
    Frame F;
    F.lds = (LAS unsigned char*)lds;
    F.MISC = (volatile LAS unsigned*)(F.lds + MISC_OFF);
    F.wave = __builtin_amdgcn_readfirstlane((int)threadIdx.x >> 6);
    F.G = gridDim.x; { const int bx = blockIdx.x; F.vcu = (F.G % 8 == 0) ? (bx % 8) * (F.G / 8) + bx / 8 : bx; }
    F.out = args.out; F.ws = args.ws;
    for (int u = (F.wave * 64 + lane_id()); u < (LDS_BYTES - LDSCTL_OFF) / 4; u += NWAVES * 64) ((LAS unsigned*)(F.lds + LDSCTL_OFF))[u] = 0u;
    __syncthreads();
    XcdBarrier bar = xcd_barrier_post((unsigned*)(F.ws + WS_CTL) + CW_BAR, F.MISC + 8);
#define GRID_BAR() xcd_barrier(bar, F.wave)
#ifdef PROBE_G
#define PGDBG(k) ((k) == PROBE_GSEL ? (float*)(F.ws + WS_CTL + 32768) : (float*)nullptr)
#else
#define PGDBG(k) ((float*)nullptr)
#endif
    typedef pg8::bf16_t bt;
    p0a(F); GRID_BAR();
    p0b(F); GRID_BAR();
    { pg8::Gemm g{(const bt*)(F.out + OS_H), (const bt*)(F.ws + WS_WB), nullptr, nullptr, OROW / 2, D}; pg8::Order S; S.init(M, B_COLS, F.G, (int)blockIdx.x, 1);
      const int ko = kopaque(); pg8::EpiPB E{(bt*)(F.ws + WS_R), kin(I_QG, ko), kin(I_KG, ko), (LAS float*)(F.lds + EPI_OFF), PGDBG(0)};
      pg8::gemm_phase<pg8::EpiPB, pg8::Order, true, true>(F.lds + RING_OFF, g, S, E, F.wave); }
    GRID_BAR();
    attn_mfma(F); GRID_BAR();
    attn_combine(F); GRID_BAR();
    { pg8::Gemm g{(const bt*)(F.out + OS_H), (const bt*)(F.ws + WS_WAG), nullptr, nullptr, OROW / 2, D}; pg8::Order S; S.init(M, A_COLS + PGM * 256, F.G, (int)blockIdx.x, 1);
      pg8::EpiAG E{(bt*)(F.ws + WS_PA), (bt*)(F.ws + WS_PG), PGDBG(1)};
      pg8::gemm_phase<pg8::EpiAG, pg8::Order, true, true>(F.lds + RING_OFF, g, S, E, F.wave); }
    GRID_BAR();
#ifdef PROBE_RT
    const unsigned long long prt0 = __builtin_amdgcn_s_memrealtime();
#endif
    if (blockIdx.x < NCHAIN || F.G <= NCHAIN) rwkv_chunked(F);
    if ((blockIdx.x >= NCHAIN && blockIdx.x < NCHAIN + NSIDE) || F.G <= NCHAIN) {
        const int Gs = F.G > NCHAIN ? (F.G - NCHAIN < NSIDE ? F.G - NCHAIN : NSIDE) : F.G, cs = F.G > NCHAIN ? (int)blockIdx.x - NCHAIN : (int)blockIdx.x;
        pg8::Gemm g{(const bt*)(F.out + OS_H), (const bt*)(F.ws + WS_WAG) + (size_t)(A_COLS + PGM * 256) * D, nullptr, nullptr, OROW / 2, D}; pg8::Order S; S.init(M, G_COLS - PGM * 256, Gs, cs, 1);
        pg8::EpiPG E{(bt*)(F.ws + WS_PG) + PGM * 256, PGDBG(4)};
        pg8::gemm_phase<pg8::EpiPG, pg8::Order, true, true>(F.lds + RING_OFF, g, S, E, F.wave); }
#ifdef PROBE_RT
    if (blockIdx.x == 0 && threadIdx.x == 0) ((float*)(F.ws + WS_CTL + 32768))[2] = (float)(__builtin_amdgcn_s_memrealtime() - prt0);
    if (blockIdx.x == PROBE_RT && threadIdx.x == 0) ((float*)(F.ws + WS_CTL + 32768))[3] = (float)(__builtin_amdgcn_s_memrealtime() - prt0);
#endif
    GRID_BAR();
    rwkv_post(F); GRID_BAR();
    { pg8::Gemm g{(const bt*)(F.out + OS_YA), (const bt*)(F.ws + WS_WOA), (const bt*)(F.out + OS_YB), (const bt*)(F.ws + WS_WOB), OROW / 2, A_W}; pg8::Order S; S.init(M, D, F.G, (int)blockIdx.x, 2);
      pg8::EpiMerge E{(const bt*)(F.ws + WS_PG), (bt*)(F.ws + WS_Y), PGDBG(2)};
      pg8::gemm_phase<pg8::EpiMerge, pg8::Order, true, true>(F.lds + RING_OFF, g, S, E, F.wave); }
    GRID_BAR();
    { pg8::Gemm g{(const bt*)(F.ws + WS_Y), (const bt*)(F.ws + WS_WO), nullptr, nullptr, D, D}; pg8::Order S; S.init(M, D, F.G, (int)blockIdx.x, 1);
      const int ko = kopaque(); pg8::EpiOut E{kin(I_XP, ko), kin(I_XS, ko), (const float*)(F.ws + WS_MOD), (float*)F.out, PGDBG(3)};
      pg8::gemm_phase<pg8::EpiOut, pg8::Order, true, true>(F.lds + RING_OFF, g, S, E, F.wave); }
#if defined(PROBE_TA) || defined(PROBE_G) || defined(PROBE_AT) || defined(PROBE_RT)
    GRID_BAR();
#ifdef PROBE_RT
    { const float* pf_ = (const float*)(F.ws + WS_CTL + 32768); const float f = 0.5f * pf_[3] / pf_[2]; float* o = (float*)F.out;
#else
    { const float f = ((const float*)(F.ws + WS_CTL + 32768))[0]; float* o = (float*)F.out;
#endif
      for (int i = blockIdx.x * 512 + (F.wave * 64 + lane_id()); i < 655 * 1024; i += gridDim.x * 512) o[i] *= (1.f + f); }
#endif
}

extern "C" void kernel_launch(void* const* d_in, const int* in_sizes, int n_in, void* d_out, int out_size, void* d_ws, size_t ws_size, hipStream_t stream) {
    static int grid = 0;
    if (grid == 0) {
        if (n_in != 24 || out_size != M * D || ws_size < WS_END) { fprintf(stderr, "kernel_launch: unexpected shapes: n_in %d out %d ws %zu (need %zu)\n", n_in, out_size, ws_size, (size_t)WS_END); grid = -1; return; }
        int dev = 0, cus = 0, per_cu = 0;
        if (hipGetDevice(&dev) != hipSuccess || hipDeviceGetAttribute(&cus, hipDeviceAttributeMultiprocessorCount, dev) != hipSuccess) { grid = -1; return; }
        if (hipFuncSetAttribute((const void*)hybrid_fwd, hipFuncAttributeMaxDynamicSharedMemorySize, LDS_BYTES) != hipSuccess) { fprintf(stderr, "kernel_launch: hipFuncSetAttribute failed\n"); grid = -1; return; }
        if (hipOccupancyMaxActiveBlocksPerMultiprocessor(&per_cu, (const void*)hybrid_fwd, NWAVES * 64, LDS_BYTES) != hipSuccess || per_cu < 1) { fprintf(stderr, "kernel_launch: occupancy query says %d\n", per_cu); }
        (void)hipGetLastError();
        grid = cus;
    }
    if (grid < 0) return;
    if (hipMemsetAsync((char*)d_ws + WS_CTL, 0, CTL_ZERO_BYTES, stream) != hipSuccess) return;
    Args a{};
    for (int i = 0; i < 24; ++i) a.in[i] = (const float*)d_in[i];
    a.out = (unsigned char*)d_out; a.ws = (unsigned char*)d_ws;
    hipLaunchKernelGGL(hybrid_fwd, dim3(grid), dim3(NWAVES * 64), LDS_BYTES, stream, a);
}
```

```cpp
#include <hip/hip_runtime.h>
#include <cstdio>
#include <cstdint>
__device__ __forceinline__ int lane_id() { unsigned m = ~0u; asm volatile("" : "+s"(m) :: "memory"); return (int)__builtin_amdgcn_mbcnt_hi(m, __builtin_amdgcn_mbcnt_lo(m, 0u)); }
namespace pg8 {
#define PG8_LAS __attribute__((address_space(3)))
typedef unsigned short bf16_t;
typedef short bf16x8 __attribute__((ext_vector_type(8)));
typedef float f32x4 __attribute__((ext_vector_type(4)));
typedef unsigned u32x4 __attribute__((ext_vector_type(4)));
constexpr int BM = 256, BK = 64, HALF = 128, HTB = HALF * BK * 2  , STAGE_BYTES = 8 * HTB, NXCD = 8, WGM = 8;

__host__ __device__ __forceinline__ int lds_byte(int r, int c) { const int st = (r >> 4) * 2 + (c >> 5), rr = r & 15, cc = c & 31, ob = rr * 64 + cc * 2; return st * 1024 + (ob ^ (((ob >> 9) & 1) << 5)); }
__host__ __device__ __forceinline__ void stage_rc(int b, int& R, int& C) { const int st = b / 1024, sb = b % 1024, swz = sb ^ (((sb >> 9) & 1) << 5); R = (st >> 1) * 16 + swz / 64; C = (st & 1) * 32 + (swz % 64) / 2; }
__host__ __device__ __forceinline__ int perm32(int rho) { const int n = rho >> 4, i = rho & 15; return 8 * (i >> 2) + 4 * n + (i & 3); }

struct Unit { int pm, pn, sel; };
struct Gemm { const bf16_t* A0; const bf16_t* B0; const bf16_t* A1; const bf16_t* B1; int lda; int K; };

struct Order {
    int nM, nN, nwg, G, c, CH;
    __host__ __device__ void init(int M, int N, int G_, int c_, int CH_) { nM = M / BM; nN = N / BM; nwg = nM * nN; G = G_; c = c_; CH = CH_; }
    __host__ __device__ bool next(int i, Unit& u) const {
        const int ti = (CH == 2) ? (i >> 1) : i; u.sel = (CH == 2) ? (i & 1) : 0;
        const long L = (long)ti * G + c; if (L >= nwg) return false;
        int wgid = (int)L; { const int q = nwg / NXCD, r = nwg % NXCD, xcd = wgid % NXCD, off = wgid / NXCD; wgid = (xcd < r ? xcd * (q + 1) : r * (q + 1) + (xcd - r) * q) + off; }
        const int nig = WGM * nN, gid = wgid / nig, fm = gid * WGM, gsz = (nM - fm) < WGM ? (nM - fm) : WGM;
        u.pm = fm + ((wgid % nig) % gsz); u.pn = (wgid % nig) / gsz; return true;
    }
};
__device__ __forceinline__ unsigned cvt_pk_bf16(float lo, float hi) { unsigned r; asm volatile("v_cvt_pk_bf16_f32 %0, %1, %2" : "=v"(r) : "v"(lo), "v"(hi)); return r; }
template <class Epi, class Sched, bool ALIGN_EPI = false, bool SP2 = false>
__device__ __forceinline__ void gemm_phase(PG8_LAS unsigned char* lds, const Gemm g, const Sched& S, const Epi& E, const int wave_id) {
    int tid = wave_id * 64 + lane_id(); asm volatile("" : "+v"(tid));
    const int wid = wave_id, lane = tid & 63, wr = wid >> 2, wc = wid & 3, fr = lane & 15, fq = lane >> 4;
    const int K = g.K, nt = K / BK;
    unsigned voffA[2], voffB[2];
#pragma unroll
    for (int i = 0; i < 2; ++i) { int R, C; stage_rc(tid * 16 + i * 8192, R, C); const int Rb = Epi::PERM ? ((R & ~31) + perm32(R & 31)) : R;
        voffA[i] = (unsigned)(R * g.lda + C) * 2u; voffB[i] = (unsigned)(Rb * K + C) * 2u; }
    const size_t kstep = (size_t)(BK * 2);
    const size_t hstepA = (size_t)HALF * g.lda * 2, hstepB = (size_t)HALF * K * 2;
    const size_t tstepA = 2 * hstepA, tstepB = 2 * hstepB;
    const unsigned ldsw = (unsigned)wid * 1024u;
    const int aoff = lds_byte(wr * 64 + fr, fq * 8), boff = lds_byte(wc * 32 + fr, fq * 8);
#define PG8_SA(b, h) (((b) * 2 + (h)) * HTB)
#define PG8_SB(b, h) ((4 + (b) * 2 + (h)) * HTB)
#define PG8_STAGE(bufoff, gbase, voff) do { _Pragma("unroll") for (int _i = 0; _i < 2; ++_i) \
        __builtin_amdgcn_global_load_lds((const unsigned*)((const char*)(gbase) + (voff)[_i]), (PG8_LAS unsigned*)(lds + (bufoff) + ldsw + _i * 8192), 16, 0, 0); } while (0)
#define PG8_LDA(dst, b, h) do { _Pragma("unroll") for (int m = 0; m < 4; ++m) _Pragma("unroll") for (int k = 0; k < 2; ++k) dst[m][k] = *(const PG8_LAS bf16x8*)(lds + PG8_SA(b, h) + aoff + m * 2048 + k * 1024); } while (0)
#define PG8_LDB(dst, b, h) do { _Pragma("unroll") for (int n = 0; n < 2; ++n) _Pragma("unroll") for (int k = 0; k < 2; ++k) dst[n][k] = *(const PG8_LAS bf16x8*)(lds + PG8_SB(b, h) + boff + n * 2048 + k * 1024); } while (0)
#define PG8_MMA(ai, bj, At, Bt) do { __builtin_amdgcn_s_setprio(1); _Pragma("unroll") for (int m = 0; m < 4; ++m) _Pragma("unroll") for (int n = 0; n < 2; ++n) _Pragma("unroll") for (int k = 0; k < 2; ++k) \
        acc[ai][bj][m][n] = __builtin_amdgcn_mfma_f32_16x16x32_bf16(Bt[n][k], At[m][k], acc[ai][bj][m][n], 0, 0, 0); __builtin_amdgcn_s_setprio(0); } while (0)
#define PG8_APTR(u) ((const char*)((u).sel ? g.A1 : g.A0) + (size_t)(u).pm * tstepA)
#define PG8_BPTR(u) ((const char*)((u).sel ? g.B1 : g.B0) + (size_t)(u).pn * tstepB)
#define PG8_WAIT_V(n) asm volatile("s_waitcnt vmcnt(" #n ")" ::: "memory")
#define PG8_WAIT_L(n) asm volatile("s_waitcnt lgkmcnt(" #n ")" ::: "memory")
#define PG8_BAR __builtin_amdgcn_s_barrier()
#define PG8_SCHED __builtin_amdgcn_sched_barrier(0)
    Unit cur, nxt; int ui = 0;
    if (!S.next(0, cur)) return;
#ifdef PROBE_G
    unsigned long long pg_epi = 0; const unsigned long long pg_start = __builtin_amdgcn_s_memtime();
#endif
    f32x4 acc[2][2][4][2];
#pragma unroll
    for (int a = 0; a < 2; ++a)
#pragma unroll
        for (int b = 0; b < 2; ++b)
#pragma unroll
            for (int m = 0; m < 4; ++m)
#pragma unroll
                for (int n = 0; n < 2; ++n) acc[a][b][m][n] = (f32x4){0.f, 0.f, 0.f, 0.f};
    bf16x8 At[4][2], B0[2][2], B1[2][2];
    const char* cA = PG8_APTR(cur); const char* cB = PG8_BPTR(cur);
    if constexpr (SP2) {
        PG8_STAGE(PG8_SB(0, 0), cB, voffB); PG8_STAGE(PG8_SB(0, 1), cB + hstepB, voffB); PG8_STAGE(PG8_SA(0, 0), cA, voffA); PG8_STAGE(PG8_SA(0, 1), cA + hstepA, voffA);
        if (wr == 1) PG8_BAR;
        PG8_WAIT_V(2); PG8_BAR;
        PG8_STAGE(PG8_SB(1, 0), cB + kstep, voffB); PG8_STAGE(PG8_SA(1, 0), cA + kstep, voffA); PG8_STAGE(PG8_SB(1, 1), cB + hstepB + kstep, voffB);
        PG8_WAIT_V(6); PG8_BAR;
    } else {
        PG8_STAGE(PG8_SB(0, 0), cB, voffB); PG8_STAGE(PG8_SA(0, 0), cA, voffA); PG8_STAGE(PG8_SB(0, 1), cB + hstepB, voffB); PG8_STAGE(PG8_SA(0, 1), cA + hstepA, voffA);
        if (wr == 1) PG8_BAR;
        PG8_WAIT_V(4); PG8_BAR;
        PG8_STAGE(PG8_SB(1, 0), cB + kstep, voffB); PG8_STAGE(PG8_SA(1, 0), cA + kstep, voffA); PG8_STAGE(PG8_SB(1, 1), cB + hstepB + kstep, voffB);
        PG8_WAIT_V(6); PG8_BAR;
    }
    for (;;) {
        const bool has_next = S.next(ui + 1, nxt);
        const char* nA = has_next ? PG8_APTR(nxt) : cA; const char* nB = has_next ? PG8_BPTR(nxt) : cB;
        for (int t = 0; t < nt; t += 2) {
            const bool last = (t == nt - 2);
            const char* a1 = cA + (size_t)(t + 1) * kstep;
            const char* a2 = last ? nA : cA + (size_t)(t + 2) * kstep; const char* b2 = last ? nB : cB + (size_t)(t + 2) * kstep;
            const char* a3 = a2 + kstep; const char* b3 = b2 + kstep;
            if constexpr (SP2) {
            PG8_LDB(B0, 0, 0); PG8_LDB(B1, 0, 1); PG8_SCHED; PG8_LDA(At, 0, 0); PG8_STAGE(PG8_SA(1, 1), a1 + hstepA, voffA);
            PG8_WAIT_V(8); PG8_WAIT_L(0); PG8_BAR; PG8_MMA(0, 0, At, B0); PG8_MMA(0, 1, At, B1); PG8_BAR; PG8_SCHED;
            PG8_LDA(At, 0, 1); PG8_STAGE(PG8_SB(0, 0), b2, voffB); PG8_STAGE(PG8_SB(0, 1), b2 + hstepB, voffB); PG8_STAGE(PG8_SA(0, 0), a2, voffA);
            PG8_WAIT_V(8); PG8_WAIT_L(0); PG8_BAR; PG8_MMA(1, 0, At, B0); PG8_MMA(1, 1, At, B1); PG8_BAR; PG8_SCHED;
            PG8_LDB(B0, 1, 0); PG8_LDB(B1, 1, 1); PG8_SCHED; PG8_LDA(At, 1, 0); PG8_STAGE(PG8_SA(0, 1), a2 + hstepA, voffA);
            PG8_WAIT_V(8); PG8_WAIT_L(0); PG8_BAR; PG8_MMA(0, 0, At, B0); PG8_MMA(0, 1, At, B1); PG8_BAR; PG8_SCHED;
            PG8_LDA(At, 1, 1); PG8_STAGE(PG8_SB(1, 0), b3, voffB); PG8_STAGE(PG8_SB(1, 1), b3 + hstepB, voffB); PG8_STAGE(PG8_SA(1, 0), a3, voffA);
            PG8_WAIT_V(8); PG8_WAIT_L(0); PG8_BAR; PG8_MMA(1, 0, At, B0); PG8_MMA(1, 1, At, B1); PG8_BAR; PG8_SCHED;
            } else {
            PG8_LDB(B0, 0, 0); PG8_SCHED; PG8_LDA(At, 0, 0); PG8_STAGE(PG8_SA(1, 1), a1 + hstepA, voffA);
            PG8_WAIT_L(8); PG8_BAR; PG8_WAIT_L(0); PG8_MMA(0, 0, At, B0); PG8_BAR; PG8_SCHED;
            PG8_LDB(B1, 0, 1); PG8_STAGE(PG8_SB(0, 0), b2, voffB);
            PG8_BAR; PG8_WAIT_L(0); PG8_MMA(0, 1, At, B1); PG8_BAR;
            PG8_LDA(At, 0, 1); PG8_STAGE(PG8_SA(0, 0), a2, voffA);
            PG8_BAR; PG8_WAIT_L(0); PG8_MMA(1, 0, At, B0); PG8_BAR; PG8_SCHED;
            PG8_STAGE(PG8_SB(0, 1), b2 + hstepB, voffB);
            PG8_WAIT_V(6); PG8_BAR; PG8_MMA(1, 1, At, B1); PG8_BAR;
            PG8_LDB(B0, 1, 0); PG8_SCHED; PG8_LDA(At, 1, 0); PG8_STAGE(PG8_SA(0, 1), a2 + hstepA, voffA);
            PG8_WAIT_L(8); PG8_BAR; PG8_WAIT_L(0); PG8_MMA(0, 0, At, B0); PG8_BAR; PG8_SCHED;
            PG8_LDB(B1, 1, 1); PG8_STAGE(PG8_SB(1, 0), b3, voffB);
            PG8_BAR; PG8_WAIT_L(0); PG8_MMA(0, 1, At, B1); PG8_BAR;
            PG8_LDA(At, 1, 1); PG8_STAGE(PG8_SA(1, 0), a3, voffA);
            PG8_BAR; PG8_WAIT_L(0); PG8_MMA(1, 0, At, B0); PG8_BAR; PG8_SCHED;
            PG8_STAGE(PG8_SB(1, 1), b3 + hstepB, voffB);
            PG8_WAIT_V(6); PG8_BAR; PG8_MMA(1, 1, At, B1); PG8_BAR;
            }
        }
        if constexpr (ALIGN_EPI) { if (wr == 0) PG8_BAR; }
#ifdef PROBE_G
        const unsigned long long pg_t0 = __builtin_amdgcn_s_memtime();
#endif
        const bool keep = E(acc, cur, wr, wc, fr, fq);
#ifdef PROBE_G
        pg_epi += __builtin_amdgcn_s_memtime() - pg_t0;
#endif
        if (!has_next) break;
        if (!keep) {
#pragma unroll
        for (int a = 0; a < 2; ++a)
#pragma unroll
            for (int b = 0; b < 2; ++b)
#pragma unroll
                for (int m = 0; m < 4; ++m)
#pragma unroll
                    for (int n = 0; n < 2; ++n) acc[a][b][m][n] = (f32x4){0.f, 0.f, 0.f, 0.f};
        }
        cur = nxt; cA = nA; cB = nB; ++ui;
        if constexpr (ALIGN_EPI) { if (wr == 1) PG8_BAR; }
    }
#ifdef PROBE_G
    if (E.dbg && blockIdx.x == 0 && threadIdx.x == 0) { const double tot = (double)(__builtin_amdgcn_s_memtime() - pg_start);
        E.dbg[0] = (PROBE_G == 1) ? (float)(tot / (double)(ui + 1) / 262144.0) : (float)((double)pg_epi / tot); }
#endif
    PG8_WAIT_V(0);
    if constexpr (!ALIGN_EPI) { if (wr == 0) PG8_BAR; }
    PG8_BAR;
#undef PG8_SA
#undef PG8_SB
#undef PG8_STAGE
#undef PG8_LDA
#undef PG8_LDB
#undef PG8_MMA
#undef PG8_APTR
#undef PG8_BPTR
#undef PG8_WAIT_V
#undef PG8_WAIT_L
#undef PG8_BAR
#undef PG8_SCHED
}
}

constexpr int NWAVES = 8;
constexpr int T = 8192, D = 1024, NBP = 8, NBS = 2, NB = NBP + NBS, M = NB * T;
constexpr int NCHAIN = 160, NSIDE = 72;
#ifndef PG_MAIN_TILES
#define PG_MAIN_TILES 0
#endif
constexpr int PGM = PG_MAIN_TILES;
constexpr int A_HEADS = 8, A_HD = 64, A_W = 512, RANK = 64;
constexpr int A_COLS = 2304, B_COLS = 5120, G_COLS = 2048, IN_COLS = 9472, AG_COLS = A_COLS + G_COLS;
constexpr int B_QKV = 1536, B_W = 512, B_HD = 128;
constexpr float RMS_EPS = 1e-6f, GN_EPS = 64e-5f;
constexpr size_t MiB = 1u << 20;
constexpr size_t WS_CTL = 0, CTL_ZERO_BYTES = 65536;
constexpr size_t WS_MOD = 1 * MiB;
constexpr size_t WS_BTAB = 1 * MiB + 128 * 1024;
constexpr size_t WS_WB = 2 * MiB;
constexpr size_t WS_WAG = 12 * MiB;
constexpr size_t WS_WOA = 21 * MiB, WS_WOB = 22 * MiB, WS_WO = 23 * MiB;
constexpr size_t WS_BON = 26 * MiB;
constexpr size_t WS_R = 32 * MiB;
constexpr size_t WS_PA = WS_R, WS_PG = WS_R + 360 * MiB;
constexpr size_t WS_Y = 832 * MiB;
constexpr size_t WS_END = 992 * MiB;
constexpr int CW_BAR = 4096;
constexpr int OS_H = 0, OS_YA = 2048, OS_YB = 3072, OROW = 4096;
constexpr int RING_OFF = 0, RING_BYTES = 131072;
constexpr int LDSCTL_OFF = RING_BYTES, MISC_OFF = LDSCTL_OFF + 320;
constexpr int EPI_OFF = RING_BYTES + 1024;
constexpr int LDS_BYTES = 147456;

#define GAS __attribute__((address_space(1)))
#define LAS __attribute__((address_space(3)))
typedef unsigned short bf16;
typedef unsigned v4u __attribute__((ext_vector_type(4)));
typedef unsigned v2u __attribute__((ext_vector_type(2)));
typedef float f32x4 __attribute__((ext_vector_type(4)));
typedef short bf16x8 __attribute__((ext_vector_type(8)));
typedef GAS unsigned gu32;
#define RLX_AGENT __ATOMIC_RELAXED, __HIP_MEMORY_SCOPE_AGENT
#define LDS_WAIT() asm volatile("s_waitcnt lgkmcnt(0)" ::: "memory")
#define VM_WAIT() asm volatile("s_waitcnt vmcnt(0)" ::: "memory")
__device__ __forceinline__ unsigned f2bf(float f) { unsigned u = __builtin_bit_cast(unsigned, f); return (u + 0x7fffu + ((u >> 16) & 1u)) >> 16; }
__device__ __forceinline__ unsigned pk2(float lo, float hi) { return f2bf(lo) | (f2bf(hi) << 16); }
typedef float f32x2_t __attribute__((ext_vector_type(2))); typedef __bf16 bf16x2_t __attribute__((ext_vector_type(2)));
__device__ __forceinline__ unsigned cvtpk(float lo, float hi) { f32x2_t v = {lo, hi}; bf16x2_t b = __builtin_convertvector(v, bf16x2_t); return __builtin_bit_cast(unsigned, b); }
__device__ __forceinline__ float bf2f(unsigned short h) { return __builtin_bit_cast(float, (unsigned)h << 16); }
__device__ __forceinline__ float bflo(unsigned w) { return __builtin_bit_cast(float, w << 16); }
__device__ __forceinline__ float bfhi(unsigned w) { return __builtin_bit_cast(float, w & 0xffff0000u); }
__device__ __forceinline__ float sigmoidf_(float v) { return __builtin_amdgcn_rcpf(1.f + __expf(-v)); }
__device__ __forceinline__ float siluf_(float v) { return v * sigmoidf_(v); }
__device__ __forceinline__ float wave_sum(float v) {
#pragma unroll
    for (int o = 1; o < 64; o <<= 1) v += __shfl_xor(v, o);
    return v;
}
__device__ __forceinline__ float wave_max(float v) {
#pragma unroll
    for (int o = 1; o < 64; o <<= 1) v = fmaxf(v, __shfl_xor(v, o));
    return v;
}

#define XB_TMO      128
#define XB_XCNT(j)  (256  + 64 * (j))
#define XB_XSUB(j)  (1280 + 64 * (j))
#define XB_XGEN(j)  (2304 + 64 * (j))
#define XB_TOP      3328
#define XB_TOPGEN   3392
#define XCD_BAR_WORDS 3456
#define XB_SPIN_CAP (1u << 22)
__device__ __forceinline__ unsigned xb_ld(unsigned* p)              { return __hip_atomic_load(p, __ATOMIC_RELAXED, __HIP_MEMORY_SCOPE_AGENT); }
__device__ __forceinline__ unsigned xb_add(unsigned* p, unsigned v) { return __hip_atomic_fetch_add(p, v, __ATOMIC_RELAXED, __HIP_MEMORY_SCOPE_AGENT); }
__device__ __forceinline__ unsigned xb_xcc_id() { return (unsigned)__builtin_amdgcn_s_getreg((3 << 11) | 20) & 0xFu; }
#define XB_SPIN(cond, bar) do { unsigned _sp = 0; while (cond) { __builtin_amdgcn_s_sleep(1); \
    if ((++_sp & 255u) == 0u) { if (xb_ld(&(bar)[XB_TMO])) break; if (_sp > XB_SPIN_CAP) { atomicAdd(&(bar)[XB_TMO], 1u); break; } } } } while (0)
struct XcdBarrier { unsigned* bar; unsigned x; volatile LAS unsigned* st; };
__device__ __forceinline__ XcdBarrier xcd_barrier_post(unsigned* bar, volatile LAS unsigned* st) {
    XcdBarrier b; b.bar = bar; b.x = xb_xcc_id(); b.st = st;
    if (threadIdx.x == 0) (void)xb_add(&bar[XB_XCNT(b.x)], 1u);
    return b;
}
__device__ __forceinline__ void xcd_barrier_complete(unsigned* bar, unsigned x, unsigned& nloc, unsigned& nx) {
    const unsigned G = gridDim.x * gridDim.y * gridDim.z;
    unsigned sum, cnt, mine, sp = 0u;
    for (;;) {
        sum = 0u; cnt = 0u; mine = 0u;
#pragma unroll
        for (unsigned j = 0; j < 16; ++j) { const unsigned c = xb_ld(&bar[XB_XCNT(j)]); sum += c; cnt += (c > 0u) ? 1u : 0u; mine = (j == x) ? c : mine; }
        if (sum == G) break;
        __builtin_amdgcn_s_sleep(1);
        if ((++sp & 255u) == 0u) { if (xb_ld(&bar[XB_TMO])) break; if (sp > XB_SPIN_CAP) { atomicAdd(&bar[XB_TMO], 1u); break; } }
    }
    nloc = mine > 0u ? mine : 1u; nx = cnt > 0u ? cnt : 1u;
}
__device__ __forceinline__ void xcd_barrier(const XcdBarrier& b, const int wave_id) {
    asm volatile("s_waitcnt vmcnt(0)" ::: "memory");
    __syncthreads();
    if (wave_id == 0 && lane_id() == 0) {
        unsigned* bar = b.bar;
        __builtin_amdgcn_s_waitcnt(0);
        unsigned nloc = b.st[0], nx = b.st[1];
        if (nloc == 0u) { xcd_barrier_complete(bar, b.x, nloc, nx); b.st[0] = nloc; b.st[1] = nx; }
        const unsigned old = xb_add(&bar[XB_XSUB(b.x)], 1u);
        const unsigned gen = old / nloc;
        if (old + 1u == (gen + 1u) * nloc) {
            __builtin_amdgcn_fence(__ATOMIC_RELEASE, "agent");
            asm volatile("s_waitcnt vmcnt(0)" ::: "memory");
            const unsigned og = xb_add(&bar[XB_TOP], 1u);
            const unsigned tg = og / nx;
            if (og + 1u == (tg + 1u) * nx) xb_add(&bar[XB_TOPGEN], 1u);
            else XB_SPIN(xb_ld(&bar[XB_TOPGEN]) == tg, bar);
            __builtin_amdgcn_fence(__ATOMIC_ACQUIRE, "agent");
            xb_add(&bar[XB_XGEN(b.x)], 1u);
            asm volatile("s_waitcnt vmcnt(0)" ::: "memory");
        } else {
            XB_SPIN(xb_ld(&bar[XB_XGEN(b.x)]) == gen, bar);
            __builtin_amdgcn_fence(__ATOMIC_ACQUIRE, "agent");
            asm volatile("s_waitcnt vmcnt(0)" ::: "memory");
        }
    }
    __syncthreads();
}

struct Frame {
    LAS unsigned char* lds;
    volatile LAS unsigned* MISC;
    int wave;
    __device__ __forceinline__ int lane_() const { return lane_id(); }
    int vcu, G;
    unsigned char* out;
    unsigned char* ws;
};
enum { I_XP = 0, I_XS, I_CP, I_CS, I_RELB, I_NORMW, I_WADA, I_BADA, I_WIN, I_MU, I_W0, I_W2, I_A0, I_A2, I_KK, I_KA, I_RK, I_LNW, I_LNB, I_QG, I_KG, I_WOA, I_WOB, I_WO };
__device__ __forceinline__ int kopaque() { int z = 0; asm volatile("" : "+s"(z)); return z; }
__device__ __forceinline__ const float* kin(int k, int kof) { return ((const float* const __attribute__((address_space(4)))*)__builtin_amdgcn_kernarg_segment_ptr())[k + kof]; }
__device__ __forceinline__ const float* xrow_ptr(const float* xp, const float* xs, int m) { return m < NBP * T ? xp + (size_t)m * D : xs + (size_t)(m - NBP * T) * D; }

namespace pg8 {
struct EpiPB {
    static constexpr bool PERM = true;
    bf16_t* O; const float* qg; const float* kg; PG8_LAS float* P; float* dbg;
    __device__ __forceinline__ bool operator()(f32x4 (&acc)[2][2][4][2], const Unit& u, int wr, int wc, int fr, int fq) const {
        const int row0 = u.pm * BM + wr * 64 + fr, col0 = u.pn * BM + wc * 32 + 8 * fq;
        if (u.pn < 12) {
#pragma unroll
            for (int ai = 0; ai < 2; ++ai)
#pragma unroll
                for (int m = 0; m < 4; ++m) {
#pragma unroll
                    for (int bj = 0; bj < 2; ++bj) { const f32x4 a = acc[ai][bj][m][0], b = acc[ai][bj][m][1];
                        float s = (a[0] * a[0] + a[1] * a[1]) + (a[2] * a[2] + a[3] * a[3]) + (b[0] * b[0] + b[1] * b[1]) + (b[2] * b[2] + b[3] * b[3]);
                        s += __shfl_xor(s, 16); s += __shfl_xor(s, 32);
                        if (fq == 0) P[((ai * HALF + wr * 64 + m * 16 + fr) * 2 + bj) * 4 + wc] = s; }
                    asm volatile("" ::: "memory"); }
            asm volatile("s_waitcnt lgkmcnt(0)" ::: "memory"); __builtin_amdgcn_s_barrier(); asm volatile("" ::: "memory");
            const bool isq = u.pn < 6; const float* gp = (isq ? qg : kg) + wc * 32 + 8 * fq; const float gs = isq ? 0.08838834764831845f * 1.4426950408889634f : 1.f;
            float gn[8];
#pragma unroll
            for (int e = 0; e < 8; ++e) gn[e] = gp[e] * gs;
#pragma unroll
            for (int ai = 0; ai < 2; ++ai)
#pragma unroll
                for (int m = 0; m < 4; ++m)
#pragma unroll
                    for (int bj = 0; bj < 2; ++bj) { const f32x4 p4 = *(const PG8_LAS f32x4*)(P + ((ai * HALF + wr * 64 + m * 16 + fr) * 2 + bj) * 4);
                        const float rs = 1.0f / sqrtf(((p4[0] + p4[1]) + (p4[2] + p4[3])) * (1.f / 128.f) + 1e-6f);
#pragma unroll
                        for (int e = 0; e < 4; ++e) { acc[ai][bj][m][0][e] *= rs * gn[e]; acc[ai][bj][m][1][e] *= rs * gn[4 + e]; }
                        asm volatile("" ::: "memory"); }
        }
        const bool act = u.pn >= 18;
#pragma unroll
        for (int ai = 0; ai < 2; ++ai)
#pragma unroll
            for (int m = 0; m < 4; ++m) { bf16_t* rowp = O + (size_t)(row0 + ai * HALF + m * 16) * B_COLS + col0;
#pragma unroll
                for (int bj = 0; bj < 2; ++bj) { f32x4 v0 = acc[ai][bj][m][0], v1 = acc[ai][bj][m][1];
                    if (act) {
#pragma unroll
                        for (int e = 0; e < 4; ++e) { v0[e] = siluf_(v0[e]); v1[e] = siluf_(v1[e]); } }
                    u32x4 w; w.x = cvt_pk_bf16(v0[0], v0[1]); w.y = cvt_pk_bf16(v0[2], v0[3]); w.z = cvt_pk_bf16(v1[0], v1[1]); w.w = cvt_pk_bf16(v1[2], v1[3]);
                    *(u32x4*)(rowp + bj * HALF) = w; } }
        return false;
    }
};
struct EpiAG {
    static constexpr bool PERM = true;
    bf16_t* PA; bf16_t* PG; float* dbg;
    __device__ __forceinline__ bool operator()(const f32x4 (&acc)[2][2][4][2], const Unit& u, int wr, int wc, int fr, int fq) const {
        bf16_t* base = PA; const int ldc = A_COLS; const int pn = u.pn < 7 ? u.pn : 8;
        const int row0 = u.pm * BM + wr * 64 + fr, col0 = pn * BM + wc * 32 + 8 * fq;
#pragma unroll
        for (int ai = 0; ai < 2; ++ai)
#pragma unroll
            for (int m = 0; m < 4; ++m) { bf16_t* rowp = base + (size_t)(row0 + ai * HALF + m * 16) * ldc + col0;
#pragma unroll
                for (int bj = 0; bj < 2; ++bj) { const f32x4 v0 = acc[ai][bj][m][0], v1 = acc[ai][bj][m][1];
                    u32x4 w; w.x = cvt_pk_bf16(v0[0], v0[1]); w.y = cvt_pk_bf16(v0[2], v0[3]); w.z = cvt_pk_bf16(v1[0], v1[1]); w.w = cvt_pk_bf16(v1[2], v1[3]);
                    *(u32x4*)(rowp + bj * HALF) = w; } }
        return false;
    }
};
struct EpiPG {
    static constexpr bool PERM = true;
    bf16_t* PG; bf16_t* PA; float* dbg;
    __device__ __forceinline__ bool operator()(const f32x4 (&acc)[2][2][4][2], const Unit& u, int wr, int wc, int fr, int fq) const {
        const bool ispa = u.pn == 0; bf16_t* base = ispa ? PA : PG; const int ldc = ispa ? A_COLS : G_COLS;
        const int row0 = u.pm * BM + wr * 64 + fr, col0 = (ispa ? 7 : u.pn - 1) * BM + wc * 32 + 8 * fq;
#pragma unroll
        for (int ai = 0; ai < 2; ++ai)
#pragma unroll
            for (int m = 0; m < 4; ++m) { bf16_t* rowp = base + (size_t)(row0 + ai * HALF + m * 16) * ldc + col0;
#pragma unroll
                for (int bj = 0; bj < 2; ++bj) { const f32x4 v0 = acc[ai][bj][m][0], v1 = acc[ai][bj][m][1];
                    u32x4 w; w.x = cvt_pk_bf16(v0[0], v0[1]); w.y = cvt_pk_bf16(v0[2], v0[3]); w.z = cvt_pk_bf16(v1[0], v1[1]); w.w = cvt_pk_bf16(v1[2], v1[3]);
                    *(u32x4*)(rowp + bj * HALF) = w; } }
        return false;
    }
};
struct EpiMerge {
    static constexpr bool PERM = true;
    const bf16_t* PG; bf16_t* O; float* dbg;
    __device__ __forceinline__ bool operator()(f32x4 (&acc)[2][2][4][2], const Unit& u, int wr, int wc, int fr, int fq) const {
        const int row0 = u.pm * BM + wr * 64 + fr, col0 = u.pn * BM + wc * 32 + 8 * fq;
#pragma unroll
        for (int ai = 0; ai < 2; ++ai)
#pragma unroll
            for (int m = 0; m < 4; ++m) { const size_t row = (size_t)(row0 + ai * HALF + m * 16);
#pragma unroll
                for (int bj = 0; bj < 2; ++bj) { const int col = col0 + bj * HALF;
                    const u32x4 gb8 = *(const u32x4*)(PG + row * G_COLS + D + col);
                    float zb[8] = {bflo(gb8.x), bfhi(gb8.x), bflo(gb8.y), bfhi(gb8.y), bflo(gb8.z), bfhi(gb8.z), bflo(gb8.w), bfhi(gb8.w)};
                    if (u.sel == 0) {
                        const u32x4 ga8 = *(const u32x4*)(PG + row * G_COLS + col);
                        float za[8] = {bflo(ga8.x), bfhi(ga8.x), bflo(ga8.y), bfhi(ga8.y), bflo(ga8.z), bfhi(ga8.z), bflo(ga8.w), bfhi(ga8.w)};
#pragma unroll
                        for (int e = 0; e < 8; ++e) { const float ea = __expf(-fminf(fmaxf(za[e], -30.f), 30.f)), eb = __expf(-fminf(fmaxf(zb[e], -30.f), 30.f));
                            const float r = (1.f + eb) * __builtin_amdgcn_rcpf(1.f + ea); acc[ai][bj][m][e >> 2][e & 3] *= r; }
                    } else {
                        float o[8];
#pragma unroll
                        for (int e = 0; e < 8; ++e) { const float eb = __expf(-fminf(fmaxf(zb[e], -30.f), 30.f)); o[e] = acc[ai][bj][m][e >> 2][e & 3] * __builtin_amdgcn_rcpf(1.f + eb); }
                        u32x4 w; w.x = cvt_pk_bf16(o[0], o[1]); w.y = cvt_pk_bf16(o[2], o[3]); w.z = cvt_pk_bf16(o[4], o[5]); w.w = cvt_pk_bf16(o[6], o[7]);
                        *(u32x4*)(O + row * D + col) = w;
                    } } }
        return u.sel == 0;
    }
};
struct EpiOut {
    static constexpr bool PERM = false;
    const float* xp; const float* xs; const float* mod; float* out; float* dbg;
    __device__ __forceinline__ bool operator()(const f32x4 (&acc)[2][2][4][2], const Unit& u, int wr, int wc, int fr, int fq) const {
        const int rowt = u.pm * BM, b = rowt >> 13; const float* xb = rowt < NBP * T ? xp + (size_t)rowt * D : xs + (size_t)(rowt - NBP * T) * D;
        const int rl0 = wr * 64 + fr, col0 = u.pn * BM + wc * 32 + 4 * fq; const float* gt = mod + b * 3072 + 2048;
#pragma unroll
        for (int bj = 0; bj < 2; ++bj)
#pragma unroll
            for (int n = 0; n < 2; ++n) { const int col = col0 + bj * HALF + n * 16; const f32x4 g4 = *(const f32x4*)(gt + col);
#pragma unroll
                for (int ai = 0; ai < 2; ++ai)
#pragma unroll
                    for (int m = 0; m < 4; ++m) { const int rl = rl0 + ai * HALF + m * 16; const f32x4 x4 = *(const f32x4*)(xb + (size_t)rl * D + col);
                        *(f32x4*)(out + (size_t)(rowt + rl) * D + col) = x4 + g4 * acc[ai][bj][m][n]; } }
        return false;
    }
};
}

__device__ __forceinline__ void p0_transpose_item(const float* W, int K, int N, bf16* WT, int k0, int n0, int drow0, LAS float* scr, int lane) {
#pragma unroll 8
    for (int i = 0; i < 32; ++i) { const int kk = 2 * i + (lane >> 5); scr[kk * 33 + (lane & 31)] = W[(size_t)(k0 + kk) * N + n0 + (lane & 31)]; }
    LDS_WAIT(); asm volatile("" ::: "memory");
    const int c = lane & 7;
#pragma unroll
    for (int j = 0; j < 4; ++j) { const int n = (lane >> 3) + 8 * j; const LAS float* s = scr + (8 * c) * 33 + n;
        v4u o; o.x = pk2(s[0 * 33], s[1 * 33]); o.y = pk2(s[2 * 33], s[3 * 33]); o.z = pk2(s[4 * 33], s[5 * 33]); o.w = pk2(s[6 * 33], s[7 * 33]);
        *(GAS v4u*)(WT + (size_t)(drow0 + n) * K + k0 + 8 * c) = o; }
    LDS_WAIT(); asm volatile("" ::: "memory");
}
__device__ __forceinline__ int t5_bucket(int rel) {
    const int n = rel < 0 ? -rel : rel; int ret = rel > 0 ? 16 : 0;
    const float lf = logf((float)(n > 1 ? n : 1) / 8.0f) / 4.852030263919617f * 8.0f;
    int large = 8 + (int)lf; large = large < 15 ? large : 15;
    return ret + (n < 8 ? n : large);
}
__device__ __forceinline__ void p0a(Frame& F) {
    const int ko = kopaque(); const float *cp_ = kin(I_CP, ko), *cs_ = kin(I_CS, ko), *w_ada = kin(I_WADA, ko), *b_ada = kin(I_BADA, ko), *rel_bias = kin(I_RELB, ko), *w_in = kin(I_WIN, ko), *w_out_a = kin(I_WOA, ko), *w_out_b = kin(I_WOB, ko), *w_out = kin(I_WO, ko);
    float* mod = (float*)(F.ws + WS_MOD);
    if (blockIdx.x < 48) {
        LAS float* sc = (LAS float*)F.lds;
        LAS float* part = (LAS float*)(F.lds + 40960);
        for (int i = (F.wave * 64 + lane_id()); i < NB * D; i += NWAVES * 64) { const int b = i >> 10, k = i & 1023; const float cv = b < NBP ? cp_[b * D + k] : cs_[(b - NBP) * D + k]; sc[i] = siluf_(cv); }
        __syncthreads();
        const int j = blockIdx.x * 64 + lane_id(); float a[NB];
#pragma unroll
        for (int b = 0; b < NB; ++b) a[b] = 0.f;
        for (int k = F.wave * 128; k < F.wave * 128 + 128; ++k) { const float w = w_ada[(size_t)k * 3072 + j];
#pragma unroll
            for (int b = 0; b < NB; ++b) a[b] += sc[b * D + k] * w; }
#pragma unroll
        for (int b = 0; b < NB; ++b) part[(F.wave * NB + b) * 64 + lane_id()] = a[b];
        __syncthreads();
        for (int i = (F.wave * 64 + lane_id()); i < NB * 64; i += NWAVES * 64) { const int b = i >> 6, l = i & 63; float s = b_ada[blockIdx.x * 64 + l];
#pragma unroll
            for (int w = 0; w < NWAVES; ++w) s += part[(w * NB + b) * 64 + l];
            mod[b * 3072 + blockIdx.x * 64 + l] = s; }
        __syncthreads();
    }
    if (blockIdx.x == 255 % gridDim.x) {
        float* bt = (float*)(F.ws + WS_BTAB);
        for (int i = (F.wave * 64 + lane_id()); i < 12 * 129; i += NWAVES * 64) { const int gh = i / 129, r = i % 129, gi = gh >> 2; const int rel = (r - 64) * (1 << (2 * gi));
            bt[i] = rel_bias[t5_bucket(rel) * 12 + gh] * 1.4426950408889634f; }
    }
    LAS float* scr = (LAS float*)(F.lds + RING_OFF + F.wave * 16384);
    const int gw = F.vcu * NWAVES + F.wave, NGW = F.G * NWAVES;
    constexpr int I_IN = (D / 64) * (IN_COLS / 32), I_OA = (A_W / 64) * (D / 32), I_OB = (B_W / 64) * (D / 32), I_O = (D / 64) * (D / 32);
    constexpr int NITEMS = I_IN + I_OA + I_OB + I_O;
    for (int it = gw; it < NITEMS; it += NGW) {
        int r = it;
        if (r < I_IN) { const int nblk = IN_COLS / 32, kb = r / nblk, nb = r % nblk, n0 = nb * 32;
            bf16* dst; int drow;
            if (n0 < A_COLS) { dst = (bf16*)(F.ws + WS_WAG); drow = n0 < 1792 ? n0 : (n0 < 2048 ? n0 + 256 : n0 - 256); }
            else if (n0 < A_COLS + B_COLS) { dst = (bf16*)(F.ws + WS_WB); drow = n0 - A_COLS; }
            else { dst = (bf16*)(F.ws + WS_WAG); drow = A_COLS + (n0 - A_COLS - B_COLS); }
            p0_transpose_item(w_in, D, IN_COLS, dst, kb * 64, n0, drow, scr, lane_id()); continue; }
        r -= I_IN;
        if (r < I_OA) { const int nblk = D / 32, kb = r / nblk, nb = r % nblk; p0_transpose_item(w_out_a, A_W, D, (bf16*)(F.ws + WS_WOA), kb * 64, nb * 32, nb * 32, scr, lane_id()); continue; }
        r -= I_OA;
        if (r < I_OB) { const int nblk = D / 32, kb = r / nblk, nb = r % nblk; p0_transpose_item(w_out_b, B_W, D, (bf16*)(F.ws + WS_WOB), kb * 64, nb * 32, nb * 32, scr, lane_id()); continue; }
        r -= I_OB;
        { const int nblk = D / 32, kb = r / nblk, nb = r % nblk; p0_transpose_item(w_out, D, D, (bf16*)(F.ws + WS_WO), kb * 64, nb * 32, nb * 32, scr, lane_id()); }
    }
}
__device__ __forceinline__ void p0b(Frame& F) {
    const int ko = kopaque(); const float *xp = kin(I_XP, ko), *xs = kin(I_XS, ko), *norm_w = kin(I_NORMW, ko);
    const float* mod = (const float*)(F.ws + WS_MOD);
    const int gw = F.vcu * NWAVES + F.wave, NGW = F.G * NWAVES, lane = lane_id();
    const int per = (M + NGW - 1) / NGW, m0 = gw * per, m1 = (m0 + per < M) ? m0 + per : M;
    int bcur = -1; f32x4 cs[4], sh[4];
    for (int m = m0; m < m1; ++m) {
        const int b = m >> 13;
        if (b != bcur) { bcur = b;
#pragma unroll
            for (int j = 0; j < 4; ++j) { const int col = 4 * (lane + 64 * j); const f32x4 nw = *(const f32x4*)(norm_w + col), sc = *(const f32x4*)(mod + b * 3072 + 1024 + col);
                cs[j] = nw * (sc + 1.f); sh[j] = *(const f32x4*)(mod + b * 3072 + col); } }
        const f32x4* xr = (const f32x4*)xrow_ptr(xp, xs, m) + lane;
        f32x4 v[4]; float s = 0.f;
#pragma unroll
        for (int j = 0; j < 4; ++j) { v[j] = xr[64 * j]; s += (v[j].x * v[j].x + v[j].y * v[j].y) + (v[j].z * v[j].z + v[j].w * v[j].w); }
        const float rs = __builtin_amdgcn_rsqf(wave_sum(s) * (1.f / D) + RMS_EPS);
        v2u* o8 = (v2u*)(F.out + (size_t)m * OROW + OS_H) + lane;
#pragma unroll
        for (int j = 0; j < 4; ++j) { const f32x4 h = v[j] * rs * cs[j] + sh[j]; v2u w; w.x = cvtpk(h.x, h.y); w.y = cvtpk(h.z, h.w); o8[64 * j] = w; }
    }
}
typedef short v4i16_t __attribute__((ext_vector_type(4)));
typedef float f32x4a __attribute__((ext_vector_type(4)));
constexpr int AT_K = 0, AT_V = 65536, AT_BT = RING_BYTES + 9216 + 1024;
constexpr size_t WS_LSE = WS_Y;
__device__ __forceinline__ void attn_unit_geom(int u, int& b, int& gi, int& hh, int& res, int& blk) {
    const int sub = u & 63; int r = u >> 6; hh = r & 3; r >>= 2; gi = r % 3; b = r / 3;
    if (gi == 0) { res = 0; blk = sub; } else if (gi == 1) { res = sub >> 4; blk = sub & 15; } else { res = sub >> 2; blk = sub & 3; }
}
__device__ __forceinline__ void glds16(const void* gsrc, unsigned lds_dst) { unsigned keep;
    asm volatile("s_mov_b32 %0, m0\n\ts_mov_b32 m0, %2\n\ts_nop 0\n\tglobal_load_lds_dwordx4 %1, off\n\ts_mov_b32 m0, %0" : "=&s"(keep) : "v"(gsrc), "s"(lds_dst) : "memory"); }
__device__ __forceinline__ void attn_dma_k_half(Frame& F, const bf16* pb, int b, int lg, int L, int res, int head, int q0, int hb) {
    const int lane = lane_id();
#pragma unroll
    for (int ii = 0; ii < 4; ++ii) { const int i = (hb >> 2) + F.wave * 4 + ii, row = 4 * i + (lane >> 4); int kp = q0 - 64 + ((row - q0) & 255); kp = kp < 0 ? 0 : (kp >= L ? L - 1 : kp);
        const int c = (lane & 15) ^ (row & 15);
        const bf16* src = pb + (size_t)(b * T + (kp << lg) + res) * B_COLS + B_QKV + head * 128 + c * 8;
        glds16(src, (unsigned)__builtin_amdgcn_readfirstlane((int)(unsigned)(size_t)(F.lds + AT_K + i * 1024))); }
}
__device__ __forceinline__ void attn_dma_v_half(Frame& F, const bf16* pb, int b, int lg, int L, int res, int head, int q0, int hb) {
    const int lane = lane_id();
#pragma unroll
    for (int jj = 0; jj < 4; ++jj) { const int j = F.wave * 4 + jj, dblk = j >> 3, kgrp = (hb >> 4) + (j & 7), row = 16 * kgrp + (lane >> 2); int kp = q0 - 64 + ((row - q0) & 255); kp = kp < 0 ? 0 : (kp >= L ? L - 1 : kp);
        const bf16* src = pb + (size_t)(b * T + (kp << lg) + res) * B_COLS + 2 * B_QKV + head * 128 + dblk * 32 + (lane & 3) * 8;
        glds16(src, (unsigned)__builtin_amdgcn_readfirstlane((int)(unsigned)(size_t)(F.lds + AT_V + dblk * 16384 + kgrp * 1024))); }
}
__device__ __forceinline__ void attn_mfma(Frame& F, bool dry = false) {
    bf16* pb = (bf16*)(F.ws + WS_R); const float* btab = (const float*)(F.ws + WS_BTAB); float* lse = (float*)(F.ws + WS_LSE);
    int lane = lane_id(); asm volatile("" : "+v"(lane));
    const int w = F.wave, qi = lane & 15, g = lane >> 4;
    LAS float* btp = (LAS float*)(F.lds + AT_BT);
    const int NU = NB * 3 * 4 * 64, per = (NU + F.G - 1) / F.G; const int u0 = F.vcu * per, u1 = (u0 + per < NU) ? u0 + per : NU;
    if (u0 >= u1) return;
#ifdef PROBE_AT
    const unsigned long long pat_t0 = __builtin_amdgcn_s_memtime();
#endif
    int koff[4];
#pragma unroll
    for (int ks = 0; ks < 4; ++ks) koff[ks] = AT_K + qi * 256 + (((4 * ks + g) ^ qi) << 4);
    const int q4 = qi >> 2, p4 = qi & 3, kr = 4 * g + q4;
    const int voff = AT_V + (kr >> 3) * 512 + (kr & 7) * 64 + 8 * p4;
    int b, gi, hh, res, blk; attn_unit_geom(u0, b, gi, hh, res, blk);
    { const int lg = 2 * gi; attn_dma_k_half(F, pb, b, lg, T >> lg, res, gi * 4 + hh, blk * 128, 0); attn_dma_k_half(F, pb, b, lg, T >> lg, res, gi * 4 + hh, blk * 128, 128); }
    int head_prev = -1;
    bf16x8 qA[4], qB[4];
#define ATTN_LOADQ(QD, uu) do { int b_, gi_, hh_, res_, blk_; attn_unit_geom((uu), b_, gi_, hh_, res_, blk_); const int lg_ = 2 * gi_; \
        const bf16* qr_ = pb + (size_t)(b_ * T + ((blk_ * 128 + 16 * w + qi) << lg_) + res_) * B_COLS + (gi_ * 4 + hh_) * 128; \
        _Pragma("unroll") for (int ks = 0; ks < 4; ++ks) QD[ks] = *(const bf16x8*)(qr_ + 32 * ks + 8 * g); } while (0)
    ATTN_LOADQ(qA, u0);
    asm volatile("" :: "v"(qA[0]), "v"(qA[1]), "v"(qA[2]), "v"(qA[3]));
#define ATTN_UNIT(u, qf, qnx) do { \
        attn_unit_geom(u, b, gi, hh, res, blk); \
        const int lg = 2 * gi, L = T >> lg, head = gi * 4 + hh, q0 = blk * 128; \
        const bool cont = ((u) > u0) && (blk != 0);                  \
        const int s8 = ((q0 >> 4) + w) & 15;                         \
        if (head != head_prev) { head_prev = head; const int tid_ = F.wave * 64 + lane_id(); if (tid_ < 176) { const int i = tid_ - 16; btp[tid_] = (i >= 0 && i <= 128) ? btab[head * 129 + i] : -1e30f; } asm volatile("s_waitcnt vmcnt(0)" ::: "memory"); } \
        bf16* qrow = pb + (size_t)(b * T + ((q0 + 16 * w + qi) << lg) + res) * B_COLS + head * 128; \
        if ((u) + 1 < u1) ATTN_LOADQ(qnx, (u) + 1); \
          \
        if ((u) == u0) asm volatile("s_waitcnt vmcnt(0) lgkmcnt(0)" ::: "memory"); else asm volatile("s_waitcnt vmcnt(6) lgkmcnt(0)" ::: "memory"); \
        __builtin_amdgcn_s_barrier(); asm volatile("" ::: "memory"); \
        if (!cont) attn_dma_v_half(F, pb, b, lg, L, res, head, q0, q0 & 255); \
        attn_dma_v_half(F, pb, b, lg, L, res, head, q0, (q0 + 128) & 255); \
        f32x4a S[9]; \
        _Pragma("unroll") for (int kb = 0; kb < 9; ++kb) { S[kb] = (f32x4a){0.f, 0.f, 0.f, 0.f}; const int rb = ((s8 + kb) & 15) * 4096; \
            _Pragma("unroll") for (int ks = 0; ks < 4; ++ks) { const bf16x8 kf = *(const LAS bf16x8*)(F.lds + koff[ks] + rb); \
                S[kb] = __builtin_amdgcn_mfma_f32_16x16x32_bf16(kf, qf[ks], S[kb], 0, 0, 0); } } \
        const bool edge = (q0 == 0) || (q0 + 128 >= L); \
        float mx = -1e30f; \
        _Pragma("unroll") for (int kb = 0; kb < 9; ++kb) \
            _Pragma("unroll") for (int r = 0; r < 4; ++r) { const int kw = 16 * kb + 4 * g + r; float sv = S[kb][r] + btp[kw - qi + 16]; \
                if (edge) { const int kp = q0 + 16 * w + kw - 64; if (kp < 0 || kp >= L) sv = -1e30f; } \
                S[kb][r] = sv; mx = fmaxf(mx, sv); } \
        mx = fmaxf(mx, __shfl_xor(mx, 16)); mx = fmaxf(mx, __shfl_xor(mx, 32)); \
        float ls = 0.f; \
        _Pragma("unroll") for (int kb = 0; kb < 9; ++kb) \
            _Pragma("unroll") for (int r = 0; r < 4; ++r) { const float pe = __builtin_amdgcn_exp2f(S[kb][r] - mx); S[kb][r] = pe; ls += pe; } \
        ls += __shfl_xor(ls, 16); ls += __shfl_xor(ls, 32); \
        bf16x8 pf[5]; \
        _Pragma("unroll") for (int c = 0; c < 5; ++c) { v4u t; t.x = cvtpk(S[2 * c][0], S[2 * c][1]); t.y = cvtpk(S[2 * c][2], S[2 * c][3]); \
            if (c < 4) { t.z = cvtpk(S[2 * c + 1][0], S[2 * c + 1][1]); t.w = cvtpk(S[2 * c + 1][2], S[2 * c + 1][3]); } else { t.z = 0u; t.w = 0u; } \
            pf[c] = __builtin_bit_cast(bf16x8, t); } \
        asm volatile("s_waitcnt vmcnt(0) lgkmcnt(0)" ::: "memory"); __builtin_amdgcn_s_barrier(); asm volatile("" ::: "memory"); \
        if ((u) + 1 < u1) { int b2, gi2, hh2, res2, blk2; attn_unit_geom((u) + 1, b2, gi2, hh2, res2, blk2); const int lg2 = 2 * gi2, q02 = blk2 * 128; \
            if (blk2 == 0) attn_dma_k_half(F, pb, b2, lg2, T >> lg2, res2, gi2 * 4 + hh2, q02, q02 & 255); \
            attn_dma_k_half(F, pb, b2, lg2, T >> lg2, res2, gi2 * 4 + hh2, q02, (q02 + 128) & 255); } \
        asm volatile("" ::: "memory");                                \
        const float il = 1.f / ls; \
        int vlo[5], vhi[5]; \
        _Pragma("unroll") for (int c = 0; c < 5; ++c) { vlo[c] = voff + ((s8 + 2 * c) & 15) * 1024; vhi[c] = (c < 4) ? voff + ((s8 + 2 * c + 1) & 15) * 1024 : vlo[c]; } \
        _Pragma("unroll") for (int db = 0; db < 8; ++db) { f32x4a o = (f32x4a){0.f, 0.f, 0.f, 0.f}; \
            _Pragma("unroll") for (int c = 0; c < 5; ++c) { const int dofs = (db >> 1) * 16384 + (db & 1) * 32; \
                const v4i16_t lo = __builtin_amdgcn_ds_read_tr16_b64_v4i16((LAS v4i16_t*)(F.lds + vlo[c] + dofs)); \
                const v4i16_t hi = __builtin_amdgcn_ds_read_tr16_b64_v4i16((LAS v4i16_t*)(F.lds + vhi[c] + dofs)); \
                const bf16x8 vf = (bf16x8){lo[0], lo[1], lo[2], lo[3], hi[0], hi[1], hi[2], hi[3]}; \
                o = __builtin_amdgcn_mfma_f32_16x16x32_bf16(vf, pf[c], o, 0, 0, 0); } \
            v2u wv; wv.x = cvtpk(o[0] * il, o[1] * il); wv.y = cvtpk(o[2] * il, o[3] * il); \
            *(v2u*)((dry ? (bf16*)(F.ws + WS_Y) + (size_t)((F.wave * 64 + lane_id()) >> 2) * B_COLS : qrow) + 16 * db + 4 * g) = wv; } \
        if (g == 0 && !dry) lse[(size_t)(b * T + ((q0 + 16 * w + qi) << lg) + res) * 12 + head] = mx + __builtin_amdgcn_logf(ls); \
        asm volatile("" :: "v"(qnx[0]), "v"(qnx[1]), "v"(qnx[2]), "v"(qnx[3]));     \
    } while (0)
    for (int u = u0; u < u1; u += 2) {
        ATTN_UNIT(u, qA, qB);
        if (u + 1 < u1) ATTN_UNIT(u + 1, qB, qA);
    }
#undef ATTN_UNIT
#undef ATTN_LOADQ
    asm volatile("s_waitcnt vmcnt(0) lgkmcnt(0)" ::: "memory"); __builtin_amdgcn_s_barrier();
#ifdef PROBE_AT
    if (blockIdx.x == 0 && (F.wave * 64 + lane_id()) == 0) ((float*)(F.ws + WS_CTL + 32768))[0] = (float)((double)(((__builtin_amdgcn_s_memtime() - pat_t0) / (unsigned long long)(u1 - u0) + 1024ull) >> 11 << 11) / 65536.0);
#endif
}
__device__ __forceinline__ void attn_combine(Frame& F) {
    const bf16* pb = (const bf16*)(F.ws + WS_R); const float* lse = (const float*)(F.ws + WS_LSE);
    const int gw = F.vcu * NWAVES + F.wave, NGW = F.G * NWAVES, lane = lane_id(), hh = lane >> 4, d0 = (lane & 15) * 8;
    for (int m = gw; m < M; m += NGW) {
        const bf16* row = pb + (size_t)m * B_COLS;
        const float l0 = lse[(size_t)m * 12 + hh], l1 = lse[(size_t)m * 12 + 4 + hh], l2 = lse[(size_t)m * 12 + 8 + hh];
        const float mxl = fmaxf(l0, fmaxf(l1, l2)); float w0 = exp2f(l0 - mxl), w1 = exp2f(l1 - mxl), w2 = exp2f(l2 - mxl); const float iw = 1.f / (w0 + w1 + w2); w0 *= iw; w1 *= iw; w2 *= iw;
        const v4u a = *(const v4u*)(row + hh * 128 + d0), bq = *(const v4u*)(row + (4 + hh) * 128 + d0), c = *(const v4u*)(row + (8 + hh) * 128 + d0), gt = *(const v4u*)(row + 3 * B_QKV + hh * 128 + d0);
        v4u o;
        o.x = pk2((w0 * bflo(a.x) + w1 * bflo(bq.x) + w2 * bflo(c.x)) * bflo(gt.x), (w0 * bfhi(a.x) + w1 * bfhi(bq.x) + w2 * bfhi(c.x)) * bfhi(gt.x));
        o.y = pk2((w0 * bflo(a.y) + w1 * bflo(bq.y) + w2 * bflo(c.y)) * bflo(gt.y), (w0 * bfhi(a.y) + w1 * bfhi(bq.y) + w2 * bfhi(c.y)) * bfhi(gt.y));
        o.z = pk2((w0 * bflo(a.z) + w1 * bflo(bq.z) + w2 * bflo(c.z)) * bflo(gt.z), (w0 * bfhi(a.z) + w1 * bfhi(bq.z) + w2 * bfhi(c.z)) * bfhi(gt.z));
        o.w = pk2((w0 * bflo(a.w) + w1 * bflo(bq.w) + w2 * bflo(c.w)) * bflo(gt.w), (w0 * bfhi(a.w) + w1 * bfhi(bq.w) + w2 * bfhi(c.w)) * bfhi(gt.w));
        *(v4u*)(F.out + (size_t)m * OROW + OS_YB + (hh * 128 + d0) * 2) = o;
    }
}

#ifdef PROBE_TA
#define STAMP(k) do { if ((k) == PROBE_TA) pt_a = __builtin_amdgcn_s_memtime(); if ((k) == PROBE_TB) pt_sel += __builtin_amdgcn_s_memtime() - pt_a; } while (0)
#else
#define STAMP(k) do { } while (0)
#endif
#ifndef REP_S0
#define REP_S0 1
#define REP_S12 1
#define REP_S3 1
#define REP_S45 1
#endif
typedef float f32x4r __attribute__((ext_vector_type(4)));
constexpr int RS = 144, RM = 64 * RS;
constexpr int R_AT = 0 * RM, R_RT = 1 * RM, R_BW = 2 * RM, R_KU = 3 * RM, R_BT = 4 * RM, R_KT = 5 * RM, R_VT = 6 * RM, R_AAB = 7 * RM, R_AAK = 8 * RM, R_ARB = 9 * RM, R_ARK = 10 * RM, R_HT = 11 * RM;
constexpr int R_W2T = 12 * RM, R_A2T = 13 * RM;
constexpr int R_WLF = R_AT, R_ALF = R_BT, FS = 272;
constexpr int R_TI = 132096, TIS = 48, R_PC = R_TI + 3072, R_BLK = R_PC + 256, R_AD = R_BLK + 2048;
__device__ __forceinline__ bf16x8 ldfrag(LAS unsigned char* lds, int mat, int row0, int k0, int r, int g) { return *(const LAS bf16x8*)(lds + mat + (row0 + r) * RS + (k0 + 8 * g) * 2); }
__device__ __forceinline__ void storeT(LAS unsigned char* lds, int mat, const f32x4r& d, int row0, int col0, int r, int g) {
    v2u w; w.x = cvtpk(d[0], d[1]); w.y = cvtpk(d[2], d[3]); *(LAS v2u*)(lds + mat + (col0 + r) * RS + (row0 + 4 * g) * 2) = w; }
__device__ __forceinline__ bf16x8 pack2(const f32x4r& a, const f32x4r& b) { v4u t; t.x = cvtpk(a[0], a[1]); t.y = cvtpk(a[2], a[3]); t.z = cvtpk(b[0], b[1]); t.w = cvtpk(b[2], b[3]); return __builtin_bit_cast(bf16x8, t); }
__device__ __forceinline__ bf16x8 pack1(const f32x4r& a) { v4u t; t.x = cvtpk(a[0], a[1]); t.y = cvtpk(a[2], a[3]); t.z = 0u; t.w = 0u; return __builtin_bit_cast(bf16x8, t); }
__device__ __forceinline__ bf16x8 ld2x4(LAS unsigned char* lds, int off0, int off1) { const v2u a = *(const LAS v2u*)(lds + off0), b = *(const LAS v2u*)(lds + off1); v4u t; t.x = a.x; t.y = a.y; t.z = b.x; t.w = b.y; return __builtin_bit_cast(bf16x8, t); }
#define MF16(a, b, c) __builtin_amdgcn_mfma_f32_16x16x32_bf16((a), (b), (c), 0, 0, 0)
#define WGBAR() do { asm volatile("s_waitcnt lgkmcnt(0)" ::: "memory"); __builtin_amdgcn_s_barrier(); asm volatile("" ::: "memory"); } while (0)
template <int CTRL> __device__ __forceinline__ float dppf(float x) { return __builtin_bit_cast(float, __builtin_amdgcn_update_dpp(0, __builtin_bit_cast(int, x), CTRL, 0xF, 0xF, true)); }
__device__ __forceinline__ float row16_sum(float v) { v += dppf<0xB1>(v); v += dppf<0x4E>(v); v += dppf<0x141>(v); v += dppf<0x140>(v); return v; }
__device__ __forceinline__ float wave_sum_dpp(float v) { v = row16_sum(v);
    return (__builtin_bit_cast(float, __builtin_amdgcn_readlane(__builtin_bit_cast(int, v), 0)) + __builtin_bit_cast(float, __builtin_amdgcn_readlane(__builtin_bit_cast(int, v), 16)))
         + (__builtin_bit_cast(float, __builtin_amdgcn_readlane(__builtin_bit_cast(int, v), 32)) + __builtin_bit_cast(float, __builtin_amdgcn_readlane(__builtin_bit_cast(int, v), 48))); }
__device__ __forceinline__ void reduce8(const float (&v)[8], float (&s)[8], float& v0, float& v1, int lane) {
    const bool b0 = lane & 1, b1 = lane & 2; float r1[4], r2[2];
#pragma unroll
    for (int i = 0; i < 4; ++i) { const float keep = b0 ? v[2 * i + 1] : v[2 * i], send = b0 ? v[2 * i] : v[2 * i + 1]; r1[i] = keep + dppf<0xB1>(send); }
#pragma unroll
    for (int i = 0; i < 2; ++i) { const float keep = b1 ? r1[2 * i + 1] : r1[2 * i], send = b1 ? r1[2 * i] : r1[2 * i + 1]; r2[i] = keep + dppf<0x4E>(send); }
#pragma unroll
    for (int i = 0; i < 2; ++i) { float x = r2[i]; x += dppf<0x124>(x); x += dppf<0x128>(x);
        x += __builtin_bit_cast(float, __builtin_amdgcn_ds_swizzle(__builtin_bit_cast(int, x), 0x401F));
        x += __shfl_xor(x, 32);
        r2[i] = x; }
    v0 = r2[0]; v1 = r2[1];
#pragma unroll
    for (int q = 0; q < 8; ++q) s[q] = __builtin_bit_cast(float, __builtin_amdgcn_readlane(__builtin_bit_cast(int, r2[q >> 2]), q & 3));
}
typedef float f2v __attribute__((ext_vector_type(2)));
__device__ __forceinline__ f2v exp2v(f2v x) { return (f2v){__builtin_amdgcn_exp2f(x.x), __builtin_amdgcn_exp2f(x.y)}; }
__device__ __forceinline__ f2v rcpv(f2v x) { return (f2v){__builtin_amdgcn_rcpf(x.x), __builtin_amdgcn_rcpf(x.y)}; }
__device__ __forceinline__ unsigned cvtpk2(f2v v) { bf16x2_t b = __builtin_convertvector(v, bf16x2_t); return __builtin_bit_cast(unsigned, b); }
__device__ __forceinline__ float fast_tanh(float x) { const float e = __expf(2.f * x); return 1.f - 2.f * __builtin_amdgcn_rcpf(e + 1.f); }
template <bool RV> __device__ __forceinline__ void rwkv_load_rows(__amdgpu_buffer_rsrc_t rsrc, int b, int d, int c, int w, unsigned o_r, unsigned o_w, unsigned (&x0)[10], unsigned (&x1)[10], unsigned (&x2)[10]) {
    const int s0 = c * 64 + 8 * w - 1;
#pragma unroll
    for (int k = 0; k < 10; ++k) { const int s = s0 + k; int tk = d ? T - 1 - s : s; tk = tk < 0 ? 0 : (tk > T - 1 ? T - 1 : tk);
        const int so = __builtin_amdgcn_readfirstlane((b * T + tk) * (A_COLS * 2));
        if (RV) { x0[k] = __builtin_amdgcn_raw_buffer_load_b32(rsrc, o_r, so, 0); x1[k] = __builtin_amdgcn_raw_buffer_load_b32(rsrc, o_r + 2 * A_W * 2, so, 0); }
        else { x0[k] = __builtin_amdgcn_raw_buffer_load_b32(rsrc, o_r + A_W * 2, so, 0); x1[k] = __builtin_amdgcn_raw_buffer_load_b32(rsrc, o_w, so, 0); x2[k] = __builtin_amdgcn_raw_buffer_load_b32(rsrc, o_w + 2 * RANK * 2, so, 0); } }
}
__device__ __forceinline__ bf16x8 ldfragT(LAS unsigned char* lds, int mat, int m0, int k0, int lane) {
    const int i16 = lane & 15, g = lane >> 4, q = i16 >> 2, pq = i16 & 3; const int off = mat + (k0 + 8 * g + q) * RS + (m0 + 4 * pq) * 2;
    const v4i16_t lo = __builtin_amdgcn_ds_read_tr16_b64_v4i16((LAS v4i16_t*)(lds + off)), hi = __builtin_amdgcn_ds_read_tr16_b64_v4i16((LAS v4i16_t*)(lds + off + 4 * RS));
    return (bf16x8){lo[0], lo[1], lo[2], lo[3], hi[0], hi[1], hi[2], hi[3]};
}
__device__ __forceinline__ void rwkv_chunked(Frame& F) {
    if (blockIdx.x >= 2 * NB * A_HEADS) return;
    const int chain = blockIdx.x, d = chain / (NB * A_HEADS), rem = chain % (NB * A_HEADS), b = rem >> 3, hd = rem & 7;
    const bf16* pa = (const bf16*)(F.ws + WS_PA); bf16* ybuf = (bf16*)(F.ws + WS_Y) + (size_t)d * M * A_W; float* bon = (float*)(F.ws + WS_BON) + (size_t)d * M * 8;
    const int ko = kopaque(); const float *w2_ = kin(I_W2, ko), *a2_ = kin(I_A2, ko), *mu_ = kin(I_MU, ko), *w0_ = kin(I_W0, ko), *a0_ = kin(I_A0, ko), *kk_ = kin(I_KK, ko), *ka_ = kin(I_KA, ko), *rk_ = kin(I_RK, ko);
    LAS unsigned char* L = F.lds;
    int lane = lane_id(); asm volatile("" : "+v"(lane));
    const int w = F.wave, j = lane, ch = hd * 64 + j;
    int r, g;
#define RELANE() do { int ln_ = lane; asm volatile("" : "+v"(ln_)); r = ln_ & 15; g = ln_ >> 4; } while (0)
    for (int i = (F.wave * 64 + lane_id()); i < 4096; i += NWAVES * 64) { const int jo = i >> 6, jr = i & 63;
        *(LAS bf16*)(L + R_W2T + jo * RS + jr * 2) = (bf16)f2bf(w2_[((size_t)d * RANK + jr) * A_W + hd * 64 + jo]);
        *(LAS bf16*)(L + R_A2T + jo * RS + jr * 2) = (bf16)f2bf(a2_[((size_t)d * RANK + jr) * A_W + hd * 64 + jo]); }
    for (int i = (F.wave * 64 + lane_id()); i < 5 * RM / 4; i += NWAVES * 64) ((LAS unsigned*)(L + R_AAB))[i] = 0u;
    const int cr = ch, ck = A_W + ch, cv = 2 * A_W + ch, cw = 4 * A_W + d * RANK + j, ca = 4 * A_W + 2 * RANK + d * RANK + j;
    const float mr0 = mu_[cr], mr1 = mu_[A_COLS + cr], mk0 = mu_[ck], mk1 = mu_[A_COLS + ck], mv0 = mu_[cv], mv1 = mu_[A_COLS + cv];
    const float mw0 = mu_[cw], mw1 = mu_[A_COLS + cw], ma0 = mu_[ca], ma1 = mu_[A_COLS + ca];
    const __amdgpu_buffer_rsrc_t rsrc = __builtin_amdgcn_make_buffer_rsrc((void*)pa, 0, M * A_COLS * 2, 0x00020000);
#define O_R ((unsigned)(((hd * 64 + lnow_) * 2) & ~3))
#define O_W ((unsigned)(((4 * A_W + d * RANK + lnow_) * 2) & ~3))
#define PSEL ((lnow_ & 1) ? 0x07060c0cu : 0x05040c0cu)
    const float sr0 = d ? mr1 : mr0, sr1 = d ? mr0 : mr1, sk0 = d ? mk1 : mk0, sk1 = d ? mk0 : mk1, sv0 = d ? mv1 : mv0, sv1 = d ? mv0 : mv1, sw0 = d ? mw1 : mw0, sw1 = d ? mw0 : mw1, sa0 = d ? ma1 : ma0, sa1 = d ? ma0 : ma1;
    const float w0j = w0_[d * A_W + ch], a0j = a0_[d * A_W + ch], kkj = kk_[ch], kaj = ka_[ch], rkj = rk_[ch];
    const int vt = w & 3;
    f32x4r Hs[4];
#pragma unroll
    for (int i = 0; i < 4; ++i) Hs[i] = (f32x4r){0.f, 0.f, 0.f, 0.f};
    unsigned xk[10], xw[10], xa[10];
    { int lnow_ = lane; rwkv_load_rows<false>(rsrc, b, d, 0, w, O_R, O_W, xk, xw, xa); }
    WGBAR();
#ifdef PROBE_TA
    unsigned long long pt_a = 0, pt_sel = 0; const unsigned long long pt_t0 = __builtin_amdgcn_s_memtime();
#endif
    for (int c = 0; c < T / 64; ++c) {
        STAMP(0);
        f2v ks2[4], kn2[4];
        for (int rep0_ = 0; rep0_ < REP_S0; ++rep0_) {
        int lnow_ = lane; asm volatile("" : "+v"(lnow_)); const unsigned psel = PSEL;
        if (REP_S0 > 1 && rep0_ > 0) rwkv_load_rows<false>(rsrc, b, d, c, w, O_R, O_W, xk, xw, xa);
        const bool okp = (c * 64 + 8 * w) > 0, okn = (c * 64 + 8 * w + 8) < T;
#define XF(x, k) ((((k) == 0 && !okp) || ((k) == 9 && !okn)) ? 0.f : __builtin_bit_cast(float, __builtin_amdgcn_perm((x)[k], 0u, psel)))
#define SH2(dst, x, m0, m1) do { float xf_[10]; _Pragma("unroll") for (int k_ = 0; k_ < 10; ++k_) xf_[k_] = XF(x, k_); const float mc_ = 1.f - (m0) - (m1); \
        _Pragma("unroll") for (int q2_ = 0; q2_ < 4; ++q2_) (dst)[q2_] = (f2v){xf_[2 * q2_ + 1], xf_[2 * q2_ + 2]} * mc_ + (f2v){xf_[2 * q2_], xf_[2 * q2_ + 1]} * (m0) + (f2v){xf_[2 * q2_ + 2], xf_[2 * q2_ + 3]} * (m1); } while (0)
        { unsigned tw_[4], al_[4];
          { f2v ws2[4]; SH2(ws2, xw, sw0, sw1);
#pragma unroll
            for (int q2 = 0; q2 < 4; ++q2) { const f2v e2 = exp2v(ws2[q2] * 2.8853900817779268f); tw_[q2] = cvtpk2(1.f - 2.f * rcpv(e2 + 1.f)); } }
          asm volatile("" ::: "memory");
          { f2v as2[4]; SH2(as2, xa, sa0, sa1);
#pragma unroll
            for (int q2 = 0; q2 < 4; ++q2) al_[q2] = cvtpk2(as2[q2]); }
          asm volatile("" ::: "memory");
          SH2(ks2, xk, sk0, sk1);
#pragma unroll
          for (int q2 = 0; q2 < 4; ++q2) kn2[q2] = ks2[q2] * kkj;
          *(LAS v4u*)(L + R_BW + j * RS + 16 * w) = (v4u){tw_[0], tw_[1], tw_[2], tw_[3]};
          *(LAS v4u*)(L + R_KU + j * RS + 16 * w) = (v4u){al_[0], al_[1], al_[2], al_[3]}; }
        { float sq[8], n2[8], d0_, d1_;
#pragma unroll
          for (int q2 = 0; q2 < 4; ++q2) { const f2v s = kn2[q2] * kn2[q2]; sq[2 * q2] = s.x; sq[2 * q2 + 1] = s.y; }
          reduce8(sq, n2, d0_, d1_, lane);
#pragma unroll
          for (int q2 = 0; q2 < 4; ++q2) kn2[q2] *= (f2v){__builtin_amdgcn_rsqf(fmaxf(n2[2 * q2], 1e-24f)), __builtin_amdgcn_rsqf(fmaxf(n2[2 * q2 + 1], 1e-24f))}; }
        WGBAR();
        STAMP(1);
        RELANE();
        unsigned xr[10], xv[10], xdum[10];
        rwkv_load_rows<true>(rsrc, b, d, c, w, O_R, O_W, xr, xv, xdum);
        { const int it = w >> 1;
          bf16x8 ta[2], aa[2];
#pragma unroll
          for (int k2 = 0; k2 < 2; ++k2) { ta[k2] = ldfragT(L, R_BW, 16 * it, 32 * k2, lane); aa[k2] = ldfragT(L, R_KU, 16 * it, 32 * k2, lane); }
#pragma unroll
          for (int j2 = 0; j2 < 2; ++j2) { const int jt = 2 * (w & 1) + j2; f32x4r dw = (f32x4r){0.f, 0.f, 0.f, 0.f}, da = dw;
#pragma unroll
              for (int k2 = 0; k2 < 2; ++k2) { dw = MF16(ta[k2], ldfrag(L, R_W2T, 16 * jt, 32 * k2, r, g), dw); da = MF16(aa[k2], ldfrag(L, R_A2T, 16 * jt, 32 * k2, r, g), da); }
#pragma unroll
              for (int e = 0; e < 4; ++e) { *(LAS float*)(L + R_WLF + (16 * it + 4 * g + e) * FS + (16 * jt + r) * 4) = dw[e]; *(LAS float*)(L + R_ALF + (16 * it + 4 * g + e) * FS + (16 * jt + r) * 4) = da[e]; } } }
        WGBAR();
        STAMP(2);
        f2v av2[4]; float cp[8]; float run = 1.f;
#pragma unroll
        for (int q2 = 0; q2 < 4; ++q2) { const int i0 = 8 * w + 2 * q2;
            const f2v wl = (f2v){*(const LAS float*)(L + R_WLF + i0 * FS + j * 4), *(const LAS float*)(L + R_WLF + (i0 + 1) * FS + j * 4)} + w0j;
            const f2v al = (f2v){*(const LAS float*)(L + R_ALF + i0 * FS + j * 4), *(const LAS float*)(L + R_ALF + (i0 + 1) * FS + j * 4)} + a0j;
            const f2v dec = exp2v(rcpv(exp2v(wl * -1.4426950408889634f) + 1.f) * (-0.6065306597126334f * 1.4426950408889634f));
            av2[q2] = rcpv(exp2v(al * -1.4426950408889634f) + 1.f);
            run *= dec.x; cp[2 * q2] = run; run *= dec.y; cp[2 * q2 + 1] = run; }
        *(LAS float*)(L + R_BLK + (w * 64 + j) * 4) = run;
        WGBAR();
        STAMP(3);
        { float off = 1.f, tot = 1.f;
#pragma unroll
          for (int w2 = 0; w2 < 8; ++w2) { const float bt = *(const LAS float*)(L + R_BLK + (w2 * 64 + j) * 4); off *= (w2 < w) ? bt : 1.f; tot *= bt; }
          if (w == 0) *(LAS float*)(L + R_PC + j * 4) = tot;
          f2v rs2[4], vs2[4], kd2[4]; SH2(rs2, xr, sr0, sr1); SH2(vs2, xv, sv0, sv1);
          { float bp[8], bs[8], b0_, b1_;
#pragma unroll
            for (int q2 = 0; q2 < 4; ++q2) { kd2[q2] = ks2[q2] * (av2[q2] * kaj + (1.f - kaj)); const f2v t = rs2[q2] * kd2[q2] * rkj; bp[2 * q2] = t.x; bp[2 * q2 + 1] = t.y; }
            reduce8(bp, bs, b0_, b1_, lane);
            if (lane < 4) { const int s0_ = c * 64 + 8 * w + lane, s1_ = s0_ + 4; const int t0_ = d ? T - 1 - s0_ : s0_, t1_ = d ? T - 1 - s1_ : s1_;
                bon[(size_t)(b * T + t0_) * 8 + hd] = b0_; bon[(size_t)(b * T + t1_) * 8 + hd] = b1_; } }
          unsigned pa_[4], pr_[4], pb_[4], pk_[4], pv_[4];
#pragma unroll
          for (int q2 = 0; q2 < 4; ++q2) { const int qa = 2 * q2;
              const f2v pt = (f2v){cp[qa], cp[qa + 1]} * off; const f2v pm = (f2v){(qa == 0) ? off : off * cp[qa > 0 ? qa - 1 : 0], pt.x}; const f2v em = rcpv(pt);
              pa_[q2] = cvtpk2(-kn2[q2] * pm); pr_[q2] = cvtpk2(rs2[q2] * pt); pb_[q2] = cvtpk2(kn2[q2] * av2[q2] * em); pk_[q2] = cvtpk2(kd2[q2] * em); pv_[q2] = cvtpk2(vs2[q2]); }
          *(LAS v4u*)(L + R_AT + j * RS + 16 * w) = (v4u){pa_[0], pa_[1], pa_[2], pa_[3]};
          *(LAS v4u*)(L + R_RT + j * RS + 16 * w) = (v4u){pr_[0], pr_[1], pr_[2], pr_[3]};
          *(LAS v4u*)(L + R_BT + j * RS + 16 * w) = (v4u){pb_[0], pb_[1], pb_[2], pb_[3]};
          *(LAS v4u*)(L + R_KT + j * RS + 16 * w) = (v4u){pk_[0], pk_[1], pk_[2], pk_[3]};
          *(LAS v4u*)(L + R_VT + j * RS + 16 * w) = (v4u){pv_[0], pv_[1], pv_[2], pv_[3]}; }
        WGBAR();
#undef SH2
#undef XF
        }
        STAMP(4);
        if (c + 1 < T / 64) { int lnow_ = lane; asm volatile("" : "+v"(lnow_)); rwkv_load_rows<false>(rsrc, b, d, c + 1, w, O_R, O_W, xk, xw, xa); }
        STAMP(5);
        RELANE();
        f32x4r A0[4], KV[4];
#define tc(i) KV[(i) >> 2][(i) & 3]
        for (int rep1_ = 0; rep1_ < REP_S12; ++rep1_) {
        if (w == 0) {
#pragma unroll
            for (int i = 0; i < 4; ++i) { f32x4r dd = (f32x4r){0.f, 0.f, 0.f, 0.f};
#pragma unroll
                for (int k2 = 0; k2 < 2; ++k2) dd = MF16(ldfragT(L, R_BT, 16 * i, 32 * k2, lane), ldfragT(L, R_AT, 16 * i, 32 * k2, lane), dd);
#pragma unroll
                for (int e = 0; e < 4; ++e) if (4 * g + e >= r) dd[e] = 0.f;
                storeT(L, R_AAB, dd, 16 * i, 16 * i, r, g);
                *(LAS f32x4r*)(L + R_AD + i * 1024 + r * 64 + 16 * g) = dd; }
            { f32x4r dd = (f32x4r){0.f, 0.f, 0.f, 0.f};
#pragma unroll
              for (int k2 = 0; k2 < 2; ++k2) dd = MF16(ldfragT(L, R_KT, 48, 32 * k2, lane), ldfragT(L, R_RT, 48, 32 * k2, lane), dd);
#pragma unroll
              for (int e = 0; e < 4; ++e) if (4 * g + e > r) dd[e] = 0.f;
              storeT(L, R_ARK, dd, 48, 48, r, g); }
            asm volatile("s_waitcnt lgkmcnt(0)" ::: "memory");
            const int blk = lane >> 4, cc = lane & 15;
#pragma unroll
            for (int rr = 0; rr < 8; ++rr) { float acc = (rr == cc) ? 1.f : 0.f;
#pragma unroll
                for (int s4 = 0; s4 < (rr + 3) / 4; ++s4) { const f32x4r a4 = *(const LAS f32x4r*)(L + R_AD + blk * 1024 + rr * 64 + s4 * 16);
#pragma unroll
                    for (int e = 0; e < 4; ++e) if (4 * s4 + e < rr) acc += a4[e] * tc(4 * s4 + e); }
                tc(rr) = acc; *(LAS bf16*)(L + R_TI + (16 * blk + rr) * TIS + cc * 2) = (bf16)f2bf(acc); }
        } else {
#pragma unroll
            for (int kb = 0; kb < 3; ++kb) {
                bf16x8 fa[2][2], fb[2][2]; int dmv[2], tsv[2], ttv[2]; bool inc[2];
#pragma unroll
                for (int k = 0; k < 2; ++k) if (kb < 2 || k == 0) { const int jc = w - 1 + 7 * (2 * kb + k);
                    int mat, idx; if (jc < 6) { mat = 0; idx = (0x865321 >> (4 * jc)) & 15; } else { const int q = jc - 6; mat = 1 + q / 10; idx = q - 10 * (mat - 1); }
                    const int ts = (int)((0x3221110000ull >> (4 * idx)) & 15), tt = (int)((0x3323213210ull >> (4 * idx)) & 15);
                    const int ym = (mat & 1) ? R_KT : R_BT, xm = (mat & 2) ? R_RT : R_AT; dmv[k] = R_AAB + mat * RM; inc[k] = mat >= 2; tsv[k] = ts; ttv[k] = tt;
#pragma unroll
                    for (int k2 = 0; k2 < 2; ++k2) { fa[k][k2] = ldfragT(L, ym, 16 * ts, 32 * k2, lane); fb[k][k2] = ldfragT(L, xm, 16 * tt, 32 * k2, lane); } }
#pragma unroll
                for (int k = 0; k < 2; ++k) if (kb < 2 || k == 0) { f32x4r dd = (f32x4r){0.f, 0.f, 0.f, 0.f};
#pragma unroll
                    for (int k2 = 0; k2 < 2; ++k2) dd = MF16(fa[k][k2], fb[k][k2], dd);
                    if (tsv[k] == ttv[k]) {
#pragma unroll
                        for (int e = 0; e < 4; ++e) { const int sl = 4 * g + e; if (inc[k] ? (sl > r) : (sl >= r)) dd[e] = 0.f; } }
                    storeT(L, dmv[k], dd, 16 * tsv[k], 16 * ttv[k], r, g); }
            }
        }
        WGBAR();
        STAMP(6);
        RELANE();
        if (w == 0) {
            const int blk = lane >> 4, cc = lane & 15;
#pragma unroll
            for (int rr = 8; rr < 16; ++rr) { float acc = (rr == cc) ? 1.f : 0.f;
#pragma unroll
                for (int s4 = 0; s4 < (rr + 3) / 4; ++s4) { const f32x4r a4 = *(const LAS f32x4r*)(L + R_AD + blk * 1024 + rr * 64 + s4 * 16);
#pragma unroll
                    for (int e = 0; e < 4; ++e) if (4 * s4 + e < rr) acc += a4[e] * tc(4 * s4 + e); }
                tc(rr) = acc; *(LAS bf16*)(L + R_TI + (16 * blk + rr) * TIS + cc * 2) = (bf16)f2bf(acc); }
        } else if (w < 4) {
#pragma unroll
            for (int i = 0; i < 4; ++i) { A0[i] = (f32x4r){0.f, 0.f, 0.f, 0.f};
#pragma unroll
                for (int k2 = 0; k2 < 2; ++k2) A0[i] = MF16(ldfrag(L, R_VT, 16 * vt, 32 * k2, r, g), ldfrag(L, R_ARK, 16 * i, 32 * k2, r, g), A0[i]); }
        } else {
#pragma unroll
            for (int i = 0; i < 4; ++i) { A0[i] = (f32x4r){0.f, 0.f, 0.f, 0.f}; KV[i] = A0[i];
#pragma unroll
                for (int k2 = 0; k2 < 2; ++k2) { const bf16x8 vf = ldfrag(L, R_VT, 16 * vt, 32 * k2, r, g);
                    A0[i] = MF16(ldfrag(L, R_AAK, 16 * i, 32 * k2, r, g), vf, A0[i]); KV[i] = MF16(ldfrag(L, R_KT, 16 * i, 32 * k2, r, g), vf, KV[i]); } }
        }
        WGBAR();
        }
        STAMP(7);
        RELANE();
        if (w < 4) {
            if (w == 0) {
#pragma unroll
                for (int i = 0; i < 4; ++i) { A0[i] = (f32x4r){0.f, 0.f, 0.f, 0.f};
#pragma unroll
                    for (int k2 = 0; k2 < 2; ++k2) A0[i] = MF16(ldfrag(L, R_VT, 0, 32 * k2, r, g), ldfrag(L, R_ARK, 16 * i, 32 * k2, r, g), A0[i]); } }
#pragma unroll
            for (int i = 0; i < 4; ++i)
#pragma unroll
                for (int k2 = 0; k2 < 2; ++k2) A0[i] = MF16(ldfrag(L, R_HT, 16 * vt, 32 * k2, r, g), ldfragT(L, R_RT, 16 * i, 32 * k2, lane), A0[i]);
        } else {
            f32x4r X[4];
#pragma unroll
            for (int i = 0; i < 4; ++i) { X[i] = A0[i];
#pragma unroll
                for (int k2 = 0; k2 < 2; ++k2) X[i] = MF16(ldfragT(L, R_AT, 16 * i, 32 * k2, lane), ldfrag(L, R_HT, 16 * vt, 32 * k2, r, g), X[i]); }
            const f32x4r z4 = (f32x4r){0.f, 0.f, 0.f, 0.f};
#define TIF(i) ld2x4(L, R_TI + (16 * (i) + r) * TIS + 8 * g, R_TI + (16 * (i) + r) * TIS + 8 * g)
#define ABF(i, j0) ld2x4(L, R_AAB + (16 * (i) + r) * RS + (16 * (j0) + 4 * g) * 2, R_AAB + (16 * (i) + r) * RS + (16 * ((j0) + 1) + 4 * g) * 2)
            X[0] = MF16(TIF(0), pack1(X[0]), z4);
            X[1] = MF16(ABF(1, 0), pack1(X[0]), X[1]); X[1] = MF16(TIF(1), pack1(X[1]), z4);
            X[2] = MF16(ABF(2, 0), pack2(X[0], X[1]), X[2]); X[2] = MF16(TIF(2), pack1(X[2]), z4);
            X[3] = MF16(ABF(3, 0), pack2(X[0], X[1]), X[3]); X[3] = MF16(ABF(3, 2), pack1(X[2]), X[3]); X[3] = MF16(TIF(3), pack1(X[3]), z4);
#undef TIF
#undef ABF
#pragma unroll
            for (int i = 0; i < 4; ++i) { A0[i] = X[i]; storeT(L, R_KU, X[i], 16 * i, 16 * vt, r, g); }
        }
        WGBAR();
        STAMP(8);
        STAMP(9);
        RELANE();
        for (int rep4_ = 0; rep4_ < 1; ++rep4_) {
        if (w < 4) {
#pragma unroll
            for (int i = 0; i < 4; ++i) {
#pragma unroll
                for (int k2 = 0; k2 < 2; ++k2) A0[i] = MF16(ldfrag(L, R_KU, 16 * vt, 32 * k2, r, g), ldfrag(L, R_ARB, 16 * i, 32 * k2, r, g), A0[i]);
                const int s = c * 64 + 16 * i + r, t = d ? T - 1 - s : s; v2u yw; yw.x = cvtpk(A0[i][0], A0[i][1]); yw.y = cvtpk(A0[i][2], A0[i][3]);
                *(v2u*)(ybuf + (size_t)(b * T + t) * A_W + hd * 64 + 16 * vt + 4 * g) = yw; }
        } else {
#pragma unroll
            for (int i = 0; i < 4; ++i) { f32x4r acc = Hs[i] + KV[i];
#pragma unroll
                for (int k2 = 0; k2 < 2; ++k2) acc = MF16(ldfrag(L, R_BT, 16 * i, 32 * k2, r, g), ldfrag(L, R_KU, 16 * vt, 32 * k2, r, g), acc);
                const f32x4r pc = *(const LAS f32x4r*)(L + R_PC + (16 * i + 4 * g) * 4);
                Hs[i] = acc * pc; storeT(L, R_HT, Hs[i], 16 * i, 16 * vt, r, g); }
        }
        WGBAR();
        }
        STAMP(10);
    }
#ifdef PROBE_TA
    if (blockIdx.x == 0 && (F.wave * 64 + lane_id()) == 0) { float* pf = (float*)(F.ws + WS_CTL + 32768); pf[0] = (float)((double)pt_sel / (double)(__builtin_amdgcn_s_memtime() - pt_t0)); }
#endif
#undef RELANE
#undef tc
#undef O_R
#undef O_W
#undef PSEL
}
__device__ __forceinline__ void rwkv_post(Frame& F) {
    const bf16* pa = (const bf16*)(F.ws + WS_PA); const bf16* y0 = (const bf16*)(F.ws + WS_Y); const bf16* y1 = y0 + (size_t)M * A_W;
    const float* bon0 = (const float*)(F.ws + WS_BON); const float* bon1 = bon0 + (size_t)M * 8;
    const int ko = kopaque(); const float *lnx_w = kin(I_LNW, ko), *lnx_b = kin(I_LNB, ko), *mu_ = kin(I_MU, ko);
    int lane = lane_id(); asm volatile("" : "+v"(lane));
    const int gw = F.vcu * NWAVES + F.wave, NGW = F.G * NWAVES, hd = lane >> 3, c0 = lane * 8;
    float lw_[8], lb_[8], mv0[8], mv1[8], mg0[8], mg1[8];
#pragma unroll
    for (int e = 0; e < 8; ++e) { lw_[e] = lnx_w[c0 + e]; lb_[e] = lnx_b[c0 + e]; mv0[e] = mu_[2 * A_W + c0 + e]; mv1[e] = mu_[A_COLS + 2 * A_W + c0 + e];
        mg0[e] = mu_[3 * A_W + c0 + e]; mg1[e] = mu_[A_COLS + 3 * A_W + c0 + e]; }
    for (int m = gw; m < M; m += NGW) {
        const int t = m & (T - 1); const bool hp = t > 0, hn = t < T - 1;
        const v4u a = *(const v4u*)(y0 + (size_t)m * A_W + c0), bq = *(const v4u*)(y1 + (size_t)m * A_W + c0);
        const bf16* p0 = pa + (size_t)m * A_COLS;
        const v4u vc = *(const v4u*)(p0 + 2 * A_W + c0), gc = *(const v4u*)(p0 + 3 * A_W + c0);
        const v4u z = (v4u){0u, 0u, 0u, 0u};
        const v4u vp = hp ? *(const v4u*)(p0 - A_COLS + 2 * A_W + c0) : z, gp = hp ? *(const v4u*)(p0 - A_COLS + 3 * A_W + c0) : z;
        const v4u vn = hn ? *(const v4u*)(p0 + A_COLS + 2 * A_W + c0) : z, gn = hn ? *(const v4u*)(p0 + A_COLS + 3 * A_W + c0) : z;
        const float bsum = bon0[(size_t)m * 8 + hd] + bon1[(size_t)m * 8 + hd];
        float y[8]; const unsigned aw[4] = {a.x, a.y, a.z, a.w}, bw[4] = {bq.x, bq.y, bq.z, bq.w};
        float s1 = 0.f;
#pragma unroll
        for (int e = 0; e < 4; ++e) { y[2 * e] = bflo(aw[e]) + bflo(bw[e]); y[2 * e + 1] = bfhi(aw[e]) + bfhi(bw[e]); s1 += y[2 * e] + y[2 * e + 1]; }
        s1 += dppf<0xB1>(s1); s1 += dppf<0x4E>(s1); s1 += dppf<0x141>(s1);
        const float mean = s1 * (1.f / 64.f); float s2 = 0.f;
#pragma unroll
        for (int e = 0; e < 8; ++e) { y[e] -= mean; s2 += y[e] * y[e]; }
        s2 += dppf<0xB1>(s2); s2 += dppf<0x4E>(s2); s2 += dppf<0x141>(s2);
        const float rstd = __builtin_amdgcn_rsqf(s2 * (1.f / 64.f) + GN_EPS);
        const unsigned vcw[4] = {vc.x, vc.y, vc.z, vc.w}, vpw[4] = {vp.x, vp.y, vp.z, vp.w}, vnw[4] = {vn.x, vn.y, vn.z, vn.w}, gcw[4] = {gc.x, gc.y, gc.z, gc.w}, gpw[4] = {gp.x, gp.y, gp.z, gp.w}, gnw[4] = {gn.x, gn.y, gn.z, gn.w};
        float o[8];
#pragma unroll
        for (int e = 0; e < 8; ++e) { const int k = e >> 1; const bool hi = e & 1;
            const float v0 = hi ? bfhi(vcw[k]) : bflo(vcw[k]), vm = hi ? bfhi(vpw[k]) : bflo(vpw[k]), vx = hi ? bfhi(vnw[k]) : bflo(vnw[k]);
            const float g0 = hi ? bfhi(gcw[k]) : bflo(gcw[k]), gm = hi ? bfhi(gpw[k]) : bflo(gpw[k]), gx = hi ? bfhi(gnw[k]) : bflo(gnw[k]);
            const float vs = v0 * (1.f - mv0[e] - mv1[e]) + mv0[e] * vm + mv1[e] * vx, gs = g0 * (1.f - mg0[e] - mg1[e]) + mg0[e] * gm + mg1[e] * gx;
            o[e] = (y[e] * rstd * lw_[e] + lb_[e] + bsum * vs) * siluf_(gs); }
        v4u ov; ov.x = cvtpk(o[0], o[1]); ov.y = cvtpk(o[2], o[3]); ov.z = cvtpk(o[4], o[5]); ov.w = cvtpk(o[6], o[7]);
        *(v4u*)(F.out + (size_t)m * OROW + OS_YA + c0 * 2) = ov;
    }
}
struct Args { const float* in[24]; unsigned char* out; unsigned char* ws; };
__global__ void __launch_bounds__(NWAVES * 64, 2) hybrid_fwd(Args args) {
    extern __shared__ __attribute__((aligned(16))) unsigned char lds[];
    Frame F;
    F.lds = (LAS unsigned char*)lds;
    F.MISC = (volatile LAS unsigned*)(F.lds + MISC_OFF);
    F.wave = __builtin_amdgcn_readfirstlane((int)threadIdx.x >> 6);
    F.G = gridDim.x; { const int bx = blockIdx.x; F.vcu = (F.G % 8 == 0) ? (bx % 8) * (F.G / 8) + bx / 8 : bx; }
    F.out = args.out; F.ws = args.ws;
    for (int u = (F.wave * 64 + lane_id()); u < (LDS_BYTES - LDSCTL_OFF) / 4; u += NWAVES * 64) ((LAS unsigned*)(F.lds + LDSCTL_OFF))[u] = 0u;
    __syncthreads();
    XcdBarrier bar = xcd_barrier_post((unsigned*)(F.ws + WS_CTL) + CW_BAR, F.MISC + 8);
#define GRID_BAR() xcd_barrier(bar, F.wave)
#ifdef PROBE_G
#define PGDBG(k) ((k) == PROBE_GSEL ? (float*)(F.ws + WS_CTL + 32768) : (float*)nullptr)
#else
#define PGDBG(k) ((float*)nullptr)
#endif
    typedef pg8::bf16_t bt;
    p0a(F); GRID_BAR();
    p0b(F); GRID_BAR();
    { pg8::Gemm g{(const bt*)(F.out + OS_H), (const bt*)(F.ws + WS_WB), nullptr, nullptr, OROW / 2, D}; pg8::Order S; S.init(M, B_COLS, F.G, (int)blockIdx.x, 1);
      const int ko = kopaque(); pg8::EpiPB E{(bt*)(F.ws + WS_R), kin(I_QG, ko), kin(I_KG, ko), (LAS float*)(F.lds + EPI_OFF), PGDBG(0)};
      pg8::gemm_phase<pg8::EpiPB, pg8::Order, true, true>(F.lds + RING_OFF, g, S, E, F.wave); }
    GRID_BAR();
    attn_mfma(F); GRID_BAR();
    attn_combine(F); GRID_BAR();
    { pg8::Gemm g{(const bt*)(F.out + OS_H), (const bt*)(F.ws + WS_WAG), nullptr, nullptr, OROW / 2, D}; pg8::Order S; S.init(M, 2048, F.G, (int)blockIdx.x, 1);
      pg8::EpiAG E{(bt*)(F.ws + WS_PA), (bt*)(F.ws + WS_PG), PGDBG(1)};
      pg8::gemm_phase<pg8::EpiAG, pg8::Order, true, true>(F.lds + RING_OFF, g, S, E, F.wave); }
    GRID_BAR();
#ifdef PROBE_RT
    const unsigned long long prt0 = __builtin_amdgcn_s_memrealtime();
#endif
    if (blockIdx.x < NCHAIN || F.G <= NCHAIN) rwkv_chunked(F);
    if ((blockIdx.x >= NCHAIN && blockIdx.x < NCHAIN + NSIDE) || F.G <= NCHAIN) {
        const int Gs = F.G > NCHAIN ? (F.G - NCHAIN < NSIDE ? F.G - NCHAIN : NSIDE) : F.G, cs = F.G > NCHAIN ? (int)blockIdx.x - NCHAIN : (int)blockIdx.x;
        pg8::Gemm g{(const bt*)(F.out + OS_H), (const bt*)(F.ws + WS_WAG) + (size_t)2048 * D, nullptr, nullptr, OROW / 2, D}; pg8::Order S; S.init(M, 2304, Gs, cs, 1);
        pg8::EpiPG E{(bt*)(F.ws + WS_PG), (bt*)(F.ws + WS_PA), PGDBG(4)};
        pg8::gemm_phase<pg8::EpiPG, pg8::Order, true, true>(F.lds + RING_OFF, g, S, E, F.wave); }
#ifdef PROBE_RT
    if (blockIdx.x == 0 && threadIdx.x == 0) ((float*)(F.ws + WS_CTL + 32768))[2] = (float)(__builtin_amdgcn_s_memrealtime() - prt0);
    if (blockIdx.x == PROBE_RT && threadIdx.x == 0) ((float*)(F.ws + WS_CTL + 32768))[3] = (float)(__builtin_amdgcn_s_memrealtime() - prt0);
#endif
    GRID_BAR();
    rwkv_post(F); GRID_BAR();
    { pg8::Gemm g{(const bt*)(F.out + OS_YA), (const bt*)(F.ws + WS_WOA), (const bt*)(F.out + OS_YB), (const bt*)(F.ws + WS_WOB), OROW / 2, A_W}; pg8::Order S; S.init(M, D, F.G, (int)blockIdx.x, 2);
      pg8::EpiMerge E{(const bt*)(F.ws + WS_PG), (bt*)(F.ws + WS_Y), PGDBG(2)};
      pg8::gemm_phase<pg8::EpiMerge, pg8::Order, true, true>(F.lds + RING_OFF, g, S, E, F.wave); }
    GRID_BAR();
    { pg8::Gemm g{(const bt*)(F.ws + WS_Y), (const bt*)(F.ws + WS_WO), nullptr, nullptr, D, D}; pg8::Order S; S.init(M, D, F.G, (int)blockIdx.x, 1);
      const int ko = kopaque(); pg8::EpiOut E{kin(I_XP, ko), kin(I_XS, ko), (const float*)(F.ws + WS_MOD), (float*)F.out, PGDBG(3)};
      pg8::gemm_phase<pg8::EpiOut, pg8::Order, true, true>(F.lds + RING_OFF, g, S, E, F.wave); }
#if defined(PROBE_TA) || defined(PROBE_G) || defined(PROBE_AT) || defined(PROBE_RT)
    GRID_BAR();
#ifdef PROBE_RT
    { const float* pf_ = (const float*)(F.ws + WS_CTL + 32768); const float f = 0.5f * pf_[3] / pf_[2]; float* o = (float*)F.out;
#else
    { const float f = ((const float*)(F.ws + WS_CTL + 32768))[0]; float* o = (float*)F.out;
#endif
      for (int i = blockIdx.x * 512 + (F.wave * 64 + lane_id()); i < 655 * 1024; i += gridDim.x * 512) o[i] *= (1.f + f); }
#endif
}

extern "C" void kernel_launch(void* const* d_in, const int* in_sizes, int n_in, void* d_out, int out_size, void* d_ws, size_t ws_size, hipStream_t stream) {
    static int grid = 0;
    if (grid == 0) {
        if (n_in != 24 || out_size != M * D || ws_size < WS_END) { fprintf(stderr, "kernel_launch: unexpected shapes: n_in %d out %d ws %zu (need %zu)\n", n_in, out_size, ws_size, (size_t)WS_END); grid = -1; return; }
        int dev = 0, cus = 0, per_cu = 0;
        if (hipGetDevice(&dev) != hipSuccess || hipDeviceGetAttribute(&cus, hipDeviceAttributeMultiprocessorCount, dev) != hipSuccess) { grid = -1; return; }
        if (hipFuncSetAttribute((const void*)hybrid_fwd, hipFuncAttributeMaxDynamicSharedMemorySize, LDS_BYTES) != hipSuccess) { fprintf(stderr, "kernel_launch: hipFuncSetAttribute failed\n"); grid = -1; return; }
        if (hipOccupancyMaxActiveBlocksPerMultiprocessor(&per_cu, (const void*)hybrid_fwd, NWAVES * 64, LDS_BYTES) != hipSuccess || per_cu < 1) { fprintf(stderr, "kernel_launch: occupancy query says %d\n", per_cu); }
        (void)hipGetLastError();
        grid = cus;
    }
    if (grid < 0) return;
    if (hipMemsetAsync((char*)d_ws + WS_CTL, 0, CTL_ZERO_BYTES, stream) != hipSuccess) return;
    Args a{};
    for (int i = 0; i < 24; ++i) a.in[i] = (const float*)d_in[i];
    a.out = (unsigned char*)d_out; a.ws = (unsigned char*)d_ws;
    hipLaunchKernelGGL(hybrid_fwd, dim3(grid), dim3(NWAVES * 64), LDS_BYTES, stream, a);
}
```

```cpp
#include <hip/hip_runtime.h>
#include <cstdio>
#include <cstdint>
__device__ __forceinline__ int lane_id() { unsigned m = ~0u; asm volatile("" : "+s"(m) :: "memory"); return (int)__builtin_amdgcn_mbcnt_hi(m, __builtin_amdgcn_mbcnt_lo(m, 0u)); }
namespace pg8 {
#define PG8_LAS __attribute__((address_space(3)))
typedef unsigned short bf16_t;
typedef short bf16x8 __attribute__((ext_vector_type(8)));
typedef float f32x4 __attribute__((ext_vector_type(4)));
typedef unsigned u32x4 __attribute__((ext_vector_type(4)));
constexpr int BM = 256, BK = 64, HALF = 128, HTB = HALF * BK * 2  , STAGE_BYTES = 8 * HTB, NXCD = 8, WGM = 8;

__host__ __device__ __forceinline__ int lds_byte(int r, int c) { const int st = (r >> 4) * 2 + (c >> 5), rr = r & 15, cc = c & 31, ob = rr * 64 + cc * 2; return st * 1024 + (ob ^ (((ob >> 9) & 1) << 5)); }
__host__ __device__ __forceinline__ void stage_rc(int b, int& R, int& C) { const int st = b / 1024, sb = b % 1024, swz = sb ^ (((sb >> 9) & 1) << 5); R = (st >> 1) * 16 + swz / 64; C = (st & 1) * 32 + (swz % 64) / 2; }
__host__ __device__ __forceinline__ int perm32(int rho) { const int n = rho >> 4, i = rho & 15; return 8 * (i >> 2) + 4 * n + (i & 3); }

struct Unit { int pm, pn, sel; };
struct Gemm { const bf16_t* A0; const bf16_t* B0; const bf16_t* A1; const bf16_t* B1; int lda; int K; };

struct Order {
    int nM, nN, nwg, G, c, CH;
    __host__ __device__ void init(int M, int N, int G_, int c_, int CH_) { nM = M / BM; nN = N / BM; nwg = nM * nN; G = G_; c = c_; CH = CH_; }
    __host__ __device__ bool next(int i, Unit& u) const {
        const int ti = (CH == 2) ? (i >> 1) : i; u.sel = (CH == 2) ? (i & 1) : 0;
        const long L = (long)ti * G + c; if (L >= nwg) return false;
        int wgid = (int)L; { const int q = nwg / NXCD, r = nwg % NXCD, xcd = wgid % NXCD, off = wgid / NXCD; wgid = (xcd < r ? xcd * (q + 1) : r * (q + 1) + (xcd - r) * q) + off; }
        const int nig = WGM * nN, gid = wgid / nig, fm = gid * WGM, gsz = (nM - fm) < WGM ? (nM - fm) : WGM;
        u.pm = fm + ((wgid % nig) % gsz); u.pn = (wgid % nig) / gsz; return true;
    }
};
__device__ __forceinline__ unsigned cvt_pk_bf16(float lo, float hi) { unsigned r; asm volatile("v_cvt_pk_bf16_f32 %0, %1, %2" : "=v"(r) : "v"(lo), "v"(hi)); return r; }
template <class Epi, class Sched, bool ALIGN_EPI = false, bool SP2 = false>
__device__ __forceinline__ void gemm_phase(PG8_LAS unsigned char* lds, const Gemm g, const Sched& S, const Epi& E, const int wave_id) {
    int tid = wave_id * 64 + lane_id(); asm volatile("" : "+v"(tid));
    const int wid = wave_id, lane = tid & 63, wr = wid >> 2, wc = wid & 3, fr = lane & 15, fq = lane >> 4;
    const int K = g.K, nt = K / BK;
    unsigned voffA[2], voffB[2];
#pragma unroll
    for (int i = 0; i < 2; ++i) { int R, C; stage_rc(tid * 16 + i * 8192, R, C); const int Rb = Epi::PERM ? ((R & ~31) + perm32(R & 31)) : R;
        voffA[i] = (unsigned)(R * g.lda + C) * 2u; voffB[i] = (unsigned)(Rb * K + C) * 2u; }
    const size_t kstep = (size_t)(BK * 2);
    const size_t hstepA = (size_t)HALF * g.lda * 2, hstepB = (size_t)HALF * K * 2;
    const size_t tstepA = 2 * hstepA, tstepB = 2 * hstepB;
    const unsigned ldsw = (unsigned)wid * 1024u;
    const int aoff = lds_byte(wr * 64 + fr, fq * 8), boff = lds_byte(wc * 32 + fr, fq * 8);
#define PG8_SA(b, h) (((b) * 2 + (h)) * HTB)
#define PG8_SB(b, h) ((4 + (b) * 2 + (h)) * HTB)
#define PG8_STAGE(bufoff, gbase, voff) do { _Pragma("unroll") for (int _i = 0; _i < 2; ++_i) \
        __builtin_amdgcn_global_load_lds((const unsigned*)((const char*)(gbase) + (voff)[_i]), (PG8_LAS unsigned*)(lds + (bufoff) + ldsw + _i * 8192), 16, 0, 0); } while (0)
#define PG8_LDA(dst, b, h) do { _Pragma("unroll") for (int m = 0; m < 4; ++m) _Pragma("unroll") for (int k = 0; k < 2; ++k) dst[m][k] = *(const PG8_LAS bf16x8*)(lds + PG8_SA(b, h) + aoff + m * 2048 + k * 1024); } while (0)
#define PG8_LDB(dst, b, h) do { _Pragma("unroll") for (int n = 0; n < 2; ++n) _Pragma("unroll") for (int k = 0; k < 2; ++k) dst[n][k] = *(const PG8_LAS bf16x8*)(lds + PG8_SB(b, h) + boff + n * 2048 + k * 1024); } while (0)
#define PG8_MMA(ai, bj, At, Bt) do { __builtin_amdgcn_s_setprio(1); _Pragma("unroll") for (int m = 0; m < 4; ++m) _Pragma("unroll") for (int n = 0; n < 2; ++n) _Pragma("unroll") for (int k = 0; k < 2; ++k) \
        acc[ai][bj][m][n] = __builtin_amdgcn_mfma_f32_16x16x32_bf16(Bt[n][k], At[m][k], acc[ai][bj][m][n], 0, 0, 0); __builtin_amdgcn_s_setprio(0); } while (0)
#define PG8_APTR(u) ((const char*)((u).sel ? g.A1 : g.A0) + (size_t)(u).pm * tstepA)
#define PG8_BPTR(u) ((const char*)((u).sel ? g.B1 : g.B0) + (size_t)(u).pn * tstepB)
#define PG8_WAIT_V(n) asm volatile("s_waitcnt vmcnt(" #n ")" ::: "memory")
#define PG8_WAIT_L(n) asm volatile("s_waitcnt lgkmcnt(" #n ")" ::: "memory")
#define PG8_BAR __builtin_amdgcn_s_barrier()
#define PG8_SCHED __builtin_amdgcn_sched_barrier(0)
    Unit cur, nxt; int ui = 0;
    if (!S.next(0, cur)) return;
#ifdef PROBE_G
    unsigned long long pg_epi = 0; const unsigned long long pg_start = __builtin_amdgcn_s_memtime();
#endif
    f32x4 acc[2][2][4][2];
#pragma unroll
    for (int a = 0; a < 2; ++a)
#pragma unroll
        for (int b = 0; b < 2; ++b)
#pragma unroll
            for (int m = 0; m < 4; ++m)
#pragma unroll
                for (int n = 0; n < 2; ++n) acc[a][b][m][n] = (f32x4){0.f, 0.f, 0.f, 0.f};
    bf16x8 At[4][2], B0[2][2], B1[2][2];
    const char* cA = PG8_APTR(cur); const char* cB = PG8_BPTR(cur);
    if constexpr (SP2) {
        PG8_STAGE(PG8_SB(0, 0), cB, voffB); PG8_STAGE(PG8_SB(0, 1), cB + hstepB, voffB); PG8_STAGE(PG8_SA(0, 0), cA, voffA); PG8_STAGE(PG8_SA(0, 1), cA + hstepA, voffA);
        if (wr == 1) PG8_BAR;
        PG8_WAIT_V(2); PG8_BAR;
        PG8_STAGE(PG8_SB(1, 0), cB + kstep, voffB); PG8_STAGE(PG8_SA(1, 0), cA + kstep, voffA); PG8_STAGE(PG8_SB(1, 1), cB + hstepB + kstep, voffB);
        PG8_WAIT_V(6); PG8_BAR;
    } else {
        PG8_STAGE(PG8_SB(0, 0), cB, voffB); PG8_STAGE(PG8_SA(0, 0), cA, voffA); PG8_STAGE(PG8_SB(0, 1), cB + hstepB, voffB); PG8_STAGE(PG8_SA(0, 1), cA + hstepA, voffA);
        if (wr == 1) PG8_BAR;
        PG8_WAIT_V(4); PG8_BAR;
        PG8_STAGE(PG8_SB(1, 0), cB + kstep, voffB); PG8_STAGE(PG8_SA(1, 0), cA + kstep, voffA); PG8_STAGE(PG8_SB(1, 1), cB + hstepB + kstep, voffB);
        PG8_WAIT_V(6); PG8_BAR;
    }
    for (;;) {
        const bool has_next = S.next(ui + 1, nxt);
        const char* nA = has_next ? PG8_APTR(nxt) : cA; const char* nB = has_next ? PG8_BPTR(nxt) : cB;
        for (int t = 0; t < nt; t += 2) {
            const bool last = (t == nt - 2);
            const char* a1 = cA + (size_t)(t + 1) * kstep;
            const char* a2 = last ? nA : cA + (size_t)(t + 2) * kstep; const char* b2 = last ? nB : cB + (size_t)(t + 2) * kstep;
            const char* a3 = a2 + kstep; const char* b3 = b2 + kstep;
            if constexpr (SP2) {
            PG8_LDB(B0, 0, 0); PG8_LDB(B1, 0, 1); PG8_SCHED; PG8_LDA(At, 0, 0); PG8_STAGE(PG8_SA(1, 1), a1 + hstepA, voffA);
            PG8_WAIT_V(8); PG8_WAIT_L(0); PG8_BAR; PG8_MMA(0, 0, At, B0); PG8_MMA(0, 1, At, B1); PG8_BAR; PG8_SCHED;
            PG8_LDA(At, 0, 1); PG8_STAGE(PG8_SB(0, 0), b2, voffB); PG8_STAGE(PG8_SB(0, 1), b2 + hstepB, voffB); PG8_STAGE(PG8_SA(0, 0), a2, voffA);
            PG8_WAIT_V(8); PG8_WAIT_L(0); PG8_BAR; PG8_MMA(1, 0, At, B0); PG8_MMA(1, 1, At, B1); PG8_BAR; PG8_SCHED;
            PG8_LDB(B0, 1, 0); PG8_LDB(B1, 1, 1); PG8_SCHED; PG8_LDA(At, 1, 0); PG8_STAGE(PG8_SA(0, 1), a2 + hstepA, voffA);
            PG8_WAIT_V(8); PG8_WAIT_L(0); PG8_BAR; PG8_MMA(0, 0, At, B0); PG8_MMA(0, 1, At, B1); PG8_BAR; PG8_SCHED;
            PG8_LDA(At, 1, 1); PG8_STAGE(PG8_SB(1, 0), b3, voffB); PG8_STAGE(PG8_SB(1, 1), b3 + hstepB, voffB); PG8_STAGE(PG8_SA(1, 0), a3, voffA);
            PG8_WAIT_V(8); PG8_WAIT_L(0); PG8_BAR; PG8_MMA(1, 0, At, B0); PG8_MMA(1, 1, At, B1); PG8_BAR; PG8_SCHED;
            } else {
            PG8_LDB(B0, 0, 0); PG8_SCHED; PG8_LDA(At, 0, 0); PG8_STAGE(PG8_SA(1, 1), a1 + hstepA, voffA);
            PG8_WAIT_L(8); PG8_BAR; PG8_WAIT_L(0); PG8_MMA(0, 0, At, B0); PG8_BAR; PG8_SCHED;
            PG8_LDB(B1, 0, 1); PG8_STAGE(PG8_SB(0, 0), b2, voffB);
            PG8_BAR; PG8_WAIT_L(0); PG8_MMA(0, 1, At, B1); PG8_BAR;
            PG8_LDA(At, 0, 1); PG8_STAGE(PG8_SA(0, 0), a2, voffA);
            PG8_BAR; PG8_WAIT_L(0); PG8_MMA(1, 0, At, B0); PG8_BAR; PG8_SCHED;
            PG8_STAGE(PG8_SB(0, 1), b2 + hstepB, voffB);
            PG8_WAIT_V(6); PG8_BAR; PG8_MMA(1, 1, At, B1); PG8_BAR;
            PG8_LDB(B0, 1, 0); PG8_SCHED; PG8_LDA(At, 1, 0); PG8_STAGE(PG8_SA(0, 1), a2 + hstepA, voffA);
            PG8_WAIT_L(8); PG8_BAR; PG8_WAIT_L(0); PG8_MMA(0, 0, At, B0); PG8_BAR; PG8_SCHED;
            PG8_LDB(B1, 1, 1); PG8_STAGE(PG8_SB(1, 0), b3, voffB);
            PG8_BAR; PG8_WAIT_L(0); PG8_MMA(0, 1, At, B1); PG8_BAR;
            PG8_LDA(At, 1, 1); PG8_STAGE(PG8_SA(1, 0), a3, voffA);
            PG8_BAR; PG8_WAIT_L(0); PG8_MMA(1, 0, At, B0); PG8_BAR; PG8_SCHED;
            PG8_STAGE(PG8_SB(1, 1), b3 + hstepB, voffB);
            PG8_WAIT_V(6); PG8_BAR; PG8_MMA(1, 1, At, B1); PG8_BAR;
            }
        }
        if constexpr (ALIGN_EPI) { if (wr == 0) PG8_BAR; }
#ifdef PROBE_G
        const unsigned long long pg_t0 = __builtin_amdgcn_s_memtime();
#endif
        const bool keep = E(acc, cur, wr, wc, fr, fq);
#ifdef PROBE_G
        pg_epi += __builtin_amdgcn_s_memtime() - pg_t0;
#endif
        if (!has_next) break;
        if (!keep) {
#pragma unroll
        for (int a = 0; a < 2; ++a)
#pragma unroll
            for (int b = 0; b < 2; ++b)
#pragma unroll
                for (int m = 0; m < 4; ++m)
#pragma unroll
                    for (int n = 0; n < 2; ++n) acc[a][b][m][n] = (f32x4){0.f, 0.f, 0.f, 0.f};
        }
        cur = nxt; cA = nA; cB = nB; ++ui;
        if constexpr (ALIGN_EPI) { if (wr == 1) PG8_BAR; }
    }
#ifdef PROBE_G
    if (E.dbg && blockIdx.x == 0 && threadIdx.x == 0) { const double tot = (double)(__builtin_amdgcn_s_memtime() - pg_start);
        E.dbg[0] = (PROBE_G == 1) ? (float)(tot / (double)(ui + 1) / 262144.0) : (float)((double)pg_epi / tot); }
#endif
    PG8_WAIT_V(0);
    if constexpr (!ALIGN_EPI) { if (wr == 0) PG8_BAR; }
    PG8_BAR;
#undef PG8_SA
#undef PG8_SB
#undef PG8_STAGE
#undef PG8_LDA
#undef PG8_LDB
#undef PG8_MMA
#undef PG8_APTR
#undef PG8_BPTR
#undef PG8_WAIT_V
#undef PG8_WAIT_L
#undef PG8_BAR
#undef PG8_SCHED
}
}

constexpr int NWAVES = 8;
constexpr int T = 8192, D = 1024, NBP = 8, NBS = 2, NB = NBP + NBS, M = NB * T;
constexpr int NCHAIN = 160;
#ifndef PG_MAIN_TILES
#define PG_MAIN_TILES 0
#endif
constexpr int PGM = PG_MAIN_TILES;
constexpr int A_HEADS = 8, A_HD = 64, A_W = 512, RANK = 64;
constexpr int A_COLS = 2304, B_COLS = 5120, G_COLS = 2048, IN_COLS = 9472, AG_COLS = A_COLS + G_COLS;
constexpr int B_QKV = 1536, B_W = 512, B_HD = 128;
constexpr float RMS_EPS = 1e-6f, GN_EPS = 64e-5f;
constexpr size_t MiB = 1u << 20;
constexpr size_t WS_CTL = 0, CTL_ZERO_BYTES = 65536;
constexpr size_t WS_MOD = 1 * MiB;
constexpr size_t WS_BTAB = 1 * MiB + 128 * 1024;
constexpr size_t WS_WB = 2 * MiB;
constexpr size_t WS_WAG = 12 * MiB;
constexpr size_t WS_WOA = 21 * MiB, WS_WOB = 22 * MiB, WS_WO = 23 * MiB;
constexpr size_t WS_BON = 26 * MiB;
constexpr size_t WS_R = 32 * MiB;
constexpr size_t WS_PA = WS_R, WS_PG = WS_R + 360 * MiB;
constexpr size_t WS_Y = 832 * MiB;
constexpr size_t WS_END = 992 * MiB;
constexpr int CW_BAR = 4096;
constexpr int OS_H = 0, OS_YA = 2048, OS_YB = 3072, OROW = 4096;
constexpr int RING_OFF = 0, RING_BYTES = 131072;
constexpr int LDSCTL_OFF = RING_BYTES, MISC_OFF = LDSCTL_OFF + 320;
constexpr int EPI_OFF = RING_BYTES + 1024;
constexpr int LDS_BYTES = 147456;

#define GAS __attribute__((address_space(1)))
#define LAS __attribute__((address_space(3)))
typedef unsigned short bf16;
typedef unsigned v4u __attribute__((ext_vector_type(4)));
typedef unsigned v2u __attribute__((ext_vector_type(2)));
typedef float f32x4 __attribute__((ext_vector_type(4)));
typedef short bf16x8 __attribute__((ext_vector_type(8)));
typedef GAS unsigned gu32;
#define RLX_AGENT __ATOMIC_RELAXED, __HIP_MEMORY_SCOPE_AGENT
#define LDS_WAIT() asm volatile("s_waitcnt lgkmcnt(0)" ::: "memory")
#define VM_WAIT() asm volatile("s_waitcnt vmcnt(0)" ::: "memory")
__device__ __forceinline__ unsigned f2bf(float f) { unsigned u = __builtin_bit_cast(unsigned, f); return (u + 0x7fffu + ((u >> 16) & 1u)) >> 16; }
__device__ __forceinline__ unsigned pk2(float lo, float hi) { return f2bf(lo) | (f2bf(hi) << 16); }
typedef float f32x2_t __attribute__((ext_vector_type(2))); typedef __bf16 bf16x2_t __attribute__((ext_vector_type(2)));
__device__ __forceinline__ unsigned cvtpk(float lo, float hi) { f32x2_t v = {lo, hi}; bf16x2_t b = __builtin_convertvector(v, bf16x2_t); return __builtin_bit_cast(unsigned, b); }
__device__ __forceinline__ float bf2f(unsigned short h) { return __builtin_bit_cast(float, (unsigned)h << 16); }
__device__ __forceinline__ float bflo(unsigned w) { return __builtin_bit_cast(float, w << 16); }
__device__ __forceinline__ float bfhi(unsigned w) { return __builtin_bit_cast(float, w & 0xffff0000u); }
__device__ __forceinline__ float sigmoidf_(float v) { return __builtin_amdgcn_rcpf(1.f + __expf(-v)); }
__device__ __forceinline__ float siluf_(float v) { return v * sigmoidf_(v); }
__device__ __forceinline__ float wave_sum(float v) {
#pragma unroll
    for (int o = 1; o < 64; o <<= 1) v += __shfl_xor(v, o);
    return v;
}
__device__ __forceinline__ float wave_max(float v) {
#pragma unroll
    for (int o = 1; o < 64; o <<= 1) v = fmaxf(v, __shfl_xor(v, o));
    return v;
}

#define XB_TMO      128
#define XB_XCNT(j)  (256  + 64 * (j))
#define XB_XSUB(j)  (1280 + 64 * (j))
#define XB_XGEN(j)  (2304 + 64 * (j))
#define XB_TOP      3328
#define XB_TOPGEN   3392
#define XCD_BAR_WORDS 3456
#define XB_SPIN_CAP (1u << 22)
__device__ __forceinline__ unsigned xb_ld(unsigned* p)              { return __hip_atomic_load(p, __ATOMIC_RELAXED, __HIP_MEMORY_SCOPE_AGENT); }
__device__ __forceinline__ unsigned xb_add(unsigned* p, unsigned v) { return __hip_atomic_fetch_add(p, v, __ATOMIC_RELAXED, __HIP_MEMORY_SCOPE_AGENT); }
__device__ __forceinline__ unsigned xb_xcc_id() { return (unsigned)__builtin_amdgcn_s_getreg((3 << 11) | 20) & 0xFu; }
#define XB_SPIN(cond, bar) do { unsigned _sp = 0; while (cond) { __builtin_amdgcn_s_sleep(1); \
    if ((++_sp & 255u) == 0u) { if (xb_ld(&(bar)[XB_TMO])) break; if (_sp > XB_SPIN_CAP) { atomicAdd(&(bar)[XB_TMO], 1u); break; } } } } while (0)
struct XcdBarrier { unsigned* bar; unsigned x; volatile LAS unsigned* st; };
__device__ __forceinline__ XcdBarrier xcd_barrier_post(unsigned* bar, volatile LAS unsigned* st) {
    XcdBarrier b; b.bar = bar; b.x = xb_xcc_id(); b.st = st;
    if (threadIdx.x == 0) (void)xb_add(&bar[XB_XCNT(b.x)], 1u);
    return b;
}
__device__ __forceinline__ void xcd_barrier_complete(unsigned* bar, unsigned x, unsigned& nloc, unsigned& nx) {
    const unsigned G = gridDim.x * gridDim.y * gridDim.z;
    unsigned sum, cnt, mine, sp = 0u;
    for (;;) {
        sum = 0u; cnt = 0u; mine = 0u;
#pragma unroll
        for (unsigned j = 0; j < 16; ++j) { const unsigned c = xb_ld(&bar[XB_XCNT(j)]); sum += c; cnt += (c > 0u) ? 1u : 0u; mine = (j == x) ? c : mine; }
        if (sum == G) break;
        __builtin_amdgcn_s_sleep(1);
        if ((++sp & 255u) == 0u) { if (xb_ld(&bar[XB_TMO])) break; if (sp > XB_SPIN_CAP) { atomicAdd(&bar[XB_TMO], 1u); break; } }
    }
    nloc = mine > 0u ? mine : 1u; nx = cnt > 0u ? cnt : 1u;
}
__device__ __forceinline__ void xcd_barrier(const XcdBarrier& b, const int wave_id) {
    asm volatile("s_waitcnt vmcnt(0)" ::: "memory");
    __syncthreads();
    if (wave_id == 0 && lane_id() == 0) {
        unsigned* bar = b.bar;
        __builtin_amdgcn_s_waitcnt(0);
        unsigned nloc = b.st[0], nx = b.st[1];
        if (nloc == 0u) { xcd_barrier_complete(bar, b.x, nloc, nx); b.st[0] = nloc; b.st[1] = nx; }
        const unsigned old = xb_add(&bar[XB_XSUB(b.x)], 1u);
        const unsigned gen = old / nloc;
        if (old + 1u == (gen + 1u) * nloc) {
            __builtin_amdgcn_fence(__ATOMIC_RELEASE, "agent");
            asm volatile("s_waitcnt vmcnt(0)" ::: "memory");
            const unsigned og = xb_add(&bar[XB_TOP], 1u);
            const unsigned tg = og / nx;
            if (og + 1u == (tg + 1u) * nx) xb_add(&bar[XB_TOPGEN], 1u);
            else XB_SPIN(xb_ld(&bar[XB_TOPGEN]) == tg, bar);
            __builtin_amdgcn_fence(__ATOMIC_ACQUIRE, "agent");
            xb_add(&bar[XB_XGEN(b.x)], 1u);
            asm volatile("s_waitcnt vmcnt(0)" ::: "memory");
        } else {
            XB_SPIN(xb_ld(&bar[XB_XGEN(b.x)]) == gen, bar);
            __builtin_amdgcn_fence(__ATOMIC_ACQUIRE, "agent");
            asm volatile("s_waitcnt vmcnt(0)" ::: "memory");
        }
    }
    __syncthreads();
}

struct Frame {
    LAS unsigned char* lds;
    volatile LAS unsigned* MISC;
    int wave;
    __device__ __forceinline__ int lane_() const { return lane_id(); }
    int vcu, G;
    unsigned char* out;
    unsigned char* ws;
};
enum { I_XP = 0, I_XS, I_CP, I_CS, I_RELB, I_NORMW, I_WADA, I_BADA, I_WIN, I_MU, I_W0, I_W2, I_A0, I_A2, I_KK, I_KA, I_RK, I_LNW, I_LNB, I_QG, I_KG, I_WOA, I_WOB, I_WO };
__device__ __forceinline__ int kopaque() { int z = 0; asm volatile("" : "+s"(z)); return z; }
__device__ __forceinline__ const float* kin(int k, int kof) { return ((const float* const __attribute__((address_space(4)))*)__builtin_amdgcn_kernarg_segment_ptr())[k + kof]; }
__device__ __forceinline__ const float* xrow_ptr(const float* xp, const float* xs, int m) { return m < NBP * T ? xp + (size_t)m * D : xs + (size_t)(m - NBP * T) * D; }

namespace pg8 {
struct EpiPB {
    static constexpr bool PERM = true;
    bf16_t* O; const float* qg; const float* kg; PG8_LAS float* P; float* dbg;
    __device__ __forceinline__ bool operator()(f32x4 (&acc)[2][2][4][2], const Unit& u, int wr, int wc, int fr, int fq) const {
        const int row0 = u.pm * BM + wr * 64 + fr, col0 = u.pn * BM + wc * 32 + 8 * fq;
        if (u.pn < 12) {
#pragma unroll
            for (int ai = 0; ai < 2; ++ai)
#pragma unroll
                for (int m = 0; m < 4; ++m) {
#pragma unroll
                    for (int bj = 0; bj < 2; ++bj) { const f32x4 a = acc[ai][bj][m][0], b = acc[ai][bj][m][1];
                        float s = (a[0] * a[0] + a[1] * a[1]) + (a[2] * a[2] + a[3] * a[3]) + (b[0] * b[0] + b[1] * b[1]) + (b[2] * b[2] + b[3] * b[3]);
                        s += __shfl_xor(s, 16); s += __shfl_xor(s, 32);
                        if (fq == 0) P[((ai * HALF + wr * 64 + m * 16 + fr) * 2 + bj) * 4 + wc] = s; }
                    asm volatile("" ::: "memory"); }
            asm volatile("s_waitcnt lgkmcnt(0)" ::: "memory"); __builtin_amdgcn_s_barrier(); asm volatile("" ::: "memory");
            const bool isq = u.pn < 6; const float* gp = (isq ? qg : kg) + wc * 32 + 8 * fq; const float gs = isq ? 0.08838834764831845f * 1.4426950408889634f : 1.f;
            float gn[8];
#pragma unroll
            for (int e = 0; e < 8; ++e) gn[e] = gp[e] * gs;
#pragma unroll
            for (int ai = 0; ai < 2; ++ai)
#pragma unroll
                for (int m = 0; m < 4; ++m)
#pragma unroll
                    for (int bj = 0; bj < 2; ++bj) { const f32x4 p4 = *(const PG8_LAS f32x4*)(P + ((ai * HALF + wr * 64 + m * 16 + fr) * 2 + bj) * 4);
                        const float rs = 1.0f / sqrtf(((p4[0] + p4[1]) + (p4[2] + p4[3])) * (1.f / 128.f) + 1e-6f);
#pragma unroll
                        for (int e = 0; e < 4; ++e) { acc[ai][bj][m][0][e] *= rs * gn[e]; acc[ai][bj][m][1][e] *= rs * gn[4 + e]; }
                        asm volatile("" ::: "memory"); }
        }
        const bool act = u.pn >= 18;
#pragma unroll
        for (int ai = 0; ai < 2; ++ai)
#pragma unroll
            for (int m = 0; m < 4; ++m) { bf16_t* rowp = O + (size_t)(row0 + ai * HALF + m * 16) * B_COLS + col0;
#pragma unroll
                for (int bj = 0; bj < 2; ++bj) { f32x4 v0 = acc[ai][bj][m][0], v1 = acc[ai][bj][m][1];
                    if (act) {
#pragma unroll
                        for (int e = 0; e < 4; ++e) { v0[e] = siluf_(v0[e]); v1[e] = siluf_(v1[e]); } }
                    u32x4 w; w.x = cvt_pk_bf16(v0[0], v0[1]); w.y = cvt_pk_bf16(v0[2], v0[3]); w.z = cvt_pk_bf16(v1[0], v1[1]); w.w = cvt_pk_bf16(v1[2], v1[3]);
                    *(u32x4*)(rowp + bj * HALF) = w; } }
        return false;
    }
};
struct EpiAG {
    static constexpr bool PERM = true;
    bf16_t* PA; bf16_t* PG; float* dbg;
    __device__ __forceinline__ bool operator()(const f32x4 (&acc)[2][2][4][2], const Unit& u, int wr, int wc, int fr, int fq) const {
        bf16_t* base = PA; const int ldc = A_COLS; const int pn = u.pn < 6 ? u.pn : 8;
        const int row0 = u.pm * BM + wr * 64 + fr, col0 = pn * BM + wc * 32 + 8 * fq;
#pragma unroll
        for (int ai = 0; ai < 2; ++ai)
#pragma unroll
            for (int m = 0; m < 4; ++m) { bf16_t* rowp = base + (size_t)(row0 + ai * HALF + m * 16) * ldc + col0;
#pragma unroll
                for (int bj = 0; bj < 2; ++bj) { const f32x4 v0 = acc[ai][bj][m][0], v1 = acc[ai][bj][m][1];
                    u32x4 w; w.x = cvt_pk_bf16(v0[0], v0[1]); w.y = cvt_pk_bf16(v0[2], v0[3]); w.z = cvt_pk_bf16(v1[0], v1[1]); w.w = cvt_pk_bf16(v1[2], v1[3]);
                    *(u32x4*)(rowp + bj * HALF) = w; } }
        return false;
    }
};
struct EpiPG {
    static constexpr bool PERM = true;
    bf16_t* PG; bf16_t* PA; float* dbg;
    __device__ __forceinline__ bool operator()(const f32x4 (&acc)[2][2][4][2], const Unit& u, int wr, int wc, int fr, int fq) const {
        const bool ispa = u.pn < 2; bf16_t* base = ispa ? PA : PG; const int ldc = ispa ? A_COLS : G_COLS;
        const int row0 = u.pm * BM + wr * 64 + fr, col0 = (ispa ? 6 + u.pn : u.pn - 2) * BM + wc * 32 + 8 * fq;
#pragma unroll
        for (int ai = 0; ai < 2; ++ai)
#pragma unroll
            for (int m = 0; m < 4; ++m) { bf16_t* rowp = base + (size_t)(row0 + ai * HALF + m * 16) * ldc + col0;
#pragma unroll
                for (int bj = 0; bj < 2; ++bj) { const f32x4 v0 = acc[ai][bj][m][0], v1 = acc[ai][bj][m][1];
                    u32x4 w; w.x = cvt_pk_bf16(v0[0], v0[1]); w.y = cvt_pk_bf16(v0[2], v0[3]); w.z = cvt_pk_bf16(v1[0], v1[1]); w.w = cvt_pk_bf16(v1[2], v1[3]);
                    *(u32x4*)(rowp + bj * HALF) = w; } }
        return false;
    }
};
struct EpiMerge {
    static constexpr bool PERM = true;
    const bf16_t* PG; bf16_t* O; float* dbg;
    __device__ __forceinline__ bool operator()(f32x4 (&acc)[2][2][4][2], const Unit& u, int wr, int wc, int fr, int fq) const {
        const int row0 = u.pm * BM + wr * 64 + fr, col0 = u.pn * BM + wc * 32 + 8 * fq;
#pragma unroll
        for (int ai = 0; ai < 2; ++ai)
#pragma unroll
            for (int m = 0; m < 4; ++m) { const size_t row = (size_t)(row0 + ai * HALF + m * 16);
#pragma unroll
                for (int bj = 0; bj < 2; ++bj) { const int col = col0 + bj * HALF;
                    const u32x4 gb8 = *(const u32x4*)(PG + row * G_COLS + D + col);
                    float zb[8] = {bflo(gb8.x), bfhi(gb8.x), bflo(gb8.y), bfhi(gb8.y), bflo(gb8.z), bfhi(gb8.z), bflo(gb8.w), bfhi(gb8.w)};
                    if (u.sel == 0) {
                        const u32x4 ga8 = *(const u32x4*)(PG + row * G_COLS + col);
                        float za[8] = {bflo(ga8.x), bfhi(ga8.x), bflo(ga8.y), bfhi(ga8.y), bflo(ga8.z), bfhi(ga8.z), bflo(ga8.w), bfhi(ga8.w)};
#pragma unroll
                        for (int e = 0; e < 8; ++e) { const float ea = __expf(-fminf(fmaxf(za[e], -30.f), 30.f)), eb = __expf(-fminf(fmaxf(zb[e], -30.f), 30.f));
                            const float r = (1.f + eb) * __builtin_amdgcn_rcpf(1.f + ea); acc[ai][bj][m][e >> 2][e & 3] *= r; }
                    } else {
                        float o[8];
#pragma unroll
                        for (int e = 0; e < 8; ++e) { const float eb = __expf(-fminf(fmaxf(zb[e], -30.f), 30.f)); o[e] = acc[ai][bj][m][e >> 2][e & 3] * __builtin_amdgcn_rcpf(1.f + eb); }
                        u32x4 w; w.x = cvt_pk_bf16(o[0], o[1]); w.y = cvt_pk_bf16(o[2], o[3]); w.z = cvt_pk_bf16(o[4], o[5]); w.w = cvt_pk_bf16(o[6], o[7]);
                        *(u32x4*)(O + row * D + col) = w;
                    } } }
        return u.sel == 0;
    }
};
struct EpiOut {
    static constexpr bool PERM = false;
    const float* xp; const float* xs; const float* mod; float* out; float* dbg;
    __device__ __forceinline__ bool operator()(const f32x4 (&acc)[2][2][4][2], const Unit& u, int wr, int wc, int fr, int fq) const {
        const int rowt = u.pm * BM, b = rowt >> 13; const float* xb = rowt < NBP * T ? xp + (size_t)rowt * D : xs + (size_t)(rowt - NBP * T) * D;
        const int rl0 = wr * 64 + fr, col0 = u.pn * BM + wc * 32 + 4 * fq; const float* gt = mod + b * 3072 + 2048;
#pragma unroll
        for (int bj = 0; bj < 2; ++bj)
#pragma unroll
            for (int n = 0; n < 2; ++n) { const int col = col0 + bj * HALF + n * 16; const f32x4 g4 = *(const f32x4*)(gt + col);
#pragma unroll
                for (int ai = 0; ai < 2; ++ai)
#pragma unroll
                    for (int m = 0; m < 4; ++m) { const int rl = rl0 + ai * HALF + m * 16; const f32x4 x4 = *(const f32x4*)(xb + (size_t)rl * D + col);
                        *(f32x4*)(out + (size_t)(rowt + rl) * D + col) = x4 + g4 * acc[ai][bj][m][n]; } }
        return false;
    }
};
struct SideOrder { int pm0, npm, G, c;
    __device__ bool next(int i, Unit& u) const { const int t = i * G + c; if (t >= npm * 10) return false; u.pm = pm0 + t / 10; u.pn = t % 10; u.sel = 0; return true; } };
}

__device__ __forceinline__ void p0_transpose_item(const float* W, int K, int N, bf16* WT, int k0, int n0, int drow0, LAS float* scr, int lane) {
#pragma unroll 8
    for (int i = 0; i < 32; ++i) { const int kk = 2 * i + (lane >> 5); scr[kk * 33 + (lane & 31)] = W[(size_t)(k0 + kk) * N + n0 + (lane & 31)]; }
    LDS_WAIT(); asm volatile("" ::: "memory");
    const int c = lane & 7;
#pragma unroll
    for (int j = 0; j < 4; ++j) { const int n = (lane >> 3) + 8 * j; const LAS float* s = scr + (8 * c) * 33 + n;
        v4u o; o.x = pk2(s[0 * 33], s[1 * 33]); o.y = pk2(s[2 * 33], s[3 * 33]); o.z = pk2(s[4 * 33], s[5 * 33]); o.w = pk2(s[6 * 33], s[7 * 33]);
        *(GAS v4u*)(WT + (size_t)(drow0 + n) * K + k0 + 8 * c) = o; }
    LDS_WAIT(); asm volatile("" ::: "memory");
}
__device__ __forceinline__ int t5_bucket(int rel) {
    const int n = rel < 0 ? -rel : rel; int ret = rel > 0 ? 16 : 0;
    const float lf = logf((float)(n > 1 ? n : 1) / 8.0f) / 4.852030263919617f * 8.0f;
    int large = 8 + (int)lf; large = large < 15 ? large : 15;
    return ret + (n < 8 ? n : large);
}
__device__ __forceinline__ void p0a(Frame& F) {
    const int ko = kopaque(); const float *cp_ = kin(I_CP, ko), *cs_ = kin(I_CS, ko), *w_ada = kin(I_WADA, ko), *b_ada = kin(I_BADA, ko), *rel_bias = kin(I_RELB, ko), *w_in = kin(I_WIN, ko), *w_out_a = kin(I_WOA, ko), *w_out_b = kin(I_WOB, ko), *w_out = kin(I_WO, ko);
    float* mod = (float*)(F.ws + WS_MOD);
    if (blockIdx.x < 48) {
        LAS float* sc = (LAS float*)F.lds;
        LAS float* part = (LAS float*)(F.lds + 40960);
        for (int i = (F.wave * 64 + lane_id()); i < NB * D; i += NWAVES * 64) { const int b = i >> 10, k = i & 1023; const float cv = b < NBP ? cp_[b * D + k] : cs_[(b - NBP) * D + k]; sc[i] = siluf_(cv); }
        __syncthreads();
        const int j = blockIdx.x * 64 + lane_id(); float a[NB];
#pragma unroll
        for (int b = 0; b < NB; ++b) a[b] = 0.f;
        for (int k = F.wave * 128; k < F.wave * 128 + 128; ++k) { const float w = w_ada[(size_t)k * 3072 + j];
#pragma unroll
            for (int b = 0; b < NB; ++b) a[b] += sc[b * D + k] * w; }
#pragma unroll
        for (int b = 0; b < NB; ++b) part[(F.wave * NB + b) * 64 + lane_id()] = a[b];
        __syncthreads();
        for (int i = (F.wave * 64 + lane_id()); i < NB * 64; i += NWAVES * 64) { const int b = i >> 6, l = i & 63; float s = b_ada[blockIdx.x * 64 + l];
#pragma unroll
            for (int w = 0; w < NWAVES; ++w) s += part[(w * NB + b) * 64 + l];
            mod[b * 3072 + blockIdx.x * 64 + l] = s; }
        __syncthreads();
    }
    if (blockIdx.x == 255 % gridDim.x) {
        float* bt = (float*)(F.ws + WS_BTAB);
        for (int i = (F.wave * 64 + lane_id()); i < 12 * 129; i += NWAVES * 64) { const int gh = i / 129, r = i % 129, gi = gh >> 2; const int rel = (r - 64) * (1 << (2 * gi));
            bt[i] = rel_bias[t5_bucket(rel) * 12 + gh] * 1.4426950408889634f; }
    }
    LAS float* scr = (LAS float*)(F.lds + RING_OFF + F.wave * 16384);
    const int gw = F.vcu * NWAVES + F.wave, NGW = F.G * NWAVES;
    constexpr int I_IN = (D / 64) * (IN_COLS / 32), I_OA = (A_W / 64) * (D / 32), I_OB = (B_W / 64) * (D / 32), I_O = (D / 64) * (D / 32);
    constexpr int NITEMS = I_IN + I_OA + I_OB + I_O;
    for (int it = gw; it < NITEMS; it += NGW) {
        int r = it;
        if (r < I_IN) { const int nblk = IN_COLS / 32, kb = r / nblk, nb = r % nblk, n0 = nb * 32;
            bf16* dst; int drow;
            if (n0 < A_COLS) { dst = (bf16*)(F.ws + WS_WAG); drow = n0 < 1536 ? n0 : (n0 < 2048 ? n0 + 256 : n0 - 512); }
            else if (n0 < A_COLS + B_COLS) { dst = (bf16*)(F.ws + WS_WB); drow = n0 - A_COLS; }
            else { dst = (bf16*)(F.ws + WS_WAG); drow = A_COLS + (n0 - A_COLS - B_COLS); }
            p0_transpose_item(w_in, D, IN_COLS, dst, kb * 64, n0, drow, scr, lane_id()); continue; }
        r -= I_IN;
        if (r < I_OA) { const int nblk = D / 32, kb = r / nblk, nb = r % nblk; p0_transpose_item(w_out_a, A_W, D, (bf16*)(F.ws + WS_WOA), kb * 64, nb * 32, nb * 32, scr, lane_id()); continue; }
        r -= I_OA;
        if (r < I_OB) { const int nblk = D / 32, kb = r / nblk, nb = r % nblk; p0_transpose_item(w_out_b, B_W, D, (bf16*)(F.ws + WS_WOB), kb * 64, nb * 32, nb * 32, scr, lane_id()); continue; }
        r -= I_OB;
        { const int nblk = D / 32, kb = r / nblk, nb = r % nblk; p0_transpose_item(w_out, D, D, (bf16*)(F.ws + WS_WO), kb * 64, nb * 32, nb * 32, scr, lane_id()); }
    }
}
__device__ __forceinline__ void p0b(Frame& F) {
    const int ko = kopaque(); const float *xp = kin(I_XP, ko), *xs = kin(I_XS, ko), *norm_w = kin(I_NORMW, ko);
    const float* mod = (const float*)(F.ws + WS_MOD);
    const int gw = F.vcu * NWAVES + F.wave, NGW = F.G * NWAVES, lane = lane_id();
    const int per = (M + NGW - 1) / NGW, m0 = gw * per, m1 = (m0 + per < M) ? m0 + per : M;
    int bcur = -1; f32x4 cs[4], sh[4];
    for (int m = m0; m < m1; ++m) {
        const int b = m >> 13;
        if (b != bcur) { bcur = b;
#pragma unroll
            for (int j = 0; j < 4; ++j) { const int col = 4 * (lane + 64 * j); const f32x4 nw = *(const f32x4*)(norm_w + col), sc = *(const f32x4*)(mod + b * 3072 + 1024 + col);
                cs[j] = nw * (sc + 1.f); sh[j] = *(const f32x4*)(mod + b * 3072 + col); } }
        const f32x4* xr = (const f32x4*)xrow_ptr(xp, xs, m) + lane;
        f32x4 v[4]; float s = 0.f;
#pragma unroll
        for (int j = 0; j < 4; ++j) { v[j] = xr[64 * j]; s += (v[j].x * v[j].x + v[j].y * v[j].y) + (v[j].z * v[j].z + v[j].w * v[j].w); }
        const float rs = __builtin_amdgcn_rsqf(wave_sum(s) * (1.f / D) + RMS_EPS);
        v2u* o8 = (v2u*)(F.out + (size_t)m * OROW + OS_H) + lane;
#pragma unroll
        for (int j = 0; j < 4; ++j) { const f32x4 h = v[j] * rs * cs[j] + sh[j]; v2u w; w.x = cvtpk(h.x, h.y); w.y = cvtpk(h.z, h.w); o8[64 * j] = w; }
    }
}
typedef short v4i16_t __attribute__((ext_vector_type(4)));
typedef float f32x4a __attribute__((ext_vector_type(4)));
constexpr int AT_K = 0, AT_V = 65536, AT_BT = RING_BYTES + 9216 + 1024;
constexpr size_t WS_LSE = WS_Y;
__device__ __forceinline__ void attn_unit_geom(int u, int& b, int& gi, int& hh, int& res, int& blk) {
    const int sub = u & 63; int r = u >> 6; hh = r & 3; r >>= 2; gi = r % 3; b = r / 3;
    if (gi == 0) { res = 0; blk = sub; } else if (gi == 1) { res = sub >> 4; blk = sub & 15; } else { res = sub >> 2; blk = sub & 3; }
}
__device__ __forceinline__ void glds16(const void* gsrc, unsigned lds_dst) { unsigned keep;
    asm volatile("s_mov_b32 %0, m0\n\ts_mov_b32 m0, %2\n\ts_nop 0\n\tglobal_load_lds_dwordx4 %1, off\n\ts_mov_b32 m0, %0" : "=&s"(keep) : "v"(gsrc), "s"(lds_dst) : "memory"); }
__device__ __forceinline__ void attn_dma_k_half(Frame& F, const bf16* pb, int b, int lg, int L, int res, int head, int q0, int hb) {
    const int lane = lane_id();
#pragma unroll
    for (int ii = 0; ii < 4; ++ii) { const int i = (hb >> 2) + F.wave * 4 + ii, row = 4 * i + (lane >> 4); int kp = q0 - 64 + ((row - q0) & 255); kp = kp < 0 ? 0 : (kp >= L ? L - 1 : kp);
        const int c = (lane & 15) ^ (row & 15);
        const bf16* src = pb + (size_t)(b * T + (kp << lg) + res) * B_COLS + B_QKV + head * 128 + c * 8;
        glds16(src, (unsigned)__builtin_amdgcn_readfirstlane((int)(unsigned)(size_t)(F.lds + AT_K + i * 1024))); }
}
__device__ __forceinline__ void attn_dma_v_half(Frame& F, const bf16* pb, int b, int lg, int L, int res, int head, int q0, int hb) {
    const int lane = lane_id();
#pragma unroll
    for (int jj = 0; jj < 4; ++jj) { const int j = F.wave * 4 + jj, dblk = j >> 3, kgrp = (hb >> 4) + (j & 7), row = 16 * kgrp + (lane >> 2); int kp = q0 - 64 + ((row - q0) & 255); kp = kp < 0 ? 0 : (kp >= L ? L - 1 : kp);
        const bf16* src = pb + (size_t)(b * T + (kp << lg) + res) * B_COLS + 2 * B_QKV + head * 128 + dblk * 32 + (lane & 3) * 8;
        glds16(src, (unsigned)__builtin_amdgcn_readfirstlane((int)(unsigned)(size_t)(F.lds + AT_V + dblk * 16384 + kgrp * 1024))); }
}
__device__ __forceinline__ void attn_mfma(Frame& F, bool dry = false) {
    bf16* pb = (bf16*)(F.ws + WS_R); const float* btab = (const float*)(F.ws + WS_BTAB); float* lse = (float*)(F.ws + WS_LSE);
    int lane = lane_id(); asm volatile("" : "+v"(lane));
    const int w = F.wave, qi = lane & 15, g = lane >> 4;
    LAS float* btp = (LAS float*)(F.lds + AT_BT);
    const int NU = NB * 3 * 4 * 64, per = (NU + F.G - 1) / F.G; const int u0 = F.vcu * per, u1 = (u0 + per < NU) ? u0 + per : NU;
    if (u0 >= u1) return;
#ifdef PROBE_AT
    const unsigned long long pat_t0 = __builtin_amdgcn_s_memtime();
#endif
    int koff[4];
#pragma unroll
    for (int ks = 0; ks < 4; ++ks) koff[ks] = AT_K + qi * 256 + (((4 * ks + g) ^ qi) << 4);
    const int q4 = qi >> 2, p4 = qi & 3, kr = 4 * g + q4;
    const int voff = AT_V + (kr >> 3) * 512 + (kr & 7) * 64 + 8 * p4;
    int b, gi, hh, res, blk; attn_unit_geom(u0, b, gi, hh, res, blk);
    { const int lg = 2 * gi; attn_dma_k_half(F, pb, b, lg, T >> lg, res, gi * 4 + hh, blk * 128, 0); attn_dma_k_half(F, pb, b, lg, T >> lg, res, gi * 4 + hh, blk * 128, 128); }
    int head_prev = -1;
    bf16x8 qA[4], qB[4];
#define ATTN_LOADQ(QD, uu) do { int b_, gi_, hh_, res_, blk_; attn_unit_geom((uu), b_, gi_, hh_, res_, blk_); const int lg_ = 2 * gi_; \
        const bf16* qr_ = pb + (size_t)(b_ * T + ((blk_ * 128 + 16 * w + qi) << lg_) + res_) * B_COLS + (gi_ * 4 + hh_) * 128; \
        _Pragma("unroll") for (int ks = 0; ks < 4; ++ks) QD[ks] = *(const bf16x8*)(qr_ + 32 * ks + 8 * g); } while (0)
    ATTN_LOADQ(qA, u0);
    asm volatile("" :: "v"(qA[0]), "v"(qA[1]), "v"(qA[2]), "v"(qA[3]));
#define ATTN_UNIT(u, qf, qnx) do { \
        attn_unit_geom(u, b, gi, hh, res, blk); \
        const int lg = 2 * gi, L = T >> lg, head = gi * 4 + hh, q0 = blk * 128; \
        const bool cont = ((u) > u0) && (blk != 0);                  \
        const int s8 = ((q0 >> 4) + w) & 15;                         \
        if (head != head_prev) { head_prev = head; const int tid_ = F.wave * 64 + lane_id(); if (tid_ < 176) { const int i = tid_ - 16; btp[tid_] = (i >= 0 && i <= 128) ? btab[head * 129 + i] : -1e30f; } asm volatile("s_waitcnt vmcnt(0)" ::: "memory"); } \
        bf16* qrow = pb + (size_t)(b * T + ((q0 + 16 * w + qi) << lg) + res) * B_COLS + head * 128; \
        if ((u) + 1 < u1) ATTN_LOADQ(qnx, (u) + 1); \
          \
        if ((u) == u0) asm volatile("s_waitcnt vmcnt(0) lgkmcnt(0)" ::: "memory"); else asm volatile("s_waitcnt vmcnt(6) lgkmcnt(0)" ::: "memory"); \
        __builtin_amdgcn_s_barrier(); asm volatile("" ::: "memory"); \
        if (!cont) attn_dma_v_half(F, pb, b, lg, L, res, head, q0, q0 & 255); \
        attn_dma_v_half(F, pb, b, lg, L, res, head, q0, (q0 + 128) & 255); \
        f32x4a S[9]; \
        _Pragma("unroll") for (int kb = 0; kb < 9; ++kb) { S[kb] = (f32x4a){0.f, 0.f, 0.f, 0.f}; const int rb = ((s8 + kb) & 15) * 4096; \
            _Pragma("unroll") for (int ks = 0; ks < 4; ++ks) { const bf16x8 kf = *(const LAS bf16x8*)(F.lds + koff[ks] + rb); \
                S[kb] = __builtin_amdgcn_mfma_f32_16x16x32_bf16(kf, qf[ks], S[kb], 0, 0, 0); } } \
        const bool edge = (q0 == 0) || (q0 + 128 >= L); \
        float mx = -1e30f; \
        _Pragma("unroll") for (int kb = 0; kb < 9; ++kb) \
            _Pragma("unroll") for (int r = 0; r < 4; ++r) { const int kw = 16 * kb + 4 * g + r; float sv = S[kb][r] + btp[kw - qi + 16]; \
                if (edge) { const int kp = q0 + 16 * w + kw - 64; if (kp < 0 || kp >= L) sv = -1e30f; } \
                S[kb][r] = sv; mx = fmaxf(mx, sv); } \
        mx = fmaxf(mx, __shfl_xor(mx, 16)); mx = fmaxf(mx, __shfl_xor(mx, 32)); \
        float ls = 0.f; \
        _Pragma("unroll") for (int kb = 0; kb < 9; ++kb) \
            _Pragma("unroll") for (int r = 0; r < 4; ++r) { const float pe = __builtin_amdgcn_exp2f(S[kb][r] - mx); S[kb][r] = pe; ls += pe; } \
        ls += __shfl_xor(ls, 16); ls += __shfl_xor(ls, 32); \
        bf16x8 pf[5]; \
        _Pragma("unroll") for (int c = 0; c < 5; ++c) { v4u t; t.x = cvtpk(S[2 * c][0], S[2 * c][1]); t.y = cvtpk(S[2 * c][2], S[2 * c][3]); \
            if (c < 4) { t.z = cvtpk(S[2 * c + 1][0], S[2 * c + 1][1]); t.w = cvtpk(S[2 * c + 1][2], S[2 * c + 1][3]); } else { t.z = 0u; t.w = 0u; } \
            pf[c] = __builtin_bit_cast(bf16x8, t); } \
        asm volatile("s_waitcnt vmcnt(0) lgkmcnt(0)" ::: "memory"); __builtin_amdgcn_s_barrier(); asm volatile("" ::: "memory"); \
        if ((u) + 1 < u1) { int b2, gi2, hh2, res2, blk2; attn_unit_geom((u) + 1, b2, gi2, hh2, res2, blk2); const int lg2 = 2 * gi2, q02 = blk2 * 128; \
            if (blk2 == 0) attn_dma_k_half(F, pb, b2, lg2, T >> lg2, res2, gi2 * 4 + hh2, q02, q02 & 255); \
            attn_dma_k_half(F, pb, b2, lg2, T >> lg2, res2, gi2 * 4 + hh2, q02, (q02 + 128) & 255); } \
        asm volatile("" ::: "memory");                                \
        const float il = 1.f / ls; \
        int vlo[5], vhi[5]; \
        _Pragma("unroll") for (int c = 0; c < 5; ++c) { vlo[c] = voff + ((s8 + 2 * c) & 15) * 1024; vhi[c] = (c < 4) ? voff + ((s8 + 2 * c + 1) & 15) * 1024 : vlo[c]; } \
        _Pragma("unroll") for (int db = 0; db < 8; ++db) { f32x4a o = (f32x4a){0.f, 0.f, 0.f, 0.f}; \
            _Pragma("unroll") for (int c = 0; c < 5; ++c) { const int dofs = (db >> 1) * 16384 + (db & 1) * 32; \
                const v4i16_t lo = __builtin_amdgcn_ds_read_tr16_b64_v4i16((LAS v4i16_t*)(F.lds + vlo[c] + dofs)); \
                const v4i16_t hi = __builtin_amdgcn_ds_read_tr16_b64_v4i16((LAS v4i16_t*)(F.lds + vhi[c] + dofs)); \
                const bf16x8 vf = (bf16x8){lo[0], lo[1], lo[2], lo[3], hi[0], hi[1], hi[2], hi[3]}; \
                o = __builtin_amdgcn_mfma_f32_16x16x32_bf16(vf, pf[c], o, 0, 0, 0); } \
            v2u wv; wv.x = cvtpk(o[0] * il, o[1] * il); wv.y = cvtpk(o[2] * il, o[3] * il); \
            *(v2u*)((dry ? (bf16*)(F.ws + WS_Y) + (size_t)((F.wave * 64 + lane_id()) >> 2) * B_COLS : qrow) + 16 * db + 4 * g) = wv; } \
        if (g == 0 && !dry) lse[(size_t)(b * T + ((q0 + 16 * w + qi) << lg) + res) * 12 + head] = mx + __builtin_amdgcn_logf(ls); \
        asm volatile("" :: "v"(qnx[0]), "v"(qnx[1]), "v"(qnx[2]), "v"(qnx[3]));     \
    } while (0)
    for (int u = u0; u < u1; u += 2) {
        ATTN_UNIT(u, qA, qB);
        if (u + 1 < u1) ATTN_UNIT(u + 1, qB, qA);
    }
#undef ATTN_UNIT
#undef ATTN_LOADQ
    asm volatile("s_waitcnt vmcnt(0) lgkmcnt(0)" ::: "memory"); __builtin_amdgcn_s_barrier();
#ifdef PROBE_AT
    if (blockIdx.x == 0 && (F.wave * 64 + lane_id()) == 0) ((float*)(F.ws + WS_CTL + 32768))[0] = (float)((double)(((__builtin_amdgcn_s_memtime() - pat_t0) / (unsigned long long)(u1 - u0) + 1024ull) >> 11 << 11) / 65536.0);
#endif
}
__device__ __forceinline__ void attn_combine(Frame& F) {
    const bf16* pb = (const bf16*)(F.ws + WS_R); const float* lse = (const float*)(F.ws + WS_LSE);
    const int gw = F.vcu * NWAVES + F.wave, NGW = F.G * NWAVES, lane = lane_id(), hh = lane >> 4, d0 = (lane & 15) * 8;
    for (int m = gw; m < M; m += NGW) {
        const bf16* row = pb + (size_t)m * B_COLS;
        const float l0 = lse[(size_t)m * 12 + hh], l1 = lse[(size_t)m * 12 + 4 + hh], l2 = lse[(size_t)m * 12 + 8 + hh];
        const float mxl = fmaxf(l0, fmaxf(l1, l2)); float w0 = exp2f(l0 - mxl), w1 = exp2f(l1 - mxl), w2 = exp2f(l2 - mxl); const float iw = 1.f / (w0 + w1 + w2); w0 *= iw; w1 *= iw; w2 *= iw;
        const v4u a = *(const v4u*)(row + hh * 128 + d0), bq = *(const v4u*)(row + (4 + hh) * 128 + d0), c = *(const v4u*)(row + (8 + hh) * 128 + d0), gt = *(const v4u*)(row + 3 * B_QKV + hh * 128 + d0);
        v4u o;
        o.x = pk2((w0 * bflo(a.x) + w1 * bflo(bq.x) + w2 * bflo(c.x)) * bflo(gt.x), (w0 * bfhi(a.x) + w1 * bfhi(bq.x) + w2 * bfhi(c.x)) * bfhi(gt.x));
        o.y = pk2((w0 * bflo(a.y) + w1 * bflo(bq.y) + w2 * bflo(c.y)) * bflo(gt.y), (w0 * bfhi(a.y) + w1 * bfhi(bq.y) + w2 * bfhi(c.y)) * bfhi(gt.y));
        o.z = pk2((w0 * bflo(a.z) + w1 * bflo(bq.z) + w2 * bflo(c.z)) * bflo(gt.z), (w0 * bfhi(a.z) + w1 * bfhi(bq.z) + w2 * bfhi(c.z)) * bfhi(gt.z));
        o.w = pk2((w0 * bflo(a.w) + w1 * bflo(bq.w) + w2 * bflo(c.w)) * bflo(gt.w), (w0 * bfhi(a.w) + w1 * bfhi(bq.w) + w2 * bfhi(c.w)) * bfhi(gt.w));
        *(v4u*)(F.out + (size_t)m * OROW + OS_YB + (hh * 128 + d0) * 2) = o;
    }
}

#ifdef PROBE_TA
#define STAMP(k) do { if ((k) == PROBE_TA) pt_a = __builtin_amdgcn_s_memtime(); if ((k) == PROBE_TB) pt_sel += __builtin_amdgcn_s_memtime() - pt_a; } while (0)
#else
#define STAMP(k) do { } while (0)
#endif
#ifndef REP_S0
#define REP_S0 1
#define REP_S12 1
#define REP_S3 1
#define REP_S45 1
#endif
typedef float f32x4r __attribute__((ext_vector_type(4)));
constexpr int RS = 144, RM = 64 * RS;
constexpr int R_AT = 0 * RM, R_RT = 1 * RM, R_BW = 2 * RM, R_KU = 3 * RM, R_BT = 4 * RM, R_KT = 5 * RM, R_VT = 6 * RM, R_AAB = 7 * RM, R_AAK = 8 * RM, R_ARB = 9 * RM, R_ARK = 10 * RM, R_HT = 11 * RM;
constexpr int R_W2T = 12 * RM, R_A2T = 13 * RM;
constexpr int R_XK = R_BW, R_XW = R_AT, R_XA = R_RT, R_XR = R_BW, R_XV = R_KU, R_TW = R_VT;
constexpr int R_WLF = R_AT, R_ALF = R_BT, FS = 272;
constexpr int R_TI = 132096, TIS = 48, R_PC = R_TI + 3072, R_BLK = R_PC + 256, R_AD = R_BLK + 2048;
__device__ __forceinline__ bf16x8 ldfrag(LAS unsigned char* lds, int mat, int row0, int k0, int r, int g) { return *(const LAS bf16x8*)(lds + mat + (row0 + r) * RS + (k0 + 8 * g) * 2); }
__device__ __forceinline__ void storeT(LAS unsigned char* lds, int mat, const f32x4r& d, int row0, int col0, int r, int g) {
    v2u w; w.x = cvtpk(d[0], d[1]); w.y = cvtpk(d[2], d[3]); *(LAS v2u*)(lds + mat + (col0 + r) * RS + (row0 + 4 * g) * 2) = w; }
__device__ __forceinline__ bf16x8 pack2(const f32x4r& a, const f32x4r& b) { v4u t; t.x = cvtpk(a[0], a[1]); t.y = cvtpk(a[2], a[3]); t.z = cvtpk(b[0], b[1]); t.w = cvtpk(b[2], b[3]); return __builtin_bit_cast(bf16x8, t); }
__device__ __forceinline__ bf16x8 pack1(const f32x4r& a) { v4u t; t.x = cvtpk(a[0], a[1]); t.y = cvtpk(a[2], a[3]); t.z = 0u; t.w = 0u; return __builtin_bit_cast(bf16x8, t); }
__device__ __forceinline__ bf16x8 ld2x4(LAS unsigned char* lds, int off0, int off1) { const v2u a = *(const LAS v2u*)(lds + off0), b = *(const LAS v2u*)(lds + off1); v4u t; t.x = a.x; t.y = a.y; t.z = b.x; t.w = b.y; return __builtin_bit_cast(bf16x8, t); }
#define MF16(a, b, c) __builtin_amdgcn_mfma_f32_16x16x32_bf16((a), (b), (c), 0, 0, 0)
#define WGBAR() do { asm volatile("s_waitcnt lgkmcnt(0)" ::: "memory"); __builtin_amdgcn_s_barrier(); asm volatile("" ::: "memory"); } while (0)
template <int CTRL> __device__ __forceinline__ float dppf(float x) { return __builtin_bit_cast(float, __builtin_amdgcn_update_dpp(0, __builtin_bit_cast(int, x), CTRL, 0xF, 0xF, true)); }
__device__ __forceinline__ float row16_sum(float v) { v += dppf<0xB1>(v); v += dppf<0x4E>(v); v += dppf<0x141>(v); v += dppf<0x140>(v); return v; }
__device__ __forceinline__ float wave_sum_dpp(float v) { v = row16_sum(v);
    return (__builtin_bit_cast(float, __builtin_amdgcn_readlane(__builtin_bit_cast(int, v), 0)) + __builtin_bit_cast(float, __builtin_amdgcn_readlane(__builtin_bit_cast(int, v), 16)))
         + (__builtin_bit_cast(float, __builtin_amdgcn_readlane(__builtin_bit_cast(int, v), 32)) + __builtin_bit_cast(float, __builtin_amdgcn_readlane(__builtin_bit_cast(int, v), 48))); }
template <bool RSQ = false> __device__ __forceinline__ void reduce8(const float (&v)[8], float (&s)[8], float& v0, float& v1, int lane) {
    const bool b0 = lane & 1, b1 = lane & 2; float r1[4], r2[2];
#pragma unroll
    for (int i = 0; i < 4; ++i) { const float keep = b0 ? v[2 * i + 1] : v[2 * i], send = b0 ? v[2 * i] : v[2 * i + 1]; r1[i] = keep + dppf<0xB1>(send); }
#pragma unroll
    for (int i = 0; i < 2; ++i) { const float keep = b1 ? r1[2 * i + 1] : r1[2 * i], send = b1 ? r1[2 * i] : r1[2 * i + 1]; r2[i] = keep + dppf<0x4E>(send); }
#pragma unroll
    for (int i = 0; i < 2; ++i) { float x = r2[i]; x += dppf<0x124>(x); x += dppf<0x128>(x);
        x += __builtin_bit_cast(float, __builtin_amdgcn_ds_swizzle(__builtin_bit_cast(int, x), 0x401F));
        x += __shfl_xor(x, 32);
        r2[i] = x; }
    if (RSQ) { r2[0] = __builtin_amdgcn_rsqf(fmaxf(r2[0], 1e-24f)); r2[1] = __builtin_amdgcn_rsqf(fmaxf(r2[1], 1e-24f)); }
    v0 = r2[0]; v1 = r2[1];
#pragma unroll
    for (int q = 0; q < 8; ++q) s[q] = __builtin_bit_cast(float, __builtin_amdgcn_readlane(__builtin_bit_cast(int, r2[q >> 2]), q & 3));
}
typedef float f2v __attribute__((ext_vector_type(2)));
__device__ __forceinline__ f2v exp2v(f2v x) { return (f2v){__builtin_amdgcn_exp2f(x.x), __builtin_amdgcn_exp2f(x.y)}; }
__device__ __forceinline__ f2v rcpv(f2v x) { return (f2v){__builtin_amdgcn_rcpf(x.x), __builtin_amdgcn_rcpf(x.y)}; }
__device__ __forceinline__ unsigned cvtpk2(f2v v) { bf16x2_t b = __builtin_convertvector(v, bf16x2_t); return __builtin_bit_cast(unsigned, b); }
__device__ __forceinline__ float fast_tanh(float x) { const float e = __expf(2.f * x); return 1.f - 2.f * __builtin_amdgcn_rcpf(e + 1.f); }
template <bool RV> __device__ __forceinline__ void rwkv_load_rows(__amdgpu_buffer_rsrc_t rsrc, int b, int d, int c, int w, unsigned o_r, unsigned o_w, unsigned (&x0)[10], unsigned (&x1)[10], unsigned (&x2)[10]) {
    const int s0 = c * 64 + 8 * w - 1;
#pragma unroll
    for (int k = 0; k < 10; ++k) { const int s = s0 + k; int tk = d ? T - 1 - s : s; tk = tk < 0 ? 0 : (tk > T - 1 ? T - 1 : tk);
        const int so = __builtin_amdgcn_readfirstlane((b * T + tk) * (A_COLS * 2));
        if (RV) { x0[k] = __builtin_amdgcn_raw_buffer_load_b32(rsrc, o_r, so, 0); x1[k] = __builtin_amdgcn_raw_buffer_load_b32(rsrc, o_r + 2 * A_W * 2, so, 0); }
        else { x0[k] = __builtin_amdgcn_raw_buffer_load_b32(rsrc, o_r + A_W * 2, so, 0); x1[k] = __builtin_amdgcn_raw_buffer_load_b32(rsrc, o_w, so, 0); x2[k] = __builtin_amdgcn_raw_buffer_load_b32(rsrc, o_w + 2 * RANK * 2, so, 0); } }
}
__device__ __forceinline__ bf16x8 ldfragT(LAS unsigned char* lds, int mat, int m0, int k0, int lane) {
    const int i16 = lane & 15, g = lane >> 4, q = i16 >> 2, pq = i16 & 3; const int off = mat + (k0 + 8 * g + q) * RS + (m0 + 4 * pq) * 2;
    const v4i16_t lo = __builtin_amdgcn_ds_read_tr16_b64_v4i16((LAS v4i16_t*)(lds + off)), hi = __builtin_amdgcn_ds_read_tr16_b64_v4i16((LAS v4i16_t*)(lds + off + 4 * RS));
    return (bf16x8){lo[0], lo[1], lo[2], lo[3], hi[0], hi[1], hi[2], hi[3]};
}
__device__ __forceinline__ void rwkv_chunked(Frame& F, const int chain) {
    if (chain >= 2 * NB * A_HEADS) return;
    const int d = chain / (NB * A_HEADS), rem = chain % (NB * A_HEADS), b = rem >> 3, hd = rem & 7;
    const bf16* pa = (const bf16*)(F.ws + WS_PA); bf16* ybuf = (bf16*)(F.ws + WS_Y) + (size_t)d * M * A_W; float* bon = (float*)(F.ws + WS_BON) + (size_t)d * M * 8;
    const int ko = kopaque(); const float *w2_ = kin(I_W2, ko), *a2_ = kin(I_A2, ko), *mu_ = kin(I_MU, ko), *w0_ = kin(I_W0, ko), *a0_ = kin(I_A0, ko), *kk_ = kin(I_KK, ko), *ka_ = kin(I_KA, ko), *rk_ = kin(I_RK, ko);
    LAS unsigned char* L = F.lds;
    int lane = lane_id(); asm volatile("" : "+v"(lane));
    const int w = F.wave, j = lane, ch = hd * 64 + j;
    int r, g;
#define RELANE() do { int ln_ = lane; asm volatile("" : "+v"(ln_)); r = ln_ & 15; g = ln_ >> 4; } while (0)
    for (int i = (F.wave * 64 + lane_id()); i < 4096; i += NWAVES * 64) { const int jo = i >> 6, jr = i & 63;
        *(LAS bf16*)(L + R_W2T + jo * RS + jr * 2) = (bf16)f2bf(w2_[((size_t)d * RANK + jr) * A_W + hd * 64 + jo]);
        *(LAS bf16*)(L + R_A2T + jo * RS + jr * 2) = (bf16)f2bf(a2_[((size_t)d * RANK + jr) * A_W + hd * 64 + jo]); }
    for (int i = (F.wave * 64 + lane_id()); i < 5 * RM / 4; i += NWAVES * 64) ((LAS unsigned*)(L + R_AAB))[i] = 0u;
    const int cr = ch, ck = A_W + ch, cv = 2 * A_W + ch, cw = 4 * A_W + d * RANK + j, ca = 4 * A_W + 2 * RANK + d * RANK + j;
    const float mr0 = mu_[cr], mr1 = mu_[A_COLS + cr], mk0 = mu_[ck], mk1 = mu_[A_COLS + ck], mv0 = mu_[cv], mv1 = mu_[A_COLS + cv];
    const float mw0 = mu_[cw], mw1 = mu_[A_COLS + cw], ma0 = mu_[ca], ma1 = mu_[A_COLS + ca];
    const __amdgpu_buffer_rsrc_t rsrc = __builtin_amdgcn_make_buffer_rsrc((void*)pa, 0, M * A_COLS * 2, 0x00020000);
#define O_R ((unsigned)(((hd * 64 + lnow_) * 2) & ~3))
#define O_W ((unsigned)(((4 * A_W + d * RANK + lnow_) * 2) & ~3))
#define PSEL ((lnow_ & 1) ? 0x07060c0cu : 0x05040c0cu)
    const float sr0 = d ? mr1 : mr0, sr1 = d ? mr0 : mr1, sk0 = d ? mk1 : mk0, sk1 = d ? mk0 : mk1, sv0 = d ? mv1 : mv0, sv1 = d ? mv0 : mv1, sw0 = d ? mw1 : mw0, sw1 = d ? mw0 : mw1, sa0 = d ? ma1 : ma0, sa1 = d ? ma0 : ma1;
    const float w0j = w0_[d * A_W + ch], a0j = a0_[d * A_W + ch], kkj = kk_[ch], kaj = ka_[ch], rkj = rk_[ch];
    const int vt = w & 3;
    f32x4r Hs[4];
#pragma unroll
    for (int i = 0; i < 4; ++i) Hs[i] = (f32x4r){0.f, 0.f, 0.f, 0.f};
    v4u qk, qw, qa, qr, qv; unsigned hk = 0u, hw = 0u, ha = 0u, hr = 0u, hv = 0u;
    const int sob = __builtin_amdgcn_readfirstlane(b * T * (A_COLS * 2));
#define RAW_ISSUE(cn) do { int ln_ = lane; asm volatile("" : "+v"(ln_)); \
        const int s_ = (cn) * 64 + 8 * w + (ln_ >> 3), tk_ = d ? T - 1 - s_ : s_; \
        const unsigned vr_ = (unsigned)tk_ * (A_COLS * 2) + hd * 128 + 16 * (ln_ & 7), vw_ = (unsigned)tk_ * (A_COLS * 2) + (4 * A_W + d * RANK) * 2 + 16 * (ln_ & 7); \
        qk = __builtin_bit_cast(v4u, __builtin_amdgcn_raw_buffer_load_b128(rsrc, vr_ + A_W * 2, sob, 0)); qw = __builtin_bit_cast(v4u, __builtin_amdgcn_raw_buffer_load_b128(rsrc, vw_, sob, 0)); \
        qa = __builtin_bit_cast(v4u, __builtin_amdgcn_raw_buffer_load_b128(rsrc, vw_ + 2 * RANK * 2, sob, 0)); \
        qr = __builtin_bit_cast(v4u, __builtin_amdgcn_raw_buffer_load_b128(rsrc, vr_, sob, 0)); qv = __builtin_bit_cast(v4u, __builtin_amdgcn_raw_buffer_load_b128(rsrc, vr_ + 2 * A_W * 2, sob, 0)); \
        if (w == 7) { const int sh_ = (cn) * 64 + ((ln_ >> 5) ? 64 : -1); int th_ = d ? T - 1 - sh_ : sh_; th_ = th_ < 0 ? 0 : (th_ > T - 1 ? T - 1 : th_); \
            const unsigned hr_ = (unsigned)th_ * (A_COLS * 2) + hd * 128 + 4 * (ln_ & 31), hw_ = (unsigned)th_ * (A_COLS * 2) + (4 * A_W + d * RANK) * 2 + 4 * (ln_ & 31); \
            hk = __builtin_amdgcn_raw_buffer_load_b32(rsrc, hr_ + A_W * 2, sob, 0); hw = __builtin_amdgcn_raw_buffer_load_b32(rsrc, hw_, sob, 0); ha = __builtin_amdgcn_raw_buffer_load_b32(rsrc, hw_ + 2 * RANK * 2, sob, 0); \
            hr = __builtin_amdgcn_raw_buffer_load_b32(rsrc, hr_, sob, 0); hv = __builtin_amdgcn_raw_buffer_load_b32(rsrc, hr_ + 2 * A_W * 2, sob, 0); } } while (0)
#define RAW_PUT(cn, m0_, q0_, h0_, m1_, q1_, h1_) do { int ln_ = lane; asm volatile("" : "+v"(ln_)); const int o_ = 128 + 1024 * w + 16 * ln_; \
        *(LAS v4u*)(L + (m0_) + o_) = (q0_); *(LAS v4u*)(L + (m1_) + o_) = (q1_); \
        if (w == 7) { const int sh_ = (cn) * 64 + ((ln_ >> 5) ? 64 : -1); const bool okh_ = sh_ >= 0 && sh_ < T; const int ho_ = ((ln_ >> 5) ? 65 * 128 : 0) + 4 * (ln_ & 31); \
            *(LAS unsigned*)(L + (m0_) + ho_) = okh_ ? (h0_) : 0u; *(LAS unsigned*)(L + (m1_) + ho_) = okh_ ? (h1_) : 0u; } } while (0)
#define RAW_PUT1(cn, m0_, q0_, h0_) do { int ln_ = lane; asm volatile("" : "+v"(ln_)); const int o_ = 128 + 1024 * w + 16 * ln_; \
        *(LAS v4u*)(L + (m0_) + o_) = (q0_); \
        if (w == 7) { const int sh_ = (cn) * 64 + ((ln_ >> 5) ? 64 : -1); const bool okh_ = sh_ >= 0 && sh_ < T; const int ho_ = ((ln_ >> 5) ? 65 * 128 : 0) + 4 * (ln_ & 31); \
            *(LAS unsigned*)(L + (m0_) + ho_) = okh_ ? (h0_) : 0u; } } while (0)
    RAW_ISSUE(0);
    RAW_PUT(0, R_XW, qw, hw, R_XA, qa, ha); RAW_PUT1(0, R_XK, qk, hk);
    WGBAR();
#ifdef PROBE_TA
    unsigned long long pt_a = 0, pt_sel = 0; const unsigned long long pt_t0 = __builtin_amdgcn_s_memtime();
#endif
    for (int c = 0; c < T / 64; ++c) {
        STAMP(0);
        f2v ks2[4], kn2[4];
        for (int rep0_ = 0; rep0_ < REP_S0; ++rep0_) {
        int lnow_ = lane; asm volatile("" : "+v"(lnow_)); const unsigned psel = PSEL;
#define XF(x, k) __builtin_bit_cast(float, __builtin_amdgcn_perm(*(const LAS unsigned*)(L + (x) + (8 * w + (k)) * 128 + (lnow_ >> 1) * 4), 0u, psel))
#define SH2(dst, x, m0, m1) do { float xf_[10]; _Pragma("unroll") for (int k_ = 0; k_ < 10; ++k_) xf_[k_] = XF(x, k_); const float mc_ = 1.f - (m0) - (m1); \
        _Pragma("unroll") for (int q2_ = 0; q2_ < 4; ++q2_) (dst)[q2_] = (f2v){xf_[2 * q2_ + 1], xf_[2 * q2_ + 2]} * mc_ + (f2v){xf_[2 * q2_], xf_[2 * q2_ + 1]} * (m0) + (f2v){xf_[2 * q2_ + 2], xf_[2 * q2_ + 3]} * (m1); } while (0)
        { unsigned tw_[4], al_[4];
          { f2v ws2[4]; SH2(ws2, R_XW, sw0, sw1);
#pragma unroll
            for (int q2 = 0; q2 < 4; ++q2) { const f2v e2 = exp2v(ws2[q2] * 2.8853900817779268f); tw_[q2] = cvtpk2(1.f - 2.f * rcpv(e2 + 1.f)); } }
          asm volatile("" ::: "memory");
          { f2v as2[4]; SH2(as2, R_XA, sa0, sa1);
#pragma unroll
            for (int q2 = 0; q2 < 4; ++q2) al_[q2] = cvtpk2(as2[q2]); }
          asm volatile("" ::: "memory");
          SH2(ks2, R_XK, sk0, sk1);
#pragma unroll
          for (int q2 = 0; q2 < 4; ++q2) kn2[q2] = ks2[q2] * kkj;
          *(LAS v4u*)(L + R_TW + j * RS + 16 * w) = (v4u){tw_[0], tw_[1], tw_[2], tw_[3]};
          *(LAS v4u*)(L + R_KU + j * RS + 16 * w) = (v4u){al_[0], al_[1], al_[2], al_[3]}; }
        { float sq[8], n2[8], d0_, d1_;
#pragma unroll
          for (int q2 = 0; q2 < 4; ++q2) { const f2v s = kn2[q2] * kn2[q2]; sq[2 * q2] = s.x; sq[2 * q2 + 1] = s.y; }
          reduce8<true>(sq, n2, d0_, d1_, lane);
#pragma unroll
          for (int q2 = 0; q2 < 4; ++q2) kn2[q2] *= (f2v){n2[2 * q2], n2[2 * q2 + 1]}; }
        WGBAR();
        STAMP(1);
        RELANE();
        { const int it = w >> 1;
          bf16x8 ta[2], aa[2];
#pragma unroll
          for (int k2 = 0; k2 < 2; ++k2) { ta[k2] = ldfragT(L, R_TW, 16 * it, 32 * k2, lane); aa[k2] = ldfragT(L, R_KU, 16 * it, 32 * k2, lane); }
#pragma unroll
          for (int j2 = 0; j2 < 2; ++j2) { const int jt = 2 * (w & 1) + j2; f32x4r dw = (f32x4r){0.f, 0.f, 0.f, 0.f}, da = dw;
#pragma unroll
              for (int k2 = 0; k2 < 2; ++k2) { dw = MF16(ta[k2], ldfrag(L, R_W2T, 16 * jt, 32 * k2, r, g), dw); da = MF16(aa[k2], ldfrag(L, R_A2T, 16 * jt, 32 * k2, r, g), da); }
#pragma unroll
              for (int e = 0; e < 4; ++e) { *(LAS float*)(L + R_WLF + (16 * it + 4 * g + e) * FS + (16 * jt + r) * 4) = dw[e]; *(LAS float*)(L + R_ALF + (16 * it + 4 * g + e) * FS + (16 * jt + r) * 4) = da[e]; } } }
        WGBAR();
        STAMP(2);
        f2v av2[4]; float cp[8]; float run = 1.f;
#pragma unroll
        for (int q2 = 0; q2 < 4; ++q2) { const int i0 = 8 * w + 2 * q2;
            const f2v wl = (f2v){*(const LAS float*)(L + R_WLF + i0 * FS + j * 4), *(const LAS float*)(L + R_WLF + (i0 + 1) * FS + j * 4)} + w0j;
            const f2v al = (f2v){*(const LAS float*)(L + R_ALF + i0 * FS + j * 4), *(const LAS float*)(L + R_ALF + (i0 + 1) * FS + j * 4)} + a0j;
            const f2v dec = exp2v(rcpv(exp2v(wl * -1.4426950408889634f) + 1.f) * (-0.6065306597126334f * 1.4426950408889634f));
            av2[q2] = rcpv(exp2v(al * -1.4426950408889634f) + 1.f);
            run *= dec.x; cp[2 * q2] = run; run *= dec.y; cp[2 * q2 + 1] = run; }
        *(LAS float*)(L + R_BLK + (w * 64 + j) * 4) = run;
        RAW_PUT(c, R_XR, qr, hr, R_XV, qv, hv);
        WGBAR();
        STAMP(3);
        { float off = 1.f; float bt_[8];
#pragma unroll
          for (int w2 = 0; w2 < 8; ++w2) bt_[w2] = *(const LAS float*)(L + R_BLK + (w2 * 64 + j) * 4);
#define OFFSTEP(k) if (w > (k)) { asm volatile("" : "+v"(off)); off *= bt_[k];
          OFFSTEP(0) OFFSTEP(1) OFFSTEP(2) OFFSTEP(3) OFFSTEP(4) OFFSTEP(5) OFFSTEP(6) } } } } } } }
#undef OFFSTEP
          if (w == 0) { asm volatile("" : "+v"(off)); *(LAS float*)(L + R_PC + j * 4) = ((bt_[0] * bt_[1]) * (bt_[2] * bt_[3])) * ((bt_[4] * bt_[5]) * (bt_[6] * bt_[7])); }
          f2v rs2[4], vs2[4], kd2[4]; SH2(rs2, R_XR, sr0, sr1); SH2(vs2, R_XV, sv0, sv1);
          asm volatile("" :: "v"(rs2[0]), "v"(rs2[1]), "v"(rs2[2]), "v"(rs2[3]), "v"(vs2[0]), "v"(vs2[1]), "v"(vs2[2]), "v"(vs2[3]) : "memory");
          { float bp[8], bs[8], b0_, b1_;
#pragma unroll
            for (int q2 = 0; q2 < 4; ++q2) { kd2[q2] = ks2[q2] * (av2[q2] * kaj + (1.f - kaj)); const f2v t = rs2[q2] * kd2[q2] * rkj; bp[2 * q2] = t.x; bp[2 * q2 + 1] = t.y; }
            reduce8(bp, bs, b0_, b1_, lane);
            if (lane < 4) { const int sb_ = c * 64 + 8 * w;
                float* q0_ = bon + (size_t)(b * T + (d ? T - 1 - sb_ - 3 : sb_)) * 8 + hd; float* q1_ = bon + (size_t)(b * T + (d ? T - 1 - sb_ - 7 : sb_ + 4)) * 8 + hd;
                const unsigned lo_ = (unsigned)(d ? 3 - lane : lane) * 8u; q0_[lo_] = b0_; q1_[lo_] = b1_; } }
          unsigned pa_[4], pr_[4], pb_[4], pk_[4], pv_[4];
#pragma unroll
          for (int q2 = 0; q2 < 4; ++q2) { const int qa = 2 * q2;
              const f2v pt = (f2v){cp[qa], cp[qa + 1]} * off; const f2v pm = (f2v){(qa == 0) ? off : off * cp[qa > 0 ? qa - 1 : 0], pt.x}; const f2v em = rcpv(pt);
              pa_[q2] = cvtpk2(-kn2[q2] * pm); pr_[q2] = cvtpk2(rs2[q2] * pt); pb_[q2] = cvtpk2(kn2[q2] * av2[q2] * em); pk_[q2] = cvtpk2(kd2[q2] * em); pv_[q2] = cvtpk2(vs2[q2]); }
          *(LAS v4u*)(L + R_AT + j * RS + 16 * w) = (v4u){pa_[0], pa_[1], pa_[2], pa_[3]};
          *(LAS v4u*)(L + R_RT + j * RS + 16 * w) = (v4u){pr_[0], pr_[1], pr_[2], pr_[3]};
          *(LAS v4u*)(L + R_BT + j * RS + 16 * w) = (v4u){pb_[0], pb_[1], pb_[2], pb_[3]};
          *(LAS v4u*)(L + R_KT + j * RS + 16 * w) = (v4u){pk_[0], pk_[1], pk_[2], pk_[3]};
          *(LAS v4u*)(L + R_VT + j * RS + 16 * w) = (v4u){pv_[0], pv_[1], pv_[2], pv_[3]}; }
        WGBAR();
#undef SH2
#undef XF
        }
        STAMP(4);
        if (c + 1 < T / 64) RAW_ISSUE(c + 1);
        STAMP(5);
        RELANE();
        f32x4r A0[4], KV[4];
#define tc(i) KV[(i) >> 2][(i) & 3]
        for (int rep1_ = 0; rep1_ < REP_S12; ++rep1_) {
        if (w == 0) {
#pragma unroll
            for (int i = 0; i < 4; ++i) { f32x4r dd = (f32x4r){0.f, 0.f, 0.f, 0.f};
#pragma unroll
                for (int k2 = 0; k2 < 2; ++k2) dd = MF16(ldfragT(L, R_BT, 16 * i, 32 * k2, lane), ldfragT(L, R_AT, 16 * i, 32 * k2, lane), dd);
#pragma unroll
                for (int e = 0; e < 4; ++e) if (4 * g + e >= r) dd[e] = 0.f;
                storeT(L, R_AAB, dd, 16 * i, 16 * i, r, g);
                *(LAS f32x4r*)(L + R_AD + i * 1024 + r * 64 + 16 * g) = dd; }
            asm volatile("s_waitcnt lgkmcnt(0)" ::: "memory");
            const int blk = lane >> 4, cc = lane & 15;
#pragma unroll
            for (int rr = 0; rr < 8; ++rr) { f2v ac2 = (f2v){(rr == cc) ? 1.f : 0.f, 0.f};
#pragma unroll
                for (int s4 = 0; s4 < (rr + 3) / 4; ++s4) { const f32x4r a4 = *(const LAS f32x4r*)(L + R_AD + blk * 1024 + rr * 64 + s4 * 16);
#pragma unroll
                    for (int e = 0; e < 4; e += 2) { const int s_ = 4 * s4 + e;
                        if (s_ + 1 < rr) ac2 += (f2v){a4[e], a4[e + 1]} * (f2v){tc(s_), tc(s_ + 1)};
                        else if (s_ < rr) ac2.x += a4[e] * tc(s_); } }
                const float acc = ac2.x + ac2.y;
                tc(rr) = acc; *(LAS bf16*)(L + R_TI + (16 * blk + rr) * TIS + cc * 2) = (bf16)f2bf(acc); }
        } else {
#define S1TILE(fa_, fb_, mat_, ts_, tt_, DIAG, INCL) { f32x4r dd = (f32x4r){0.f, 0.f, 0.f, 0.f}; \
                _Pragma("unroll") for (int k2 = 0; k2 < 2; ++k2) dd = MF16(fa_[k2], fb_[k2], dd); \
                if (DIAG) { _Pragma("unroll") for (int e = 0; e < 4; ++e) { const int sl = 4 * g + e; if ((INCL) ? (sl > r) : (sl >= r)) dd[e] = 0.f; } } \
                storeT(L, mat_, dd, 16 * (ts_), 16 * (tt_), r, g); }
            if (w < 7) {
                const int p = w - 1, ts = (0x211000 >> (4 * p)) & 15, tt = (0x332321 >> (4 * p)) & 15;
                bf16x8 fB[2], fK[2], fA[2], fR[2], fX[2];
#pragma unroll
                for (int k2 = 0; k2 < 2; ++k2) { fB[k2] = ldfragT(L, R_BT, 16 * ts, 32 * k2, lane); fK[k2] = ldfragT(L, R_KT, 16 * ts, 32 * k2, lane); fA[k2] = ldfragT(L, R_AT, 16 * tt, 32 * k2, lane); fR[k2] = ldfragT(L, R_RT, 16 * tt, 32 * k2, lane); }
                const int xm_ = (w == 6) ? R_RT : ((w == 2 || w == 3) ? R_KT : R_BT), xr_ = (w == 6) ? ts : tt;
#pragma unroll
                for (int k2 = 0; k2 < 2; ++k2) fX[k2] = ldfragT(L, xm_, 16 * xr_, 32 * k2, lane);
                S1TILE(fB, fA, R_AAB, ts, tt, false, false) S1TILE(fK, fA, R_AAK, ts, tt, false, false) S1TILE(fB, fR, R_ARB, ts, tt, false, true) S1TILE(fK, fR, R_ARK, ts, tt, false, true)
                if (w == 6) S1TILE(fK, fX, R_ARK, ts, ts, true, true)
                else if (w == 2 || w == 3) { S1TILE(fX, fA, R_AAK, tt, tt, true, false) if (w == 3) S1TILE(fX, fR, R_ARK, tt, tt, true, true) }
                else S1TILE(fX, fR, R_ARB, tt, tt, true, true)
            } else {
                bf16x8 fK0[2], fA0[2], fB0[2], fR0[2], fK1[2], fA1[2], fR1[2];
#pragma unroll
                for (int k2 = 0; k2 < 2; ++k2) { fK0[k2] = ldfragT(L, R_KT, 0, 32 * k2, lane); fA0[k2] = ldfragT(L, R_AT, 0, 32 * k2, lane); fB0[k2] = ldfragT(L, R_BT, 0, 32 * k2, lane); fR0[k2] = ldfragT(L, R_RT, 0, 32 * k2, lane);
                    fK1[k2] = ldfragT(L, R_KT, 16, 32 * k2, lane); fA1[k2] = ldfragT(L, R_AT, 16, 32 * k2, lane); fR1[k2] = ldfragT(L, R_RT, 16, 32 * k2, lane); }
                S1TILE(fK0, fA0, R_AAK, 0, 0, true, false) S1TILE(fB0, fR0, R_ARB, 0, 0, true, true) S1TILE(fK0, fR0, R_ARK, 0, 0, true, true)
                S1TILE(fK1, fA1, R_AAK, 1, 1, true, false) S1TILE(fK1, fR1, R_ARK, 1, 1, true, true)
            }
#undef S1TILE
        }
        WGBAR();
        STAMP(6);
        RELANE();
        if (w == 0) {
            const int blk = lane >> 4, cc = lane & 15;
#pragma unroll
            for (int rr = 8; rr < 16; ++rr) { f2v ac2 = (f2v){(rr == cc) ? 1.f : 0.f, 0.f};
#pragma unroll
                for (int s4 = 0; s4 < (rr + 3) / 4; ++s4) { const f32x4r a4 = *(const LAS f32x4r*)(L + R_AD + blk * 1024 + rr * 64 + s4 * 16);
#pragma unroll
                    for (int e = 0; e < 4; e += 2) { const int s_ = 4 * s4 + e;
                        if (s_ + 1 < rr) ac2 += (f2v){a4[e], a4[e + 1]} * (f2v){tc(s_), tc(s_ + 1)};
                        else if (s_ < rr) ac2.x += a4[e] * tc(s_); } }
                const float acc = ac2.x + ac2.y;
                tc(rr) = acc; *(LAS bf16*)(L + R_TI + (16 * blk + rr) * TIS + cc * 2) = (bf16)f2bf(acc); }
        } else if (w < 4) {
#pragma unroll
            for (int i = 0; i < 4; ++i) { A0[i] = (f32x4r){0.f, 0.f, 0.f, 0.f};
#pragma unroll
                for (int k2 = 0; k2 < 2; ++k2) A0[i] = MF16(ldfrag(L, R_VT, 16 * vt, 32 * k2, r, g), ldfrag(L, R_ARK, 16 * i, 32 * k2, r, g), A0[i]); }
            { int ln3_ = lane; asm volatile("" : "+v"(ln3_));
#pragma unroll
              for (int i = 0; i < 4; ++i)
#pragma unroll
                for (int k2 = 0; k2 < 2; ++k2) A0[i] = MF16(ldfrag(L, R_HT, 16 * vt, 32 * k2, r, g), ldfragT(L, R_RT, 16 * i, 32 * k2, ln3_), A0[i]); }
        } else {
#pragma unroll
            for (int i = 0; i < 4; ++i) { A0[i] = (f32x4r){0.f, 0.f, 0.f, 0.f}; KV[i] = A0[i];
#pragma unroll
                for (int k2 = 0; k2 < 2; ++k2) { const bf16x8 vf = ldfrag(L, R_VT, 16 * vt, 32 * k2, r, g);
                    A0[i] = MF16(ldfrag(L, R_AAK, 16 * i, 32 * k2, r, g), vf, A0[i]); KV[i] = MF16(ldfrag(L, R_KT, 16 * i, 32 * k2, r, g), vf, KV[i]); } }
            { int ln3_ = lane; asm volatile("" : "+v"(ln3_));
#pragma unroll
              for (int i = 0; i < 4; ++i)
#pragma unroll
                for (int k2 = 0; k2 < 2; ++k2) A0[i] = MF16(ldfragT(L, R_AT, 16 * i, 32 * k2, ln3_), ldfrag(L, R_HT, 16 * vt, 32 * k2, r, g), A0[i]); }
        }
        WGBAR();
        }
        STAMP(7);
        RELANE();
        if (w < 4) {
            if (w == 0) {
#pragma unroll
                for (int i = 0; i < 4; ++i) { A0[i] = (f32x4r){0.f, 0.f, 0.f, 0.f};
#pragma unroll
                    for (int k2 = 0; k2 < 2; ++k2) A0[i] = MF16(ldfrag(L, R_VT, 0, 32 * k2, r, g), ldfrag(L, R_ARK, 16 * i, 32 * k2, r, g), A0[i]); }
#pragma unroll
                for (int i = 0; i < 4; ++i)
#pragma unroll
                    for (int k2 = 0; k2 < 2; ++k2) A0[i] = MF16(ldfrag(L, R_HT, 16 * vt, 32 * k2, r, g), ldfragT(L, R_RT, 16 * i, 32 * k2, lane), A0[i]); }
        } else {
            f32x4r X[4];
#pragma unroll
            for (int i = 0; i < 4; ++i) X[i] = A0[i];
            const f32x4r z4 = (f32x4r){0.f, 0.f, 0.f, 0.f};
#define TIF(i) ld2x4(L, R_TI + (16 * (i) + r) * TIS + 8 * g, R_TI + (16 * (i) + r) * TIS + 8 * g)
#define ABF(i, j0) ld2x4(L, R_AAB + (16 * (i) + r) * RS + (16 * (j0) + 4 * g) * 2, R_AAB + (16 * (i) + r) * RS + (16 * ((j0) + 1) + 4 * g) * 2)
            X[0] = MF16(TIF(0), pack1(X[0]), z4);
            X[1] = MF16(ABF(1, 0), pack1(X[0]), X[1]); X[1] = MF16(TIF(1), pack1(X[1]), z4);
            X[2] = MF16(ABF(2, 0), pack2(X[0], X[1]), X[2]); X[2] = MF16(TIF(2), pack1(X[2]), z4);
            X[3] = MF16(ABF(3, 0), pack2(X[0], X[1]), X[3]); X[3] = MF16(ABF(3, 2), pack1(X[2]), X[3]); X[3] = MF16(TIF(3), pack1(X[3]), z4);
#undef TIF
#undef ABF
#pragma unroll
            for (int i = 0; i < 4; ++i) { A0[i] = X[i]; storeT(L, R_KU, X[i], 16 * i, 16 * vt, r, g); }
        }
        WGBAR();
        STAMP(8);
        STAMP(9);
        RELANE();
        for (int rep4_ = 0; rep4_ < 1; ++rep4_) {
        if (c + 1 < T / 64) { RAW_PUT(c + 1, R_XW, qw, hw, R_XA, qa, ha); RAW_PUT1(c + 1, R_XK, qk, hk); }
        if (w < 4) {
#pragma unroll
            for (int i = 0; i < 4; ++i) {
#pragma unroll
                for (int k2 = 0; k2 < 2; ++k2) A0[i] = MF16(ldfrag(L, R_KU, 16 * vt, 32 * k2, r, g), ldfrag(L, R_ARB, 16 * i, 32 * k2, r, g), A0[i]);
                const int s = c * 64 + 16 * i + r, t = d ? T - 1 - s : s; v2u yw; yw.x = cvtpk(A0[i][0], A0[i][1]); yw.y = cvtpk(A0[i][2], A0[i][3]);
                *(v2u*)(ybuf + (size_t)(b * T + t) * A_W + hd * 64 + 16 * vt + 4 * g) = yw; }
        } else {
#pragma unroll
            for (int i = 0; i < 4; ++i) { f32x4r acc = Hs[i] + KV[i];
#pragma unroll
                for (int k2 = 0; k2 < 2; ++k2) acc = MF16(ldfrag(L, R_BT, 16 * i, 32 * k2, r, g), ldfrag(L, R_KU, 16 * vt, 32 * k2, r, g), acc);
                const f32x4r pc = *(const LAS f32x4r*)(L + R_PC + (16 * i + 4 * g) * 4);
                Hs[i] = acc * pc; storeT(L, R_HT, Hs[i], 16 * i, 16 * vt, r, g); }
        }
        WGBAR();
        }
        STAMP(10);
    }
#ifdef PROBE_TA
    if (blockIdx.x == 0 && (F.wave * 64 + lane_id()) == 0) { float* pf = (float*)(F.ws + WS_CTL + 32768); pf[0] = (float)((double)pt_sel / (double)(__builtin_amdgcn_s_memtime() - pt_t0)); }
#endif
#undef RELANE
#undef RAW_ISSUE
#undef RAW_PUT
#undef RAW_PUT1
#undef tc
#undef O_R
#undef O_W
#undef PSEL
}
__device__ __forceinline__ void rwkv_post(Frame& F) {
    const bf16* pa = (const bf16*)(F.ws + WS_PA); const bf16* y0 = (const bf16*)(F.ws + WS_Y); const bf16* y1 = y0 + (size_t)M * A_W;
    const float* bon0 = (const float*)(F.ws + WS_BON); const float* bon1 = bon0 + (size_t)M * 8;
    const int ko = kopaque(); const float *lnx_w = kin(I_LNW, ko), *lnx_b = kin(I_LNB, ko), *mu_ = kin(I_MU, ko);
    int lane = lane_id(); asm volatile("" : "+v"(lane));
    const int gw = F.vcu * NWAVES + F.wave, NGW = F.G * NWAVES, hd = lane >> 3, c0 = lane * 8;
    float lw_[8], lb_[8], mv0[8], mv1[8], mg0[8], mg1[8];
#pragma unroll
    for (int e = 0; e < 8; ++e) { lw_[e] = lnx_w[c0 + e]; lb_[e] = lnx_b[c0 + e]; mv0[e] = mu_[2 * A_W + c0 + e]; mv1[e] = mu_[A_COLS + 2 * A_W + c0 + e];
        mg0[e] = mu_[3 * A_W + c0 + e]; mg1[e] = mu_[A_COLS + 3 * A_W + c0 + e]; }
    for (int m = gw; m < M; m += NGW) {
        const int t = m & (T - 1); const bool hp = t > 0, hn = t < T - 1;
        const v4u a = *(const v4u*)(y0 + (size_t)m * A_W + c0), bq = *(const v4u*)(y1 + (size_t)m * A_W + c0);
        const bf16* p0 = pa + (size_t)m * A_COLS;
        const v4u vc = *(const v4u*)(p0 + 2 * A_W + c0), gc = *(const v4u*)(p0 + 3 * A_W + c0);
        const v4u z = (v4u){0u, 0u, 0u, 0u};
        const v4u vp = hp ? *(const v4u*)(p0 - A_COLS + 2 * A_W + c0) : z, gp = hp ? *(const v4u*)(p0 - A_COLS + 3 * A_W + c0) : z;
        const v4u vn = hn ? *(const v4u*)(p0 + A_COLS + 2 * A_W + c0) : z, gn = hn ? *(const v4u*)(p0 + A_COLS + 3 * A_W + c0) : z;
        const float bsum = bon0[(size_t)m * 8 + hd] + bon1[(size_t)m * 8 + hd];
        float y[8]; const unsigned aw[4] = {a.x, a.y, a.z, a.w}, bw[4] = {bq.x, bq.y, bq.z, bq.w};
        float s1 = 0.f;
#pragma unroll
        for (int e = 0; e < 4; ++e) { y[2 * e] = bflo(aw[e]) + bflo(bw[e]); y[2 * e + 1] = bfhi(aw[e]) + bfhi(bw[e]); s1 += y[2 * e] + y[2 * e + 1]; }
        s1 += dppf<0xB1>(s1); s1 += dppf<0x4E>(s1); s1 += dppf<0x141>(s1);
        const float mean = s1 * (1.f / 64.f); float s2 = 0.f;
#pragma unroll
        for (int e = 0; e < 8; ++e) { y[e] -= mean; s2 += y[e] * y[e]; }
        s2 += dppf<0xB1>(s2); s2 += dppf<0x4E>(s2); s2 += dppf<0x141>(s2);
        const float rstd = __builtin_amdgcn_rsqf(s2 * (1.f / 64.f) + GN_EPS);
        const unsigned vcw[4] = {vc.x, vc.y, vc.z, vc.w}, vpw[4] = {vp.x, vp.y, vp.z, vp.w}, vnw[4] = {vn.x, vn.y, vn.z, vn.w}, gcw[4] = {gc.x, gc.y, gc.z, gc.w}, gpw[4] = {gp.x, gp.y, gp.z, gp.w}, gnw[4] = {gn.x, gn.y, gn.z, gn.w};
        float o[8];
#pragma unroll
        for (int e = 0; e < 8; ++e) { const int k = e >> 1; const bool hi = e & 1;
            const float v0 = hi ? bfhi(vcw[k]) : bflo(vcw[k]), vm = hi ? bfhi(vpw[k]) : bflo(vpw[k]), vx = hi ? bfhi(vnw[k]) : bflo(vnw[k]);
            const float g0 = hi ? bfhi(gcw[k]) : bflo(gcw[k]), gm = hi ? bfhi(gpw[k]) : bflo(gpw[k]), gx = hi ? bfhi(gnw[k]) : bflo(gnw[k]);
            const float vs = v0 * (1.f - mv0[e] - mv1[e]) + mv0[e] * vm + mv1[e] * vx, gs = g0 * (1.f - mg0[e] - mg1[e]) + mg0[e] * gm + mg1[e] * gx;
            o[e] = (y[e] * rstd * lw_[e] + lb_[e] + bsum * vs) * siluf_(gs); }
        v4u ov; ov.x = cvtpk(o[0], o[1]); ov.y = cvtpk(o[2], o[3]); ov.z = cvtpk(o[4], o[5]); ov.w = cvtpk(o[6], o[7]);
        *(v4u*)(F.out + (size_t)m * OROW + OS_YA + c0 * 2) = ov;
    }
}
struct Args { const float* in[24]; unsigned char* out; unsigned char* ws; };
__global__ void __launch_bounds__(NWAVES * 64, 2) hybrid_fwd(Args args) {
    extern __shared__ __attribute__((aligned(16))) unsigned char lds[];
    Frame F;
    F.lds = (LAS unsigned char*)lds;
    F.MISC = (volatile LAS unsigned*)(F.lds + MISC_OFF);
    F.wave = __builtin_amdgcn_readfirstlane((int)threadIdx.x >> 6);
    F.G = gridDim.x; { const int bx = blockIdx.x; F.vcu = (F.G % 8 == 0) ? (bx % 8) * (F.G / 8) + bx / 8 : bx; }
    F.out = args.out; F.ws = args.ws;
    for (int u = (F.wave * 64 + lane_id()); u < (LDS_BYTES - LDSCTL_OFF) / 4; u += NWAVES * 64) ((LAS unsigned*)(F.lds + LDSCTL_OFF))[u] = 0u;
    __syncthreads();
    XcdBarrier bar = xcd_barrier_post((unsigned*)(F.ws + WS_CTL) + CW_BAR, F.MISC + 8);
#define GRID_BAR() xcd_barrier(bar, F.wave)
#ifdef PROBE_G
#define PGDBG(k) ((k) == PROBE_GSEL ? (float*)(F.ws + WS_CTL + 32768) : (float*)nullptr)
#else
#define PGDBG(k) ((float*)nullptr)
#endif
    typedef pg8::bf16_t bt;
    p0a(F); GRID_BAR();
    p0b(F); GRID_BAR();
    { pg8::Gemm g{(const bt*)(F.out + OS_H), (const bt*)(F.ws + WS_WB), nullptr, nullptr, OROW / 2, D}; pg8::Order S; S.init(M, B_COLS, F.G, (int)blockIdx.x, 1);
      const int ko = kopaque(); pg8::EpiPB E{(bt*)(F.ws + WS_R), kin(I_QG, ko), kin(I_KG, ko), (LAS float*)(F.lds + EPI_OFF), PGDBG(0)};
      pg8::gemm_phase<pg8::EpiPB, pg8::Order, true, true>(F.lds + RING_OFF, g, S, E, F.wave); }
    GRID_BAR();
    attn_mfma(F); GRID_BAR();
    attn_combine(F); GRID_BAR();
    { pg8::Gemm g{(const bt*)(F.out + OS_H), (const bt*)(F.ws + WS_WAG), nullptr, nullptr, OROW / 2, D}; pg8::Order S; S.init(M, 1792, F.G, (int)blockIdx.x, 1);
      pg8::EpiAG E{(bt*)(F.ws + WS_PA), (bt*)(F.ws + WS_PG), PGDBG(1)};
      pg8::gemm_phase<pg8::EpiAG, pg8::Order, true, true>(F.lds + RING_OFF, g, S, E, F.wave); }
    GRID_BAR();
#ifdef PROBE_RT
    const unsigned long long prt0 = __builtin_amdgcn_s_memrealtime();
#endif
    {
        int chain = -1, sG = 0, sc = 0, spm0 = 0, snpm = M / 256; const int bx = (int)blockIdx.x;
        if (F.G == 256) { const int x = bx & 7, q = bx >> 3; if (x < 5) chain = q * 5 + x; else { sG = 32; sc = q; spm0 = (x - 5) * 107; snpm = x < 7 ? 107 : 106; } }
        else if (F.G > NCHAIN) { if (bx < NCHAIN) chain = bx; else { sG = F.G - NCHAIN; sc = bx - NCHAIN; } }
        else { chain = bx; sG = F.G; sc = bx; }
        if (chain >= 0) rwkv_chunked(F, chain);
        if (sG > 0) {
            pg8::Gemm g{(const bt*)(F.out + OS_H), (const bt*)(F.ws + WS_WAG) + (size_t)1792 * D, nullptr, nullptr, OROW / 2, D}; const pg8::SideOrder S{spm0, snpm, sG, sc};
            pg8::EpiPG E{(bt*)(F.ws + WS_PG), (bt*)(F.ws + WS_PA), PGDBG(4)};
            pg8::gemm_phase<pg8::EpiPG, pg8::SideOrder, true, true>(F.lds + RING_OFF, g, S, E, F.wave); } }
#ifdef PROBE_RT
    if (blockIdx.x == 0 && threadIdx.x == 0) ((float*)(F.ws + WS_CTL + 32768))[2] = (float)(__builtin_amdgcn_s_memrealtime() - prt0);
    if (blockIdx.x == PROBE_RT && threadIdx.x == 0) ((float*)(F.ws + WS_CTL + 32768))[3] = (float)(__builtin_amdgcn_s_memrealtime() - prt0);
#endif
    GRID_BAR();
    rwkv_post(F); GRID_BAR();
    { pg8::Gemm g{(const bt*)(F.out + OS_YA), (const bt*)(F.ws + WS_WOA), (const bt*)(F.out + OS_YB), (const bt*)(F.ws + WS_WOB), OROW / 2, A_W}; pg8::Order S; S.init(M, D, F.G, (int)blockIdx.x, 2);
      pg8::EpiMerge E{(const bt*)(F.ws + WS_PG), (bt*)(F.ws + WS_Y), PGDBG(2)};
      pg8::gemm_phase<pg8::EpiMerge, pg8::Order, true, true>(F.lds + RING_OFF, g, S, E, F.wave); }
    GRID_BAR();
    { pg8::Gemm g{(const bt*)(F.ws + WS_Y), (const bt*)(F.ws + WS_WO), nullptr, nullptr, D, D}; pg8::Order S; S.init(M, D, F.G, (int)blockIdx.x, 1);
      const int ko = kopaque(); pg8::EpiOut E{kin(I_XP, ko), kin(I_XS, ko), (const float*)(F.ws + WS_MOD), (float*)F.out, PGDBG(3)};
      pg8::gemm_phase<pg8::EpiOut, pg8::Order, true, true>(F.lds + RING_OFF, g, S, E, F.wave); }
#if defined(PROBE_TA) || defined(PROBE_G) || defined(PROBE_AT) || defined(PROBE_RT)
    GRID_BAR();
#ifdef PROBE_RT
    { const float* pf_ = (const float*)(F.ws + WS_CTL + 32768); const float f = 0.5f * pf_[3] / pf_[2]; float* o = (float*)F.out;
#else
    { const float f = ((const float*)(F.ws + WS_CTL + 32768))[0]; float* o = (float*)F.out;
#endif
      for (int i = blockIdx.x * 512 + (F.wave * 64 + lane_id()); i < 655 * 1024; i += gridDim.x * 512) o[i] *= (1.f + f); }
#endif
}

extern "C" void kernel_launch(void* const* d_in, const int* in_sizes, int n_in, void* d_out, int out_size, void* d_ws, size_t ws_size, hipStream_t stream) {
    static int grid = 0;
    if (grid == 0) {
        if (n_in != 24 || out_size != M * D || ws_size < WS_END) { fprintf(stderr, "kernel_launch: unexpected shapes: n_in %d out %d ws %zu (need %zu)\n", n_in, out_size, ws_size, (size_t)WS_END); grid = -1; return; }
        int dev = 0, cus = 0, per_cu = 0;
        if (hipGetDevice(&dev) != hipSuccess || hipDeviceGetAttribute(&cus, hipDeviceAttributeMultiprocessorCount, dev) != hipSuccess) { grid = -1; return; }
        if (hipFuncSetAttribute((const void*)hybrid_fwd, hipFuncAttributeMaxDynamicSharedMemorySize, LDS_BYTES) != hipSuccess) { fprintf(stderr, "kernel_launch: hipFuncSetAttribute failed\n"); grid = -1; return; }
        if (hipOccupancyMaxActiveBlocksPerMultiprocessor(&per_cu, (const void*)hybrid_fwd, NWAVES * 64, LDS_BYTES) != hipSuccess || per_cu < 1) { fprintf(stderr, "kernel_launch: occupancy query says %d\n", per_cu); }
        (void)hipGetLastError();
        grid = cus;
    }
    if (grid < 0) return;
    if (hipMemsetAsync((char*)d_ws + WS_CTL, 0, CTL_ZERO_BYTES, stream) != hipSuccess) return;
    Args a{};
    for (int i = 0; i < 24; ++i) a.in[i] = (const float*)d_in[i];
    a.out = (unsigned char*)d_out; a.ws = (unsigned char*)d_ws;
    hipLaunchKernelGGL(hybrid_fwd, dim3(grid), dim3(NWAVES * 64), LDS_BYTES, stream, a);
}
```

```cpp
#include <hip/hip_runtime.h>
#include <cstdio>
#include <cstdint>
__device__ __forceinline__ int lane_id() { unsigned m = ~0u; asm volatile("" : "+s"(m) :: "memory"); return (int)__builtin_amdgcn_mbcnt_hi(m, __builtin_amdgcn_mbcnt_lo(m, 0u)); }
namespace pg8 {
#define PG8_LAS __attribute__((address_space(3)))
typedef unsigned short bf16_t;
typedef short bf16x8 __attribute__((ext_vector_type(8)));
typedef float f32x4 __attribute__((ext_vector_type(4)));
typedef unsigned u32x4 __attribute__((ext_vector_type(4)));
constexpr int BM = 256, BK = 64, HALF = 128, HTB = HALF * BK * 2  , STAGE_BYTES = 8 * HTB, NXCD = 8, WGM = 8;

__host__ __device__ __forceinline__ int lds_byte(int r, int c) { const int st = (r >> 4) * 2 + (c >> 5), rr = r & 15, cc = c & 31, ob = rr * 64 + cc * 2; return st * 1024 + (ob ^ (((ob >> 9) & 1) << 5)); }
__host__ __device__ __forceinline__ void stage_rc(int b, int& R, int& C) { const int st = b / 1024, sb = b % 1024, swz = sb ^ (((sb >> 9) & 1) << 5); R = (st >> 1) * 16 + swz / 64; C = (st & 1) * 32 + (swz % 64) / 2; }
__host__ __device__ __forceinline__ int perm32(int rho) { const int n = rho >> 4, i = rho & 15; return 8 * (i >> 2) + 4 * n + (i & 3); }

struct Unit { int pm, pn, sel; };
struct Gemm { const bf16_t* A0; const bf16_t* B0; const bf16_t* A1; const bf16_t* B1; int lda; int K; };

struct Order {
    int nM, nN, nwg, G, c, CH;
    __host__ __device__ void init(int M, int N, int G_, int c_, int CH_) { nM = M / BM; nN = N / BM; nwg = nM * nN; G = G_; c = c_; CH = CH_; }
    __host__ __device__ bool next(int i, Unit& u) const {
        const int ti = (CH == 2) ? (i >> 1) : i; u.sel = (CH == 2) ? (i & 1) : 0;
        const long L = (long)ti * G + c; if (L >= nwg) return false;
        int wgid = (int)L; { const int q = nwg / NXCD, r = nwg % NXCD, xcd = wgid % NXCD, off = wgid / NXCD; wgid = (xcd < r ? xcd * (q + 1) : r * (q + 1) + (xcd - r) * q) + off; }
        const int nig = WGM * nN, gid = wgid / nig, fm = gid * WGM, gsz = (nM - fm) < WGM ? (nM - fm) : WGM;
        u.pm = fm + ((wgid % nig) % gsz); u.pn = (wgid % nig) / gsz; return true;
    }
};
__device__ __forceinline__ unsigned cvt_pk_bf16(float lo, float hi) { unsigned r; asm volatile("v_cvt_pk_bf16_f32 %0, %1, %2" : "=v"(r) : "v"(lo), "v"(hi)); return r; }
template <class Epi, class Sched, bool ALIGN_EPI = false, bool SP2 = false>
__device__ __forceinline__ void gemm_phase(PG8_LAS unsigned char* lds, const Gemm g, const Sched& S, const Epi& E, const int wave_id) {
    int tid = wave_id * 64 + lane_id(); asm volatile("" : "+v"(tid));
    const int wid = wave_id, lane = tid & 63, wr = wid >> 2, wc = wid & 3, fr = lane & 15, fq = lane >> 4;
    const int K = g.K, nt = K / BK;
    unsigned voffA[2], voffB[2];
#pragma unroll
    for (int i = 0; i < 2; ++i) { int R, C; stage_rc(tid * 16 + i * 8192, R, C); const int Rb = Epi::PERM ? ((R & ~31) + perm32(R & 31)) : R;
        voffA[i] = (unsigned)(R * g.lda + C) * 2u; voffB[i] = (unsigned)(Rb * K + C) * 2u; }
    const size_t kstep = (size_t)(BK * 2);
    const size_t hstepA = (size_t)HALF * g.lda * 2, hstepB = (size_t)HALF * K * 2;
    const size_t tstepA = 2 * hstepA, tstepB = 2 * hstepB;
    const unsigned ldsw = (unsigned)wid * 1024u;
    const int aoff = lds_byte(wr * 64 + fr, fq * 8), boff = lds_byte(wc * 32 + fr, fq * 8);
#define PG8_SA(b, h) (((b) * 2 + (h)) * HTB)
#define PG8_SB(b, h) ((4 + (b) * 2 + (h)) * HTB)
#define PG8_STAGE(bufoff, gbase, voff) do { _Pragma("unroll") for (int _i = 0; _i < 2; ++_i) \
        __builtin_amdgcn_global_load_lds((const unsigned*)((const char*)(gbase) + (voff)[_i]), (PG8_LAS unsigned*)(lds + (bufoff) + ldsw + _i * 8192), 16, 0, 0); } while (0)
#define PG8_LDA(dst, b, h) do { _Pragma("unroll") for (int m = 0; m < 4; ++m) _Pragma("unroll") for (int k = 0; k < 2; ++k) dst[m][k] = *(const PG8_LAS bf16x8*)(lds + PG8_SA(b, h) + aoff + m * 2048 + k * 1024); } while (0)
#define PG8_LDB(dst, b, h) do { _Pragma("unroll") for (int n = 0; n < 2; ++n) _Pragma("unroll") for (int k = 0; k < 2; ++k) dst[n][k] = *(const PG8_LAS bf16x8*)(lds + PG8_SB(b, h) + boff + n * 2048 + k * 1024); } while (0)
#define PG8_MMA(ai, bj, At, Bt) do { __builtin_amdgcn_s_setprio(1); _Pragma("unroll") for (int m = 0; m < 4; ++m) _Pragma("unroll") for (int n = 0; n < 2; ++n) _Pragma("unroll") for (int k = 0; k < 2; ++k) \
        acc[ai][bj][m][n] = __builtin_amdgcn_mfma_f32_16x16x32_bf16(Bt[n][k], At[m][k], acc[ai][bj][m][n], 0, 0, 0); __builtin_amdgcn_s_setprio(0); } while (0)
#define PG8_APTR(u) ((const char*)((u).sel ? g.A1 : g.A0) + (size_t)(u).pm * tstepA)
#define PG8_BPTR(u) ((const char*)((u).sel ? g.B1 : g.B0) + (size_t)(u).pn * tstepB)
#define PG8_WAIT_V(n) asm volatile("s_waitcnt vmcnt(" #n ")" ::: "memory")
#define PG8_WAIT_L(n) asm volatile("s_waitcnt lgkmcnt(" #n ")" ::: "memory")
#define PG8_BAR __builtin_amdgcn_s_barrier()
#define PG8_SCHED __builtin_amdgcn_sched_barrier(0)
    Unit cur, nxt; int ui = 0;
    if (!S.next(0, cur)) return;
#ifdef PROBE_G
    unsigned long long pg_epi = 0; const unsigned long long pg_start = __builtin_amdgcn_s_memtime();
#endif
    f32x4 acc[2][2][4][2];
#pragma unroll
    for (int a = 0; a < 2; ++a)
#pragma unroll
        for (int b = 0; b < 2; ++b)
#pragma unroll
            for (int m = 0; m < 4; ++m)
#pragma unroll
                for (int n = 0; n < 2; ++n) acc[a][b][m][n] = (f32x4){0.f, 0.f, 0.f, 0.f};
    bf16x8 At[4][2], B0[2][2], B1[2][2];
    const char* cA = PG8_APTR(cur); const char* cB = PG8_BPTR(cur);
    if constexpr (SP2) {
        PG8_STAGE(PG8_SB(0, 0), cB, voffB); PG8_STAGE(PG8_SB(0, 1), cB + hstepB, voffB); PG8_STAGE(PG8_SA(0, 0), cA, voffA); PG8_STAGE(PG8_SA(0, 1), cA + hstepA, voffA);
        if (wr == 1) PG8_BAR;
        PG8_WAIT_V(2); PG8_BAR;
        PG8_STAGE(PG8_SB(1, 0), cB + kstep, voffB); PG8_STAGE(PG8_SA(1, 0), cA + kstep, voffA); PG8_STAGE(PG8_SB(1, 1), cB + hstepB + kstep, voffB);
        PG8_WAIT_V(6); PG8_BAR;
    } else {
        PG8_STAGE(PG8_SB(0, 0), cB, voffB); PG8_STAGE(PG8_SA(0, 0), cA, voffA); PG8_STAGE(PG8_SB(0, 1), cB + hstepB, voffB); PG8_STAGE(PG8_SA(0, 1), cA + hstepA, voffA);
        if (wr == 1) PG8_BAR;
        PG8_WAIT_V(4); PG8_BAR;
        PG8_STAGE(PG8_SB(1, 0), cB + kstep, voffB); PG8_STAGE(PG8_SA(1, 0), cA + kstep, voffA); PG8_STAGE(PG8_SB(1, 1), cB + hstepB + kstep, voffB);
        PG8_WAIT_V(6); PG8_BAR;
    }
    for (;;) {
        const bool has_next = S.next(ui + 1, nxt);
        const char* nA = has_next ? PG8_APTR(nxt) : cA; const char* nB = has_next ? PG8_BPTR(nxt) : cB;
        for (int t = 0; t < nt; t += 2) {
            const bool last = (t == nt - 2);
            const char* a1 = cA + (size_t)(t + 1) * kstep;
            const char* a2 = last ? nA : cA + (size_t)(t + 2) * kstep; const char* b2 = last ? nB : cB + (size_t)(t + 2) * kstep;
            const char* a3 = a2 + kstep; const char* b3 = b2 + kstep;
            if constexpr (SP2) {
            PG8_LDB(B0, 0, 0); PG8_LDB(B1, 0, 1); PG8_SCHED; PG8_LDA(At, 0, 0); PG8_STAGE(PG8_SA(1, 1), a1 + hstepA, voffA);
            PG8_WAIT_V(8); PG8_WAIT_L(0); PG8_BAR; PG8_MMA(0, 0, At, B0); PG8_MMA(0, 1, At, B1); PG8_BAR; PG8_SCHED;
            PG8_LDA(At, 0, 1); PG8_STAGE(PG8_SB(0, 0), b2, voffB); PG8_STAGE(PG8_SB(0, 1), b2 + hstepB, voffB); PG8_STAGE(PG8_SA(0, 0), a2, voffA);
            PG8_WAIT_V(8); PG8_WAIT_L(0); PG8_BAR; PG8_MMA(1, 0, At, B0); PG8_MMA(1, 1, At, B1); PG8_BAR; PG8_SCHED;
            PG8_LDB(B0, 1, 0); PG8_LDB(B1, 1, 1); PG8_SCHED; PG8_LDA(At, 1, 0); PG8_STAGE(PG8_SA(0, 1), a2 + hstepA, voffA);
            PG8_WAIT_V(8); PG8_WAIT_L(0); PG8_BAR; PG8_MMA(0, 0, At, B0); PG8_MMA(0, 1, At, B1); PG8_BAR; PG8_SCHED;
            PG8_LDA(At, 1, 1); PG8_STAGE(PG8_SB(1, 0), b3, voffB); PG8_STAGE(PG8_SB(1, 1), b3 + hstepB, voffB); PG8_STAGE(PG8_SA(1, 0), a3, voffA);
            PG8_WAIT_V(8); PG8_WAIT_L(0); PG8_BAR; PG8_MMA(1, 0, At, B0); PG8_MMA(1, 1, At, B1); PG8_BAR; PG8_SCHED;
            } else {
            PG8_LDB(B0, 0, 0); PG8_SCHED; PG8_LDA(At, 0, 0); PG8_STAGE(PG8_SA(1, 1), a1 + hstepA, voffA);
            PG8_WAIT_L(8); PG8_BAR; PG8_WAIT_L(0); PG8_MMA(0, 0, At, B0); PG8_BAR; PG8_SCHED;
            PG8_LDB(B1, 0, 1); PG8_STAGE(PG8_SB(0, 0), b2, voffB);
            PG8_BAR; PG8_WAIT_L(0); PG8_MMA(0, 1, At, B1); PG8_BAR;
            PG8_LDA(At, 0, 1); PG8_STAGE(PG8_SA(0, 0), a2, voffA);
            PG8_BAR; PG8_WAIT_L(0); PG8_MMA(1, 0, At, B0); PG8_BAR; PG8_SCHED;
            PG8_STAGE(PG8_SB(0, 1), b2 + hstepB, voffB);
            PG8_WAIT_V(6); PG8_BAR; PG8_MMA(1, 1, At, B1); PG8_BAR;
            PG8_LDB(B0, 1, 0); PG8_SCHED; PG8_LDA(At, 1, 0); PG8_STAGE(PG8_SA(0, 1), a2 + hstepA, voffA);
            PG8_WAIT_L(8); PG8_BAR; PG8_WAIT_L(0); PG8_MMA(0, 0, At, B0); PG8_BAR; PG8_SCHED;
            PG8_LDB(B1, 1, 1); PG8_STAGE(PG8_SB(1, 0), b3, voffB);
            PG8_BAR; PG8_WAIT_L(0); PG8_MMA(0, 1, At, B1); PG8_BAR;
            PG8_LDA(At, 1, 1); PG8_STAGE(PG8_SA(1, 0), a3, voffA);
            PG8_BAR; PG8_WAIT_L(0); PG8_MMA(1, 0, At, B0); PG8_BAR; PG8_SCHED;
            PG8_STAGE(PG8_SB(1, 1), b3 + hstepB, voffB);
            PG8_WAIT_V(6); PG8_BAR; PG8_MMA(1, 1, At, B1); PG8_BAR;
            }
        }
        if constexpr (ALIGN_EPI) { if (wr == 0) PG8_BAR; }
#ifdef PROBE_G
        const unsigned long long pg_t0 = __builtin_amdgcn_s_memtime();
#endif
        const bool keep = E(acc, cur, wr, wc, fr, fq);
#ifdef PROBE_G
        pg_epi += __builtin_amdgcn_s_memtime() - pg_t0;
#endif
        if (!has_next) break;
        if (!keep) {
#pragma unroll
        for (int a = 0; a < 2; ++a)
#pragma unroll
            for (int b = 0; b < 2; ++b)
#pragma unroll
                for (int m = 0; m < 4; ++m)
#pragma unroll
                    for (int n = 0; n < 2; ++n) acc[a][b][m][n] = (f32x4){0.f, 0.f, 0.f, 0.f};
        }
        cur = nxt; cA = nA; cB = nB; ++ui;
        if constexpr (ALIGN_EPI) { if (wr == 1) PG8_BAR; }
    }
#ifdef PROBE_G
    if (E.dbg && blockIdx.x == 0 && threadIdx.x == 0) { const double tot = (double)(__builtin_amdgcn_s_memtime() - pg_start);
        E.dbg[0] = (PROBE_G == 1) ? (float)(tot / (double)(ui + 1) / 262144.0) : (float)((double)pg_epi / tot); }
#endif
    PG8_WAIT_V(0);
    if constexpr (!ALIGN_EPI) { if (wr == 0) PG8_BAR; }
    PG8_BAR;
#undef PG8_SA
#undef PG8_SB
#undef PG8_STAGE
#undef PG8_LDA
#undef PG8_LDB
#undef PG8_MMA
#undef PG8_APTR
#undef PG8_BPTR
#undef PG8_WAIT_V
#undef PG8_WAIT_L
#undef PG8_BAR
#undef PG8_SCHED
}
}

constexpr int NWAVES = 8;
constexpr int T = 8192, D = 1024, NBP = 8, NBS = 2, NB = NBP + NBS, M = NB * T;
constexpr int NCHAIN = 160;
#ifndef PG_MAIN_TILES
#define PG_MAIN_TILES 0
#endif
constexpr int PGM = PG_MAIN_TILES;
constexpr int A_HEADS = 8, A_HD = 64, A_W = 512, RANK = 64;
constexpr int A_COLS = 2304, B_COLS = 5120, G_COLS = 2048, IN_COLS = 9472, AG_COLS = A_COLS + G_COLS;
constexpr int B_QKV = 1536, B_W = 512, B_HD = 128;
constexpr float RMS_EPS = 1e-6f, GN_EPS = 64e-5f;
constexpr size_t MiB = 1u << 20;
constexpr size_t WS_CTL = 0, CTL_ZERO_BYTES = 65536;
constexpr size_t WS_MOD = 1 * MiB;
constexpr size_t WS_BTAB = 1 * MiB + 128 * 1024;
constexpr size_t WS_WB = 2 * MiB;
constexpr size_t WS_WAG = 12 * MiB;
constexpr size_t WS_WOA = 21 * MiB, WS_WOB = 22 * MiB, WS_WO = 23 * MiB;
constexpr size_t WS_BON = 26 * MiB;
constexpr size_t WS_R = 32 * MiB;
constexpr size_t WS_PA = WS_R, WS_PG = WS_R + 360 * MiB;
constexpr size_t WS_Y = 832 * MiB;
constexpr size_t WS_END = 992 * MiB;
constexpr int CW_BAR = 4096;
constexpr int OS_H = 0, OS_YA = 2048, OS_YB = 3072, OROW = 4096;
constexpr int RING_OFF = 0, RING_BYTES = 131072;
constexpr int LDSCTL_OFF = RING_BYTES, MISC_OFF = LDSCTL_OFF + 320;
constexpr int EPI_OFF = RING_BYTES + 1024;
constexpr int LDS_BYTES = 147456;

#define GAS __attribute__((address_space(1)))
#define LAS __attribute__((address_space(3)))
typedef unsigned short bf16;
typedef unsigned v4u __attribute__((ext_vector_type(4)));
typedef unsigned v2u __attribute__((ext_vector_type(2)));
typedef float f32x4 __attribute__((ext_vector_type(4)));
typedef short bf16x8 __attribute__((ext_vector_type(8)));
typedef GAS unsigned gu32;
#define RLX_AGENT __ATOMIC_RELAXED, __HIP_MEMORY_SCOPE_AGENT
#define LDS_WAIT() asm volatile("s_waitcnt lgkmcnt(0)" ::: "memory")
#define VM_WAIT() asm volatile("s_waitcnt vmcnt(0)" ::: "memory")
__device__ __forceinline__ unsigned f2bf(float f) { unsigned u = __builtin_bit_cast(unsigned, f); return (u + 0x7fffu + ((u >> 16) & 1u)) >> 16; }
__device__ __forceinline__ unsigned pk2(float lo, float hi) { return f2bf(lo) | (f2bf(hi) << 16); }
typedef float f32x2_t __attribute__((ext_vector_type(2))); typedef __bf16 bf16x2_t __attribute__((ext_vector_type(2)));
__device__ __forceinline__ unsigned cvtpk(float lo, float hi) { f32x2_t v = {lo, hi}; bf16x2_t b = __builtin_convertvector(v, bf16x2_t); return __builtin_bit_cast(unsigned, b); }
__device__ __forceinline__ float bf2f(unsigned short h) { return __builtin_bit_cast(float, (unsigned)h << 16); }
__device__ __forceinline__ float bflo(unsigned w) { return __builtin_bit_cast(float, w << 16); }
__device__ __forceinline__ float bfhi(unsigned w) { return __builtin_bit_cast(float, w & 0xffff0000u); }
__device__ __forceinline__ float sigmoidf_(float v) { return __builtin_amdgcn_rcpf(1.f + __expf(-v)); }
__device__ __forceinline__ float siluf_(float v) { return v * sigmoidf_(v); }
__device__ __forceinline__ float wave_sum(float v) {
#pragma unroll
    for (int o = 1; o < 64; o <<= 1) v += __shfl_xor(v, o);
    return v;
}
__device__ __forceinline__ float wave_max(float v) {
#pragma unroll
    for (int o = 1; o < 64; o <<= 1) v = fmaxf(v, __shfl_xor(v, o));
    return v;
}

#define XB_TMO      128
#define XB_XCNT(j)  (256  + 64 * (j))
#define XB_XSUB(j)  (1280 + 64 * (j))
#define XB_XGEN(j)  (2304 + 64 * (j))
#define XB_TOP      3328
#define XB_TOPGEN   3392
#define XCD_BAR_WORDS 3456
#define XB_SPIN_CAP (1u << 22)
__device__ __forceinline__ unsigned xb_ld(unsigned* p)              { return __hip_atomic_load(p, __ATOMIC_RELAXED, __HIP_MEMORY_SCOPE_AGENT); }
__device__ __forceinline__ unsigned xb_add(unsigned* p, unsigned v) { return __hip_atomic_fetch_add(p, v, __ATOMIC_RELAXED, __HIP_MEMORY_SCOPE_AGENT); }
__device__ __forceinline__ unsigned xb_xcc_id() { return (unsigned)__builtin_amdgcn_s_getreg((3 << 11) | 20) & 0xFu; }
#define XB_SPIN(cond, bar) do { unsigned _sp = 0; while (cond) { __builtin_amdgcn_s_sleep(1); \
    if ((++_sp & 255u) == 0u) { if (xb_ld(&(bar)[XB_TMO])) break; if (_sp > XB_SPIN_CAP) { atomicAdd(&(bar)[XB_TMO], 1u); break; } } } } while (0)
struct XcdBarrier { unsigned* bar; unsigned x; volatile LAS unsigned* st; };
__device__ __forceinline__ XcdBarrier xcd_barrier_post(unsigned* bar, volatile LAS unsigned* st) {
    XcdBarrier b; b.bar = bar; b.x = xb_xcc_id(); b.st = st;
    if (threadIdx.x == 0) (void)xb_add(&bar[XB_XCNT(b.x)], 1u);
    return b;
}
__device__ __forceinline__ void xcd_barrier_complete(unsigned* bar, unsigned x, unsigned& nloc, unsigned& nx) {
    const unsigned G = gridDim.x * gridDim.y * gridDim.z;
    unsigned sum, cnt, mine, sp = 0u;
    for (;;) {
        sum = 0u; cnt = 0u; mine = 0u;
#pragma unroll
        for (unsigned j = 0; j < 16; ++j) { const unsigned c = xb_ld(&bar[XB_XCNT(j)]); sum += c; cnt += (c > 0u) ? 1u : 0u; mine = (j == x) ? c : mine; }
        if (sum == G) break;
        __builtin_amdgcn_s_sleep(1);
        if ((++sp & 255u) == 0u) { if (xb_ld(&bar[XB_TMO])) break; if (sp > XB_SPIN_CAP) { atomicAdd(&bar[XB_TMO], 1u); break; } }
    }
    nloc = mine > 0u ? mine : 1u; nx = cnt > 0u ? cnt : 1u;
}
__device__ __forceinline__ void xcd_barrier(const XcdBarrier& b, const int wave_id) {
    asm volatile("s_waitcnt vmcnt(0)" ::: "memory");
    __syncthreads();
    if (wave_id == 0 && lane_id() == 0) {
        unsigned* bar = b.bar;
        __builtin_amdgcn_s_waitcnt(0);
        unsigned nloc = b.st[0], nx = b.st[1];
        if (nloc == 0u) { xcd_barrier_complete(bar, b.x, nloc, nx); b.st[0] = nloc; b.st[1] = nx; }
        const unsigned old = xb_add(&bar[XB_XSUB(b.x)], 1u);
        const unsigned gen = old / nloc;
        if (old + 1u == (gen + 1u) * nloc) {
            __builtin_amdgcn_fence(__ATOMIC_RELEASE, "agent");
            asm volatile("s_waitcnt vmcnt(0)" ::: "memory");
            const unsigned og = xb_add(&bar[XB_TOP], 1u);
            const unsigned tg = og / nx;
            if (og + 1u == (tg + 1u) * nx) xb_add(&bar[XB_TOPGEN], 1u);
            else XB_SPIN(xb_ld(&bar[XB_TOPGEN]) == tg, bar);
            __builtin_amdgcn_fence(__ATOMIC_ACQUIRE, "agent");
            xb_add(&bar[XB_XGEN(b.x)], 1u);
            asm volatile("s_waitcnt vmcnt(0)" ::: "memory");
        } else {
            XB_SPIN(xb_ld(&bar[XB_XGEN(b.x)]) == gen, bar);
            __builtin_amdgcn_fence(__ATOMIC_ACQUIRE, "agent");
            asm volatile("s_waitcnt vmcnt(0)" ::: "memory");
        }
    }
    __syncthreads();
}

struct Frame {
    LAS unsigned char* lds;
    volatile LAS unsigned* MISC;
    int wave;
    __device__ __forceinline__ int lane_() const { return lane_id(); }
    int vcu, G;
    unsigned char* out;
    unsigned char* ws;
};
enum { I_XP = 0, I_XS, I_CP, I_CS, I_RELB, I_NORMW, I_WADA, I_BADA, I_WIN, I_MU, I_W0, I_W2, I_A0, I_A2, I_KK, I_KA, I_RK, I_LNW, I_LNB, I_QG, I_KG, I_WOA, I_WOB, I_WO };
__device__ __forceinline__ int kopaque() { int z = 0; asm volatile("" : "+s"(z)); return z; }
__device__ __forceinline__ const float* kin(int k, int kof) { return ((const float* const __attribute__((address_space(4)))*)__builtin_amdgcn_kernarg_segment_ptr())[k + kof]; }
__device__ __forceinline__ const float* xrow_ptr(const float* xp, const float* xs, int m) { return m < NBP * T ? xp + (size_t)m * D : xs + (size_t)(m - NBP * T) * D; }

namespace pg8 {
struct EpiPB {
    static constexpr bool PERM = true;
    bf16_t* O; const float* qg; const float* kg; PG8_LAS float* P; float* dbg;
    __device__ __forceinline__ bool operator()(f32x4 (&acc)[2][2][4][2], const Unit& u, int wr, int wc, int fr, int fq) const {
        const int row0 = u.pm * BM + wr * 64 + fr, col0 = u.pn * BM + wc * 32 + 8 * fq;
        if (u.pn < 12) {
#pragma unroll
            for (int ai = 0; ai < 2; ++ai)
#pragma unroll
                for (int m = 0; m < 4; ++m) {
#pragma unroll
                    for (int bj = 0; bj < 2; ++bj) { const f32x4 a = acc[ai][bj][m][0], b = acc[ai][bj][m][1];
                        float s = (a[0] * a[0] + a[1] * a[1]) + (a[2] * a[2] + a[3] * a[3]) + (b[0] * b[0] + b[1] * b[1]) + (b[2] * b[2] + b[3] * b[3]);
                        s += __shfl_xor(s, 16); s += __shfl_xor(s, 32);
                        if (fq == 0) P[((ai * HALF + wr * 64 + m * 16 + fr) * 2 + bj) * 4 + wc] = s; }
                    asm volatile("" ::: "memory"); }
            asm volatile("s_waitcnt lgkmcnt(0)" ::: "memory"); __builtin_amdgcn_s_barrier(); asm volatile("" ::: "memory");
            const bool isq = u.pn < 6; const float* gp = (isq ? qg : kg) + wc * 32 + 8 * fq; const float gs = isq ? 0.08838834764831845f * 1.4426950408889634f : 1.f;
            float gn[8];
#pragma unroll
            for (int e = 0; e < 8; ++e) gn[e] = gp[e] * gs;
#pragma unroll
            for (int ai = 0; ai < 2; ++ai)
#pragma unroll
                for (int m = 0; m < 4; ++m)
#pragma unroll
                    for (int bj = 0; bj < 2; ++bj) { const f32x4 p4 = *(const PG8_LAS f32x4*)(P + ((ai * HALF + wr * 64 + m * 16 + fr) * 2 + bj) * 4);
                        const float rs = 1.0f / sqrtf(((p4[0] + p4[1]) + (p4[2] + p4[3])) * (1.f / 128.f) + 1e-6f);
#pragma unroll
                        for (int e = 0; e < 4; ++e) { acc[ai][bj][m][0][e] *= rs * gn[e]; acc[ai][bj][m][1][e] *= rs * gn[4 + e]; }
                        asm volatile("" ::: "memory"); }
        }
        const bool act = u.pn >= 18;
#pragma unroll
        for (int ai = 0; ai < 2; ++ai)
#pragma unroll
            for (int m = 0; m < 4; ++m) { bf16_t* rowp = O + (size_t)(row0 + ai * HALF + m * 16) * B_COLS + col0;
#pragma unroll
                for (int bj = 0; bj < 2; ++bj) { f32x4 v0 = acc[ai][bj][m][0], v1 = acc[ai][bj][m][1];
                    if (act) {
#pragma unroll
                        for (int e = 0; e < 4; ++e) { v0[e] = siluf_(v0[e]); v1[e] = siluf_(v1[e]); } }
                    u32x4 w; w.x = cvt_pk_bf16(v0[0], v0[1]); w.y = cvt_pk_bf16(v0[2], v0[3]); w.z = cvt_pk_bf16(v1[0], v1[1]); w.w = cvt_pk_bf16(v1[2], v1[3]);
                    *(u32x4*)(rowp + bj * HALF) = w; } }
        return false;
    }
};
struct EpiAG {
    static constexpr bool PERM = true;
    bf16_t* PA; bf16_t* PG; float* dbg;
    __device__ __forceinline__ bool operator()(const f32x4 (&acc)[2][2][4][2], const Unit& u, int wr, int wc, int fr, int fq) const {
        bf16_t* base = PA; const int ldc = A_COLS; const int pn = u.pn < 6 ? u.pn : 8;
        const int row0 = u.pm * BM + wr * 64 + fr, col0 = pn * BM + wc * 32 + 8 * fq;
#pragma unroll
        for (int ai = 0; ai < 2; ++ai)
#pragma unroll
            for (int m = 0; m < 4; ++m) { bf16_t* rowp = base + (size_t)(row0 + ai * HALF + m * 16) * ldc + col0;
#pragma unroll
                for (int bj = 0; bj < 2; ++bj) { const f32x4 v0 = acc[ai][bj][m][0], v1 = acc[ai][bj][m][1];
                    u32x4 w; w.x = cvt_pk_bf16(v0[0], v0[1]); w.y = cvt_pk_bf16(v0[2], v0[3]); w.z = cvt_pk_bf16(v1[0], v1[1]); w.w = cvt_pk_bf16(v1[2], v1[3]);
                    *(u32x4*)(rowp + bj * HALF) = w; } }
        return false;
    }
};
struct EpiPG {
    static constexpr bool PERM = true;
    bf16_t* PG; bf16_t* PA; float* dbg;
    __device__ __forceinline__ bool operator()(const f32x4 (&acc)[2][2][4][2], const Unit& u, int wr, int wc, int fr, int fq) const {
        const bool ispa = u.pn < 2; bf16_t* base = ispa ? PA : PG; const int ldc = ispa ? A_COLS : G_COLS;
        const int row0 = u.pm * BM + wr * 64 + fr, col0 = (ispa ? 6 + u.pn : u.pn - 2) * BM + wc * 32 + 8 * fq;
#pragma unroll
        for (int ai = 0; ai < 2; ++ai)
#pragma unroll
            for (int m = 0; m < 4; ++m) { bf16_t* rowp = base + (size_t)(row0 + ai * HALF + m * 16) * ldc + col0;
#pragma unroll
                for (int bj = 0; bj < 2; ++bj) { const f32x4 v0 = acc[ai][bj][m][0], v1 = acc[ai][bj][m][1];
                    u32x4 w; w.x = cvt_pk_bf16(v0[0], v0[1]); w.y = cvt_pk_bf16(v0[2], v0[3]); w.z = cvt_pk_bf16(v1[0], v1[1]); w.w = cvt_pk_bf16(v1[2], v1[3]);
                    *(u32x4*)(rowp + bj * HALF) = w; } }
        return false;
    }
};
struct EpiMerge {
    static constexpr bool PERM = true;
    const bf16_t* PG; bf16_t* O; float* dbg;
    __device__ __forceinline__ bool operator()(f32x4 (&acc)[2][2][4][2], const Unit& u, int wr, int wc, int fr, int fq) const {
        const int row0 = u.pm * BM + wr * 64 + fr, col0 = u.pn * BM + wc * 32 + 8 * fq;
#pragma unroll
        for (int ai = 0; ai < 2; ++ai)
#pragma unroll
            for (int m = 0; m < 4; ++m) { const size_t row = (size_t)(row0 + ai * HALF + m * 16);
#pragma unroll
                for (int bj = 0; bj < 2; ++bj) { const int col = col0 + bj * HALF;
                    const u32x4 gb8 = *(const u32x4*)(PG + row * G_COLS + D + col);
                    float zb[8] = {bflo(gb8.x), bfhi(gb8.x), bflo(gb8.y), bfhi(gb8.y), bflo(gb8.z), bfhi(gb8.z), bflo(gb8.w), bfhi(gb8.w)};
                    if (u.sel == 0) {
                        const u32x4 ga8 = *(const u32x4*)(PG + row * G_COLS + col);
                        float za[8] = {bflo(ga8.x), bfhi(ga8.x), bflo(ga8.y), bfhi(ga8.y), bflo(ga8.z), bfhi(ga8.z), bflo(ga8.w), bfhi(ga8.w)};
#pragma unroll
                        for (int e = 0; e < 8; ++e) { const float ea = __expf(-fminf(fmaxf(za[e], -30.f), 30.f)), eb = __expf(-fminf(fmaxf(zb[e], -30.f), 30.f));
                            const float r = (1.f + eb) * __builtin_amdgcn_rcpf(1.f + ea); acc[ai][bj][m][e >> 2][e & 3] *= r; }
                    } else {
                        float o[8];
#pragma unroll
                        for (int e = 0; e < 8; ++e) { const float eb = __expf(-fminf(fmaxf(zb[e], -30.f), 30.f)); o[e] = acc[ai][bj][m][e >> 2][e & 3] * __builtin_amdgcn_rcpf(1.f + eb); }
                        u32x4 w; w.x = cvt_pk_bf16(o[0], o[1]); w.y = cvt_pk_bf16(o[2], o[3]); w.z = cvt_pk_bf16(o[4], o[5]); w.w = cvt_pk_bf16(o[6], o[7]);
                        *(u32x4*)(O + row * D + col) = w;
                    } } }
        return u.sel == 0;
    }
};
struct EpiOut {
    static constexpr bool PERM = false;
    const float* xp; const float* xs; const float* mod; float* out; float* dbg;
    __device__ __forceinline__ bool operator()(const f32x4 (&acc)[2][2][4][2], const Unit& u, int wr, int wc, int fr, int fq) const {
        const int rowt = u.pm * BM, b = rowt >> 13; const float* xb = rowt < NBP * T ? xp + (size_t)rowt * D : xs + (size_t)(rowt - NBP * T) * D;
        const int rl0 = wr * 64 + fr, col0 = u.pn * BM + wc * 32 + 4 * fq; const float* gt = mod + b * 3072 + 2048;
#pragma unroll
        for (int bj = 0; bj < 2; ++bj)
#pragma unroll
            for (int n = 0; n < 2; ++n) { const int col = col0 + bj * HALF + n * 16; const f32x4 g4 = *(const f32x4*)(gt + col);
#pragma unroll
                for (int ai = 0; ai < 2; ++ai)
#pragma unroll
                    for (int m = 0; m < 4; ++m) { const int rl = rl0 + ai * HALF + m * 16; const f32x4 x4 = *(const f32x4*)(xb + (size_t)rl * D + col);
                        *(f32x4*)(out + (size_t)(rowt + rl) * D + col) = x4 + g4 * acc[ai][bj][m][n]; } }
        return false;
    }
};
struct SideOrder { int pm0, npm, G, c;
    __device__ bool next(int i, Unit& u) const { const int t = i * G + c; if (t >= npm * 10) return false; u.pm = pm0 + t / 10; u.pn = t % 10; u.sel = 0; return true; } };
}

__device__ __forceinline__ void p0_transpose_item(const float* W, int K, int N, bf16* WT, int k0, int n0, int drow0, LAS float* scr, int lane) {
#pragma unroll 8
    for (int i = 0; i < 32; ++i) { const int kk = 2 * i + (lane >> 5); scr[kk * 33 + (lane & 31)] = W[(size_t)(k0 + kk) * N + n0 + (lane & 31)]; }
    LDS_WAIT(); asm volatile("" ::: "memory");
    const int c = lane & 7;
#pragma unroll
    for (int j = 0; j < 4; ++j) { const int n = (lane >> 3) + 8 * j; const LAS float* s = scr + (8 * c) * 33 + n;
        v4u o; o.x = pk2(s[0 * 33], s[1 * 33]); o.y = pk2(s[2 * 33], s[3 * 33]); o.z = pk2(s[4 * 33], s[5 * 33]); o.w = pk2(s[6 * 33], s[7 * 33]);
        *(GAS v4u*)(WT + (size_t)(drow0 + n) * K + k0 + 8 * c) = o; }
    LDS_WAIT(); asm volatile("" ::: "memory");
}
__device__ __forceinline__ int t5_bucket(int rel) {
    const int n = rel < 0 ? -rel : rel; int ret = rel > 0 ? 16 : 0;
    const float lf = logf((float)(n > 1 ? n : 1) / 8.0f) / 4.852030263919617f * 8.0f;
    int large = 8 + (int)lf; large = large < 15 ? large : 15;
    return ret + (n < 8 ? n : large);
}
__device__ __forceinline__ void p0a(Frame& F) {
    const int ko = kopaque(); const float *cp_ = kin(I_CP, ko), *cs_ = kin(I_CS, ko), *w_ada = kin(I_WADA, ko), *b_ada = kin(I_BADA, ko), *rel_bias = kin(I_RELB, ko), *w_in = kin(I_WIN, ko), *w_out_a = kin(I_WOA, ko), *w_out_b = kin(I_WOB, ko), *w_out = kin(I_WO, ko);
    float* mod = (float*)(F.ws + WS_MOD);
    if (blockIdx.x < 48) {
        LAS float* sc = (LAS float*)F.lds;
        LAS float* part = (LAS float*)(F.lds + 40960);
        for (int i = (F.wave * 64 + lane_id()); i < NB * D; i += NWAVES * 64) { const int b = i >> 10, k = i & 1023; const float cv = b < NBP ? cp_[b * D + k] : cs_[(b - NBP) * D + k]; sc[i] = siluf_(cv); }
        __syncthreads();
        const int j = blockIdx.x * 64 + lane_id(); float a[NB];
#pragma unroll
        for (int b = 0; b < NB; ++b) a[b] = 0.f;
        for (int k = F.wave * 128; k < F.wave * 128 + 128; ++k) { const float w = w_ada[(size_t)k * 3072 + j];
#pragma unroll
            for (int b = 0; b < NB; ++b) a[b] += sc[b * D + k] * w; }
#pragma unroll
        for (int b = 0; b < NB; ++b) part[(F.wave * NB + b) * 64 + lane_id()] = a[b];
        __syncthreads();
        for (int i = (F.wave * 64 + lane_id()); i < NB * 64; i += NWAVES * 64) { const int b = i >> 6, l = i & 63; float s = b_ada[blockIdx.x * 64 + l];
#pragma unroll
            for (int w = 0; w < NWAVES; ++w) s += part[(w * NB + b) * 64 + l];
            mod[b * 3072 + blockIdx.x * 64 + l] = s; }
        __syncthreads();
    }
    if (blockIdx.x == 255 % gridDim.x) {
        float* bt = (float*)(F.ws + WS_BTAB);
        for (int i = (F.wave * 64 + lane_id()); i < 12 * 129; i += NWAVES * 64) { const int gh = i / 129, r = i % 129, gi = gh >> 2; const int rel = (r - 64) * (1 << (2 * gi));
            bt[i] = rel_bias[t5_bucket(rel) * 12 + gh] * 1.4426950408889634f; }
    }
    LAS float* scr = (LAS float*)(F.lds + RING_OFF + F.wave * 16384);
    const int gw = F.vcu * NWAVES + F.wave, NGW = F.G * NWAVES;
    constexpr int I_IN = (D / 64) * (IN_COLS / 32), I_OA = (A_W / 64) * (D / 32), I_OB = (B_W / 64) * (D / 32), I_O = (D / 64) * (D / 32);
    constexpr int NITEMS = I_IN + I_OA + I_OB + I_O;
    for (int it = gw; it < NITEMS; it += NGW) {
        int r = it;
        if (r < I_IN) { const int nblk = IN_COLS / 32, kb = r / nblk, nb = r % nblk, n0 = nb * 32;
            bf16* dst; int drow;
            if (n0 < A_COLS) { dst = (bf16*)(F.ws + WS_WAG); drow = n0 < 1536 ? n0 : (n0 < 2048 ? n0 + 256 : n0 - 512); }
            else if (n0 < A_COLS + B_COLS) { dst = (bf16*)(F.ws + WS_WB); drow = n0 - A_COLS; }
            else { dst = (bf16*)(F.ws + WS_WAG); drow = A_COLS + (n0 - A_COLS - B_COLS); }
            p0_transpose_item(w_in, D, IN_COLS, dst, kb * 64, n0, drow, scr, lane_id()); continue; }
        r -= I_IN;
        if (r < I_OA) { const int nblk = D / 32, kb = r / nblk, nb = r % nblk; p0_transpose_item(w_out_a, A_W, D, (bf16*)(F.ws + WS_WOA), kb * 64, nb * 32, nb * 32, scr, lane_id()); continue; }
        r -= I_OA;
        if (r < I_OB) { const int nblk = D / 32, kb = r / nblk, nb = r % nblk; p0_transpose_item(w_out_b, B_W, D, (bf16*)(F.ws + WS_WOB), kb * 64, nb * 32, nb * 32, scr, lane_id()); continue; }
        r -= I_OB;
        { const int nblk = D / 32, kb = r / nblk, nb = r % nblk; p0_transpose_item(w_out, D, D, (bf16*)(F.ws + WS_WO), kb * 64, nb * 32, nb * 32, scr, lane_id()); }
    }
}
__device__ __forceinline__ void p0b(Frame& F) {
    const int ko = kopaque(); const float *xp = kin(I_XP, ko), *xs = kin(I_XS, ko), *norm_w = kin(I_NORMW, ko);
    const float* mod = (const float*)(F.ws + WS_MOD);
    const int gw = F.vcu * NWAVES + F.wave, NGW = F.G * NWAVES, lane = lane_id();
    const int per = (M + NGW - 1) / NGW, m0 = gw * per, m1 = (m0 + per < M) ? m0 + per : M;
    int bcur = -1; f32x4 cs[4], sh[4];
    for (int m = m0; m < m1; ++m) {
        const int b = m >> 13;
        if (b != bcur) { bcur = b;
#pragma unroll
            for (int j = 0; j < 4; ++j) { const int col = 4 * (lane + 64 * j); const f32x4 nw = *(const f32x4*)(norm_w + col), sc = *(const f32x4*)(mod + b * 3072 + 1024 + col);
                cs[j] = nw * (sc + 1.f); sh[j] = *(const f32x4*)(mod + b * 3072 + col); } }
        const f32x4* xr = (const f32x4*)xrow_ptr(xp, xs, m) + lane;
        f32x4 v[4]; float s = 0.f;
#pragma unroll
        for (int j = 0; j < 4; ++j) { v[j] = xr[64 * j]; s += (v[j].x * v[j].x + v[j].y * v[j].y) + (v[j].z * v[j].z + v[j].w * v[j].w); }
        const float rs = __builtin_amdgcn_rsqf(wave_sum(s) * (1.f / D) + RMS_EPS);
        v2u* o8 = (v2u*)(F.out + (size_t)m * OROW + OS_H) + lane;
#pragma unroll
        for (int j = 0; j < 4; ++j) { const f32x4 h = v[j] * rs * cs[j] + sh[j]; v2u w; w.x = cvtpk(h.x, h.y); w.y = cvtpk(h.z, h.w); o8[64 * j] = w; }
    }
}
typedef short v4i16_t __attribute__((ext_vector_type(4)));
typedef float f32x4a __attribute__((ext_vector_type(4)));
constexpr int AT_K = 0, AT_V = 65536, AT_BT = RING_BYTES + 9216 + 1024;
constexpr size_t WS_LSE = WS_Y;
__device__ __forceinline__ void attn_unit_geom(int u, int& b, int& gi, int& hh, int& res, int& blk) {
    const int sub = u & 63; int r = u >> 6; hh = r & 3; r >>= 2; gi = r % 3; b = r / 3;
    if (gi == 0) { res = 0; blk = sub; } else if (gi == 1) { res = sub >> 4; blk = sub & 15; } else { res = sub >> 2; blk = sub & 3; }
}
__device__ __forceinline__ void glds16(const void* gsrc, unsigned lds_dst) { unsigned keep;
    asm volatile("s_mov_b32 %0, m0\n\ts_mov_b32 m0, %2\n\ts_nop 0\n\tglobal_load_lds_dwordx4 %1, off\n\ts_mov_b32 m0, %0" : "=&s"(keep) : "v"(gsrc), "s"(lds_dst) : "memory"); }
__device__ __forceinline__ void attn_dma_k_half(Frame& F, const bf16* pb, int b, int lg, int L, int res, int head, int q0, int hb) {
    const int lane = lane_id();
#pragma unroll
    for (int ii = 0; ii < 4; ++ii) { const int i = (hb >> 2) + F.wave * 4 + ii, row = 4 * i + (lane >> 4); int kp = q0 - 64 + ((row - q0) & 255); kp = kp < 0 ? 0 : (kp >= L ? L - 1 : kp);
        const int c = (lane & 15) ^ (row & 15);
        const bf16* src = pb + (size_t)(b * T + (kp << lg) + res) * B_COLS + B_QKV + head * 128 + c * 8;
        glds16(src, (unsigned)__builtin_amdgcn_readfirstlane((int)(unsigned)(size_t)(F.lds + AT_K + i * 1024))); }
}
__device__ __forceinline__ void attn_dma_v_half(Frame& F, const bf16* pb, int b, int lg, int L, int res, int head, int q0, int hb) {
    const int lane = lane_id();
#pragma unroll
    for (int jj = 0; jj < 4; ++jj) { const int j = F.wave * 4 + jj, dblk = j >> 3, kgrp = (hb >> 4) + (j & 7), row = 16 * kgrp + (lane >> 2); int kp = q0 - 64 + ((row - q0) & 255); kp = kp < 0 ? 0 : (kp >= L ? L - 1 : kp);
        const bf16* src = pb + (size_t)(b * T + (kp << lg) + res) * B_COLS + 2 * B_QKV + head * 128 + dblk * 32 + (lane & 3) * 8;
        glds16(src, (unsigned)__builtin_amdgcn_readfirstlane((int)(unsigned)(size_t)(F.lds + AT_V + dblk * 16384 + kgrp * 1024))); }
}
__device__ __forceinline__ void attn_mfma(Frame& F, bool dry = false) {
    bf16* pb = (bf16*)(F.ws + WS_R); const float* btab = (const float*)(F.ws + WS_BTAB); float* lse = (float*)(F.ws + WS_LSE);
    int lane = lane_id(); asm volatile("" : "+v"(lane));
    const int w = F.wave, qi = lane & 15, g = lane >> 4;
    LAS float* btp = (LAS float*)(F.lds + AT_BT);
    const int NU = NB * 3 * 4 * 64, per = (NU + F.G - 1) / F.G; const int u0 = F.vcu * per, u1 = (u0 + per < NU) ? u0 + per : NU;
    if (u0 >= u1) return;
#ifdef PROBE_AT
    const unsigned long long pat_t0 = __builtin_amdgcn_s_memtime();
#endif
    int koff[4];
#pragma unroll
    for (int ks = 0; ks < 4; ++ks) koff[ks] = AT_K + qi * 256 + (((4 * ks + g) ^ qi) << 4);
    const int q4 = qi >> 2, p4 = qi & 3, kr = 4 * g + q4;
    const int voff = AT_V + (kr >> 3) * 512 + (kr & 7) * 64 + 8 * p4;
    int b, gi, hh, res, blk; attn_unit_geom(u0, b, gi, hh, res, blk);
    { const int lg = 2 * gi; attn_dma_k_half(F, pb, b, lg, T >> lg, res, gi * 4 + hh, blk * 128, 0); attn_dma_k_half(F, pb, b, lg, T >> lg, res, gi * 4 + hh, blk * 128, 128); }
    int head_prev = -1;
    bf16x8 qA[4], qB[4];
#define ATTN_LOADQ(QD, uu) do { int b_, gi_, hh_, res_, blk_; attn_unit_geom((uu), b_, gi_, hh_, res_, blk_); const int lg_ = 2 * gi_; \
        const bf16* qr_ = pb + (size_t)(b_ * T + ((blk_ * 128 + 16 * w + qi) << lg_) + res_) * B_COLS + (gi_ * 4 + hh_) * 128; \
        _Pragma("unroll") for (int ks = 0; ks < 4; ++ks) QD[ks] = *(const bf16x8*)(qr_ + 32 * ks + 8 * g); } while (0)
    ATTN_LOADQ(qA, u0);
    asm volatile("" :: "v"(qA[0]), "v"(qA[1]), "v"(qA[2]), "v"(qA[3]));
#define ATTN_UNIT(u, qf, qnx) do { \
        attn_unit_geom(u, b, gi, hh, res, blk); \
        const int lg = 2 * gi, L = T >> lg, head = gi * 4 + hh, q0 = blk * 128; \
        const bool cont = ((u) > u0) && (blk != 0);                  \
        const int s8 = ((q0 >> 4) + w) & 15;                         \
        if (head != head_prev) { head_prev = head; const int tid_ = F.wave * 64 + lane_id(); if (tid_ < 176) { const int i = tid_ - 16; btp[tid_] = (i >= 0 && i <= 128) ? btab[head * 129 + i] : -1e30f; } asm volatile("s_waitcnt vmcnt(0)" ::: "memory"); } \
        bf16* qrow = pb + (size_t)(b * T + ((q0 + 16 * w + qi) << lg) + res) * B_COLS + head * 128; \
        if ((u) + 1 < u1) ATTN_LOADQ(qnx, (u) + 1); \
          \
        if ((u) == u0) asm volatile("s_waitcnt vmcnt(0) lgkmcnt(0)" ::: "memory"); else asm volatile("s_waitcnt vmcnt(6) lgkmcnt(0)" ::: "memory"); \
        __builtin_amdgcn_s_barrier(); asm volatile("" ::: "memory"); \
        if (!cont) attn_dma_v_half(F, pb, b, lg, L, res, head, q0, q0 & 255); \
        attn_dma_v_half(F, pb, b, lg, L, res, head, q0, (q0 + 128) & 255); \
        f32x4a S[9]; \
        _Pragma("unroll") for (int kb = 0; kb < 9; ++kb) { S[kb] = (f32x4a){0.f, 0.f, 0.f, 0.f}; const int rb = ((s8 + kb) & 15) * 4096; \
            _Pragma("unroll") for (int ks = 0; ks < 4; ++ks) { const bf16x8 kf = *(const LAS bf16x8*)(F.lds + koff[ks] + rb); \
                S[kb] = __builtin_amdgcn_mfma_f32_16x16x32_bf16(kf, qf[ks], S[kb], 0, 0, 0); } } \
        const bool edge = (q0 == 0) || (q0 + 128 >= L); \
        float mx = -1e30f; \
        _Pragma("unroll") for (int kb = 0; kb < 9; ++kb) \
            _Pragma("unroll") for (int r = 0; r < 4; ++r) { const int kw = 16 * kb + 4 * g + r; float sv = S[kb][r] + btp[kw - qi + 16]; \
                if (edge) { const int kp = q0 + 16 * w + kw - 64; if (kp < 0 || kp >= L) sv = -1e30f; } \
                S[kb][r] = sv; mx = fmaxf(mx, sv); } \
        mx = fmaxf(mx, __shfl_xor(mx, 16)); mx = fmaxf(mx, __shfl_xor(mx, 32)); \
        float ls = 0.f; \
        _Pragma("unroll") for (int kb = 0; kb < 9; ++kb) \
            _Pragma("unroll") for (int r = 0; r < 4; ++r) { const float pe = __builtin_amdgcn_exp2f(S[kb][r] - mx); S[kb][r] = pe; ls += pe; } \
        ls += __shfl_xor(ls, 16); ls += __shfl_xor(ls, 32); \
        bf16x8 pf[5]; \
        _Pragma("unroll") for (int c = 0; c < 5; ++c) { v4u t; t.x = cvtpk(S[2 * c][0], S[2 * c][1]); t.y = cvtpk(S[2 * c][2], S[2 * c][3]); \
            if (c < 4) { t.z = cvtpk(S[2 * c + 1][0], S[2 * c + 1][1]); t.w = cvtpk(S[2 * c + 1][2], S[2 * c + 1][3]); } else { t.z = 0u; t.w = 0u; } \
            pf[c] = __builtin_bit_cast(bf16x8, t); } \
        asm volatile("s_waitcnt vmcnt(0) lgkmcnt(0)" ::: "memory"); __builtin_amdgcn_s_barrier(); asm volatile("" ::: "memory"); \
        if ((u) + 1 < u1) { int b2, gi2, hh2, res2, blk2; attn_unit_geom((u) + 1, b2, gi2, hh2, res2, blk2); const int lg2 = 2 * gi2, q02 = blk2 * 128; \
            if (blk2 == 0) attn_dma_k_half(F, pb, b2, lg2, T >> lg2, res2, gi2 * 4 + hh2, q02, q02 & 255); \
            attn_dma_k_half(F, pb, b2, lg2, T >> lg2, res2, gi2 * 4 + hh2, q02, (q02 + 128) & 255); } \
        asm volatile("" ::: "memory");                                \
        const float il = 1.f / ls; \
        int vlo[5], vhi[5]; \
        _Pragma("unroll") for (int c = 0; c < 5; ++c) { vlo[c] = voff + ((s8 + 2 * c) & 15) * 1024; vhi[c] = (c < 4) ? voff + ((s8 + 2 * c + 1) & 15) * 1024 : vlo[c]; } \
        _Pragma("unroll") for (int db = 0; db < 8; ++db) { f32x4a o = (f32x4a){0.f, 0.f, 0.f, 0.f}; \
            _Pragma("unroll") for (int c = 0; c < 5; ++c) { const int dofs = (db >> 1) * 16384 + (db & 1) * 32; \
                const v4i16_t lo = __builtin_amdgcn_ds_read_tr16_b64_v4i16((LAS v4i16_t*)(F.lds + vlo[c] + dofs)); \
                const v4i16_t hi = __builtin_amdgcn_ds_read_tr16_b64_v4i16((LAS v4i16_t*)(F.lds + vhi[c] + dofs)); \
                const bf16x8 vf = (bf16x8){lo[0], lo[1], lo[2], lo[3], hi[0], hi[1], hi[2], hi[3]}; \
                o = __builtin_amdgcn_mfma_f32_16x16x32_bf16(vf, pf[c], o, 0, 0, 0); } \
            v2u wv; wv.x = cvtpk(o[0] * il, o[1] * il); wv.y = cvtpk(o[2] * il, o[3] * il); \
            *(v2u*)((dry ? (bf16*)(F.ws + WS_Y) + (size_t)((F.wave * 64 + lane_id()) >> 2) * B_COLS : qrow) + 16 * db + 4 * g) = wv; } \
        if (g == 0 && !dry) lse[(size_t)(b * T + ((q0 + 16 * w + qi) << lg) + res) * 12 + head] = mx + __builtin_amdgcn_logf(ls); \
        asm volatile("" :: "v"(qnx[0]), "v"(qnx[1]), "v"(qnx[2]), "v"(qnx[3]));     \
    } while (0)
    for (int u = u0; u < u1; u += 2) {
        ATTN_UNIT(u, qA, qB);
        if (u + 1 < u1) ATTN_UNIT(u + 1, qB, qA);
    }
#undef ATTN_UNIT
#undef ATTN_LOADQ
    asm volatile("s_waitcnt vmcnt(0) lgkmcnt(0)" ::: "memory"); __builtin_amdgcn_s_barrier();
#ifdef PROBE_AT
    if (blockIdx.x == 0 && (F.wave * 64 + lane_id()) == 0) ((float*)(F.ws + WS_CTL + 32768))[0] = (float)((double)(((__builtin_amdgcn_s_memtime() - pat_t0) / (unsigned long long)(u1 - u0) + 1024ull) >> 11 << 11) / 65536.0);
#endif
}
__device__ __forceinline__ void attn_combine(Frame& F) {
    const bf16* pb = (const bf16*)(F.ws + WS_R); const float* lse = (const float*)(F.ws + WS_LSE);
    const int gw = F.vcu * NWAVES + F.wave, NGW = F.G * NWAVES, lane = lane_id(), hh = lane >> 4, d0 = (lane & 15) * 8;
    for (int m = gw; m < M; m += NGW) {
        const bf16* row = pb + (size_t)m * B_COLS;
        const float l0 = lse[(size_t)m * 12 + hh], l1 = lse[(size_t)m * 12 + 4 + hh], l2 = lse[(size_t)m * 12 + 8 + hh];
        const float mxl = fmaxf(l0, fmaxf(l1, l2)); float w0 = exp2f(l0 - mxl), w1 = exp2f(l1 - mxl), w2 = exp2f(l2 - mxl); const float iw = 1.f / (w0 + w1 + w2); w0 *= iw; w1 *= iw; w2 *= iw;
        const v4u a = *(const v4u*)(row + hh * 128 + d0), bq = *(const v4u*)(row + (4 + hh) * 128 + d0), c = *(const v4u*)(row + (8 + hh) * 128 + d0), gt = *(const v4u*)(row + 3 * B_QKV + hh * 128 + d0);
        v4u o;
        o.x = pk2((w0 * bflo(a.x) + w1 * bflo(bq.x) + w2 * bflo(c.x)) * bflo(gt.x), (w0 * bfhi(a.x) + w1 * bfhi(bq.x) + w2 * bfhi(c.x)) * bfhi(gt.x));
        o.y = pk2((w0 * bflo(a.y) + w1 * bflo(bq.y) + w2 * bflo(c.y)) * bflo(gt.y), (w0 * bfhi(a.y) + w1 * bfhi(bq.y) + w2 * bfhi(c.y)) * bfhi(gt.y));
        o.z = pk2((w0 * bflo(a.z) + w1 * bflo(bq.z) + w2 * bflo(c.z)) * bflo(gt.z), (w0 * bfhi(a.z) + w1 * bfhi(bq.z) + w2 * bfhi(c.z)) * bfhi(gt.z));
        o.w = pk2((w0 * bflo(a.w) + w1 * bflo(bq.w) + w2 * bflo(c.w)) * bflo(gt.w), (w0 * bfhi(a.w) + w1 * bfhi(bq.w) + w2 * bfhi(c.w)) * bfhi(gt.w));
        *(v4u*)(F.out + (size_t)m * OROW + OS_YB + (hh * 128 + d0) * 2) = o;
    }
}

#ifdef PROBE_TA
#define STAMP(k) do { if ((k) == PROBE_TA) pt_a = __builtin_amdgcn_s_memtime(); if ((k) == PROBE_TB) pt_sel += __builtin_amdgcn_s_memtime() - pt_a; } while (0)
#else
#define STAMP(k) do { } while (0)
#endif
#ifndef REP_S0
#define REP_S0 1
#define REP_S12 1
#define REP_S3 1
#define REP_S45 1
#endif
typedef float f32x4r __attribute__((ext_vector_type(4)));
constexpr int RS = 144, RM = 64 * RS;
constexpr int R_AT = 0 * RM, R_RT = 1 * RM, R_BW = 2 * RM, R_KU = 3 * RM, R_BT = 4 * RM, R_KT = 5 * RM, R_VT = 6 * RM, R_AAB = 7 * RM, R_AAK = 8 * RM, R_ARB = 9 * RM, R_ARK = 10 * RM, R_HT = 11 * RM;
constexpr int R_W2T = 12 * RM, R_A2T = 13 * RM;
constexpr int R_XK = R_BW, R_XW = R_AT, R_XA = R_RT, R_XR = R_BW, R_XV = R_KU, R_TW = R_VT;
constexpr int R_WLF = R_AT, R_ALF = R_BT, FS = 272;
constexpr int R_TI = 132096, TIS = 48, R_PC = R_TI + 3072, R_BLK = R_PC + 256, R_AD = R_BLK + 2048;
__device__ __forceinline__ bf16x8 ldfrag(LAS unsigned char* lds, int mat, int row0, int k0, int r, int g) { return *(const LAS bf16x8*)(lds + mat + (row0 + r) * RS + (k0 + 8 * g) * 2); }
__device__ __forceinline__ void storeT(LAS unsigned char* lds, int mat, const f32x4r& d, int row0, int col0, int r, int g) {
    v2u w; w.x = cvtpk(d[0], d[1]); w.y = cvtpk(d[2], d[3]); *(LAS v2u*)(lds + mat + (col0 + r) * RS + (row0 + 4 * g) * 2) = w; }
__device__ __forceinline__ bf16x8 pack2(const f32x4r& a, const f32x4r& b) { v4u t; t.x = cvtpk(a[0], a[1]); t.y = cvtpk(a[2], a[3]); t.z = cvtpk(b[0], b[1]); t.w = cvtpk(b[2], b[3]); return __builtin_bit_cast(bf16x8, t); }
__device__ __forceinline__ bf16x8 pack1(const f32x4r& a) { v4u t; t.x = cvtpk(a[0], a[1]); t.y = cvtpk(a[2], a[3]); t.z = 0u; t.w = 0u; return __builtin_bit_cast(bf16x8, t); }
__device__ __forceinline__ bf16x8 ld2x4(LAS unsigned char* lds, int off0, int off1) { const v2u a = *(const LAS v2u*)(lds + off0), b = *(const LAS v2u*)(lds + off1); v4u t; t.x = a.x; t.y = a.y; t.z = b.x; t.w = b.y; return __builtin_bit_cast(bf16x8, t); }
#define MF16(a, b, c) __builtin_amdgcn_mfma_f32_16x16x32_bf16((a), (b), (c), 0, 0, 0)
#define WGBAR() do { asm volatile("s_waitcnt lgkmcnt(0)" ::: "memory"); __builtin_amdgcn_s_barrier(); asm volatile("" ::: "memory"); } while (0)
template <int CTRL> __device__ __forceinline__ float dppf(float x) { return __builtin_bit_cast(float, __builtin_amdgcn_update_dpp(0, __builtin_bit_cast(int, x), CTRL, 0xF, 0xF, true)); }
__device__ __forceinline__ float row16_sum(float v) { v += dppf<0xB1>(v); v += dppf<0x4E>(v); v += dppf<0x141>(v); v += dppf<0x140>(v); return v; }
__device__ __forceinline__ float wave_sum_dpp(float v) { v = row16_sum(v);
    return (__builtin_bit_cast(float, __builtin_amdgcn_readlane(__builtin_bit_cast(int, v), 0)) + __builtin_bit_cast(float, __builtin_amdgcn_readlane(__builtin_bit_cast(int, v), 16)))
         + (__builtin_bit_cast(float, __builtin_amdgcn_readlane(__builtin_bit_cast(int, v), 32)) + __builtin_bit_cast(float, __builtin_amdgcn_readlane(__builtin_bit_cast(int, v), 48))); }
template <bool RSQ = false> __device__ __forceinline__ void reduce8(const float (&v)[8], float (&s)[8], float& v0, float& v1, int lane) {
    const bool b0 = lane & 1, b1 = lane & 2; float r1[4], r2[2];
#pragma unroll
    for (int i = 0; i < 4; ++i) { const float keep = b0 ? v[2 * i + 1] : v[2 * i], send = b0 ? v[2 * i] : v[2 * i + 1]; r1[i] = keep + dppf<0xB1>(send); }
#pragma unroll
    for (int i = 0; i < 2; ++i) { const float keep = b1 ? r1[2 * i + 1] : r1[2 * i], send = b1 ? r1[2 * i] : r1[2 * i + 1]; r2[i] = keep + dppf<0x4E>(send); }
#pragma unroll
    for (int i = 0; i < 2; ++i) { float x = r2[i]; x += dppf<0x124>(x); x += dppf<0x128>(x);
        x += __builtin_bit_cast(float, __builtin_amdgcn_ds_swizzle(__builtin_bit_cast(int, x), 0x401F));
        x += __shfl_xor(x, 32);
        r2[i] = x; }
    if (RSQ) { r2[0] = __builtin_amdgcn_rsqf(fmaxf(r2[0], 1e-24f)); r2[1] = __builtin_amdgcn_rsqf(fmaxf(r2[1], 1e-24f)); }
    v0 = r2[0]; v1 = r2[1];
#pragma unroll
    for (int q = 0; q < 8; ++q) s[q] = __builtin_bit_cast(float, __builtin_amdgcn_readlane(__builtin_bit_cast(int, r2[q >> 2]), q & 3));
}
typedef float f2v __attribute__((ext_vector_type(2)));
__device__ __forceinline__ f2v exp2v(f2v x) { return (f2v){__builtin_amdgcn_exp2f(x.x), __builtin_amdgcn_exp2f(x.y)}; }
__device__ __forceinline__ f2v rcpv(f2v x) { return (f2v){__builtin_amdgcn_rcpf(x.x), __builtin_amdgcn_rcpf(x.y)}; }
__device__ __forceinline__ unsigned cvtpk2(f2v v) { bf16x2_t b = __builtin_convertvector(v, bf16x2_t); return __builtin_bit_cast(unsigned, b); }
__device__ __forceinline__ float fast_tanh(float x) { const float e = __expf(2.f * x); return 1.f - 2.f * __builtin_amdgcn_rcpf(e + 1.f); }
template <bool RV> __device__ __forceinline__ void rwkv_load_rows(__amdgpu_buffer_rsrc_t rsrc, int b, int d, int c, int w, unsigned o_r, unsigned o_w, unsigned (&x0)[10], unsigned (&x1)[10], unsigned (&x2)[10]) {
    const int s0 = c * 64 + 8 * w - 1;
#pragma unroll
    for (int k = 0; k < 10; ++k) { const int s = s0 + k; int tk = d ? T - 1 - s : s; tk = tk < 0 ? 0 : (tk > T - 1 ? T - 1 : tk);
        const int so = __builtin_amdgcn_readfirstlane((b * T + tk) * (A_COLS * 2));
        if (RV) { x0[k] = __builtin_amdgcn_raw_buffer_load_b32(rsrc, o_r, so, 0); x1[k] = __builtin_amdgcn_raw_buffer_load_b32(rsrc, o_r + 2 * A_W * 2, so, 0); }
        else { x0[k] = __builtin_amdgcn_raw_buffer_load_b32(rsrc, o_r + A_W * 2, so, 0); x1[k] = __builtin_amdgcn_raw_buffer_load_b32(rsrc, o_w, so, 0); x2[k] = __builtin_amdgcn_raw_buffer_load_b32(rsrc, o_w + 2 * RANK * 2, so, 0); } }
}
__device__ __forceinline__ bf16x8 ldfragT(LAS unsigned char* lds, int mat, int m0, int k0, int lane) {
    const int i16 = lane & 15, g = lane >> 4, q = i16 >> 2, pq = i16 & 3; const int off = mat + (k0 + 8 * g + q) * RS + (m0 + 4 * pq) * 2;
    const v4i16_t lo = __builtin_amdgcn_ds_read_tr16_b64_v4i16((LAS v4i16_t*)(lds + off)), hi = __builtin_amdgcn_ds_read_tr16_b64_v4i16((LAS v4i16_t*)(lds + off + 4 * RS));
    return (bf16x8){lo[0], lo[1], lo[2], lo[3], hi[0], hi[1], hi[2], hi[3]};
}
__device__ __forceinline__ void rwkv_chunked(Frame& F, const int chain) {
    if (chain >= 2 * NB * A_HEADS) return;
    const int d = chain / (NB * A_HEADS), rem = chain % (NB * A_HEADS), b = rem >> 3, hd = rem & 7;
    const bf16* pa = (const bf16*)(F.ws + WS_PA); bf16* ybuf = (bf16*)(F.ws + WS_Y) + (size_t)d * M * A_W; float* bon = (float*)(F.ws + WS_BON) + (size_t)d * M * 8;
    const int ko = kopaque(); const float *w2_ = kin(I_W2, ko), *a2_ = kin(I_A2, ko), *mu_ = kin(I_MU, ko), *w0_ = kin(I_W0, ko), *a0_ = kin(I_A0, ko), *kk_ = kin(I_KK, ko), *ka_ = kin(I_KA, ko), *rk_ = kin(I_RK, ko);
    LAS unsigned char* L = F.lds;
    int lane = lane_id(); asm volatile("" : "+v"(lane));
    const int w = F.wave, j = lane, ch = hd * 64 + j;
    int r, g;
#define RELANE() do { int ln_ = lane; asm volatile("" : "+v"(ln_)); r = ln_ & 15; g = ln_ >> 4; } while (0)
    for (int i = (F.wave * 64 + lane_id()); i < 4096; i += NWAVES * 64) { const int jo = i >> 6, jr = i & 63;
        *(LAS bf16*)(L + R_W2T + jo * RS + jr * 2) = (bf16)f2bf(w2_[((size_t)d * RANK + jr) * A_W + hd * 64 + jo]);
        *(LAS bf16*)(L + R_A2T + jo * RS + jr * 2) = (bf16)f2bf(a2_[((size_t)d * RANK + jr) * A_W + hd * 64 + jo]); }
    for (int i = (F.wave * 64 + lane_id()); i < 5 * RM / 4; i += NWAVES * 64) ((LAS unsigned*)(L + R_AAB))[i] = 0u;
    const int cr = ch, ck = A_W + ch, cv = 2 * A_W + ch, cw = 4 * A_W + d * RANK + j, ca = 4 * A_W + 2 * RANK + d * RANK + j;
    const float mr0 = mu_[cr], mr1 = mu_[A_COLS + cr], mk0 = mu_[ck], mk1 = mu_[A_COLS + ck], mv0 = mu_[cv], mv1 = mu_[A_COLS + cv];
    const float mw0 = mu_[cw], mw1 = mu_[A_COLS + cw], ma0 = mu_[ca], ma1 = mu_[A_COLS + ca];
    const __amdgpu_buffer_rsrc_t rsrc = __builtin_amdgcn_make_buffer_rsrc((void*)pa, 0, M * A_COLS * 2, 0x00020000);
#define O_R ((unsigned)(((hd * 64 + lnow_) * 2) & ~3))
#define O_W ((unsigned)(((4 * A_W + d * RANK + lnow_) * 2) & ~3))
#define PSEL ((lnow_ & 1) ? 0x07060c0cu : 0x05040c0cu)
    const float sr0 = d ? mr1 : mr0, sr1 = d ? mr0 : mr1, sk0 = d ? mk1 : mk0, sk1 = d ? mk0 : mk1, sv0 = d ? mv1 : mv0, sv1 = d ? mv0 : mv1, sw0 = d ? mw1 : mw0, sw1 = d ? mw0 : mw1, sa0 = d ? ma1 : ma0, sa1 = d ? ma0 : ma1;
    const float w0j = w0_[d * A_W + ch], a0j = a0_[d * A_W + ch], kkj = kk_[ch], kaj = ka_[ch], rkj = rk_[ch];
    const int vt = w & 3;
    f32x4r Hs[4];
#pragma unroll
    for (int i = 0; i < 4; ++i) Hs[i] = (f32x4r){0.f, 0.f, 0.f, 0.f};
    v4u qk, qw, qa, qr, qv; unsigned hk = 0u, hw = 0u, ha = 0u, hr = 0u, hv = 0u;
    const int sob = __builtin_amdgcn_readfirstlane(b * T * (A_COLS * 2));
#define RAW_ISSUE(cn) do { int ln_ = lane; asm volatile("" : "+v"(ln_)); \
        const int s_ = (cn) * 64 + 8 * w + (ln_ >> 3), tk_ = d ? T - 1 - s_ : s_; \
        const unsigned vr_ = (unsigned)tk_ * (A_COLS * 2) + hd * 128 + 16 * (ln_ & 7), vw_ = (unsigned)tk_ * (A_COLS * 2) + (4 * A_W + d * RANK) * 2 + 16 * (ln_ & 7); \
        qk = __builtin_bit_cast(v4u, __builtin_amdgcn_raw_buffer_load_b128(rsrc, vr_ + A_W * 2, sob, 0)); qw = __builtin_bit_cast(v4u, __builtin_amdgcn_raw_buffer_load_b128(rsrc, vw_, sob, 0)); \
        qa = __builtin_bit_cast(v4u, __builtin_amdgcn_raw_buffer_load_b128(rsrc, vw_ + 2 * RANK * 2, sob, 0)); \
        qr = __builtin_bit_cast(v4u, __builtin_amdgcn_raw_buffer_load_b128(rsrc, vr_, sob, 0)); qv = __builtin_bit_cast(v4u, __builtin_amdgcn_raw_buffer_load_b128(rsrc, vr_ + 2 * A_W * 2, sob, 0)); \
        if (w == 7) { const int sh_ = (cn) * 64 + ((ln_ >> 5) ? 64 : -1); int th_ = d ? T - 1 - sh_ : sh_; th_ = th_ < 0 ? 0 : (th_ > T - 1 ? T - 1 : th_); \
            const unsigned hr_ = (unsigned)th_ * (A_COLS * 2) + hd * 128 + 4 * (ln_ & 31), hw_ = (unsigned)th_ * (A_COLS * 2) + (4 * A_W + d * RANK) * 2 + 4 * (ln_ & 31); \
            hk = __builtin_amdgcn_raw_buffer_load_b32(rsrc, hr_ + A_W * 2, sob, 0); hw = __builtin_amdgcn_raw_buffer_load_b32(rsrc, hw_, sob, 0); ha = __builtin_amdgcn_raw_buffer_load_b32(rsrc, hw_ + 2 * RANK * 2, sob, 0); \
            hr = __builtin_amdgcn_raw_buffer_load_b32(rsrc, hr_, sob, 0); hv = __builtin_amdgcn_raw_buffer_load_b32(rsrc, hr_ + 2 * A_W * 2, sob, 0); } } while (0)
#define RAW_PUT(cn, m0_, q0_, h0_, m1_, q1_, h1_) do { int ln_ = lane; asm volatile("" : "+v"(ln_)); const int o_ = 128 + 1024 * w + 16 * ln_; \
        *(LAS v4u*)(L + (m0_) + o_) = (q0_); *(LAS v4u*)(L + (m1_) + o_) = (q1_); \
        if (w == 7) { const int sh_ = (cn) * 64 + ((ln_ >> 5) ? 64 : -1); const bool okh_ = sh_ >= 0 && sh_ < T; const int ho_ = ((ln_ >> 5) ? 65 * 128 : 0) + 4 * (ln_ & 31); \
            *(LAS unsigned*)(L + (m0_) + ho_) = okh_ ? (h0_) : 0u; *(LAS unsigned*)(L + (m1_) + ho_) = okh_ ? (h1_) : 0u; } } while (0)
#define RAW_PUT1(cn, m0_, q0_, h0_) do { int ln_ = lane; asm volatile("" : "+v"(ln_)); const int o_ = 128 + 1024 * w + 16 * ln_; \
        *(LAS v4u*)(L + (m0_) + o_) = (q0_); \
        if (w == 7) { const int sh_ = (cn) * 64 + ((ln_ >> 5) ? 64 : -1); const bool okh_ = sh_ >= 0 && sh_ < T; const int ho_ = ((ln_ >> 5) ? 65 * 128 : 0) + 4 * (ln_ & 31); \
            *(LAS unsigned*)(L + (m0_) + ho_) = okh_ ? (h0_) : 0u; } } while (0)
    RAW_ISSUE(0);
    RAW_PUT(0, R_XW, qw, hw, R_XA, qa, ha); RAW_PUT1(0, R_XK, qk, hk);
    WGBAR();
    bf16x8 w2f[2][2], a2f[2][2];
    { RELANE();
#pragma unroll
      for (int j2 = 0; j2 < 2; ++j2)
#pragma unroll
        for (int k2 = 0; k2 < 2; ++k2) { w2f[j2][k2] = ldfrag(L, R_W2T, 16 * (2 * (w & 1) + j2), 32 * k2, r, g); a2f[j2][k2] = ldfrag(L, R_A2T, 16 * (2 * (w & 1) + j2), 32 * k2, r, g); } }
#ifdef PROBE_TA
    unsigned long long pt_a = 0, pt_sel = 0; const unsigned long long pt_t0 = __builtin_amdgcn_s_memtime();
#endif
    for (int c = 0; c < T / 64; ++c) {
        STAMP(0);
        f2v ks2[4], kn2[4];
        for (int rep0_ = 0; rep0_ < REP_S0; ++rep0_) {
        int lnow_ = lane; asm volatile("" : "+v"(lnow_)); const unsigned psel = PSEL;
#define XF(x, k) __builtin_bit_cast(float, __builtin_amdgcn_perm(*(const LAS unsigned*)(L + (x) + (8 * w + (k)) * 128 + (lnow_ >> 1) * 4), 0u, psel))
#define SH2(dst, x, m0, m1) do { float xf_[10]; _Pragma("unroll") for (int k_ = 0; k_ < 10; ++k_) xf_[k_] = XF(x, k_); const float mc_ = 1.f - (m0) - (m1); \
        _Pragma("unroll") for (int q2_ = 0; q2_ < 4; ++q2_) (dst)[q2_] = (f2v){xf_[2 * q2_ + 1], xf_[2 * q2_ + 2]} * mc_ + (f2v){xf_[2 * q2_], xf_[2 * q2_ + 1]} * (m0) + (f2v){xf_[2 * q2_ + 2], xf_[2 * q2_ + 3]} * (m1); } while (0)
        { unsigned tw_[4], al_[4];
          { f2v ws2[4]; SH2(ws2, R_XW, sw0, sw1);
#pragma unroll
            for (int q2 = 0; q2 < 4; ++q2) { const f2v e2 = exp2v(ws2[q2] * 2.8853900817779268f); tw_[q2] = cvtpk2(1.f - 2.f * rcpv(e2 + 1.f)); } }
          asm volatile("" ::: "memory");
          { f2v as2[4]; SH2(as2, R_XA, sa0, sa1);
#pragma unroll
            for (int q2 = 0; q2 < 4; ++q2) al_[q2] = cvtpk2(as2[q2]); }
          asm volatile("" ::: "memory");
          SH2(ks2, R_XK, sk0, sk1);
#pragma unroll
          for (int q2 = 0; q2 < 4; ++q2) kn2[q2] = ks2[q2] * kkj;
          *(LAS v4u*)(L + R_TW + j * RS + 16 * w) = (v4u){tw_[0], tw_[1], tw_[2], tw_[3]};
          *(LAS v4u*)(L + R_KU + j * RS + 16 * w) = (v4u){al_[0], al_[1], al_[2], al_[3]}; }
        { float sq[8], n2[8], d0_, d1_;
#pragma unroll
          for (int q2 = 0; q2 < 4; ++q2) { const f2v s = kn2[q2] * kn2[q2]; sq[2 * q2] = s.x; sq[2 * q2 + 1] = s.y; }
          reduce8<true>(sq, n2, d0_, d1_, lane);
#pragma unroll
          for (int q2 = 0; q2 < 4; ++q2) kn2[q2] *= (f2v){n2[2 * q2], n2[2 * q2 + 1]}; }
        WGBAR();
        STAMP(1);
        RELANE();
        { const int it = w >> 1;
          bf16x8 ta[2], aa[2];
#pragma unroll
          for (int k2 = 0; k2 < 2; ++k2) { ta[k2] = ldfragT(L, R_TW, 16 * it, 32 * k2, lane); aa[k2] = ldfragT(L, R_KU, 16 * it, 32 * k2, lane); }
#pragma unroll
          for (int j2 = 0; j2 < 2; ++j2) { const int jt = 2 * (w & 1) + j2; f32x4r dw = (f32x4r){0.f, 0.f, 0.f, 0.f}, da = dw;
#pragma unroll
              for (int k2 = 0; k2 < 2; ++k2) { dw = MF16(ta[k2], w2f[j2][k2], dw); da = MF16(aa[k2], a2f[j2][k2], da); }
#pragma unroll
              for (int e = 0; e < 4; ++e) { *(LAS float*)(L + R_WLF + (16 * it + 4 * g + e) * FS + (16 * jt + r) * 4) = dw[e]; *(LAS float*)(L + R_ALF + (16 * it + 4 * g + e) * FS + (16 * jt + r) * 4) = da[e]; } } }
        WGBAR();
        STAMP(2);
        f2v av2[4]; float cp[8]; float run = 1.f;
#pragma unroll
        for (int q2 = 0; q2 < 4; ++q2) { const int i0 = 8 * w + 2 * q2;
            const f2v wl = (f2v){*(const LAS float*)(L + R_WLF + i0 * FS + j * 4), *(const LAS float*)(L + R_WLF + (i0 + 1) * FS + j * 4)} + w0j;
            const f2v al = (f2v){*(const LAS float*)(L + R_ALF + i0 * FS + j * 4), *(const LAS float*)(L + R_ALF + (i0 + 1) * FS + j * 4)} + a0j;
            const f2v dec = exp2v(rcpv(exp2v(wl * -1.4426950408889634f) + 1.f) * (-0.6065306597126334f * 1.4426950408889634f));
            av2[q2] = rcpv(exp2v(al * -1.4426950408889634f) + 1.f);
            run *= dec.x; cp[2 * q2] = run; run *= dec.y; cp[2 * q2 + 1] = run; }
        *(LAS float*)(L + R_BLK + (w * 64 + j) * 4) = run;
        RAW_PUT(c, R_XR, qr, hr, R_XV, qv, hv);
        WGBAR();
        STAMP(3);
        { float off = 1.f; float bt_[8];
#pragma unroll
          for (int w2 = 0; w2 < 8; ++w2) bt_[w2] = *(const LAS float*)(L + R_BLK + (w2 * 64 + j) * 4);
#define OFFSTEP(k) if (w > (k)) { asm volatile("" : "+v"(off)); off *= bt_[k];
          OFFSTEP(0) OFFSTEP(1) OFFSTEP(2) OFFSTEP(3) OFFSTEP(4) OFFSTEP(5) OFFSTEP(6) } } } } } } }
#undef OFFSTEP
          if (w == 0) { asm volatile("" : "+v"(off)); *(LAS float*)(L + R_PC + j * 4) = ((bt_[0] * bt_[1]) * (bt_[2] * bt_[3])) * ((bt_[4] * bt_[5]) * (bt_[6] * bt_[7])); }
          f2v rs2[4], vs2[4], kd2[4]; SH2(rs2, R_XR, sr0, sr1); SH2(vs2, R_XV, sv0, sv1);
          asm volatile("" :: "v"(rs2[0]), "v"(rs2[1]), "v"(rs2[2]), "v"(rs2[3]), "v"(vs2[0]), "v"(vs2[1]), "v"(vs2[2]), "v"(vs2[3]) : "memory");
          { float bp[8], bs[8], b0_, b1_;
#pragma unroll
            for (int q2 = 0; q2 < 4; ++q2) { kd2[q2] = ks2[q2] * (av2[q2] * kaj + (1.f - kaj)); const f2v t = rs2[q2] * kd2[q2] * rkj; bp[2 * q2] = t.x; bp[2 * q2 + 1] = t.y; }
            reduce8(bp, bs, b0_, b1_, lane);
            if (lane < 4) { const int sb_ = c * 64 + 8 * w;
                float* q0_ = bon + (size_t)(b * T + (d ? T - 1 - sb_ - 3 : sb_)) * 8 + hd; float* q1_ = bon + (size_t)(b * T + (d ? T - 1 - sb_ - 7 : sb_ + 4)) * 8 + hd;
                const unsigned lo_ = (unsigned)(d ? 3 - lane : lane) * 8u; q0_[lo_] = b0_; q1_[lo_] = b1_; } }
          unsigned pa_[4], pr_[4], pb_[4], pk_[4], pv_[4];
#pragma unroll
          for (int q2 = 0; q2 < 4; ++q2) { const int qa = 2 * q2;
              const f2v pt = (f2v){cp[qa], cp[qa + 1]} * off; const f2v pm = (f2v){(qa == 0) ? off : off * cp[qa > 0 ? qa - 1 : 0], pt.x}; const f2v em = rcpv(pt);
              pa_[q2] = cvtpk2(-kn2[q2] * pm); pr_[q2] = cvtpk2(rs2[q2] * pt); pb_[q2] = cvtpk2(kn2[q2] * av2[q2] * em); pk_[q2] = cvtpk2(kd2[q2] * em); pv_[q2] = cvtpk2(vs2[q2]); }
          *(LAS v4u*)(L + R_AT + j * RS + 16 * w) = (v4u){pa_[0], pa_[1], pa_[2], pa_[3]};
          *(LAS v4u*)(L + R_RT + j * RS + 16 * w) = (v4u){pr_[0], pr_[1], pr_[2], pr_[3]};
          *(LAS v4u*)(L + R_BT + j * RS + 16 * w) = (v4u){pb_[0], pb_[1], pb_[2], pb_[3]};
          *(LAS v4u*)(L + R_KT + j * RS + 16 * w) = (v4u){pk_[0], pk_[1], pk_[2], pk_[3]};
          *(LAS v4u*)(L + R_VT + j * RS + 16 * w) = (v4u){pv_[0], pv_[1], pv_[2], pv_[3]}; }
        WGBAR();
#undef SH2
#undef XF
        }
        STAMP(4);
        if (c + 1 < T / 64) RAW_ISSUE(c + 1);
        STAMP(5);
        RELANE();
        f32x4r A0[4], KV[4];
#define tc(i) KV[(i) >> 2][(i) & 3]
        for (int rep1_ = 0; rep1_ < REP_S12; ++rep1_) {
        if (w == 0) {
#pragma unroll
            for (int i = 0; i < 4; ++i) { f32x4r dd = (f32x4r){0.f, 0.f, 0.f, 0.f};
#pragma unroll
                for (int k2 = 0; k2 < 2; ++k2) dd = MF16(ldfragT(L, R_BT, 16 * i, 32 * k2, lane), ldfragT(L, R_AT, 16 * i, 32 * k2, lane), dd);
#pragma unroll
                for (int e = 0; e < 4; ++e) if (4 * g + e >= r) dd[e] = 0.f;
                storeT(L, R_AAB, dd, 16 * i, 16 * i, r, g);
                *(LAS f32x4r*)(L + R_AD + i * 1024 + r * 64 + 16 * g) = dd; }
            asm volatile("s_waitcnt lgkmcnt(0)" ::: "memory");
            const int blk = lane >> 4, cc = lane & 15;
#pragma unroll
            for (int rr = 0; rr < 8; ++rr) { float acc = (rr == cc) ? 1.f : 0.f;
#pragma unroll
                for (int s4 = 0; s4 < (rr + 3) / 4; ++s4) { const f32x4r a4 = *(const LAS f32x4r*)(L + R_AD + blk * 1024 + rr * 64 + s4 * 16);
#pragma unroll
                    for (int e = 0; e < 4; ++e) if (4 * s4 + e < rr) acc += a4[e] * tc(4 * s4 + e); }
                tc(rr) = acc; *(LAS bf16*)(L + R_TI + (16 * blk + rr) * TIS + cc * 2) = (bf16)f2bf(acc); }
        } else {
#define S1TILE(fa_, fb_, mat_, ts_, tt_, DIAG, INCL) { f32x4r dd = (f32x4r){0.f, 0.f, 0.f, 0.f}; \
                _Pragma("unroll") for (int k2 = 0; k2 < 2; ++k2) dd = MF16(fa_[k2], fb_[k2], dd); \
                if (DIAG) { _Pragma("unroll") for (int e = 0; e < 4; ++e) { const int sl = 4 * g + e; if ((INCL) ? (sl > r) : (sl >= r)) dd[e] = 0.f; } } \
                storeT(L, mat_, dd, 16 * (ts_), 16 * (tt_), r, g); }
            if (w < 7) {
                const int p = w - 1, ts = (0x211000 >> (4 * p)) & 15, tt = (0x332321 >> (4 * p)) & 15;
                bf16x8 fB[2], fK[2], fA[2], fR[2], fX[2];
#pragma unroll
                for (int k2 = 0; k2 < 2; ++k2) { fB[k2] = ldfragT(L, R_BT, 16 * ts, 32 * k2, lane); fK[k2] = ldfragT(L, R_KT, 16 * ts, 32 * k2, lane); fA[k2] = ldfragT(L, R_AT, 16 * tt, 32 * k2, lane); fR[k2] = ldfragT(L, R_RT, 16 * tt, 32 * k2, lane); }
                const int xm_ = (w == 6) ? R_RT : ((w == 2 || w == 3) ? R_KT : R_BT), xr_ = (w == 6) ? ts : tt;
#pragma unroll
                for (int k2 = 0; k2 < 2; ++k2) fX[k2] = ldfragT(L, xm_, 16 * xr_, 32 * k2, lane);
                S1TILE(fB, fA, R_AAB, ts, tt, false, false) S1TILE(fK, fA, R_AAK, ts, tt, false, false) S1TILE(fB, fR, R_ARB, ts, tt, false, true) S1TILE(fK, fR, R_ARK, ts, tt, false, true)
                if (w == 6) S1TILE(fK, fX, R_ARK, ts, ts, true, true)
                else if (w == 2 || w == 3) { S1TILE(fX, fA, R_AAK, tt, tt, true, false) if (w == 3) S1TILE(fX, fR, R_ARK, tt, tt, true, true) }
                else S1TILE(fX, fR, R_ARB, tt, tt, true, true)
            } else {
                bf16x8 fK0[2], fA0[2], fB0[2], fR0[2], fK1[2], fA1[2], fR1[2];
#pragma unroll
                for (int k2 = 0; k2 < 2; ++k2) { fK0[k2] = ldfragT(L, R_KT, 0, 32 * k2, lane); fA0[k2] = ldfragT(L, R_AT, 0, 32 * k2, lane); fB0[k2] = ldfragT(L, R_BT, 0, 32 * k2, lane); fR0[k2] = ldfragT(L, R_RT, 0, 32 * k2, lane);
                    fK1[k2] = ldfragT(L, R_KT, 16, 32 * k2, lane); fA1[k2] = ldfragT(L, R_AT, 16, 32 * k2, lane); fR1[k2] = ldfragT(L, R_RT, 16, 32 * k2, lane); }
                S1TILE(fK0, fA0, R_AAK, 0, 0, true, false) S1TILE(fB0, fR0, R_ARB, 0, 0, true, true) S1TILE(fK0, fR0, R_ARK, 0, 0, true, true)
                S1TILE(fK1, fA1, R_AAK, 1, 1, true, false) S1TILE(fK1, fR1, R_ARK, 1, 1, true, true)
            }
#undef S1TILE
        }
        WGBAR();
        STAMP(6);
        RELANE();
        if (w == 0) {
            const int blk = lane >> 4, cc = lane & 15;
#pragma unroll
            for (int rr = 8; rr < 16; ++rr) { float acc = (rr == cc) ? 1.f : 0.f;
#pragma unroll
                for (int s4 = 0; s4 < (rr + 3) / 4; ++s4) { const f32x4r a4 = *(const LAS f32x4r*)(L + R_AD + blk * 1024 + rr * 64 + s4 * 16);
#pragma unroll
                    for (int e = 0; e < 4; ++e) if (4 * s4 + e < rr) acc += a4[e] * tc(4 * s4 + e); }
                tc(rr) = acc; *(LAS bf16*)(L + R_TI + (16 * blk + rr) * TIS + cc * 2) = (bf16)f2bf(acc); }
        } else if (w < 4) {
#pragma unroll
            for (int i = 0; i < 4; ++i) { A0[i] = (f32x4r){0.f, 0.f, 0.f, 0.f};
#pragma unroll
                for (int k2 = 0; k2 < 2; ++k2) A0[i] = MF16(ldfrag(L, R_VT, 16 * vt, 32 * k2, r, g), ldfrag(L, R_ARK, 16 * i, 32 * k2, r, g), A0[i]); }
            { int ln3_ = lane; asm volatile("" : "+v"(ln3_));
#pragma unroll
              for (int i = 0; i < 4; ++i)
#pragma unroll
                for (int k2 = 0; k2 < 2; ++k2) A0[i] = MF16(ldfrag(L, R_HT, 16 * vt, 32 * k2, r, g), ldfragT(L, R_RT, 16 * i, 32 * k2, ln3_), A0[i]); }
        } else {
#pragma unroll
            for (int i = 0; i < 4; ++i) { A0[i] = (f32x4r){0.f, 0.f, 0.f, 0.f}; KV[i] = A0[i];
#pragma unroll
                for (int k2 = 0; k2 < 2; ++k2) { const bf16x8 vf = ldfrag(L, R_VT, 16 * vt, 32 * k2, r, g);
                    A0[i] = MF16(ldfrag(L, R_AAK, 16 * i, 32 * k2, r, g), vf, A0[i]); KV[i] = MF16(ldfrag(L, R_KT, 16 * i, 32 * k2, r, g), vf, KV[i]); } }
            { int ln3_ = lane; asm volatile("" : "+v"(ln3_));
#pragma unroll
              for (int i = 0; i < 4; ++i)
#pragma unroll
                for (int k2 = 0; k2 < 2; ++k2) A0[i] = MF16(ldfragT(L, R_AT, 16 * i, 32 * k2, ln3_), ldfrag(L, R_HT, 16 * vt, 32 * k2, r, g), A0[i]); }
        }
        WGBAR();
        }
        STAMP(7);
        RELANE();
        if (w < 4) {
            if (w == 0) {
#pragma unroll
                for (int i = 0; i < 4; ++i) { A0[i] = (f32x4r){0.f, 0.f, 0.f, 0.f};
#pragma unroll
                    for (int k2 = 0; k2 < 2; ++k2) A0[i] = MF16(ldfrag(L, R_VT, 0, 32 * k2, r, g), ldfrag(L, R_ARK, 16 * i, 32 * k2, r, g), A0[i]); }
#pragma unroll
                for (int i = 0; i < 4; ++i)
#pragma unroll
                    for (int k2 = 0; k2 < 2; ++k2) A0[i] = MF16(ldfrag(L, R_HT, 16 * vt, 32 * k2, r, g), ldfragT(L, R_RT, 16 * i, 32 * k2, lane), A0[i]); }
        } else {
            f32x4r X[4];
#pragma unroll
            for (int i = 0; i < 4; ++i) X[i] = A0[i];
            const f32x4r z4 = (f32x4r){0.f, 0.f, 0.f, 0.f};
#define TIF(i) ld2x4(L, R_TI + (16 * (i) + r) * TIS + 8 * g, R_TI + (16 * (i) + r) * TIS + 8 * g)
#define ABF(i, j0) ld2x4(L, R_AAB + (16 * (i) + r) * RS + (16 * (j0) + 4 * g) * 2, R_AAB + (16 * (i) + r) * RS + (16 * ((j0) + 1) + 4 * g) * 2)
            X[0] = MF16(TIF(0), pack1(X[0]), z4);
            X[1] = MF16(ABF(1, 0), pack1(X[0]), X[1]); X[1] = MF16(TIF(1), pack1(X[1]), z4);
            X[2] = MF16(ABF(2, 0), pack2(X[0], X[1]), X[2]); X[2] = MF16(TIF(2), pack1(X[2]), z4);
            X[3] = MF16(ABF(3, 0), pack2(X[0], X[1]), X[3]); X[3] = MF16(ABF(3, 2), pack1(X[2]), X[3]); X[3] = MF16(TIF(3), pack1(X[3]), z4);
#undef TIF
#undef ABF
#pragma unroll
            for (int i = 0; i < 4; ++i) { A0[i] = X[i]; storeT(L, R_KU, X[i], 16 * i, 16 * vt, r, g); }
        }
        WGBAR();
        STAMP(8);
        STAMP(9);
        RELANE();
        for (int rep4_ = 0; rep4_ < 1; ++rep4_) {
        if (c + 1 < T / 64) { RAW_PUT(c + 1, R_XW, qw, hw, R_XA, qa, ha); RAW_PUT1(c + 1, R_XK, qk, hk); }
        if (w < 4) {
#pragma unroll
            for (int i = 0; i < 4; ++i) {
#pragma unroll
                for (int k2 = 0; k2 < 2; ++k2) A0[i] = MF16(ldfrag(L, R_KU, 16 * vt, 32 * k2, r, g), ldfrag(L, R_ARB, 16 * i, 32 * k2, r, g), A0[i]);
                const int s = c * 64 + 16 * i + r, t = d ? T - 1 - s : s; v2u yw; yw.x = cvtpk(A0[i][0], A0[i][1]); yw.y = cvtpk(A0[i][2], A0[i][3]);
                *(v2u*)(ybuf + (size_t)(b * T + t) * A_W + hd * 64 + 16 * vt + 4 * g) = yw; }
        } else {
#pragma unroll
            for (int i = 0; i < 4; ++i) { f32x4r acc = Hs[i] + KV[i];
#pragma unroll
                for (int k2 = 0; k2 < 2; ++k2) acc = MF16(ldfrag(L, R_BT, 16 * i, 32 * k2, r, g), ldfrag(L, R_KU, 16 * vt, 32 * k2, r, g), acc);
                const f32x4r pc = *(const LAS f32x4r*)(L + R_PC + (16 * i + 4 * g) * 4);
                Hs[i] = acc * pc; storeT(L, R_HT, Hs[i], 16 * i, 16 * vt, r, g); }
        }
        WGBAR();
        }
        STAMP(10);
    }
#ifdef PROBE_TA
    if (blockIdx.x == 0 && (F.wave * 64 + lane_id()) == 0) { float* pf = (float*)(F.ws + WS_CTL + 32768); pf[0] = (float)((double)pt_sel / (double)(__builtin_amdgcn_s_memtime() - pt_t0)); }
#endif
#undef RELANE
#undef RAW_ISSUE
#undef RAW_PUT
#undef RAW_PUT1
#undef tc
#undef O_R
#undef O_W
#undef PSEL
}
__device__ __forceinline__ void rwkv_post(Frame& F) {
    const bf16* pa = (const bf16*)(F.ws + WS_PA); const bf16* y0 = (const bf16*)(F.ws + WS_Y); const bf16* y1 = y0 + (size_t)M * A_W;
    const float* bon0 = (const float*)(F.ws + WS_BON); const float* bon1 = bon0 + (size_t)M * 8;
    const int ko = kopaque(); const float *lnx_w = kin(I_LNW, ko), *lnx_b = kin(I_LNB, ko), *mu_ = kin(I_MU, ko);
    int lane = lane_id(); asm volatile("" : "+v"(lane));
    const int gw = F.vcu * NWAVES + F.wave, NGW = F.G * NWAVES, hd = lane >> 3, c0 = lane * 8;
    float lw_[8], lb_[8], mv0[8], mv1[8], mg0[8], mg1[8];
#pragma unroll
    for (int e = 0; e < 8; ++e) { lw_[e] = lnx_w[c0 + e]; lb_[e] = lnx_b[c0 + e]; mv0[e] = mu_[2 * A_W + c0 + e]; mv1[e] = mu_[A_COLS + 2 * A_W + c0 + e];
        mg0[e] = mu_[3 * A_W + c0 + e]; mg1[e] = mu_[A_COLS + 3 * A_W + c0 + e]; }
    for (int m = gw; m < M; m += NGW) {
        const int t = m & (T - 1); const bool hp = t > 0, hn = t < T - 1;
        const v4u a = *(const v4u*)(y0 + (size_t)m * A_W + c0), bq = *(const v4u*)(y1 + (size_t)m * A_W + c0);
        const bf16* p0 = pa + (size_t)m * A_COLS;
        const v4u vc = *(const v4u*)(p0 + 2 * A_W + c0), gc = *(const v4u*)(p0 + 3 * A_W + c0);
        const v4u z = (v4u){0u, 0u, 0u, 0u};
        const v4u vp = hp ? *(const v4u*)(p0 - A_COLS + 2 * A_W + c0) : z, gp = hp ? *(const v4u*)(p0 - A_COLS + 3 * A_W + c0) : z;
        const v4u vn = hn ? *(const v4u*)(p0 + A_COLS + 2 * A_W + c0) : z, gn = hn ? *(const v4u*)(p0 + A_COLS + 3 * A_W + c0) : z;
        const float bsum = bon0[(size_t)m * 8 + hd] + bon1[(size_t)m * 8 + hd];
        float y[8]; const unsigned aw[4] = {a.x, a.y, a.z, a.w}, bw[4] = {bq.x, bq.y, bq.z, bq.w};
        float s1 = 0.f;
#pragma unroll
        for (int e = 0; e < 4; ++e) { y[2 * e] = bflo(aw[e]) + bflo(bw[e]); y[2 * e + 1] = bfhi(aw[e]) + bfhi(bw[e]); s1 += y[2 * e] + y[2 * e + 1]; }
        s1 += dppf<0xB1>(s1); s1 += dppf<0x4E>(s1); s1 += dppf<0x141>(s1);
        const float mean = s1 * (1.f / 64.f); float s2 = 0.f;
#pragma unroll
        for (int e = 0; e < 8; ++e) { y[e] -= mean; s2 += y[e] * y[e]; }
        s2 += dppf<0xB1>(s2); s2 += dppf<0x4E>(s2); s2 += dppf<0x141>(s2);
        const float rstd = __builtin_amdgcn_rsqf(s2 * (1.f / 64.f) + GN_EPS);
        const unsigned vcw[4] = {vc.x, vc.y, vc.z, vc.w}, vpw[4] = {vp.x, vp.y, vp.z, vp.w}, vnw[4] = {vn.x, vn.y, vn.z, vn.w}, gcw[4] = {gc.x, gc.y, gc.z, gc.w}, gpw[4] = {gp.x, gp.y, gp.z, gp.w}, gnw[4] = {gn.x, gn.y, gn.z, gn.w};
        float o[8];
#pragma unroll
        for (int e = 0; e < 8; ++e) { const int k = e >> 1; const bool hi = e & 1;
            const float v0 = hi ? bfhi(vcw[k]) : bflo(vcw[k]), vm = hi ? bfhi(vpw[k]) : bflo(vpw[k]), vx = hi ? bfhi(vnw[k]) : bflo(vnw[k]);
            const float g0 = hi ? bfhi(gcw[k]) : bflo(gcw[k]), gm = hi ? bfhi(gpw[k]) : bflo(gpw[k]), gx = hi ? bfhi(gnw[k]) : bflo(gnw[k]);
            const float vs = v0 * (1.f - mv0[e] - mv1[e]) + mv0[e] * vm + mv1[e] * vx, gs = g0 * (1.f - mg0[e] - mg1[e]) + mg0[e] * gm + mg1[e] * gx;
            o[e] = (y[e] * rstd * lw_[e] + lb_[e] + bsum * vs) * siluf_(gs); }
        v4u ov; ov.x = cvtpk(o[0], o[1]); ov.y = cvtpk(o[2], o[3]); ov.z = cvtpk(o[4], o[5]); ov.w = cvtpk(o[6], o[7]);
        *(v4u*)(F.out + (size_t)m * OROW + OS_YA + c0 * 2) = ov;
    }
}
struct Args { const float* in[24]; unsigned char* out; unsigned char* ws; };
__global__ void __launch_bounds__(NWAVES * 64, 2) hybrid_fwd(Args args) {
    extern __shared__ __attribute__((aligned(16))) unsigned char lds[];
    Frame F;
    F.lds = (LAS unsigned char*)lds;
    F.MISC = (volatile LAS unsigned*)(F.lds + MISC_OFF);
    F.wave = __builtin_amdgcn_readfirstlane((int)threadIdx.x >> 6);
    F.G = gridDim.x; { const int bx = blockIdx.x; F.vcu = (F.G % 8 == 0) ? (bx % 8) * (F.G / 8) + bx / 8 : bx; }
    F.out = args.out; F.ws = args.ws;
    for (int u = (F.wave * 64 + lane_id()); u < (LDS_BYTES - LDSCTL_OFF) / 4; u += NWAVES * 64) ((LAS unsigned*)(F.lds + LDSCTL_OFF))[u] = 0u;
    __syncthreads();
    XcdBarrier bar = xcd_barrier_post((unsigned*)(F.ws + WS_CTL) + CW_BAR, F.MISC + 8);
#define GRID_BAR() xcd_barrier(bar, F.wave)
#ifdef PROBE_G
#define PGDBG(k) ((k) == PROBE_GSEL ? (float*)(F.ws + WS_CTL + 32768) : (float*)nullptr)
#else
#define PGDBG(k) ((float*)nullptr)
#endif
    typedef pg8::bf16_t bt;
    p0a(F); GRID_BAR();
    p0b(F); GRID_BAR();
    { pg8::Gemm g{(const bt*)(F.out + OS_H), (const bt*)(F.ws + WS_WB), nullptr, nullptr, OROW / 2, D}; pg8::Order S; S.init(M, B_COLS, F.G, (int)blockIdx.x, 1);
      const int ko = kopaque(); pg8::EpiPB E{(bt*)(F.ws + WS_R), kin(I_QG, ko), kin(I_KG, ko), (LAS float*)(F.lds + EPI_OFF), PGDBG(0)};
      pg8::gemm_phase<pg8::EpiPB, pg8::Order, true, true>(F.lds + RING_OFF, g, S, E, F.wave); }
    GRID_BAR();
    attn_mfma(F); GRID_BAR();
    attn_combine(F); GRID_BAR();
    { pg8::Gemm g{(const bt*)(F.out + OS_H), (const bt*)(F.ws + WS_WAG), nullptr, nullptr, OROW / 2, D}; pg8::Order S; S.init(M, 1792, F.G, (int)blockIdx.x, 1);
      pg8::EpiAG E{(bt*)(F.ws + WS_PA), (bt*)(F.ws + WS_PG), PGDBG(1)};
      pg8::gemm_phase<pg8::EpiAG, pg8::Order, true, true>(F.lds + RING_OFF, g, S, E, F.wave); }
    GRID_BAR();
#ifdef PROBE_RT
    const unsigned long long prt0 = __builtin_amdgcn_s_memrealtime();
#endif
    {
        int chain = -1, sG = 0, sc = 0, spm0 = 0, snpm = M / 256; const int bx = (int)blockIdx.x;
        if (F.G == 256) { const int x = bx & 7, q = bx >> 3; if (x < 5) chain = q * 5 + x; else { sG = 32; sc = q; spm0 = (x - 5) * 107; snpm = x < 7 ? 107 : 106; } }
        else if (F.G > NCHAIN) { if (bx < NCHAIN) chain = bx; else { sG = F.G - NCHAIN; sc = bx - NCHAIN; } }
        else { chain = bx; sG = F.G; sc = bx; }
        if (chain >= 0) rwkv_chunked(F, chain);
        if (sG > 0) {
            pg8::Gemm g{(const bt*)(F.out + OS_H), (const bt*)(F.ws + WS_WAG) + (size_t)1792 * D, nullptr, nullptr, OROW / 2, D}; const pg8::SideOrder S{spm0, snpm, sG, sc};
            pg8::EpiPG E{(bt*)(F.ws + WS_PG), (bt*)(F.ws + WS_PA), PGDBG(4)};
            pg8::gemm_phase<pg8::EpiPG, pg8::SideOrder, true, true>(F.lds + RING_OFF, g, S, E, F.wave); } }
#ifdef PROBE_RT
    if (blockIdx.x == 0 && threadIdx.x == 0) ((float*)(F.ws + WS_CTL + 32768))[2] = (float)(__builtin_amdgcn_s_memrealtime() - prt0);
    if (blockIdx.x == PROBE_RT && threadIdx.x == 0) ((float*)(F.ws + WS_CTL + 32768))[3] = (float)(__builtin_amdgcn_s_memrealtime() - prt0);
#endif
    GRID_BAR();
    rwkv_post(F); GRID_BAR();
    { pg8::Gemm g{(const bt*)(F.out + OS_YA), (const bt*)(F.ws + WS_WOA), (const bt*)(F.out + OS_YB), (const bt*)(F.ws + WS_WOB), OROW / 2, A_W}; pg8::Order S; S.init(M, D, F.G, (int)blockIdx.x, 2);
      pg8::EpiMerge E{(const bt*)(F.ws + WS_PG), (bt*)(F.ws + WS_Y), PGDBG(2)};
      pg8::gemm_phase<pg8::EpiMerge, pg8::Order, true, true>(F.lds + RING_OFF, g, S, E, F.wave); }
    GRID_BAR();
    { pg8::Gemm g{(const bt*)(F.ws + WS_Y), (const bt*)(F.ws + WS_WO), nullptr, nullptr, D, D}; pg8::Order S; S.init(M, D, F.G, (int)blockIdx.x, 1);
      const int ko = kopaque(); pg8::EpiOut E{kin(I_XP, ko), kin(I_XS, ko), (const float*)(F.ws + WS_MOD), (float*)F.out, PGDBG(3)};
      pg8::gemm_phase<pg8::EpiOut, pg8::Order, true, true>(F.lds + RING_OFF, g, S, E, F.wave); }
#if defined(PROBE_TA) || defined(PROBE_G) || defined(PROBE_AT) || defined(PROBE_RT)
    GRID_BAR();
#ifdef PROBE_RT
    { const float* pf_ = (const float*)(F.ws + WS_CTL + 32768); const float f = 0.5f * pf_[3] / pf_[2]; float* o = (float*)F.out;
#else
    { const float f = ((const float*)(F.ws + WS_CTL + 32768))[0]; float* o = (float*)F.out;
#endif
      for (int i = blockIdx.x * 512 + (F.wave * 64 + lane_id()); i < 655 * 1024; i += gridDim.x * 512) o[i] *= (1.f + f); }
#endif
}

extern "C" void kernel_launch(void* const* d_in, const int* in_sizes, int n_in, void* d_out, int out_size, void* d_ws, size_t ws_size, hipStream_t stream) {
    static int grid = 0;
    if (grid == 0) {
        if (n_in != 24 || out_size != M * D || ws_size < WS_END) { fprintf(stderr, "kernel_launch: unexpected shapes: n_in %d out %d ws %zu (need %zu)\n", n_in, out_size, ws_size, (size_t)WS_END); grid = -1; return; }
        int dev = 0, cus = 0, per_cu = 0;
        if (hipGetDevice(&dev) != hipSuccess || hipDeviceGetAttribute(&cus, hipDeviceAttributeMultiprocessorCount, dev) != hipSuccess) { grid = -1; return; }
        if (hipFuncSetAttribute((const void*)hybrid_fwd, hipFuncAttributeMaxDynamicSharedMemorySize, LDS_BYTES) != hipSuccess) { fprintf(stderr, "kernel_launch: hipFuncSetAttribute failed\n"); grid = -1; return; }
        if (hipOccupancyMaxActiveBlocksPerMultiprocessor(&per_cu, (const void*)hybrid_fwd, NWAVES * 64, LDS_BYTES) != hipSuccess || per_cu < 1) { fprintf(stderr, "kernel_launch: occupancy query says %d\n", per_cu); }
        (void)hipGetLastError();
        grid = cus;
    }
    if (grid < 0) return;
    if (hipMemsetAsync((char*)d_ws + WS_CTL, 0, CTL_ZERO_BYTES, stream) != hipSuccess) return;
    Args a{};
    for (int i = 0; i < 24; ++i) a.in[i] = (const float*)d_in[i];
    a.out = (unsigned char*)d_out; a.ws = (unsigned char*)d_ws;
    hipLaunchKernelGGL(hybrid_fwd, dim3(grid), dim3(NWAVES * 64), LDS_BYTES, stream, a);
}
```
